# Optimizing an MI355X kernel written in HIP

```python
import jax
import jax.numpy as jnp
from jax import lax
import numpy as np

D_MODEL = 1024
BATCH = 4
SEQ = 4096
DEPTH = 2
DEC_BATCH = 16
DEC_SEQ = 32
PAST_LEN = 1024

CHUNK = 64
N_GROUPS = 4
GROUP_WIDTH = D_MODEL // N_GROUPS
MIX_WIDTH = N_GROUPS * GROUP_WIDTH
CONV_WIDTH = 31
CONV_HIST = CONV_WIDTH - 1
RWKV_HEAD = 64
RWKV_HEADS = GROUP_WIDTH // RWKV_HEAD
DECAY_RANK = 32
AAA_RANK = 32
GATE_RANK = 64
POOL_WINDOWS = (2, 4, 8, 16)
POOL_GROUPS = len(POOL_WINDOWS)
POOL_CH = GROUP_WIDTH // POOL_GROUPS
POOL_HIST = max(POOL_WINDOWS) - 1
HEAD_DIM = 64
N_Q_HEADS = GROUP_WIDTH // HEAD_DIM
N_KV_HEADS = 2
GQA_GROUP = N_Q_HEADS // N_KV_HEADS
WINDOW = 128
WIN_CHUNKS = WINDOW // CHUNK
D_FF = -(-(8 * D_MODEL) // (3 * 256)) * 256

A_COLS = 2 * GROUP_WIDTH
B_COLS = 3 * GROUP_WIDTH + DECAY_RANK + AAA_RANK + GATE_RANK
C_COLS = GROUP_WIDTH
D_COLS = (N_Q_HEADS + 2 * N_KV_HEADS) * HEAD_DIM
IN_COLS = A_COLS + B_COLS + C_COLS + D_COLS
IN_SPLITS = (A_COLS, A_COLS + B_COLS, A_COLS + B_COLS + C_COLS)
B_SPLITS = (GROUP_WIDTH, 2 * GROUP_WIDTH, 3 * GROUP_WIDTH,
            3 * GROUP_WIDTH + DECAY_RANK, 3 * GROUP_WIDTH + DECAY_RANK + AAA_RANK)
D_SPLITS = (N_Q_HEADS * HEAD_DIM, (N_Q_HEADS + N_KV_HEADS) * HEAD_DIM)
RMS_EPS = 1e-6
LN_EPS = 1e-5
GN_EPS = 64e-5
ATTN_SCALE = HEAD_DIM ** -0.5
NEG_INF = -1e30

kernel_name = 'hybrid_streaming_encoder_step'


def rms_norm(x, g):
    x32 = x.astype(jnp.float32)
    y = x32 * lax.rsqrt(jnp.mean(x32 * x32, axis=-1, keepdims=True) + RMS_EPS)
    return (y * g.astype(jnp.float32)).astype(x.dtype)


def layer_norm(x, g, b):
    x32 = x.astype(jnp.float32)
    mu = jnp.mean(x32, axis=-1, keepdims=True)
    var = jnp.mean(jnp.square(x32 - mu), axis=-1, keepdims=True)
    y = (x32 - mu) * lax.rsqrt(var + LN_EPS) * g.astype(jnp.float32) + b.astype(jnp.float32)
    return y.astype(x.dtype)


def conv_module(u, hist, conv_w, conv_b, ln_g, ln_b):
    val, gate = jnp.split(u, 2, axis=-1)
    glu = val * jax.nn.sigmoid(gate)
    ext = jnp.concatenate([hist.astype(glu.dtype), glu], axis=1)
    y = lax.conv_general_dilated(
        ext, conv_w[:, None, :].astype(ext.dtype), window_strides=(1,), padding='VALID',
        dimension_numbers=('NWC', 'WIO', 'NWC'), feature_group_count=GROUP_WIDTH)
    y = jax.nn.silu(layer_norm(y + conv_b, ln_g, ln_b))
    return y, ext[:, -CONV_HIST:]


def wkv7_step(S, inp):
    r_t, w_t, k_t, v_t, a_t, b_t = inp
    sa = jnp.einsum('bhvk,bhk->bhv', S, a_t)
    S = S * w_t[:, :, None, :] + sa[..., None] * b_t[:, :, None, :] + v_t[..., None] * k_t[:, :, None, :]
    return S, jnp.einsum('bhvk,bhk->bhv', S, r_t)


def rwkv7_mixer(u, shift_prev, wkv_state, mu, w0, w2, a0, a2, g2, k_k, k_a, r_k, gn_g, gn_b):
    bsz, seq_len, _ = u.shape
    f32 = jnp.float32
    prev = jnp.concatenate([shift_prev[:, None, :].astype(u.dtype), u[:, :-1]], axis=1)
    xs = u + mu * (prev - u)
    r, k, v, lat_w, lat_a, lat_g = jnp.split(xs, B_SPLITS, axis=-1)
    w_log = -jax.nn.softplus(-(w0 + jnp.tanh(lat_w) @ w2).astype(f32)) - 0.5
    decay = jnp.exp(-jnp.exp(w_log))
    a_rate = jax.nn.sigmoid((a0 + lat_a @ a2).astype(f32))
    gate = jax.nn.sigmoid(lat_g) @ g2

    def heads(t):
        return t.astype(f32).reshape(bsz, seq_len, RWKV_HEADS, RWKV_HEAD)

    kk = heads(k * k_k)
    kk = kk / jnp.maximum(jnp.sqrt(jnp.sum(kk * kk, axis=-1, keepdims=True)), 1e-12)
    k_mod = heads(k.astype(f32) * (1.0 + (a_rate - 1.0) * k_a.astype(f32)))
    rh, vh, ah, wh = heads(r), heads(v), heads(a_rate), heads(decay)
    scan_in = tuple(jnp.moveaxis(t, 1, 0) for t in (rh, wh, k_mod, vh, -kk, kk * ah))
    s_final, y = lax.scan(wkv7_step, wkv_state.astype(f32), scan_in)
    y = jnp.moveaxis(y, 0, 1)
    m = jnp.mean(y, axis=-1, keepdims=True)
    var = jnp.mean(jnp.square(y - m), axis=-1, keepdims=True)
    y = ((y - m) * lax.rsqrt(var + GN_EPS)).reshape(bsz, seq_len, GROUP_WIDTH)
    y = y * gn_g.astype(f32) + gn_b.astype(f32)
    bonus = jnp.sum(rh * k_mod * r_k.astype(f32), axis=-1, keepdims=True) * vh
    y = (y + bonus.reshape(bsz, seq_len, GROUP_WIDTH)) * gate.astype(f32)
    return y.astype(u.dtype), s_final.astype(u.dtype), u[:, -1]


def pool_mixer(u, hist, pos0, pool_w, pool_scale):
    bsz, seq_len, _ = u.shape
    ext = jnp.concatenate([hist.astype(u.dtype), u], axis=1)
    cs = jnp.pad(jnp.cumsum(ext.astype(jnp.float32), axis=1), ((0, 0), (1, 0), (0, 0)))
    pos = pos0 + jnp.arange(seq_len)
    means = []
    for gi, w in enumerate(POOL_WINDOWS):
        sl = slice(gi * POOL_CH, (gi + 1) * POOL_CH)
        end = cs[:, POOL_HIST + 1:POOL_HIST + 1 + seq_len, sl]
        start = cs[:, POOL_HIST + 1 - w:POOL_HIST + 1 - w + seq_len, sl]
        cnt = jnp.minimum(w, pos + 1).astype(jnp.float32)[None, :, None]
        means.append((end - start) / cnt)
    d = (jnp.concatenate(means, axis=-1) - u.astype(jnp.float32)).reshape(bsz, seq_len, POOL_GROUPS, POOL_CH)
    y = jnp.einsum('blgc,gcd->blgd', d, pool_w.astype(jnp.float32)).reshape(bsz, seq_len, GROUP_WIDTH)
    return (y * pool_scale.astype(jnp.float32)).astype(u.dtype), ext[:, -POOL_HIST:]


def sink_softmax(s, sinks):
    sk = sinks.astype(jnp.float32).reshape(N_KV_HEADS, GQA_GROUP)[:, :, None, None]
    m = jnp.maximum(jnp.max(s, axis=-1, keepdims=True), sk)
    p = jnp.exp(s - m)
    return p / (jnp.sum(p, axis=-1, keepdims=True) + jnp.exp(sk - m))


def attention_qkv(u, q_norm_g, k_norm_g):
    bsz, seq_len, _ = u.shape
    q, k, v = jnp.split(u, D_SPLITS, axis=-1)
    q = rms_norm(q.reshape(bsz, seq_len, N_Q_HEADS, HEAD_DIM), q_norm_g)
    k = rms_norm(k.reshape(bsz, seq_len, N_KV_HEADS, HEAD_DIM), k_norm_g)
    v = v.reshape(bsz, seq_len, N_KV_HEADS, HEAD_DIM)
    return q, k, v


def window_attention_prompt(q, k, v, sinks):
    bsz, seq_len = q.shape[0], q.shape[1]
    n_chunks = seq_len // CHUNK
    qc = q.reshape(bsz, n_chunks, CHUNK, N_KV_HEADS, GQA_GROUP, HEAD_DIM)

    def band(t):
        tc = t.reshape(bsz, n_chunks, CHUNK, N_KV_HEADS, HEAD_DIM)
        tp = jnp.pad(tc, ((0, 0), (WIN_CHUNKS, 0), (0, 0), (0, 0), (0, 0)))
        return jnp.concatenate([tp[:, j:j + n_chunks] for j in range(WIN_CHUNKS + 1)], axis=2)

    kb, vb = band(k), band(v)
    key_chunk = jnp.arange(n_chunks)[:, None] + jnp.arange(WIN_CHUNKS + 1)[None, :] - WIN_CHUNKS
    valid = jnp.repeat(key_chunk >= 0, CHUNK, axis=1)
    s = jnp.einsum('bnqhgd,bnkhd->bnhgqk', qc, kb).astype(jnp.float32) * ATTN_SCALE
    s = jnp.where(valid[None, :, None, None, None, :], s, NEG_INF)
    p = sink_softmax(s, sinks).astype(v.dtype)
    o = jnp.einsum('bnhgqk,bnkhd->bnqhgd', p, vb)
    return o.reshape(bsz, seq_len, N_Q_HEADS * HEAD_DIM)


def window_attention_sample(q, k, v, k_cache, v_cache, sinks):
    bsz, t = q.shape[0], q.shape[1]
    kf = jnp.concatenate([k_cache.astype(k.dtype), k], axis=1)
    vf = jnp.concatenate([v_cache.astype(v.dtype), v], axis=1)
    qg = q.reshape(bsz, t, N_KV_HEADS, GQA_GROUP, HEAD_DIM)
    s = jnp.einsum('bqhgd,bkhd->bhgqk', qg, kf).astype(jnp.float32) * ATTN_SCALE
    p = sink_softmax(s, sinks).astype(v.dtype)
    o = jnp.einsum('bhgqk,bkhd->bqhgd', p, vf).reshape(bsz, t, N_Q_HEADS * HEAD_DIM)
    return o, kf[:, -WINDOW:], vf[:, -WINDOW:]


def run_trunk(x, conv_hist, rwkv_state, shift_prev, pool_hist, k_cache, v_cache, pos0, w):
    bsz = x.shape[0]
    new_conv, new_rwkv, new_shift, new_pool, new_k, new_v = [], [], [], [], [], []
    for l in range(DEPTH):
        if conv_hist is None:
            ch = jnp.zeros((bsz, CONV_HIST, GROUP_WIDTH), x.dtype)
            rs = jnp.zeros((bsz, RWKV_HEADS, RWKV_HEAD, RWKV_HEAD), x.dtype)
            sp = jnp.zeros((bsz, B_COLS), x.dtype)
            ph = jnp.zeros((bsz, POOL_HIST, GROUP_WIDTH), x.dtype)
        else:
            ch, rs, sp, ph = conv_hist[l], rwkv_state[l], shift_prev[l], pool_hist[l]
        xn = rms_norm(x, w['norm_mix_g'][l])
        proj = xn @ w['w_in'][l]
        u_a, u_b, u_c, u_d = jnp.split(proj, IN_SPLITS, axis=-1)
        y_a, ch_new = conv_module(u_a, ch, w['conv_w'][l], w['conv_b'][l], w['conv_ln_g'][l], w['conv_ln_b'][l])
        y_b, rs_new, sp_new = rwkv7_mixer(
            u_b, sp, rs, w['rwkv_mu'][l], w['rwkv_w0'][l], w['rwkv_w2'][l], w['rwkv_a0'][l], w['rwkv_a2'][l],
            w['rwkv_g2'][l], w['rwkv_k_k'][l], w['rwkv_k_a'][l], w['rwkv_r_k'][l], w['rwkv_gn_g'][l], w['rwkv_gn_b'][l])
        y_c, ph_new = pool_mixer(u_c, ph, pos0, w['pool_w'][l], w['pool_scale'][l])
        q, k, v = attention_qkv(u_d, w['attn_q_norm'][l], w['attn_k_norm'][l])
        if k_cache is None:
            y_d = window_attention_prompt(q, k, v, w['attn_sinks'][l])
            k_new, v_new = k[:, -WINDOW:], v[:, -WINDOW:]
        else:
            y_d, k_new, v_new = window_attention_sample(q, k, v, k_cache[l], v_cache[l], w['attn_sinks'][l])
        x = x + jnp.concatenate([y_a, y_b, y_c, y_d], axis=-1) @ w['w_out'][l]
        hn = rms_norm(x, w['norm_ffn_g'][l])
        x = x + (jax.nn.silu(hn @ w['ffn_w_gate'][l]) * (hn @ w['ffn_w_up'][l])) @ w['ffn_w_down'][l]
        new_conv.append(ch_new)
        new_rwkv.append(rs_new)
        new_shift.append(sp_new)
        new_pool.append(ph_new)
        new_k.append(k_new)
        new_v.append(v_new)
    return x, (jnp.stack(new_conv), jnp.stack(new_rwkv), jnp.stack(new_shift),
               jnp.stack(new_pool), jnp.stack(new_k), jnp.stack(new_v))


def setup_inputs(seed: int = 0) -> dict:
    key = jax.random.key(seed)
    ks = jax.random.split(key, 40)
    f32 = jnp.float32

    def nrm(i, shape, scale=1.0, shift=0.0):
        return shift + scale * jax.random.normal(ks[i], shape, f32)

    return {
        'x_prompt': nrm(0, (BATCH, SEQ, D_MODEL)),
        'x_sample': nrm(1, (DEC_BATCH, DEC_SEQ, D_MODEL)),
        'cache_conv': nrm(2, (DEPTH, DEC_BATCH, CONV_HIST, GROUP_WIDTH), 0.5),
        'state_rwkv': nrm(3, (DEPTH, DEC_BATCH, RWKV_HEADS, RWKV_HEAD, RWKV_HEAD), 0.5),
        'state_rwkv_shift': nrm(4, (DEPTH, DEC_BATCH, B_COLS)),
        'cache_pool': nrm(5, (DEPTH, DEC_BATCH, POOL_HIST, GROUP_WIDTH)),
        'cache_k': nrm(6, (DEPTH, DEC_BATCH, WINDOW, N_KV_HEADS, HEAD_DIM)),
        'cache_v': nrm(7, (DEPTH, DEC_BATCH, WINDOW, N_KV_HEADS, HEAD_DIM)),
        'norm_mix_g': nrm(8, (DEPTH, D_MODEL), 0.1, 1.0),
        'w_in': nrm(9, (DEPTH, D_MODEL, IN_COLS), D_MODEL ** -0.5),
        'conv_w': nrm(10, (DEPTH, CONV_WIDTH, GROUP_WIDTH), CONV_WIDTH ** -0.5),
        'conv_b': nrm(11, (DEPTH, GROUP_WIDTH), 0.02),
        'conv_ln_g': nrm(12, (DEPTH, GROUP_WIDTH), 0.1, 1.0),
        'conv_ln_b': nrm(13, (DEPTH, GROUP_WIDTH), 0.02),
        'rwkv_mu': jax.random.uniform(ks[14], (DEPTH, B_COLS), f32),
        'rwkv_w0': nrm(15, (DEPTH, GROUP_WIDTH), 0.5, -1.0),
        'rwkv_w2': nrm(16, (DEPTH, DECAY_RANK, GROUP_WIDTH), 0.5 * DECAY_RANK ** -0.5),
        'rwkv_a0': nrm(17, (DEPTH, GROUP_WIDTH), 0.5),
        'rwkv_a2': nrm(18, (DEPTH, AAA_RANK, GROUP_WIDTH), 0.5 * AAA_RANK ** -0.5),
        'rwkv_g2': nrm(19, (DEPTH, GATE_RANK, GROUP_WIDTH), GATE_RANK ** -0.5),
        'rwkv_k_k': nrm(20, (DEPTH, GROUP_WIDTH), 0.1, 1.0),
        'rwkv_k_a': nrm(21, (DEPTH, GROUP_WIDTH), 0.1, 1.0),
        'rwkv_r_k': nrm(22, (DEPTH, RWKV_HEADS, RWKV_HEAD), 0.1),
        'rwkv_gn_g': nrm(23, (DEPTH, GROUP_WIDTH), 0.1, 1.0),
        'rwkv_gn_b': nrm(24, (DEPTH, GROUP_WIDTH), 0.02),
        'pool_w': nrm(25, (DEPTH, POOL_GROUPS, POOL_CH, POOL_CH), POOL_CH ** -0.5),
        'pool_scale': nrm(26, (DEPTH, GROUP_WIDTH), 0.1, 1.0),
        'attn_q_norm': nrm(27, (DEPTH, HEAD_DIM), 0.1, 1.0),
        'attn_k_norm': nrm(28, (DEPTH, HEAD_DIM), 0.1, 1.0),
        'attn_sinks': nrm(29, (DEPTH, N_Q_HEADS), 0.5),
        'w_out': nrm(30, (DEPTH, MIX_WIDTH, D_MODEL), MIX_WIDTH ** -0.5),
        'norm_ffn_g': nrm(31, (DEPTH, D_MODEL), 0.1, 1.0),
        'ffn_w_gate': nrm(32, (DEPTH, D_MODEL, D_FF), D_MODEL ** -0.5),
        'ffn_w_up': nrm(33, (DEPTH, D_MODEL, D_FF), D_MODEL ** -0.5),
        'ffn_w_down': nrm(34, (DEPTH, D_FF, D_MODEL), D_FF ** -0.5),
    }


def reference(x_prompt, x_sample, cache_conv, state_rwkv, state_rwkv_shift, cache_pool, cache_k, cache_v,
              norm_mix_g, w_in, conv_w, conv_b, conv_ln_g, conv_ln_b, rwkv_mu, rwkv_w0, rwkv_w2, rwkv_a0,
              rwkv_a2, rwkv_g2, rwkv_k_k, rwkv_k_a, rwkv_r_k, rwkv_gn_g, rwkv_gn_b, pool_w, pool_scale,
              attn_q_norm, attn_k_norm, attn_sinks, w_out, norm_ffn_g, ffn_w_gate, ffn_w_up, ffn_w_down):
    w = {
        'norm_mix_g': norm_mix_g, 'w_in': w_in, 'conv_w': conv_w, 'conv_b': conv_b,
        'conv_ln_g': conv_ln_g, 'conv_ln_b': conv_ln_b, 'rwkv_mu': rwkv_mu, 'rwkv_w0': rwkv_w0,
        'rwkv_w2': rwkv_w2, 'rwkv_a0': rwkv_a0, 'rwkv_a2': rwkv_a2, 'rwkv_g2': rwkv_g2,
        'rwkv_k_k': rwkv_k_k, 'rwkv_k_a': rwkv_k_a, 'rwkv_r_k': rwkv_r_k, 'rwkv_gn_g': rwkv_gn_g,
        'rwkv_gn_b': rwkv_gn_b, 'pool_w': pool_w, 'pool_scale': pool_scale, 'attn_q_norm': attn_q_norm,
        'attn_k_norm': attn_k_norm, 'attn_sinks': attn_sinks, 'w_out': w_out, 'norm_ffn_g': norm_ffn_g,
        'ffn_w_gate': ffn_w_gate, 'ffn_w_up': ffn_w_up, 'ffn_w_down': ffn_w_down,
    }
    y_prompt, (conv_p, rwkv_p, shift_p, pool_p, k_p, v_p) = run_trunk(
        x_prompt, None, None, None, None, None, None, 0, w)
    y_sample, (conv_s, rwkv_s, shift_s, pool_s, k_s, v_s) = run_trunk(
        x_sample, cache_conv, state_rwkv, state_rwkv_shift, cache_pool, cache_k, cache_v, PAST_LEN, w)
    return (y_prompt, y_sample, conv_p, conv_s, rwkv_p, rwkv_s, shift_p, shift_s,
            pool_p, pool_s, k_p, k_s, v_p, v_s)
```

```cpp
#include <hip/hip_runtime.h>
#include <cstdint>
#include <cstdio>

typedef unsigned short bf16_t;
typedef short bf16x8 __attribute__((ext_vector_type(8)));
typedef float f32x4 __attribute__((ext_vector_type(4)));
typedef unsigned u32x4 __attribute__((ext_vector_type(4)));
typedef unsigned u32x2 __attribute__((ext_vector_type(2)));

#ifndef DBG_STOP
#define DBG_STOP 99
#endif
constexpr int T_P = 16384, T_S = 512, T = 16896, DM = 1024;
constexpr int NIN = 2176, NINP = 2304, DFF = 2816;
constexpr int C_A = 0, C_B = 512, C_C = 1408, C_Q = 1664, C_K = 1920, C_V = 2048;

constexpr size_t O_Y = 0, O_CONV_P = 17301504, O_CONV_S = 17362944, O_RWKV_P = 17608704, O_RWKV_S = 17739776,
                 O_SHIFT_P = 18264064, O_SHIFT_S = 18271232, O_POOL_P = 18299904, O_POOL_S = 18330624,
                 O_K_P = 18453504, O_K_S = 18584576, O_V_P = 19108864, O_V_S = 19239936, O_END = 19764224;

constexpr size_t WS_CTL = 0;
constexpr size_t WS_WIN = 4096;
constexpr size_t WS_WOUT = WS_WIN + 2ull * NINP * DM * 2;
constexpr size_t WS_WGU = WS_WOUT + 2ull * DM * DM * 2;
constexpr size_t WS_WD = WS_WGU + 2ull * 2 * DFF * DM * 2;
constexpr size_t WS_XB = WS_WD + 2ull * DM * DFF * 2;
constexpr size_t WS_YMIX = WS_XB + (size_t)T * DM * 2;
constexpr size_t WS_RSS = WS_YMIX + (size_t)T * DM * 2;
constexpr size_t WS_R = WS_RSS + (size_t)T * 32 * 4;
constexpr size_t WS_PROJ = WS_R;
constexpr size_t WS_H = WS_R;
constexpr size_t WS_RW = WS_PROJ + (size_t)T * NINP * 2;
constexpr size_t RW_BF = (size_t)T * 256 * 2;
constexpr size_t WS_RW_R = WS_RW, WS_RW_K = WS_RW + RW_BF, WS_RW_V = WS_RW + 2 * RW_BF, WS_RW_A = WS_RW + 3 * RW_BF,
                 WS_RW_B = WS_RW + 4 * RW_BF, WS_RW_G = WS_RW + 5 * RW_BF, WS_RW_W = WS_RW + 6 * RW_BF;
constexpr size_t WS_END = WS_RW_W + (size_t)T * 256 * 4;

__device__ __forceinline__ float bf2f(bf16_t h) { return __uint_as_float((unsigned)h << 16); }
__device__ __forceinline__ unsigned pk2(float lo, float hi) { unsigned r; asm("v_cvt_pk_bf16_f32 %0, %1, %2" : "=v"(r) : "v"(lo), "v"(hi)); return r; }
__device__ __forceinline__ bf16_t f2bf(float f) { return (bf16_t)(pk2(f, 0.f) & 0xffffu); }
__device__ __forceinline__ float wave_sum(float v) {
#pragma unroll
    for (int o = 1; o < 64; o <<= 1) v += __shfl_xor(v, o);
    return v;
}
__device__ __forceinline__ float sigmoidf_(float x) { return 1.f / (1.f + __expf(-x)); }

__global__ __launch_bounds__(256) void k_transpose(const float* __restrict__ W, int K, int N, bf16_t* __restrict__ WT, const float* __restrict__ g, int grp, int stride, int off) {
    __shared__ float t[32][33];
    const int k0 = blockIdx.y * 32, n0 = blockIdx.x * 32, tx = threadIdx.x & 31, ty = threadIdx.x >> 5;
    for (int i = ty; i < 32; i += 8) { float v = W[(size_t)(k0 + i) * N + n0 + tx]; if (g) v *= g[k0 + i]; t[i][tx] = v; }
    __syncthreads();
    for (int i = ty; i < 32; i += 8) { const int n = n0 + i; const int r = (n / grp) * stride + off + (n % grp); WT[(size_t)r * K + k0 + tx] = f2bf(t[tx][i]); }
}

__global__ __launch_bounds__(256) void k_xprep(const float* __restrict__ xp, const float* __restrict__ xs, bf16_t* __restrict__ XB, float* __restrict__ RSS) {
    const int row = blockIdx.x * 4 + (threadIdx.x >> 6), lane = threadIdx.x & 63;
    const float* x = row < T_P ? xp + (size_t)row * DM : xs + (size_t)(row - T_P) * DM;
    float ss = 0.f;
#pragma unroll
    for (int j = 0; j < 4; ++j) {
        const f32x4 v = ((const f32x4*)x)[lane + 64 * j];
        ss += v.x * v.x + v.y * v.y + v.z * v.z + v.w * v.w;
        u32x2 o; o.x = pk2(v.x, v.y); o.y = pk2(v.z, v.w);
        *(u32x2*)(XB + (size_t)row * DM + (lane + 64 * j) * 4) = o;
    }
    ss = wave_sum(ss);
    if (lane < 32) RSS[(size_t)row * 32 + lane] = lane == 0 ? ss : 0.f;
}

struct EpiProj {
    bf16_t* PROJ; const float* RSS;
    __device__ __forceinline__ float rowscale(int row) const {
        float s = 0.f;
#pragma unroll
        for (int j = 0; j < 8; ++j) { const f32x4 v = ((const f32x4*)(RSS + (size_t)row * 32))[j]; s += (v.x + v.y) + (v.z + v.w); }
        return rsqrtf(s * (1.f / DM) + 1e-6f);
    }
    __device__ __forceinline__ void operator()(int row, int col, f32x4 v0, f32x4 v1, float rs) const {
        u32x4 o; o.x = pk2(v0.x * rs, v0.y * rs); o.y = pk2(v0.z * rs, v0.w * rs); o.z = pk2(v1.x * rs, v1.y * rs); o.w = pk2(v1.z * rs, v1.w * rs);
        *(u32x4*)(PROJ + (size_t)row * NINP + col) = o;
    }
};
struct EpiRes {
    const float* xin_p; const float* xin_s; float* xout; bf16_t* XB; float* RSS;
    __device__ __forceinline__ float rowscale(int) const { return 1.f; }
    __device__ __forceinline__ void operator()(int row, int col, f32x4 v0, f32x4 v1, float) const {
        const float* xi = row < T_P ? xin_p + (size_t)row * DM : xin_s + (size_t)(row - T_P) * DM;
        f32x4 a = *(const f32x4*)(xi + col), b = *(const f32x4*)(xi + col + 4);
        a += v0; b += v1;
        *(f32x4*)(xout + (size_t)row * DM + col) = a; *(f32x4*)(xout + (size_t)row * DM + col + 4) = b;
        u32x4 o; o.x = pk2(a.x, a.y); o.y = pk2(a.z, a.w); o.z = pk2(b.x, b.y); o.w = pk2(b.z, b.w);
        *(u32x4*)(XB + (size_t)row * DM + col) = o;
        float ss = (a.x * a.x + a.y * a.y) + (a.z * a.z + a.w * a.w) + (b.x * b.x + b.y * b.y) + (b.z * b.z + b.w * b.w);
        ss += __shfl_xor(ss, 16); ss += __shfl_xor(ss, 32);
        if ((threadIdx.x & 63) < 16) RSS[(size_t)row * 32 + (col >> 5)] = ss;
    }
};
struct EpiGU {
    bf16_t* H; const float* RSS;
    __device__ __forceinline__ float rowscale(int row) const {
        float s = 0.f;
#pragma unroll
        for (int j = 0; j < 8; ++j) { const f32x4 v = ((const f32x4*)(RSS + (size_t)row * 32))[j]; s += (v.x + v.y) + (v.z + v.w); }
        return rsqrtf(s * (1.f / DM) + 1e-6f);
    }
    __device__ __forceinline__ void operator()(int row, int col, f32x4 g, f32x4 u, float rs) const {
        g *= rs; u *= rs;
        float h0 = g.x * sigmoidf_(g.x) * u.x, h1 = g.y * sigmoidf_(g.y) * u.y, h2 = g.z * sigmoidf_(g.z) * u.z, h3 = g.w * sigmoidf_(g.w) * u.w;
        u32x2 o; o.x = pk2(h0, h1); o.y = pk2(h2, h3);
        *(u32x2*)(H + (size_t)row * DFF + (col >> 1)) = o;
    }
};

template <class Epi>
__global__ __launch_bounds__(256) void k_gemm(const bf16_t* __restrict__ A, const bf16_t* __restrict__ Bt, int K, Epi E) {
    __shared__ __attribute__((aligned(16))) bf16_t sA[128][40];
    __shared__ __attribute__((aligned(16))) bf16_t sB[128][40];
    const int tid = threadIdx.x, wid = tid >> 6, lane = tid & 63, wr = wid >> 1, wc = wid & 1, fr = lane & 15, fq = lane >> 4;
    const int m0 = blockIdx.y * 128, n0 = blockIdx.x * 128;
    f32x4 acc[4][2][2];
#pragma unroll
    for (int m = 0; m < 4; ++m)
#pragma unroll
        for (int p = 0; p < 2; ++p)
#pragma unroll
            for (int t = 0; t < 2; ++t) acc[m][p][t] = (f32x4){0.f, 0.f, 0.f, 0.f};
    const int lr0 = tid >> 2, lc = (tid & 3) * 8;
    for (int k0 = 0; k0 < K; k0 += 32) {
        u32x4 va0 = *(const u32x4*)(A + (size_t)(m0 + lr0) * K + k0 + lc), va1 = *(const u32x4*)(A + (size_t)(m0 + lr0 + 64) * K + k0 + lc);
        u32x4 vb0 = *(const u32x4*)(Bt + (size_t)(n0 + lr0) * K + k0 + lc), vb1 = *(const u32x4*)(Bt + (size_t)(n0 + lr0 + 64) * K + k0 + lc);
        __syncthreads();
        *(u32x4*)&sA[lr0][lc] = va0; *(u32x4*)&sA[lr0 + 64][lc] = va1; *(u32x4*)&sB[lr0][lc] = vb0; *(u32x4*)&sB[lr0 + 64][lc] = vb1;
        __syncthreads();
        bf16x8 a[4], b[2][2];
#pragma unroll
        for (int m = 0; m < 4; ++m) a[m] = *(const bf16x8*)&sA[wr * 64 + m * 16 + fr][fq * 8];
#pragma unroll
        for (int p = 0; p < 2; ++p)
#pragma unroll
            for (int t = 0; t < 2; ++t) b[p][t] = *(const bf16x8*)&sB[wc * 64 + p * 32 + 8 * (fr >> 2) + 4 * t + (fr & 3)][fq * 8];
#pragma unroll
        for (int m = 0; m < 4; ++m)
#pragma unroll
            for (int p = 0; p < 2; ++p)
#pragma unroll
                for (int t = 0; t < 2; ++t) acc[m][p][t] = __builtin_amdgcn_mfma_f32_16x16x32_bf16(b[p][t], a[m], acc[m][p][t], 0, 0, 0);
    }
#pragma unroll
    for (int m = 0; m < 4; ++m) {
        const int row = m0 + wr * 64 + m * 16 + fr;
        const float rs = E.rowscale(row);
#pragma unroll
        for (int p = 0; p < 2; ++p) E(row, n0 + wc * 64 + p * 32 + 8 * fq, acc[m][p][0], acc[m][p][1], rs);
    }
}

struct Seq { int base, L, b, sample, pos0; };
__device__ __forceinline__ Seq seq_of(int sq) { Seq s; if (sq < 4) { s.base = sq * 4096; s.L = 4096; s.b = sq; s.sample = 0; s.pos0 = 0; } else { s.b = sq - 4; s.base = T_P + s.b * 32; s.L = 32; s.sample = 1; s.pos0 = 1024; } return s; }

__global__ __launch_bounds__(256) void k_conv(const bf16_t* __restrict__ PROJ, const float* __restrict__ cache_conv  , const float* __restrict__ cw, const float* __restrict__ cb,
                                              const float* __restrict__ lg, const float* __restrict__ lb, bf16_t* __restrict__ YMIX, float* __restrict__ out_p  , float* __restrict__ out_s  ) {
    extern __shared__ __attribute__((aligned(16))) float sm[];
    float* ext = sm;
    float* yb = sm + 62 * 256;
    const int bid = blockIdx.x, tid = threadIdx.x;
    int sq, t0; if (bid < 512) { sq = bid >> 7; t0 = (bid & 127) * 32; } else { sq = 4 + (bid - 512); t0 = 0; }
    const Seq s = seq_of(sq);
    const int c = tid;
    for (int i = 0; i < 62; ++i) {
        const int t = t0 - 30 + i; float e = 0.f;
        if (t >= 0) { const size_t o = (size_t)(s.base + t) * NINP + C_A + c; const float val = bf2f(PROJ[o]), gate = bf2f(PROJ[o + 256]); e = val * sigmoidf_(gate); }
        else if (s.sample) e = cache_conv[((size_t)s.b * 30 + 30 + t) * 256 + c];
        ext[i * 256 + c] = e;
    }
    __syncthreads();
    {
        float w[31];
#pragma unroll
        for (int j = 0; j < 31; ++j) w[j] = cw[j * 256 + c];
        const float bias = cb[c];
        for (int i = 0; i < 32; ++i) {
            float y = bias;
#pragma unroll
            for (int j = 0; j < 31; ++j) y += w[j] * ext[(i + j) * 256 + c];
            yb[i * 256 + c] = y;
        }
    }
    __syncthreads();
    {
        const int w = tid >> 6, lane = tid & 63;
        const f32x4 g4 = ((const f32x4*)lg)[lane], b4 = ((const f32x4*)lb)[lane];
        for (int i = w; i < 32; i += 4) {
            const f32x4 v = ((const f32x4*)(yb + i * 256))[lane];
            const float mean = wave_sum((v.x + v.y) + (v.z + v.w)) * (1.f / 256.f);
            const f32x4 d = v - mean;
            const float var = wave_sum((d.x * d.x + d.y * d.y) + (d.z * d.z + d.w * d.w)) * (1.f / 256.f);
            const float rstd = rsqrtf(var + 1e-5f);
            f32x4 o = d * rstd * g4 + b4;
            o.x *= sigmoidf_(o.x); o.y *= sigmoidf_(o.y); o.z *= sigmoidf_(o.z); o.w *= sigmoidf_(o.w);
            u32x2 pk; pk.x = pk2(o.x, o.y); pk.y = pk2(o.z, o.w);
            *(u32x2*)(YMIX + (size_t)(s.base + t0 + i) * DM + 0 + lane * 4) = pk;
        }
    }
    if (t0 + 32 == s.L) {
        float* o = s.sample ? out_s + (size_t)s.b * 30 * 256 : out_p + (size_t)s.b * 30 * 256;
        for (int i = 0; i < 30; ++i) o[i * 256 + c] = ext[(32 + i) * 256 + c];
    }
}

__global__ __launch_bounds__(256) void k_pool(const bf16_t* __restrict__ PROJ, const float* __restrict__ cache_pool  , const float* __restrict__ pw  , const float* __restrict__ psc,
                                              bf16_t* __restrict__ YMIX, float* __restrict__ out_p  , float* __restrict__ out_s  ) {
    extern __shared__ __attribute__((aligned(16))) float sm[];
    float* ext = sm;
    float* dd = sm + 47 * 256;
    const int bid = blockIdx.x, tid = threadIdx.x;
    int sq, t0; if (bid < 512) { sq = bid >> 7; t0 = (bid & 127) * 32; } else { sq = 4 + (bid - 512); t0 = 0; }
    const Seq s = seq_of(sq);
    const int c = tid;
    for (int i = 0; i < 47; ++i) {
        const int t = t0 - 15 + i; float e = 0.f;
        if (t >= 0) e = bf2f(PROJ[(size_t)(s.base + t) * NINP + C_C + c]);
        else if (s.sample) e = cache_pool[((size_t)s.b * 15 + 15 + t) * 256 + c];
        ext[i * 256 + c] = e;
    }
    __syncthreads();
    {
        const int g = c >> 6, w = 2 << g;
        for (int i = 0; i < 32; ++i) {
            float sum = 0.f;
            for (int j = 0; j < w; ++j) sum += ext[(15 + i - j) * 256 + c];
            const int pos = s.pos0 + t0 + i; const int cnt = (pos + 1) < w ? (pos + 1) : w;
            dd[i * 256 + c] = sum / (float)cnt - ext[(15 + i) * 256 + c];
        }
    }
    __syncthreads();
    {
        const int g = tid >> 6, dch = tid & 63;
        float wv[64];
#pragma unroll
        for (int cc = 0; cc < 64; ++cc) wv[cc] = pw[((size_t)g * 64 + cc) * 64 + dch];
        const float sc = psc[tid];
        for (int i = 0; i < 32; ++i) {
            float a = 0.f;
#pragma unroll
            for (int cc = 0; cc < 64; ++cc) a += dd[i * 256 + g * 64 + cc] * wv[cc];
            YMIX[(size_t)(s.base + t0 + i) * DM + 512 + tid] = f2bf(a * sc);
        }
    }
    if (t0 + 32 == s.L) {
        float* o = s.sample ? out_s + (size_t)s.b * 15 * 256 : out_p + (size_t)s.b * 15 * 256;
        for (int i = 0; i < 15; ++i) o[i * 256 + c] = ext[(32 + i) * 256 + c];
    }
}

__global__ __launch_bounds__(128) void k_attn(const bf16_t* __restrict__ PROJ, const float* __restrict__ cache_k  , const float* __restrict__ cache_v, const float* __restrict__ qn, const float* __restrict__ kn,
                                              const float* __restrict__ sinks, bf16_t* __restrict__ YMIX, float* __restrict__ ko_p  , float* __restrict__ ko_s  , float* __restrict__ vo_p, float* __restrict__ vo_s) {
    extern __shared__ __attribute__((aligned(16))) float sm[];
    float* Ks = sm;
    float* Vs = sm + 192 * 64;
    const int bid = blockIdx.x, tid = threadIdx.x;
    int sq, chunk, hkv; if (bid < 512) { sq = bid >> 7; chunk = (bid & 127) >> 1; hkv = bid & 1; } else { sq = 4 + ((bid - 512) >> 1); chunk = 0; hkv = bid & 1; }
    const Seq s = seq_of(sq);
    int nk, nq, ncache, ktok0;
    if (s.sample) { nk = 160; nq = 32; ncache = 128; ktok0 = s.base; }
    else { const int back = chunk < 2 ? chunk : 2; nk = 64 * (back + 1); nq = 64; ncache = 0; ktok0 = s.base + (chunk - back) * 64; }
    for (int j = tid; j < nk; j += 128) {
        float kr[64], vr[64];
        if (j < ncache) {
            const float* kp = cache_k + (((size_t)s.b * 128 + j) * 2 + hkv) * 64; const float* vp = cache_v + (((size_t)s.b * 128 + j) * 2 + hkv) * 64;
#pragma unroll
            for (int d = 0; d < 64; ++d) { kr[d] = kp[d]; vr[d] = vp[d]; }
        } else {
            const size_t o = (size_t)(ktok0 + j - ncache) * NINP;
            float ss = 0.f;
#pragma unroll
            for (int d = 0; d < 64; ++d) { kr[d] = bf2f(PROJ[o + C_K + hkv * 64 + d]); vr[d] = bf2f(PROJ[o + C_V + hkv * 64 + d]); ss += kr[d] * kr[d]; }
            const float rs = rsqrtf(ss * (1.f / 64.f) + 1e-6f);
#pragma unroll
            for (int d = 0; d < 64; ++d) kr[d] = kr[d] * rs * kn[d];
        }
#pragma unroll
        for (int d = 0; d < 64; ++d) { Ks[j * 64 + d] = kr[d]; Vs[j * 64 + d] = vr[d]; }
        if (s.sample) {
            if (j >= 32) { float* ko = ko_s + ((size_t)s.b * 128 + (j - 32)) * 128 + hkv * 64; float* vo = vo_s + ((size_t)s.b * 128 + (j - 32)) * 128 + hkv * 64;
#pragma unroll
                for (int d = 0; d < 64; ++d) { ko[d] = kr[d]; vo[d] = vr[d]; } }
        } else if (chunk >= 62 && j >= nk - 64) {
            const int jj = (chunk - 62) * 64 + (j - (nk - 64));
            float* ko = ko_p + ((size_t)s.b * 128 + jj) * 128 + hkv * 64; float* vo = vo_p + ((size_t)s.b * 128 + jj) * 128 + hkv * 64;
#pragma unroll
            for (int d = 0; d < 64; ++d) { ko[d] = kr[d]; vo[d] = vr[d]; }
        }
    }
    __syncthreads();
    const int g = tid >> 6, i = tid & 63;
    if (i < nq) {
        const int tok = s.base + chunk * 64 + i, qh = hkv * 2 + g;
        float q[64], o[64]; float ss = 0.f;
#pragma unroll
        for (int d = 0; d < 64; ++d) { q[d] = bf2f(PROJ[(size_t)tok * NINP + C_Q + qh * 64 + d]); ss += q[d] * q[d]; o[d] = 0.f; }
        const float rs = rsqrtf(ss * (1.f / 64.f) + 1e-6f) * 0.125f;
#pragma unroll
        for (int d = 0; d < 64; ++d) q[d] = q[d] * rs * qn[d];
        float m = sinks[qh], l = 1.f;
        for (int j = 0; j < nk; ++j) {
            float sc = 0.f;
#pragma unroll
            for (int d = 0; d < 64; ++d) sc += q[d] * Ks[j * 64 + d];
            const float mn = fmaxf(m, sc), f = __expf(m - mn), p = __expf(sc - mn);
            l = l * f + p;
#pragma unroll
            for (int d = 0; d < 64; ++d) o[d] = o[d] * f + p * Vs[j * 64 + d];
            m = mn;
        }
        const float inv = 1.f / l;
#pragma unroll
        for (int d = 0; d < 64; d += 2) *(unsigned*)(YMIX + (size_t)tok * DM + 768 + qh * 64 + d) = pk2(o[d] * inv, o[d + 1] * inv);
    }
}

struct RwkvW { const float *mu, *w0, *w2, *a0, *a2, *g2, *k_k, *k_a, *r_k, *gn_g, *gn_b; };
__global__ __launch_bounds__(256) void k_rwkv_prep(const bf16_t* __restrict__ PROJ, const float* __restrict__ shift_in  , RwkvW w, bf16_t* __restrict__ Rr, bf16_t* __restrict__ Rk, bf16_t* __restrict__ Rv,
                                                   bf16_t* __restrict__ Ra, bf16_t* __restrict__ Rb, bf16_t* __restrict__ Rg, float* __restrict__ Rw, float* __restrict__ sh_p  , float* __restrict__ sh_s  ) {
    __shared__ float xs[896]; __shared__ float tw[32]; __shared__ float la[32]; __shared__ float sg[64];
    const int tid = threadIdx.x;
    for (int ii = 0; ii < 8; ++ii) {
        const int tok = blockIdx.x * 8 + ii;
        int t, L, b, sample; if (tok < T_P) { t = tok & 4095; L = 4096; b = tok >> 12; sample = 0; } else { t = (tok - T_P) & 31; L = 32; b = (tok - T_P) >> 5; sample = 1; }
        for (int c = tid; c < 896; c += 256) {
            const float u = bf2f(PROJ[(size_t)tok * NINP + C_B + c]);
            float prev = 0.f;
            if (t > 0) prev = bf2f(PROJ[(size_t)(tok - 1) * NINP + C_B + c]); else if (sample) prev = shift_in[(size_t)b * 896 + c];
            xs[c] = u + w.mu[c] * (prev - u);
            if (t == L - 1) { if (sample) sh_s[(size_t)b * 896 + c] = u; else sh_p[(size_t)b * 896 + c] = u; }
        }
        __syncthreads();
        if (tid < 32) tw[tid] = tanhf(xs[768 + tid]); else if (tid < 64) la[tid - 32] = xs[800 + tid - 32]; else if (tid < 128) sg[tid - 64] = sigmoidf_(xs[832 + tid - 64]);
        __syncthreads();
        {
            const int c = tid; const float r = xs[c], k = xs[256 + c], v = xs[512 + c];
            float wl = w.w0[c], al = w.a0[c], gt = 0.f;
#pragma unroll 8
            for (int j = 0; j < 32; ++j) { wl += tw[j] * w.w2[j * 256 + c]; al += la[j] * w.a2[j * 256 + c]; }
#pragma unroll 8
            for (int j = 0; j < 64; ++j) gt += sg[j] * w.g2[j * 256 + c];
            const float decay = __expf(-0.60653066f * sigmoidf_(wl));
            const float ar = sigmoidf_(al);
            const float kk = k * w.k_k[c]; const float ss = wave_sum(kk * kk);
            const float kkn = kk / fmaxf(sqrtf(ss), 1e-12f);
            const float kmod = k * (1.f + (ar - 1.f) * w.k_a[c]);
            const size_t o = (size_t)tok * 256 + c;
            Rr[o] = f2bf(r); Rk[o] = f2bf(kmod); Rv[o] = f2bf(v); Ra[o] = f2bf(-kkn); Rb[o] = f2bf(kkn * ar); Rg[o] = f2bf(gt); Rw[o] = decay;
        }
        __syncthreads();
    }
}

__device__ __forceinline__ float rl(float x, int k) { return __int_as_float(__builtin_amdgcn_readlane(__float_as_int(x), k)); }
__global__ __launch_bounds__(64) void k_rwkv_scan(const bf16_t* __restrict__ Rr, const bf16_t* __restrict__ Rk, const bf16_t* __restrict__ Rv, const bf16_t* __restrict__ Ra, const bf16_t* __restrict__ Rb, const bf16_t* __restrict__ Rg,
                                                  const float* __restrict__ Rw, const float* __restrict__ state_in  , RwkvW w, bf16_t* __restrict__ YMIX, float* __restrict__ st_p  , float* __restrict__ st_s) {
    const int sq = blockIdx.x >> 2, h = blockIdx.x & 3, lane = threadIdx.x;
    const Seq s = seq_of(sq);
    float S[64];
    if (s.sample) { const float* p = state_in + (((size_t)s.b * 4 + h) * 64 + lane) * 64;
#pragma unroll
        for (int k = 0; k < 64; ++k) S[k] = p[k]; }
    else {
#pragma unroll
        for (int k = 0; k < 64; ++k) S[k] = 0.f; }
    const int c = h * 64 + lane;
    const float gng = w.gn_g[c], gnb = w.gn_b[c], rk = w.r_k[c];
    size_t idx = (size_t)s.base * 256 + c;
    float nr = bf2f(Rr[idx]), nw = Rw[idx], nk = bf2f(Rk[idx]), nv = bf2f(Rv[idx]), na = bf2f(Ra[idx]), nb = bf2f(Rb[idx]), ng = bf2f(Rg[idx]);
    for (int t = 0; t < s.L; ++t) {
        const float rr = nr, ww = nw, kk = nk, vv = nv, aa = na, bb = nb, gg = ng;
        if (t + 1 < s.L) { const size_t i2 = idx + 256; nr = bf2f(Rr[i2]); nw = Rw[i2]; nk = bf2f(Rk[i2]); nv = bf2f(Rv[i2]); na = bf2f(Ra[i2]); nb = bf2f(Rb[i2]); ng = bf2f(Rg[i2]); }
        float sa = 0.f;
#pragma unroll
        for (int k = 0; k < 64; ++k) sa += S[k] * rl(aa, k);
        float y = 0.f;
#pragma unroll
        for (int k = 0; k < 64; ++k) { S[k] = S[k] * rl(ww, k) + sa * rl(bb, k) + vv * rl(kk, k); y += S[k] * rl(rr, k); }
        const float mean = wave_sum(y) * (1.f / 64.f); const float d = y - mean;
        const float var = wave_sum(d * d) * (1.f / 64.f);
        const float yn = d * rsqrtf(var + 64e-5f) * gng + gnb;
        const float bonus = wave_sum(rr * kk * rk) * vv;
        YMIX[(size_t)(s.base + t) * DM + 256 + c] = f2bf((yn + bonus) * gg);
        idx += 256;
    }
    float* o = (s.sample ? st_s : st_p) + (((size_t)s.b * 4 + h) * 64 + lane) * 64;
#pragma unroll
    for (int k = 0; k < 64; ++k) o[k] = S[k];
}

__global__ void k_fill0(float* p, int n) { int i = blockIdx.x * 256 + threadIdx.x; if (i < n) p[i] = 0.f; }
extern "C" void kernel_launch(void* const* d_in, const int* in_sizes, int n_in, void* d_out, int out_size, void* d_ws, size_t ws_size, hipStream_t stream) {
    static int ok = 0;
    if (ok == 0) {
        if (DBG_STOP > -2 && (n_in != 35 || (size_t)out_size != O_END || ws_size < WS_END)) { fprintf(stderr, "kernel_launch: unexpected sizes n_in %d out %d ws %zu (need %zu)\n", n_in, out_size, ws_size, (size_t)WS_END); ok = -1; return; }
        if (DBG_STOP > -2) hipFuncSetAttribute((const void*)k_conv, hipFuncAttributeMaxDynamicSharedMemorySize, 94 * 256 * 4);
        if (DBG_STOP > -2) hipFuncSetAttribute((const void*)k_pool, hipFuncAttributeMaxDynamicSharedMemorySize, 79 * 256 * 4);
        if (DBG_STOP > -2) hipFuncSetAttribute((const void*)k_attn, hipFuncAttributeMaxDynamicSharedMemorySize, 2 * 192 * 64 * 4);
        ok = 1;
    }
    if (ok < 0) return;
    const float* const* in = (const float* const*)d_in;
    float* out = (float*)d_out; unsigned char* ws = (unsigned char*)d_ws;
    bf16_t* WIN = (bf16_t*)(ws + WS_WIN); bf16_t* WOUT = (bf16_t*)(ws + WS_WOUT); bf16_t* WGU = (bf16_t*)(ws + WS_WGU); bf16_t* WD = (bf16_t*)(ws + WS_WD);
    bf16_t* XB = (bf16_t*)(ws + WS_XB); bf16_t* YMIX = (bf16_t*)(ws + WS_YMIX); float* RSS = (float*)(ws + WS_RSS);
    bf16_t* PROJ = (bf16_t*)(ws + WS_PROJ); bf16_t* H = (bf16_t*)(ws + WS_H);
    bf16_t *Rr = (bf16_t*)(ws + WS_RW_R), *Rk = (bf16_t*)(ws + WS_RW_K), *Rv = (bf16_t*)(ws + WS_RW_V), *Ra = (bf16_t*)(ws + WS_RW_A), *Rb = (bf16_t*)(ws + WS_RW_B), *Rg = (bf16_t*)(ws + WS_RW_G);
    float* Rw = (float*)(ws + WS_RW_W);
    if (DBG_STOP == -2) { k_fill0<<<240, 256, 0, stream>>>(out + O_CONV_P, (int)(ws_size >> 20)); k_fill0<<<28, 256, 0, stream>>>(out + O_SHIFT_P, n_in); k_fill0<<<120, 256, 0, stream>>>(out + O_POOL_P, out_size / 1000); return; }
    for (int l = 0; l < 2; ++l) {
        k_transpose<<<dim3(NIN / 32, DM / 32), 256, 0, stream>>>(in[9] + (size_t)l * DM * NIN, DM, NIN, WIN + (size_t)l * NINP * DM, in[8] + l * DM, NIN, 0, 0);
        k_transpose<<<dim3(DM / 32, DM / 32), 256, 0, stream>>>(in[30] + (size_t)l * DM * DM, DM, DM, WOUT + (size_t)l * DM * DM, nullptr, DM, 0, 0);
        k_transpose<<<dim3(DFF / 32, DM / 32), 256, 0, stream>>>(in[32] + (size_t)l * DM * DFF, DM, DFF, WGU + (size_t)l * 2 * DFF * DM, in[31] + l * DM, 4, 8, 0);
        k_transpose<<<dim3(DFF / 32, DM / 32), 256, 0, stream>>>(in[33] + (size_t)l * DM * DFF, DM, DFF, WGU + (size_t)l * 2 * DFF * DM, in[31] + l * DM, 4, 8, 4);
        k_transpose<<<dim3(DM / 32, DFF / 32), 256, 0, stream>>>(in[34] + (size_t)l * DFF * DM, DFF, DM, WD + (size_t)l * DM * DFF, nullptr, DM, 0, 0);
    }
    k_xprep<<<T / 4, 256, 0, stream>>>(in[0], in[1], XB, RSS);
    if (DBG_STOP == 0) return;
    for (int l = 0; l < 2; ++l) {
        k_gemm<EpiProj><<<dim3(NINP / 128, T / 128), 256, 0, stream>>>(XB, WIN + (size_t)l * NINP * DM, DM, EpiProj{PROJ, RSS});
        if (DBG_STOP == 1) return;
        k_conv<<<528, 256, 94 * 256 * 4, stream>>>(PROJ, in[2] + (size_t)l * 16 * 30 * 256, in[10] + l * 31 * 256, in[11] + l * 256, in[12] + l * 256, in[13] + l * 256, YMIX,
                                                   out + O_CONV_P + (size_t)l * 4 * 30 * 256, out + O_CONV_S + (size_t)l * 16 * 30 * 256);
        k_pool<<<528, 256, 79 * 256 * 4, stream>>>(PROJ, in[5] + (size_t)l * 16 * 15 * 256, in[25] + (size_t)l * 4 * 64 * 64, in[26] + l * 256, YMIX,
                                                   out + O_POOL_P + (size_t)l * 4 * 15 * 256, out + O_POOL_S + (size_t)l * 16 * 15 * 256);
        k_attn<<<544, 128, 2 * 192 * 64 * 4, stream>>>(PROJ, in[6] + (size_t)l * 16 * 128 * 128, in[7] + (size_t)l * 16 * 128 * 128, in[27] + l * 64, in[28] + l * 64, in[29] + l * 4, YMIX,
                                                       out + O_K_P + (size_t)l * 4 * 128 * 128, out + O_K_S + (size_t)l * 16 * 128 * 128, out + O_V_P + (size_t)l * 4 * 128 * 128, out + O_V_S + (size_t)l * 16 * 128 * 128);
        if (DBG_STOP == 2) return;
        RwkvW rw{in[14] + l * 896, in[15] + l * 256, in[16] + l * 32 * 256, in[17] + l * 256, in[18] + l * 32 * 256, in[19] + l * 64 * 256, in[20] + l * 256, in[21] + l * 256, in[22] + l * 256, in[23] + l * 256, in[24] + l * 256};
        k_rwkv_prep<<<T / 8, 256, 0, stream>>>(PROJ, in[4] + (size_t)l * 16 * 896, rw, Rr, Rk, Rv, Ra, Rb, Rg, Rw, out + O_SHIFT_P + (size_t)l * 4 * 896, out + O_SHIFT_S + (size_t)l * 16 * 896);
        k_rwkv_scan<<<80, 64, 0, stream>>>(Rr, Rk, Rv, Ra, Rb, Rg, Rw, in[3] + (size_t)l * 16 * 4 * 4096, rw, YMIX, out + O_RWKV_P + (size_t)l * 4 * 4 * 4096, out + O_RWKV_S + (size_t)l * 16 * 4 * 4096);
        if (DBG_STOP == 3) return;
        if (l == 0) k_gemm<EpiRes><<<dim3(DM / 128, T / 128), 256, 0, stream>>>(YMIX, WOUT + (size_t)l * DM * DM, DM, EpiRes{in[0], in[1], out, XB, RSS});
        else k_gemm<EpiRes><<<dim3(DM / 128, T / 128), 256, 0, stream>>>(YMIX, WOUT + (size_t)l * DM * DM, DM, EpiRes{out, out + (size_t)T_P * DM, out, XB, RSS});
        k_gemm<EpiGU><<<dim3(2 * DFF / 128, T / 128), 256, 0, stream>>>(XB, WGU + (size_t)l * 2 * DFF * DM, DM, EpiGU{H, RSS});
        k_gemm<EpiRes><<<dim3(DM / 128, T / 128), 256, 0, stream>>>(H, WD + (size_t)l * DM * DFF, DFF, EpiRes{out, out + (size_t)T_P * DM, out, XB, RSS});
    }
}
```

```cpp
#include <hip/hip_runtime.h>
#include <hip/hip_cooperative_groups.h>
namespace cg = cooperative_groups;
#include <cstdint>
#include <cstdio>

typedef unsigned short bf16_t;
typedef short bf16x8 __attribute__((ext_vector_type(8)));
typedef float f32x4 __attribute__((ext_vector_type(4)));
typedef unsigned u32x4 __attribute__((ext_vector_type(4)));
typedef unsigned u32x2 __attribute__((ext_vector_type(2)));

#ifndef DBG_STOP
#define DBG_STOP 99
#endif
constexpr int T_P = 16384, T_S = 512, T = 16896, DM = 1024;
constexpr int NIN = 2176, NINP = 2304, DFF = 2816;
constexpr int C_A = 0, C_B = 512, C_C = 1408, C_Q = 1664, C_K = 1920, C_V = 2048;

constexpr size_t O_Y = 0, O_CONV_P = 17301504, O_CONV_S = 17362944, O_RWKV_P = 17608704, O_RWKV_S = 17739776,
                 O_SHIFT_P = 18264064, O_SHIFT_S = 18271232, O_POOL_P = 18299904, O_POOL_S = 18330624,
                 O_K_P = 18453504, O_K_S = 18584576, O_V_P = 19108864, O_V_S = 19239936, O_END = 19764224;

constexpr size_t WS_CTL = 0;
constexpr size_t WS_WIN = 4096;
constexpr size_t WS_WOUT = WS_WIN + 2ull * NINP * DM * 2;
constexpr size_t WS_WGU = WS_WOUT + 2ull * DM * DM * 2;
constexpr size_t WS_WD = WS_WGU + 2ull * 2 * DFF * DM * 2;
constexpr size_t WS_XB = WS_WD + 2ull * DM * DFF * 2;
constexpr size_t WS_YMIX = WS_XB + (size_t)T * DM * 2;
constexpr size_t WS_RSS = WS_YMIX + (size_t)T * DM * 2;
constexpr size_t WS_R = WS_RSS + (size_t)T * 32 * 4;
constexpr size_t WS_PROJ = WS_R;
constexpr size_t WS_H = WS_R;
constexpr size_t WS_RW = WS_PROJ + (size_t)T * NINP * 2;
constexpr size_t RW_BF = (size_t)T * 256 * 2;
constexpr size_t WS_RW_R = WS_RW, WS_RW_K = WS_RW + RW_BF, WS_RW_V = WS_RW + 2 * RW_BF, WS_RW_A = WS_RW + 3 * RW_BF,
                 WS_RW_B = WS_RW + 4 * RW_BF, WS_RW_G = WS_RW + 5 * RW_BF, WS_RW_W = WS_RW + 6 * RW_BF;
constexpr size_t WS_END = WS_RW_W + (size_t)T * 256 * 4;

__device__ __forceinline__ float bf2f(bf16_t h) { return __uint_as_float((unsigned)h << 16); }
__device__ __forceinline__ unsigned pk2(float lo, float hi) { unsigned r; asm("v_cvt_pk_bf16_f32 %0, %1, %2" : "=v"(r) : "v"(lo), "v"(hi)); return r; }
__device__ __forceinline__ bf16_t f2bf(float f) { return (bf16_t)(pk2(f, 0.f) & 0xffffu); }
__device__ __forceinline__ float wave_sum(float v) {
#pragma unroll
    for (int o = 1; o < 64; o <<= 1) v += __shfl_xor(v, o);
    return v;
}
__device__ __forceinline__ float sigmoidf_(float x) { return 1.f / (1.f + __expf(-x)); }

__device__ __forceinline__ void d_transpose(int bx, int by, const float* __restrict__ W, int K, int N, bf16_t* __restrict__ WT, const float* __restrict__ g, int grp, int stride, int off) {
    extern __shared__ __attribute__((aligned(16))) float sm[];
    float (*t)[33] = (float(*)[33])sm;
    const int k0 = by * 32, n0 = bx * 32, tx = threadIdx.x & 31, ty = threadIdx.x >> 5;
    for (int i = ty; i < 32; i += 8) { float v = W[(size_t)(k0 + i) * N + n0 + tx]; if (g) v *= g[k0 + i]; t[i][tx] = v; }
    __syncthreads();
    for (int i = ty; i < 32; i += 8) { const int n = n0 + i; const int r = (n / grp) * stride + off + (n % grp); WT[(size_t)r * K + k0 + tx] = f2bf(t[tx][i]); }
}

__device__ __forceinline__ void d_xprep(int bx, const float* __restrict__ xp, const float* __restrict__ xs, bf16_t* __restrict__ XB, float* __restrict__ RSS) {
    const int row = bx * 4 + (threadIdx.x >> 6), lane = threadIdx.x & 63;
    const float* x = row < T_P ? xp + (size_t)row * DM : xs + (size_t)(row - T_P) * DM;
    float ss = 0.f;
#pragma unroll
    for (int j = 0; j < 4; ++j) {
        const f32x4 v = ((const f32x4*)x)[lane + 64 * j];
        ss += v.x * v.x + v.y * v.y + v.z * v.z + v.w * v.w;
        u32x2 o; o.x = pk2(v.x, v.y); o.y = pk2(v.z, v.w);
        *(u32x2*)(XB + (size_t)row * DM + (lane + 64 * j) * 4) = o;
    }
    ss = wave_sum(ss);
    if (lane < 32) RSS[(size_t)row * 32 + lane] = lane == 0 ? ss : 0.f;
}

struct EpiProj {
    bf16_t* PROJ; const float* RSS;
    __device__ __forceinline__ float rowscale(int row) const {
        float s = 0.f;
#pragma unroll
        for (int j = 0; j < 8; ++j) { const f32x4 v = ((const f32x4*)(RSS + (size_t)row * 32))[j]; s += (v.x + v.y) + (v.z + v.w); }
        return rsqrtf(s * (1.f / DM) + 1e-6f);
    }
    __device__ __forceinline__ void operator()(int row, int col, f32x4 v0, f32x4 v1, float rs) const {
        u32x4 o; o.x = pk2(v0.x * rs, v0.y * rs); o.y = pk2(v0.z * rs, v0.w * rs); o.z = pk2(v1.x * rs, v1.y * rs); o.w = pk2(v1.z * rs, v1.w * rs);
        *(u32x4*)(PROJ + (size_t)row * NINP + col) = o;
    }
};
struct EpiRes {
    const float* xin_p; const float* xin_s; float* xout; bf16_t* XB; float* RSS;
    __device__ __forceinline__ float rowscale(int) const { return 1.f; }
    __device__ __forceinline__ void operator()(int row, int col, f32x4 v0, f32x4 v1, float) const {
        const float* xi = row < T_P ? xin_p + (size_t)row * DM : xin_s + (size_t)(row - T_P) * DM;
        f32x4 a = *(const f32x4*)(xi + col), b = *(const f32x4*)(xi + col + 4);
        a += v0; b += v1;
        *(f32x4*)(xout + (size_t)row * DM + col) = a; *(f32x4*)(xout + (size_t)row * DM + col + 4) = b;
        u32x4 o; o.x = pk2(a.x, a.y); o.y = pk2(a.z, a.w); o.z = pk2(b.x, b.y); o.w = pk2(b.z, b.w);
        *(u32x4*)(XB + (size_t)row * DM + col) = o;
        float ss = (a.x * a.x + a.y * a.y) + (a.z * a.z + a.w * a.w) + (b.x * b.x + b.y * b.y) + (b.z * b.z + b.w * b.w);
        ss += __shfl_xor(ss, 16); ss += __shfl_xor(ss, 32);
        if ((threadIdx.x & 63) < 16) RSS[(size_t)row * 32 + (col >> 5)] = ss;
    }
};
struct EpiGU {
    bf16_t* H; const float* RSS;
    __device__ __forceinline__ float rowscale(int row) const {
        float s = 0.f;
#pragma unroll
        for (int j = 0; j < 8; ++j) { const f32x4 v = ((const f32x4*)(RSS + (size_t)row * 32))[j]; s += (v.x + v.y) + (v.z + v.w); }
        return rsqrtf(s * (1.f / DM) + 1e-6f);
    }
    __device__ __forceinline__ void operator()(int row, int col, f32x4 g, f32x4 u, float rs) const {
        g *= rs; u *= rs;
        float h0 = g.x * sigmoidf_(g.x) * u.x, h1 = g.y * sigmoidf_(g.y) * u.y, h2 = g.z * sigmoidf_(g.z) * u.z, h3 = g.w * sigmoidf_(g.w) * u.w;
        u32x2 o; o.x = pk2(h0, h1); o.y = pk2(h2, h3);
        *(u32x2*)(H + (size_t)row * DFF + (col >> 1)) = o;
    }
};

template <class Epi>
__device__ __forceinline__ void d_gemm(int bx, int by, const bf16_t* __restrict__ A, const bf16_t* __restrict__ Bt, int K, Epi E) {
    extern __shared__ __attribute__((aligned(16))) float sm[];
    bf16_t (*sA)[40] = (bf16_t(*)[40])sm;
    bf16_t (*sB)[40] = sA + 128;
    const int tid = threadIdx.x, wid = tid >> 6, lane = tid & 63, wr = wid >> 1, wc = wid & 1, fr = lane & 15, fq = lane >> 4;
    const int m0 = by * 128, n0 = bx * 128;
    f32x4 acc[4][2][2];
#pragma unroll
    for (int m = 0; m < 4; ++m)
#pragma unroll
        for (int p = 0; p < 2; ++p)
#pragma unroll
            for (int t = 0; t < 2; ++t) acc[m][p][t] = (f32x4){0.f, 0.f, 0.f, 0.f};
    const int lr0 = tid >> 2, lc = (tid & 3) * 8;
    for (int k0 = 0; k0 < K; k0 += 32) {
        u32x4 va0 = *(const u32x4*)(A + (size_t)(m0 + lr0) * K + k0 + lc), va1 = *(const u32x4*)(A + (size_t)(m0 + lr0 + 64) * K + k0 + lc);
        u32x4 vb0 = *(const u32x4*)(Bt + (size_t)(n0 + lr0) * K + k0 + lc), vb1 = *(const u32x4*)(Bt + (size_t)(n0 + lr0 + 64) * K + k0 + lc);
        __syncthreads();
        *(u32x4*)&sA[lr0][lc] = va0; *(u32x4*)&sA[lr0 + 64][lc] = va1; *(u32x4*)&sB[lr0][lc] = vb0; *(u32x4*)&sB[lr0 + 64][lc] = vb1;
        __syncthreads();
        bf16x8 a[4], b[2][2];
#pragma unroll
        for (int m = 0; m < 4; ++m) a[m] = *(const bf16x8*)&sA[wr * 64 + m * 16 + fr][fq * 8];
#pragma unroll
        for (int p = 0; p < 2; ++p)
#pragma unroll
            for (int t = 0; t < 2; ++t) b[p][t] = *(const bf16x8*)&sB[wc * 64 + p * 32 + 8 * (fr >> 2) + 4 * t + (fr & 3)][fq * 8];
#pragma unroll
        for (int m = 0; m < 4; ++m)
#pragma unroll
            for (int p = 0; p < 2; ++p)
#pragma unroll
                for (int t = 0; t < 2; ++t) acc[m][p][t] = __builtin_amdgcn_mfma_f32_16x16x32_bf16(b[p][t], a[m], acc[m][p][t], 0, 0, 0);
    }
#pragma unroll
    for (int m = 0; m < 4; ++m) {
        const int row = m0 + wr * 64 + m * 16 + fr;
        const float rs = E.rowscale(row);
#pragma unroll
        for (int p = 0; p < 2; ++p) E(row, n0 + wc * 64 + p * 32 + 8 * fq, acc[m][p][0], acc[m][p][1], rs);
    }
}

struct Seq { int base, L, b, sample, pos0; };
__device__ __forceinline__ Seq seq_of(int sq) { Seq s; if (sq < 4) { s.base = sq * 4096; s.L = 4096; s.b = sq; s.sample = 0; s.pos0 = 0; } else { s.b = sq - 4; s.base = T_P + s.b * 32; s.L = 32; s.sample = 1; s.pos0 = 1024; } return s; }

__device__ __forceinline__ void d_conv(int bid, const bf16_t* __restrict__ PROJ, const float* __restrict__ cache_conv  , const float* __restrict__ cw, const float* __restrict__ cb,
                                              const float* __restrict__ lg, const float* __restrict__ lb, bf16_t* __restrict__ YMIX, float* __restrict__ out_p  , float* __restrict__ out_s  ) {
    extern __shared__ __attribute__((aligned(16))) float sm[];
    float* ext = sm;
    float* yb = sm + 62 * 256;
    const int tid = threadIdx.x;
    int sq, t0; if (bid < 512) { sq = bid >> 7; t0 = (bid & 127) * 32; } else { sq = 4 + (bid - 512); t0 = 0; }
    const Seq s = seq_of(sq);
    const int c = tid;
    for (int i = 0; i < 62; ++i) {
        const int t = t0 - 30 + i; float e = 0.f;
        if (t >= 0) { const size_t o = (size_t)(s.base + t) * NINP + C_A + c; const float val = bf2f(PROJ[o]), gate = bf2f(PROJ[o + 256]); e = val * sigmoidf_(gate); }
        else if (s.sample) e = cache_conv[((size_t)s.b * 30 + 30 + t) * 256 + c];
        ext[i * 256 + c] = e;
    }
    __syncthreads();
    {
        float w[31];
#pragma unroll
        for (int j = 0; j < 31; ++j) w[j] = cw[j * 256 + c];
        const float bias = cb[c];
        for (int i = 0; i < 32; ++i) {
            float y = bias;
#pragma unroll
            for (int j = 0; j < 31; ++j) y += w[j] * ext[(i + j) * 256 + c];
            yb[i * 256 + c] = y;
        }
    }
    __syncthreads();
    {
        const int w = tid >> 6, lane = tid & 63;
        const f32x4 g4 = ((const f32x4*)lg)[lane], b4 = ((const f32x4*)lb)[lane];
        for (int i = w; i < 32; i += 4) {
            const f32x4 v = ((const f32x4*)(yb + i * 256))[lane];
            const float mean = wave_sum((v.x + v.y) + (v.z + v.w)) * (1.f / 256.f);
            const f32x4 d = v - mean;
            const float var = wave_sum((d.x * d.x + d.y * d.y) + (d.z * d.z + d.w * d.w)) * (1.f / 256.f);
            const float rstd = rsqrtf(var + 1e-5f);
            f32x4 o = d * rstd * g4 + b4;
            o.x *= sigmoidf_(o.x); o.y *= sigmoidf_(o.y); o.z *= sigmoidf_(o.z); o.w *= sigmoidf_(o.w);
            u32x2 pk; pk.x = pk2(o.x, o.y); pk.y = pk2(o.z, o.w);
            *(u32x2*)(YMIX + (size_t)(s.base + t0 + i) * DM + 0 + lane * 4) = pk;
        }
    }
    if (t0 + 32 == s.L) {
        float* o = s.sample ? out_s + (size_t)s.b * 30 * 256 : out_p + (size_t)s.b * 30 * 256;
        for (int i = 0; i < 30; ++i) o[i * 256 + c] = ext[(32 + i) * 256 + c];
    }
}

__device__ __forceinline__ void d_pool(int bid, const bf16_t* __restrict__ PROJ, const float* __restrict__ cache_pool  , const float* __restrict__ pw  , const float* __restrict__ psc,
                                              bf16_t* __restrict__ YMIX, float* __restrict__ out_p  , float* __restrict__ out_s  ) {
    extern __shared__ __attribute__((aligned(16))) float sm[];
    float* ext = sm;
    float* dd = sm + 47 * 256;
    const int tid = threadIdx.x;
    int sq, t0; if (bid < 512) { sq = bid >> 7; t0 = (bid & 127) * 32; } else { sq = 4 + (bid - 512); t0 = 0; }
    const Seq s = seq_of(sq);
    const int c = tid;
    for (int i = 0; i < 47; ++i) {
        const int t = t0 - 15 + i; float e = 0.f;
        if (t >= 0) e = bf2f(PROJ[(size_t)(s.base + t) * NINP + C_C + c]);
        else if (s.sample) e = cache_pool[((size_t)s.b * 15 + 15 + t) * 256 + c];
        ext[i * 256 + c] = e;
    }
    __syncthreads();
    {
        const int g = c >> 6, w = 2 << g;
        for (int i = 0; i < 32; ++i) {
            float sum = 0.f;
            for (int j = 0; j < w; ++j) sum += ext[(15 + i - j) * 256 + c];
            const int pos = s.pos0 + t0 + i; const int cnt = (pos + 1) < w ? (pos + 1) : w;
            dd[i * 256 + c] = sum / (float)cnt - ext[(15 + i) * 256 + c];
        }
    }
    __syncthreads();
    {
        const int g = tid >> 6, dch = tid & 63;
        float wv[64];
#pragma unroll
        for (int cc = 0; cc < 64; ++cc) wv[cc] = pw[((size_t)g * 64 + cc) * 64 + dch];
        const float sc = psc[tid];
        for (int i = 0; i < 32; ++i) {
            float a = 0.f;
#pragma unroll
            for (int cc = 0; cc < 64; ++cc) a += dd[i * 256 + g * 64 + cc] * wv[cc];
            YMIX[(size_t)(s.base + t0 + i) * DM + 512 + tid] = f2bf(a * sc);
        }
    }
    if (t0 + 32 == s.L) {
        float* o = s.sample ? out_s + (size_t)s.b * 15 * 256 : out_p + (size_t)s.b * 15 * 256;
        for (int i = 0; i < 15; ++i) o[i * 256 + c] = ext[(32 + i) * 256 + c];
    }
}

__device__ __forceinline__ void d_attn(int bid, const bf16_t* __restrict__ PROJ, const float* __restrict__ cache_k  , const float* __restrict__ cache_v, const float* __restrict__ qn, const float* __restrict__ kn,
                                              const float* __restrict__ sinks, bf16_t* __restrict__ YMIX, float* __restrict__ ko_p  , float* __restrict__ ko_s  , float* __restrict__ vo_p, float* __restrict__ vo_s) {
    extern __shared__ __attribute__((aligned(16))) float sm[];
    float* Ks = sm;
    float* Vs = sm + 192 * 64;
    const int tid = threadIdx.x;
    int sq, chunk, hkv; if (bid < 512) { sq = bid >> 7; chunk = (bid & 127) >> 1; hkv = bid & 1; } else { sq = 4 + ((bid - 512) >> 1); chunk = 0; hkv = bid & 1; }
    const Seq s = seq_of(sq);
    int nk, nq, ncache, ktok0;
    if (s.sample) { nk = 160; nq = 32; ncache = 128; ktok0 = s.base; }
    else { const int back = chunk < 2 ? chunk : 2; nk = 64 * (back + 1); nq = 64; ncache = 0; ktok0 = s.base + (chunk - back) * 64; }
    for (int j = tid; j < nk; j += 256) {
        float kr[64], vr[64];
        if (j < ncache) {
            const float* kp = cache_k + (((size_t)s.b * 128 + j) * 2 + hkv) * 64; const float* vp = cache_v + (((size_t)s.b * 128 + j) * 2 + hkv) * 64;
#pragma unroll
            for (int d = 0; d < 64; ++d) { kr[d] = kp[d]; vr[d] = vp[d]; }
        } else {
            const size_t o = (size_t)(ktok0 + j - ncache) * NINP;
            float ss = 0.f;
#pragma unroll
            for (int d = 0; d < 64; ++d) { kr[d] = bf2f(PROJ[o + C_K + hkv * 64 + d]); vr[d] = bf2f(PROJ[o + C_V + hkv * 64 + d]); ss += kr[d] * kr[d]; }
            const float rs = rsqrtf(ss * (1.f / 64.f) + 1e-6f);
#pragma unroll
            for (int d = 0; d < 64; ++d) kr[d] = kr[d] * rs * kn[d];
        }
#pragma unroll
        for (int d = 0; d < 64; ++d) { Ks[j * 64 + d] = kr[d]; Vs[j * 64 + d] = vr[d]; }
        if (s.sample) {
            if (j >= 32) { float* ko = ko_s + ((size_t)s.b * 128 + (j - 32)) * 128 + hkv * 64; float* vo = vo_s + ((size_t)s.b * 128 + (j - 32)) * 128 + hkv * 64;
#pragma unroll
                for (int d = 0; d < 64; ++d) { ko[d] = kr[d]; vo[d] = vr[d]; } }
        } else if (chunk >= 62 && j >= nk - 64) {
            const int jj = (chunk - 62) * 64 + (j - (nk - 64));
            float* ko = ko_p + ((size_t)s.b * 128 + jj) * 128 + hkv * 64; float* vo = vo_p + ((size_t)s.b * 128 + jj) * 128 + hkv * 64;
#pragma unroll
            for (int d = 0; d < 64; ++d) { ko[d] = kr[d]; vo[d] = vr[d]; }
        }
    }
    __syncthreads();
    const int g = (tid >> 6) & 1, i = tid & 63;
    if (tid < 128 && i < nq) {
        const int tok = s.base + chunk * 64 + i, qh = hkv * 2 + g;
        float q[64], o[64]; float ss = 0.f;
#pragma unroll
        for (int d = 0; d < 64; ++d) { q[d] = bf2f(PROJ[(size_t)tok * NINP + C_Q + qh * 64 + d]); ss += q[d] * q[d]; o[d] = 0.f; }
        const float rs = rsqrtf(ss * (1.f / 64.f) + 1e-6f) * 0.125f;
#pragma unroll
        for (int d = 0; d < 64; ++d) q[d] = q[d] * rs * qn[d];
        float m = sinks[qh], l = 1.f;
        for (int j = 0; j < nk; ++j) {
            float sc = 0.f;
#pragma unroll
            for (int d = 0; d < 64; ++d) sc += q[d] * Ks[j * 64 + d];
            const float mn = fmaxf(m, sc), f = __expf(m - mn), p = __expf(sc - mn);
            l = l * f + p;
#pragma unroll
            for (int d = 0; d < 64; ++d) o[d] = o[d] * f + p * Vs[j * 64 + d];
            m = mn;
        }
        const float inv = 1.f / l;
#pragma unroll
        for (int d = 0; d < 64; d += 2) *(unsigned*)(YMIX + (size_t)tok * DM + 768 + qh * 64 + d) = pk2(o[d] * inv, o[d + 1] * inv);
    }
}

struct RwkvW { const float *mu, *w0, *w2, *a0, *a2, *g2, *k_k, *k_a, *r_k, *gn_g, *gn_b; };
__device__ __forceinline__ void d_rwkv_prep(int bx, const bf16_t* __restrict__ PROJ, const float* __restrict__ shift_in  , RwkvW w, bf16_t* __restrict__ Rr, bf16_t* __restrict__ Rk, bf16_t* __restrict__ Rv,
                                                   bf16_t* __restrict__ Ra, bf16_t* __restrict__ Rb, bf16_t* __restrict__ Rg, float* __restrict__ Rw, float* __restrict__ sh_p  , float* __restrict__ sh_s  ) {
    extern __shared__ __attribute__((aligned(16))) float sm[];
    float* xs = sm; float* tw = sm + 896; float* la = sm + 928; float* sg = sm + 960;
    const int tid = threadIdx.x;
    for (int ii = 0; ii < 8; ++ii) {
        const int tok = bx * 8 + ii;
        int t, L, b, sample; if (tok < T_P) { t = tok & 4095; L = 4096; b = tok >> 12; sample = 0; } else { t = (tok - T_P) & 31; L = 32; b = (tok - T_P) >> 5; sample = 1; }
        for (int c = tid; c < 896; c += 256) {
            const float u = bf2f(PROJ[(size_t)tok * NINP + C_B + c]);
            float prev = 0.f;
            if (t > 0) prev = bf2f(PROJ[(size_t)(tok - 1) * NINP + C_B + c]); else if (sample) prev = shift_in[(size_t)b * 896 + c];
            xs[c] = u + w.mu[c] * (prev - u);
            if (t == L - 1) { if (sample) sh_s[(size_t)b * 896 + c] = u; else sh_p[(size_t)b * 896 + c] = u; }
        }
        __syncthreads();
        if (tid < 32) tw[tid] = tanhf(xs[768 + tid]); else if (tid < 64) la[tid - 32] = xs[800 + tid - 32]; else if (tid < 128) sg[tid - 64] = sigmoidf_(xs[832 + tid - 64]);
        __syncthreads();
        {
            const int c = tid; const float r = xs[c], k = xs[256 + c], v = xs[512 + c];
            float wl = w.w0[c], al = w.a0[c], gt = 0.f;
#pragma unroll 8
            for (int j = 0; j < 32; ++j) { wl += tw[j] * w.w2[j * 256 + c]; al += la[j] * w.a2[j * 256 + c]; }
#pragma unroll 8
            for (int j = 0; j < 64; ++j) gt += sg[j] * w.g2[j * 256 + c];
            const float decay = __expf(-0.60653066f * sigmoidf_(wl));
            const float ar = sigmoidf_(al);
            const float kk = k * w.k_k[c]; const float ss = wave_sum(kk * kk);
            const float kkn = kk / fmaxf(sqrtf(ss), 1e-12f);
            const float kmod = k * (1.f + (ar - 1.f) * w.k_a[c]);
            const size_t o = (size_t)tok * 256 + c;
            Rr[o] = f2bf(r); Rk[o] = f2bf(kmod); Rv[o] = f2bf(v); Ra[o] = f2bf(-kkn); Rb[o] = f2bf(kkn * ar); Rg[o] = f2bf(gt); Rw[o] = decay;
        }
        __syncthreads();
    }
}

__device__ __forceinline__ float rl(float x, int k) { return __int_as_float(__builtin_amdgcn_readlane(__float_as_int(x), k)); }
__device__ __forceinline__ void d_rwkv_scan(int bx, const bf16_t* __restrict__ Rr, const bf16_t* __restrict__ Rk, const bf16_t* __restrict__ Rv, const bf16_t* __restrict__ Ra, const bf16_t* __restrict__ Rb, const bf16_t* __restrict__ Rg,
                                                  const float* __restrict__ Rw, const float* __restrict__ state_in  , RwkvW w, bf16_t* __restrict__ YMIX, float* __restrict__ st_p  , float* __restrict__ st_s) {
    const int sq = bx >> 2, h = bx & 3, lane = threadIdx.x;
    const Seq s = seq_of(sq);
    float S[64];
    if (s.sample) { const float* p = state_in + (((size_t)s.b * 4 + h) * 64 + lane) * 64;
#pragma unroll
        for (int k = 0; k < 64; ++k) S[k] = p[k]; }
    else {
#pragma unroll
        for (int k = 0; k < 64; ++k) S[k] = 0.f; }
    const int c = h * 64 + lane;
    const float gng = w.gn_g[c], gnb = w.gn_b[c], rk = w.r_k[c];
    size_t idx = (size_t)s.base * 256 + c;
    float nr = bf2f(Rr[idx]), nw = Rw[idx], nk = bf2f(Rk[idx]), nv = bf2f(Rv[idx]), na = bf2f(Ra[idx]), nb = bf2f(Rb[idx]), ng = bf2f(Rg[idx]);
    for (int t = 0; t < s.L; ++t) {
        const float rr = nr, ww = nw, kk = nk, vv = nv, aa = na, bb = nb, gg = ng;
        if (t + 1 < s.L) { const size_t i2 = idx + 256; nr = bf2f(Rr[i2]); nw = Rw[i2]; nk = bf2f(Rk[i2]); nv = bf2f(Rv[i2]); na = bf2f(Ra[i2]); nb = bf2f(Rb[i2]); ng = bf2f(Rg[i2]); }
        float sa = 0.f;
#pragma unroll
        for (int k = 0; k < 64; ++k) sa += S[k] * rl(aa, k);
        float y = 0.f;
#pragma unroll
        for (int k = 0; k < 64; ++k) { S[k] = S[k] * rl(ww, k) + sa * rl(bb, k) + vv * rl(kk, k); y += S[k] * rl(rr, k); }
        const float mean = wave_sum(y) * (1.f / 64.f); const float d = y - mean;
        const float var = wave_sum(d * d) * (1.f / 64.f);
        const float yn = d * rsqrtf(var + 64e-5f) * gng + gnb;
        const float bonus = wave_sum(rr * kk * rk) * vv;
        YMIX[(size_t)(s.base + t) * DM + 256 + c] = f2bf((yn + bonus) * gg);
        idx += 256;
    }
    float* o = (s.sample ? st_s : st_p) + (((size_t)s.b * 4 + h) * 64 + lane) * 64;
#pragma unroll
    for (int k = 0; k < 64; ++k) o[k] = S[k];
}

struct MP { const float* in[35]; float* out; unsigned char* ws; };
#define VB(n) for (int vb = blockIdx.x; vb < (n); vb += gridDim.x)
__global__ __launch_bounds__(256) void mega(MP p) {
    cg::grid_group grid = cg::this_grid();
    const float* const* in = p.in; float* out = p.out; unsigned char* ws = p.ws;
    bf16_t* WIN = (bf16_t*)(ws + WS_WIN); bf16_t* WOUT = (bf16_t*)(ws + WS_WOUT); bf16_t* WGU = (bf16_t*)(ws + WS_WGU); bf16_t* WD = (bf16_t*)(ws + WS_WD);
    bf16_t* XB = (bf16_t*)(ws + WS_XB); bf16_t* YMIX = (bf16_t*)(ws + WS_YMIX); float* RSS = (float*)(ws + WS_RSS);
    bf16_t* PROJ = (bf16_t*)(ws + WS_PROJ); bf16_t* H = (bf16_t*)(ws + WS_H);
    bf16_t *Rr = (bf16_t*)(ws + WS_RW_R), *Rk = (bf16_t*)(ws + WS_RW_K), *Rv = (bf16_t*)(ws + WS_RW_V), *Ra = (bf16_t*)(ws + WS_RW_A), *Rb = (bf16_t*)(ws + WS_RW_B), *Rg = (bf16_t*)(ws + WS_RW_G);
    float* Rw = (float*)(ws + WS_RW_W);
    for (int l = 0; l < 2; ++l) {
        VB((NIN / 32) * (DM / 32)) { d_transpose(vb % (NIN / 32), vb / (NIN / 32), in[9] + (size_t)l * DM * NIN, DM, NIN, WIN + (size_t)l * NINP * DM, in[8] + l * DM, NIN, 0, 0); __syncthreads(); }
        VB((DM / 32) * (DM / 32)) { d_transpose(vb % (DM / 32), vb / (DM / 32), in[30] + (size_t)l * DM * DM, DM, DM, WOUT + (size_t)l * DM * DM, nullptr, DM, 0, 0); __syncthreads(); }
        VB((DFF / 32) * (DM / 32)) { d_transpose(vb % (DFF / 32), vb / (DFF / 32), in[32] + (size_t)l * DM * DFF, DM, DFF, WGU + (size_t)l * 2 * DFF * DM, in[31] + l * DM, 4, 8, 0); __syncthreads(); }
        VB((DFF / 32) * (DM / 32)) { d_transpose(vb % (DFF / 32), vb / (DFF / 32), in[33] + (size_t)l * DM * DFF, DM, DFF, WGU + (size_t)l * 2 * DFF * DM, in[31] + l * DM, 4, 8, 4); __syncthreads(); }
        VB((DM / 32) * (DFF / 32)) { d_transpose(vb % (DM / 32), vb / (DM / 32), in[34] + (size_t)l * DFF * DM, DFF, DM, WD + (size_t)l * DM * DFF, nullptr, DM, 0, 0); __syncthreads(); }
    }
    VB(T / 4) d_xprep(vb, in[0], in[1], XB, RSS);
    grid.sync();
    for (int l = 0; l < 2; ++l) {
        VB((NINP / 128) * (T / 128)) { d_gemm<EpiProj>(vb % (NINP / 128), vb / (NINP / 128), XB, WIN + (size_t)l * NINP * DM, DM, EpiProj{PROJ, RSS}); __syncthreads(); }
        grid.sync();
        VB(528) { d_conv(vb, PROJ, in[2] + (size_t)l * 16 * 30 * 256, in[10] + l * 31 * 256, in[11] + l * 256, in[12] + l * 256, in[13] + l * 256, YMIX,
                         out + O_CONV_P + (size_t)l * 4 * 30 * 256, out + O_CONV_S + (size_t)l * 16 * 30 * 256); __syncthreads(); }
        VB(528) { d_pool(vb, PROJ, in[5] + (size_t)l * 16 * 15 * 256, in[25] + (size_t)l * 4 * 64 * 64, in[26] + l * 256, YMIX,
                         out + O_POOL_P + (size_t)l * 4 * 15 * 256, out + O_POOL_S + (size_t)l * 16 * 15 * 256); __syncthreads(); }
        VB(544) { d_attn(vb, PROJ, in[6] + (size_t)l * 16 * 128 * 128, in[7] + (size_t)l * 16 * 128 * 128, in[27] + l * 64, in[28] + l * 64, in[29] + l * 4, YMIX,
                         out + O_K_P + (size_t)l * 4 * 128 * 128, out + O_K_S + (size_t)l * 16 * 128 * 128, out + O_V_P + (size_t)l * 4 * 128 * 128, out + O_V_S + (size_t)l * 16 * 128 * 128); __syncthreads(); }
        RwkvW rw{in[14] + l * 896, in[15] + l * 256, in[16] + l * 32 * 256, in[17] + l * 256, in[18] + l * 32 * 256, in[19] + l * 64 * 256, in[20] + l * 256, in[21] + l * 256, in[22] + l * 256, in[23] + l * 256, in[24] + l * 256};
        VB(T / 8) d_rwkv_prep(vb, PROJ, in[4] + (size_t)l * 16 * 896, rw, Rr, Rk, Rv, Ra, Rb, Rg, Rw, out + O_SHIFT_P + (size_t)l * 4 * 896, out + O_SHIFT_S + (size_t)l * 16 * 896);
        grid.sync();
        VB(80) { if (threadIdx.x < 64) d_rwkv_scan(vb, Rr, Rk, Rv, Ra, Rb, Rg, Rw, in[3] + (size_t)l * 16 * 4 * 4096, rw, YMIX, out + O_RWKV_P + (size_t)l * 4 * 4 * 4096, out + O_RWKV_S + (size_t)l * 16 * 4 * 4096); }
        grid.sync();
        if (l == 0) { VB((DM / 128) * (T / 128)) { d_gemm<EpiRes>(vb % (DM / 128), vb / (DM / 128), YMIX, WOUT + (size_t)l * DM * DM, DM, EpiRes{in[0], in[1], out, XB, RSS}); __syncthreads(); } }
        else { VB((DM / 128) * (T / 128)) { d_gemm<EpiRes>(vb % (DM / 128), vb / (DM / 128), YMIX, WOUT + (size_t)l * DM * DM, DM, EpiRes{out, out + (size_t)T_P * DM, out, XB, RSS}); __syncthreads(); } }
        grid.sync();
        VB((2 * DFF / 128) * (T / 128)) { d_gemm<EpiGU>(vb % (2 * DFF / 128), vb / (2 * DFF / 128), XB, WGU + (size_t)l * 2 * DFF * DM, DM, EpiGU{H, RSS}); __syncthreads(); }
        grid.sync();
        VB((DM / 128) * (T / 128)) { d_gemm<EpiRes>(vb % (DM / 128), vb / (DM / 128), H, WD + (size_t)l * DM * DFF, DFF, EpiRes{out, out + (size_t)T_P * DM, out, XB, RSS}); __syncthreads(); }
        grid.sync();
    }
}

extern "C" void kernel_launch(void* const* d_in, const int* in_sizes, int n_in, void* d_out, int out_size, void* d_ws, size_t ws_size, hipStream_t stream) {
    constexpr size_t kDynLds = 2 * 192 * 64 * 4;
    static int grid_blocks = 0;
    if (grid_blocks == 0) {
        if (n_in != 35 || (size_t)out_size != O_END || ws_size < WS_END) { fprintf(stderr, "kernel_launch: unexpected sizes n_in %d out %d ws %zu (need %zu)\n", n_in, out_size, ws_size, (size_t)WS_END); grid_blocks = -1; return; }
        int dev = 0, cus = 0, per_cu = 0;
        (void)hipGetDevice(&dev);
        (void)hipDeviceGetAttribute(&cus, hipDeviceAttributeMultiprocessorCount, dev);
        (void)hipFuncSetAttribute((const void*)mega, hipFuncAttributeMaxDynamicSharedMemorySize, (int)kDynLds);
        (void)hipOccupancyMaxActiveBlocksPerMultiprocessor(&per_cu, mega, 256, kDynLds);
        if (per_cu < 1) per_cu = 1;
        grid_blocks = cus * per_cu;
        fprintf(stderr, "kernel_launch: cus %d per_cu %d grid %d\n", cus, per_cu, grid_blocks);
    }
    if (grid_blocks < 0) return;
    MP p{};
    for (int i = 0; i < 35; ++i) p.in[i] = (const float*)d_in[i];
    p.out = (float*)d_out; p.ws = (unsigned char*)d_ws;
    void* args[] = {&p};
    hipError_t e = hipLaunchCooperativeKernel((const void*)mega, dim3(grid_blocks), dim3(256), args, kDynLds, stream);
    if (e != hipSuccess) fprintf(stderr, "cooperative launch failed: %s (grid %d)\n", hipGetErrorString(e), grid_blocks);
}
```

```cpp
#include <hip/hip_runtime.h>
#include <hip/hip_cooperative_groups.h>
namespace cg = cooperative_groups;
#include <cstdint>
#include <cstdio>

typedef unsigned short bf16_t;
typedef short bf16x8 __attribute__((ext_vector_type(8)));
typedef float f32x4 __attribute__((ext_vector_type(4)));
typedef unsigned u32x4 __attribute__((ext_vector_type(4)));
typedef unsigned u32x2 __attribute__((ext_vector_type(2)));

constexpr int T_P = 16384, T_S = 512, T = 16896, DM = 1024;
constexpr int NIN = 2176, NINP = 2304, DFF = 2816;
constexpr int C_A = 0, C_B = 512, C_C = 1408, C_Q = 1664, C_K = 1920, C_V = 2048;

constexpr size_t O_Y = 0, O_CONV_P = 17301504, O_CONV_S = 17362944, O_RWKV_P = 17608704, O_RWKV_S = 17739776,
                 O_SHIFT_P = 18264064, O_SHIFT_S = 18271232, O_POOL_P = 18299904, O_POOL_S = 18330624,
                 O_K_P = 18453504, O_K_S = 18584576, O_V_P = 19108864, O_V_S = 19239936, O_END = 19764224;

constexpr size_t WS_CTL = 0;
constexpr size_t WS_WIN = 4096;
constexpr size_t WS_WOUT = WS_WIN + 2ull * NINP * DM * 2;
constexpr size_t WS_WGU = WS_WOUT + 2ull * DM * DM * 2;
constexpr size_t WS_WD = WS_WGU + 2ull * 2 * DFF * DM * 2;
constexpr size_t WS_LWT = WS_WD + 2ull * DM * DFF * 2;
constexpr size_t WS_XB = WS_LWT + 2ull * 256 * 128 * 2;
constexpr size_t WS_YMIX = WS_XB + (size_t)T * DM * 2;
constexpr size_t WS_RSS = WS_YMIX + (size_t)T * DM * 2;
constexpr size_t WS_R = WS_RSS + (size_t)T * 32 * 4;
constexpr size_t WS_PROJ = WS_R;
constexpr size_t WS_H = WS_R;
constexpr size_t WS_RW = WS_PROJ + (size_t)T * NINP * 2;
constexpr int NCH = T / 32, NCHH = NCH * 4;
constexpr size_t WS_PT = WS_RW;
constexpr size_t WS_QQ = WS_PT + (size_t)NCHH * 4096 * 2;
constexpr size_t WS_ZZ = WS_QQ + (size_t)NCHH * 4096 * 2;
constexpr size_t WS_Y0 = WS_ZZ + (size_t)NCHH * 2048 * 2;
constexpr size_t WS_SC = WS_Y0 + (size_t)NCHH * 2048 * 2;
constexpr size_t WS_GATE = WS_SC + (size_t)NCHH * 4096 * 2;
constexpr size_t WS_BV = WS_GATE + (size_t)T * 256 * 2;
constexpr size_t WS_RWEND = WS_BV + (size_t)T * 256 * 2;
constexpr size_t RW_BF = (size_t)T * 256 * 2;
constexpr size_t WS_RW_R = WS_RWEND, WS_RW_K = WS_RW_R + RW_BF, WS_RW_V = WS_RW_R + 2 * RW_BF, WS_RW_A = WS_RW_R + 3 * RW_BF,
                 WS_RW_B = WS_RW_R + 4 * RW_BF, WS_RW_G = WS_RW_R + 5 * RW_BF, WS_RW_W = WS_RW_R + 6 * RW_BF;
constexpr size_t WS_END = WS_RWEND;

__device__ __forceinline__ float bf2f(bf16_t h) { return __uint_as_float((unsigned)h << 16); }
typedef __bf16 bf16x2_t __attribute__((ext_vector_type(2)));
typedef float f32x2 __attribute__((ext_vector_type(2)));
__device__ __forceinline__ unsigned pk2(float lo, float hi) { const f32x2 v = {lo, hi}; return __builtin_bit_cast(unsigned, __builtin_convertvector(v, bf16x2_t)); }
__device__ __forceinline__ bf16_t f2bf(float f) { return (bf16_t)(pk2(f, 0.f) & 0xffffu); }
__device__ __forceinline__ float wave_sum(float v) {
#pragma unroll
    for (int o = 1; o < 64; o <<= 1) v += __shfl_xor(v, o);
    return v;
}
__device__ __forceinline__ float sigmoidf_(float x) { return 1.f / (1.f + __expf(-x)); }

__device__ __forceinline__ void d_transpose(float* sm_, int bx, int by, const float* __restrict__ W, int K, int N, bf16_t* __restrict__ WT, const float* __restrict__ g, int grp, int stride, int off) {
    float (*t)[33] = (float(*)[33])sm_;
    const int k0 = by * 32, n0 = bx * 32, tx = threadIdx.x & 31, ty = (threadIdx.x >> 5) & 7;
    for (int i = ty; i < 32; i += 8) { float v = W[(size_t)(k0 + i) * N + n0 + tx]; if (g) v *= g[k0 + i]; t[i][tx] = v; }
    __syncthreads();
    for (int i = ty; i < 32; i += 8) { const int n = n0 + i; const int r = (n / grp) * stride + off + (n % grp); WT[(size_t)r * K + k0 + tx] = f2bf(t[tx][i]); }
}

__device__ __forceinline__ void d_xprep(int row, const float* __restrict__ xp, const float* __restrict__ xs, bf16_t* __restrict__ XB, float* __restrict__ RSS) {
    const int lane = threadIdx.x & 63;
    const float* x = row < T_P ? xp + (size_t)row * DM : xs + (size_t)(row - T_P) * DM;
    float ss = 0.f;
#pragma unroll
    for (int j = 0; j < 4; ++j) {
        const f32x4 v = ((const f32x4*)x)[lane + 64 * j];
        ss += v.x * v.x + v.y * v.y + v.z * v.z + v.w * v.w;
        u32x2 o; o.x = pk2(v.x, v.y); o.y = pk2(v.z, v.w);
        *(u32x2*)(XB + (size_t)row * DM + (lane + 64 * j) * 4) = o;
    }
    ss = wave_sum(ss);
    if (lane < 16) RSS[(size_t)row * 16 + lane] = lane == 0 ? ss : 0.f;
}

__device__ __forceinline__ float rss_rstd(const float* RSS, int row) {
    float s = 0.f;
#pragma unroll
    for (int j = 0; j < 4; ++j) { const f32x4 v = ((const f32x4*)(RSS + (size_t)row * 16))[j]; s += (v.x + v.y) + (v.z + v.w); }
    return rsqrtf(s * (1.f / DM) + 1e-6f);
}
struct EpiProj {
    bf16_t* PROJ; const float* RSS;
    __device__ __forceinline__ float rowscale(int row) const { return rss_rstd(RSS, row); }
    __device__ __forceinline__ void operator()(int row, int col, f32x4 v0, f32x4 v1, f32x4 w0, f32x4 w1, float rs) const {
        u32x4 o; o.x = pk2(v0.x * rs, v0.y * rs); o.y = pk2(v0.z * rs, v0.w * rs); o.z = pk2(v1.x * rs, v1.y * rs); o.w = pk2(v1.z * rs, v1.w * rs);
        *(u32x4*)(PROJ + (size_t)row * NINP + col) = o;
        o.x = pk2(w0.x * rs, w0.y * rs); o.y = pk2(w0.z * rs, w0.w * rs); o.z = pk2(w1.x * rs, w1.y * rs); o.w = pk2(w1.z * rs, w1.w * rs);
        *(u32x4*)(PROJ + (size_t)row * NINP + col + 128) = o;
    }
};
struct EpiRes {
    const float* xin_p; const float* xin_s; float* xout; bf16_t* XB; float* RSS;
    __device__ __forceinline__ float rowscale(int) const { return 1.f; }
    __device__ __forceinline__ float half8(const float* xi, float* xo, bf16_t* xb, f32x4 v0, f32x4 v1) const {
        f32x4 a = *(const f32x4*)(xi), b = *(const f32x4*)(xi + 4);
        a += v0; b += v1;
        *(f32x4*)(xo) = a; *(f32x4*)(xo + 4) = b;
        u32x4 o; o.x = pk2(a.x, a.y); o.y = pk2(a.z, a.w); o.z = pk2(b.x, b.y); o.w = pk2(b.z, b.w);
        *(u32x4*)(xb) = o;
        return (a.x * a.x + a.y * a.y) + (a.z * a.z + a.w * a.w) + (b.x * b.x + b.y * b.y) + (b.z * b.z + b.w * b.w);
    }
    __device__ __forceinline__ void operator()(int row, int col, f32x4 v0, f32x4 v1, f32x4 w0, f32x4 w1, float) const {
        const float* xi = (row < T_P ? xin_p + (size_t)row * DM : xin_s + (size_t)(row - T_P) * DM) + col;
        float* xo = xout + (size_t)row * DM + col; bf16_t* xb = XB + (size_t)row * DM + col;
        float ss = half8(xi, xo, xb, v0, v1);
        ss += half8(xi + 128, xo + 128, xb + 128, w0, w1);
        ss += __shfl_xor(ss, 16); ss += __shfl_xor(ss, 32);
        if ((threadIdx.x & 63) < 16) RSS[(size_t)row * 16 + (col >> 8) * 4 + ((col >> 5) & 3)] = ss;
    }
};
struct EpiGU {
    bf16_t* H; const float* RSS;
    __device__ __forceinline__ float rowscale(int row) const { return rss_rstd(RSS, row); }
    __device__ __forceinline__ u32x2 gu(f32x4 g, f32x4 u, float rs) const {
        g *= rs; u *= rs;
        const float h0 = g.x * sigmoidf_(g.x) * u.x, h1 = g.y * sigmoidf_(g.y) * u.y, h2 = g.z * sigmoidf_(g.z) * u.z, h3 = g.w * sigmoidf_(g.w) * u.w;
        u32x2 o; o.x = pk2(h0, h1); o.y = pk2(h2, h3); return o;
    }
    __device__ __forceinline__ void operator()(int row, int col, f32x4 g0, f32x4 u0, f32x4 g1, f32x4 u1, float rs) const {
        *(u32x2*)(H + (size_t)row * DFF + (col >> 1)) = gu(g0, u0, rs);
        *(u32x2*)(H + (size_t)row * DFF + (col >> 1) + 64) = gu(g1, u1, rs);
    }
};

struct Seq { int base, L, b, sample, pos0; };
__device__ __forceinline__ Seq seq_of(int sq) { Seq s; if (sq < 4) { s.base = sq * 4096; s.L = 4096; s.b = sq; s.sample = 0; s.pos0 = 0; } else { s.b = sq - 4; s.base = T_P + s.b * 32; s.L = 32; s.sample = 1; s.pos0 = 1024; } return s; }

__global__ __launch_bounds__(256) void k_conv(const bf16_t* __restrict__ PROJ, const float* __restrict__ cache_conv  , const float* __restrict__ cw, const float* __restrict__ cb,
                                              const float* __restrict__ lg, const float* __restrict__ lb, bf16_t* __restrict__ YMIX, float* __restrict__ out_p  , float* __restrict__ out_s  ) {
    extern __shared__ __attribute__((aligned(16))) float sm[];
    float* ext = sm;
    float* yb = sm + 62 * 256;
    const int bid = blockIdx.x, tid = threadIdx.x;
    int sq, t0; if (bid < 512) { sq = bid >> 7; t0 = (bid & 127) * 32; } else { sq = 4 + (bid - 512); t0 = 0; }
    const Seq s = seq_of(sq);
    const int c = tid;
    for (int i = 0; i < 62; ++i) {
        const int t = t0 - 30 + i; float e = 0.f;
        if (t >= 0) { const size_t o = (size_t)(s.base + t) * NINP + C_A + c; const float val = bf2f(PROJ[o]), gate = bf2f(PROJ[o + 256]); e = val * sigmoidf_(gate); }
        else if (s.sample) e = cache_conv[((size_t)s.b * 30 + 30 + t) * 256 + c];
        ext[i * 256 + c] = e;
    }
    __syncthreads();
    {
        float w[31];
#pragma unroll
        for (int j = 0; j < 31; ++j) w[j] = cw[j * 256 + c];
        const float bias = cb[c];
        for (int i = 0; i < 32; ++i) {
            float y = bias;
#pragma unroll
            for (int j = 0; j < 31; ++j) y += w[j] * ext[(i + j) * 256 + c];
            yb[i * 256 + c] = y;
        }
    }
    __syncthreads();
    {
        const int w = tid >> 6, lane = tid & 63;
        const f32x4 g4 = ((const f32x4*)lg)[lane], b4 = ((const f32x4*)lb)[lane];
        for (int i = w; i < 32; i += 4) {
            const f32x4 v = ((const f32x4*)(yb + i * 256))[lane];
            const float mean = wave_sum((v.x + v.y) + (v.z + v.w)) * (1.f / 256.f);
            const f32x4 d = v - mean;
            const float var = wave_sum((d.x * d.x + d.y * d.y) + (d.z * d.z + d.w * d.w)) * (1.f / 256.f);
            const float rstd = rsqrtf(var + 1e-5f);
            f32x4 o = d * rstd * g4 + b4;
            o.x *= sigmoidf_(o.x); o.y *= sigmoidf_(o.y); o.z *= sigmoidf_(o.z); o.w *= sigmoidf_(o.w);
            u32x2 pk; pk.x = pk2(o.x, o.y); pk.y = pk2(o.z, o.w);
            *(u32x2*)(YMIX + (size_t)(s.base + t0 + i) * DM + 0 + lane * 4) = pk;
        }
    }
    if (t0 + 32 == s.L) {
        float* o = s.sample ? out_s + (size_t)s.b * 30 * 256 : out_p + (size_t)s.b * 30 * 256;
        for (int i = 0; i < 30; ++i) o[i * 256 + c] = ext[(32 + i) * 256 + c];
    }
}

__global__ __launch_bounds__(256) void k_pool(const bf16_t* __restrict__ PROJ, const float* __restrict__ cache_pool  , const float* __restrict__ pw  , const float* __restrict__ psc,
                                              bf16_t* __restrict__ YMIX, float* __restrict__ out_p  , float* __restrict__ out_s  ) {
    extern __shared__ __attribute__((aligned(16))) float sm[];
    float* ext = sm;
    float* dd = sm + 47 * 256;
    const int bid = blockIdx.x, tid = threadIdx.x;
    int sq, t0; if (bid < 512) { sq = bid >> 7; t0 = (bid & 127) * 32; } else { sq = 4 + (bid - 512); t0 = 0; }
    const Seq s = seq_of(sq);
    const int c = tid;
    for (int i = 0; i < 47; ++i) {
        const int t = t0 - 15 + i; float e = 0.f;
        if (t >= 0) e = bf2f(PROJ[(size_t)(s.base + t) * NINP + C_C + c]);
        else if (s.sample) e = cache_pool[((size_t)s.b * 15 + 15 + t) * 256 + c];
        ext[i * 256 + c] = e;
    }
    __syncthreads();
    {
        const int g = c >> 6, w = 2 << g;
        for (int i = 0; i < 32; ++i) {
            float sum = 0.f;
            for (int j = 0; j < w; ++j) sum += ext[(15 + i - j) * 256 + c];
            const int pos = s.pos0 + t0 + i; const int cnt = (pos + 1) < w ? (pos + 1) : w;
            dd[i * 256 + c] = sum / (float)cnt - ext[(15 + i) * 256 + c];
        }
    }
    __syncthreads();
    {
        const int g = tid >> 6, dch = tid & 63;
        float wv[64];
#pragma unroll
        for (int cc = 0; cc < 64; ++cc) wv[cc] = pw[((size_t)g * 64 + cc) * 64 + dch];
        const float sc = psc[tid];
        for (int i = 0; i < 32; ++i) {
            float a = 0.f;
#pragma unroll
            for (int cc = 0; cc < 64; ++cc) a += dd[i * 256 + g * 64 + cc] * wv[cc];
            YMIX[(size_t)(s.base + t0 + i) * DM + 512 + tid] = f2bf(a * sc);
        }
    }
    if (t0 + 32 == s.L) {
        float* o = s.sample ? out_s + (size_t)s.b * 15 * 256 : out_p + (size_t)s.b * 15 * 256;
        for (int i = 0; i < 15; ++i) o[i * 256 + c] = ext[(32 + i) * 256 + c];
    }
}

__global__ __launch_bounds__(128) void k_attn(const bf16_t* __restrict__ PROJ, const float* __restrict__ cache_k  , const float* __restrict__ cache_v, const float* __restrict__ qn, const float* __restrict__ kn,
                                              const float* __restrict__ sinks, bf16_t* __restrict__ YMIX, float* __restrict__ ko_p  , float* __restrict__ ko_s  , float* __restrict__ vo_p, float* __restrict__ vo_s) {
    extern __shared__ __attribute__((aligned(16))) float sm[];
    float* Ks = sm;
    float* Vs = sm + 192 * 64;
    const int bid = blockIdx.x, tid = threadIdx.x;
    int sq, chunk, hkv; if (bid < 512) { sq = bid >> 7; chunk = (bid & 127) >> 1; hkv = bid & 1; } else { sq = 4 + ((bid - 512) >> 1); chunk = 0; hkv = bid & 1; }
    const Seq s = seq_of(sq);
    int nk, nq, ncache, ktok0;
    if (s.sample) { nk = 160; nq = 32; ncache = 128; ktok0 = s.base; }
    else { const int back = chunk < 2 ? chunk : 2; nk = 64 * (back + 1); nq = 64; ncache = 0; ktok0 = s.base + (chunk - back) * 64; }
    for (int j = tid; j < nk; j += 128) {
        float kr[64], vr[64];
        if (j < ncache) {
            const float* kp = cache_k + (((size_t)s.b * 128 + j) * 2 + hkv) * 64; const float* vp = cache_v + (((size_t)s.b * 128 + j) * 2 + hkv) * 64;
#pragma unroll
            for (int d = 0; d < 64; ++d) { kr[d] = kp[d]; vr[d] = vp[d]; }
        } else {
            const size_t o = (size_t)(ktok0 + j - ncache) * NINP;
            float ss = 0.f;
#pragma unroll
            for (int d = 0; d < 64; ++d) { kr[d] = bf2f(PROJ[o + C_K + hkv * 64 + d]); vr[d] = bf2f(PROJ[o + C_V + hkv * 64 + d]); ss += kr[d] * kr[d]; }
            const float rs = rsqrtf(ss * (1.f / 64.f) + 1e-6f);
#pragma unroll
            for (int d = 0; d < 64; ++d) kr[d] = kr[d] * rs * kn[d];
        }
#pragma unroll
        for (int d = 0; d < 64; ++d) { Ks[j * 64 + d] = kr[d]; Vs[j * 64 + d] = vr[d]; }
        if (s.sample) {
            if (j >= 32) { float* ko = ko_s + ((size_t)s.b * 128 + (j - 32)) * 128 + hkv * 64; float* vo = vo_s + ((size_t)s.b * 128 + (j - 32)) * 128 + hkv * 64;
#pragma unroll
                for (int d = 0; d < 64; ++d) { ko[d] = kr[d]; vo[d] = vr[d]; } }
        } else if (chunk >= 62 && j >= nk - 64) {
            const int jj = (chunk - 62) * 64 + (j - (nk - 64));
            float* ko = ko_p + ((size_t)s.b * 128 + jj) * 128 + hkv * 64; float* vo = vo_p + ((size_t)s.b * 128 + jj) * 128 + hkv * 64;
#pragma unroll
            for (int d = 0; d < 64; ++d) { ko[d] = kr[d]; vo[d] = vr[d]; }
        }
    }
    __syncthreads();
    const int g = tid >> 6, i = tid & 63;
    if (i < nq) {
        const int tok = s.base + chunk * 64 + i, qh = hkv * 2 + g;
        float q[64], o[64]; float ss = 0.f;
#pragma unroll
        for (int d = 0; d < 64; ++d) { q[d] = bf2f(PROJ[(size_t)tok * NINP + C_Q + qh * 64 + d]); ss += q[d] * q[d]; o[d] = 0.f; }
        const float rs = rsqrtf(ss * (1.f / 64.f) + 1e-6f) * 0.125f;
#pragma unroll
        for (int d = 0; d < 64; ++d) q[d] = q[d] * rs * qn[d];
        float m = sinks[qh], l = 1.f;
        for (int j = 0; j < nk; ++j) {
            float sc = 0.f;
#pragma unroll
            for (int d = 0; d < 64; ++d) sc += q[d] * Ks[j * 64 + d];
            const float mn = fmaxf(m, sc), f = __expf(m - mn), p = __expf(sc - mn);
            l = l * f + p;
#pragma unroll
            for (int d = 0; d < 64; ++d) o[d] = o[d] * f + p * Vs[j * 64 + d];
            m = mn;
        }
        const float inv = 1.f / l;
#pragma unroll
        for (int d = 0; d < 64; d += 2) *(unsigned*)(YMIX + (size_t)tok * DM + 768 + qh * 64 + d) = pk2(o[d] * inv, o[d + 1] * inv);
    }
}

struct RwkvW { const float *mu, *w0, *w2, *a0, *a2, *g2, *k_k, *k_a, *r_k, *gn_g, *gn_b; };
__global__ __launch_bounds__(256) void k_rwkv_prep(const bf16_t* __restrict__ PROJ, const float* __restrict__ shift_in  , RwkvW w, bf16_t* __restrict__ Rr, bf16_t* __restrict__ Rk, bf16_t* __restrict__ Rv,
                                                   bf16_t* __restrict__ Ra, bf16_t* __restrict__ Rb, bf16_t* __restrict__ Rg, float* __restrict__ Rw, float* __restrict__ sh_p  , float* __restrict__ sh_s  ) {
    __shared__ float xs[896]; __shared__ float tw[32]; __shared__ float la[32]; __shared__ float sg[64];
    const int tid = threadIdx.x;
    for (int ii = 0; ii < 8; ++ii) {
        const int tok = blockIdx.x * 8 + ii;
        int t, L, b, sample; if (tok < T_P) { t = tok & 4095; L = 4096; b = tok >> 12; sample = 0; } else { t = (tok - T_P) & 31; L = 32; b = (tok - T_P) >> 5; sample = 1; }
        for (int c = tid; c < 896; c += 256) {
            const float u = bf2f(PROJ[(size_t)tok * NINP + C_B + c]);
            float prev = 0.f;
            if (t > 0) prev = bf2f(PROJ[(size_t)(tok - 1) * NINP + C_B + c]); else if (sample) prev = shift_in[(size_t)b * 896 + c];
            xs[c] = u + w.mu[c] * (prev - u);
            if (t == L - 1) { if (sample) sh_s[(size_t)b * 896 + c] = u; else sh_p[(size_t)b * 896 + c] = u; }
        }
        __syncthreads();
        if (tid < 32) tw[tid] = tanhf(xs[768 + tid]); else if (tid < 64) la[tid - 32] = xs[800 + tid - 32]; else if (tid < 128) sg[tid - 64] = sigmoidf_(xs[832 + tid - 64]);
        __syncthreads();
        {
            const int c = tid; const float r = xs[c], k = xs[256 + c], v = xs[512 + c];
            float wl = w.w0[c], al = w.a0[c], gt = 0.f;
#pragma unroll 8
            for (int j = 0; j < 32; ++j) { wl += tw[j] * w.w2[j * 256 + c]; al += la[j] * w.a2[j * 256 + c]; }
#pragma unroll 8
            for (int j = 0; j < 64; ++j) gt += sg[j] * w.g2[j * 256 + c];
            const float decay = __expf(-0.60653066f * sigmoidf_(wl));
            const float ar = sigmoidf_(al);
            const float kk = k * w.k_k[c]; const float ss = wave_sum(kk * kk);
            const float kkn = kk / fmaxf(sqrtf(ss), 1e-12f);
            const float kmod = k * (1.f + (ar - 1.f) * w.k_a[c]);
            const size_t o = (size_t)tok * 256 + c;
            Rr[o] = f2bf(r); Rk[o] = f2bf(kmod); Rv[o] = f2bf(v); Ra[o] = f2bf(-kkn); Rb[o] = f2bf(kkn * ar); Rg[o] = f2bf(gt); Rw[o] = decay;
        }
        __syncthreads();
    }
}

__device__ __forceinline__ float rl(float x, int k) { return __int_as_float(__builtin_amdgcn_readlane(__float_as_int(x), k)); }
__global__ __launch_bounds__(64) void k_rwkv_scan(const bf16_t* __restrict__ Rr, const bf16_t* __restrict__ Rk, const bf16_t* __restrict__ Rv, const bf16_t* __restrict__ Ra, const bf16_t* __restrict__ Rb, const bf16_t* __restrict__ Rg,
                                                  const float* __restrict__ Rw, const float* __restrict__ state_in  , RwkvW w, bf16_t* __restrict__ YMIX, float* __restrict__ st_p  , float* __restrict__ st_s) {
    const int sq = blockIdx.x >> 2, h = blockIdx.x & 3, lane = threadIdx.x;
    const Seq s = seq_of(sq);
    float S[64];
    if (s.sample) { const float* p = state_in + (((size_t)s.b * 4 + h) * 64 + lane) * 64;
#pragma unroll
        for (int k = 0; k < 64; ++k) S[k] = p[k]; }
    else {
#pragma unroll
        for (int k = 0; k < 64; ++k) S[k] = 0.f; }
    const int c = h * 64 + lane;
    const float gng = w.gn_g[c], gnb = w.gn_b[c], rk = w.r_k[c];
    size_t idx = (size_t)s.base * 256 + c;
    float nr = bf2f(Rr[idx]), nw = Rw[idx], nk = bf2f(Rk[idx]), nv = bf2f(Rv[idx]), na = bf2f(Ra[idx]), nb = bf2f(Rb[idx]), ng = bf2f(Rg[idx]);
    for (int t = 0; t < s.L; ++t) {
        const float rr = nr, ww = nw, kk = nk, vv = nv, aa = na, bb = nb, gg = ng;
        if (t + 1 < s.L) { const size_t i2 = idx + 256; nr = bf2f(Rr[i2]); nw = Rw[i2]; nk = bf2f(Rk[i2]); nv = bf2f(Rv[i2]); na = bf2f(Ra[i2]); nb = bf2f(Rb[i2]); ng = bf2f(Rg[i2]); }
        float sa = 0.f;
#pragma unroll
        for (int k = 0; k < 64; ++k) sa += S[k] * rl(aa, k);
        float y = 0.f;
#pragma unroll
        for (int k = 0; k < 64; ++k) { S[k] = S[k] * rl(ww, k) + sa * rl(bb, k) + vv * rl(kk, k); y += S[k] * rl(rr, k); }
        const float mean = wave_sum(y) * (1.f / 64.f); const float d = y - mean;
        const float var = wave_sum(d * d) * (1.f / 64.f);
        const float yn = d * rsqrtf(var + 64e-5f) * gng + gnb;
        const float bonus = wave_sum(rr * kk * rk) * vv;
        YMIX[(size_t)(s.base + t) * DM + 256 + c] = f2bf((yn + bonus) * gg);
        idx += 256;
    }
    float* o = (s.sample ? st_s : st_p) + (((size_t)s.b * 4 + h) * 64 + lane) * 64;
#pragma unroll
    for (int k = 0; k < 64; ++k) o[k] = S[k];
}

namespace pg8 {
#define PG8_LAS __attribute__((address_space(3)))
typedef unsigned short bf16_t;
typedef short bf16x8 __attribute__((ext_vector_type(8)));
typedef float f32x4 __attribute__((ext_vector_type(4)));
typedef unsigned u32x4 __attribute__((ext_vector_type(4)));
constexpr int BM = 256, BK = 64, HALF = 128, HTB = HALF * BK * 2  , STAGE_BYTES = 8 * HTB, NXCD = 8, WGM = 8;

__host__ __device__ __forceinline__ int lds_byte(int r, int c) { const int st = (r >> 4) * 2 + (c >> 5), rr = r & 15, cc = c & 31, ob = rr * 64 + cc * 2; return st * 1024 + (ob ^ (((ob >> 9) & 1) << 5)); }
__host__ __device__ __forceinline__ void stage_rc(int b, int& R, int& C) { const int st = b / 1024, sb = b % 1024, swz = sb ^ (((sb >> 9) & 1) << 5); R = (st >> 1) * 16 + swz / 64; C = (st & 1) * 32 + (swz % 64) / 2; }
__host__ __device__ __forceinline__ int perm32(int rho) { const int n = rho >> 4, i = rho & 15; return 8 * (i >> 2) + 4 * n + (i & 3); }

struct Unit { int pm, pn; };
struct Gemm { const bf16_t* A; const bf16_t* Bt; int M, N, K; };

struct StaticOrder {
    int nM, nN, nwg, G, c;
    __host__ __device__ void init(int M, int N, int G_, int c_) { nM = M / BM; nN = N / BM; nwg = nM * nN; G = G_; c = c_; }
    __host__ __device__ bool next(int i, Unit& u) const {
        const long L = (long)i * G + c; if (L >= nwg) return false;
        int wgid = (int)L; { const int q = nwg / NXCD, r = nwg % NXCD, xcd = wgid % NXCD, off = wgid / NXCD; wgid = (xcd < r ? xcd * (q + 1) : r * (q + 1) + (xcd - r) * q) + off; }
        const int nig = WGM * nN, gid = wgid / nig, fm = gid * WGM, gsz = (nM - fm) < WGM ? (nM - fm) : WGM;
        u.pm = fm + ((wgid % nig) % gsz); u.pn = (wgid % nig) / gsz; return true;
    }
    __device__ __forceinline__ void a_ready(const Unit&) const {}
    __device__ __forceinline__ void done(const Unit&) const {}
};


template <class Epi, class Sched, bool ALIGN_EPI = false, bool SP2 = false>
__device__ __forceinline__ void gemm_phase(PG8_LAS unsigned char* lds, const Gemm g, const Sched& S, const Epi& E) {
    int tid_ = threadIdx.x; asm volatile("" : "+v"(tid_));
    const int tid = tid_, wid = __builtin_amdgcn_readfirstlane(tid >> 6), lane = tid & 63, wr = wid >> 2, wc = wid & 3, fr = lane & 15, fq = lane >> 4;
    const int K = g.K, nt = K / BK;
    unsigned voffA[2], voffB[2];
#pragma unroll
    for (int i = 0; i < 2; ++i) { int R, C; stage_rc(tid * 16 + i * 8192, R, C); const int Rb = Epi::PERM ? ((R & ~31) + perm32(R & 31)) : R;
        voffA[i] = (unsigned)(R * K + C) * 2u; voffB[i] = (unsigned)(Rb * K + C) * 2u; }
    const size_t kstep = (size_t)(BK * 2);
    const size_t hstep = (size_t)HALF * K * 2;
    const size_t tstep = 2 * hstep;
    const unsigned ldsw = (unsigned)wid * 1024u;
    const int aoff = lds_byte(wr * 64 + fr, fq * 8), boff = lds_byte(wc * 32 + fr, fq * 8);
#define PG8_SA(b, h) (((b) * 2 + (h)) * HTB)
#define PG8_SB(b, h) ((4 + (b) * 2 + (h)) * HTB)
#define PG8_STAGE(bufoff, gbase, voff) do { _Pragma("unroll") for (int _i = 0; _i < 2; ++_i) \
        __builtin_amdgcn_global_load_lds((const unsigned*)((const char*)(gbase) + (voff)[_i]), (PG8_LAS unsigned*)(lds + (bufoff) + ldsw + _i * 8192), 16, 0, 0); } while (0)
#define PG8_LDA(dst, b, h) do { _Pragma("unroll") for (int m = 0; m < 4; ++m) _Pragma("unroll") for (int k = 0; k < 2; ++k) dst[m][k] = *(const PG8_LAS bf16x8*)(lds + PG8_SA(b, h) + aoff + m * 2048 + k * 1024); } while (0)
#define PG8_LDB(dst, b, h) do { _Pragma("unroll") for (int n = 0; n < 2; ++n) _Pragma("unroll") for (int k = 0; k < 2; ++k) dst[n][k] = *(const PG8_LAS bf16x8*)(lds + PG8_SB(b, h) + boff + n * 2048 + k * 1024); } while (0)
#define PG8_MMA(ai, bj, At, Bt) do { __builtin_amdgcn_s_setprio(1); _Pragma("unroll") for (int m = 0; m < 4; ++m) _Pragma("unroll") for (int n = 0; n < 2; ++n) _Pragma("unroll") for (int k = 0; k < 2; ++k) \
        acc[ai][bj][m][n] = __builtin_amdgcn_mfma_f32_16x16x32_bf16(Bt[n][k], At[m][k], acc[ai][bj][m][n], 0, 0, 0); __builtin_amdgcn_s_setprio(0); } while (0)
#define PG8_WAIT_V(n) asm volatile("s_waitcnt vmcnt(" #n ")" ::: "memory")
#define PG8_WAIT_L(n) asm volatile("s_waitcnt lgkmcnt(" #n ")" ::: "memory")
#define PG8_BAR __builtin_amdgcn_s_barrier()
#define PG8_SCHED __builtin_amdgcn_sched_barrier(0)
    Unit cur, nxt; int ui = 0;
    if (!S.next(0, cur)) return;
    f32x4 acc[2][2][4][2];
#pragma unroll
    for (int a = 0; a < 2; ++a)
#pragma unroll
        for (int b = 0; b < 2; ++b)
#pragma unroll
            for (int m = 0; m < 4; ++m)
#pragma unroll
                for (int n = 0; n < 2; ++n) acc[a][b][m][n] = (f32x4){0.f, 0.f, 0.f, 0.f};
    bf16x8 At[4][2], B0[2][2], B1[2][2];
    const char* cA = (const char*)g.A + (size_t)cur.pm * tstep; const char* cB = (const char*)g.Bt + (size_t)cur.pn * tstep;
    S.a_ready(cur);
    if constexpr (SP2) {
        PG8_STAGE(PG8_SB(0, 0), cB, voffB); PG8_STAGE(PG8_SB(0, 1), cB + hstep, voffB); PG8_STAGE(PG8_SA(0, 0), cA, voffA); PG8_STAGE(PG8_SA(0, 1), cA + hstep, voffA);
        if (wr == 1) PG8_BAR;
        PG8_WAIT_V(2); PG8_BAR;
        PG8_STAGE(PG8_SB(1, 0), cB + kstep, voffB); PG8_STAGE(PG8_SA(1, 0), cA + kstep, voffA); PG8_STAGE(PG8_SB(1, 1), cB + hstep + kstep, voffB);
        PG8_WAIT_V(6); PG8_BAR;
    } else {
        PG8_STAGE(PG8_SB(0, 0), cB, voffB); PG8_STAGE(PG8_SA(0, 0), cA, voffA); PG8_STAGE(PG8_SB(0, 1), cB + hstep, voffB); PG8_STAGE(PG8_SA(0, 1), cA + hstep, voffA);
        if (wr == 1) PG8_BAR;
        PG8_WAIT_V(4); PG8_BAR;
        PG8_STAGE(PG8_SB(1, 0), cB + kstep, voffB); PG8_STAGE(PG8_SA(1, 0), cA + kstep, voffA); PG8_STAGE(PG8_SB(1, 1), cB + hstep + kstep, voffB);
        PG8_WAIT_V(6); PG8_BAR;
    }
    for (;;) {
        const bool has_next = S.next(ui + 1, nxt);
        const char* nA = has_next ? (const char*)g.A + (size_t)nxt.pm * tstep : cA; const char* nB = has_next ? (const char*)g.Bt + (size_t)nxt.pn * tstep : cB;
        for (int t = 0; t < nt; t += 2) {
            const bool last = (t == nt - 2);
            const char* a1 = cA + (size_t)(t + 1) * kstep;
            const char* a2 = last ? nA : cA + (size_t)(t + 2) * kstep; const char* b2 = last ? nB : cB + (size_t)(t + 2) * kstep;
            const char* a3 = a2 + kstep; const char* b3 = b2 + kstep;
            if (last && has_next) S.a_ready(nxt);
            if constexpr (SP2) {
            PG8_LDB(B0, 0, 0); PG8_LDB(B1, 0, 1); PG8_SCHED; PG8_LDA(At, 0, 0); PG8_STAGE(PG8_SA(1, 1), a1 + hstep, voffA);
            PG8_WAIT_V(8); PG8_WAIT_L(0); PG8_BAR; PG8_MMA(0, 0, At, B0); PG8_MMA(0, 1, At, B1); PG8_BAR; PG8_SCHED;
            PG8_LDA(At, 0, 1); PG8_STAGE(PG8_SB(0, 0), b2, voffB); PG8_STAGE(PG8_SB(0, 1), b2 + hstep, voffB); PG8_STAGE(PG8_SA(0, 0), a2, voffA);
            PG8_WAIT_V(8); PG8_WAIT_L(0); PG8_BAR; PG8_MMA(1, 0, At, B0); PG8_MMA(1, 1, At, B1); PG8_BAR; PG8_SCHED;
            PG8_LDB(B0, 1, 0); PG8_LDB(B1, 1, 1); PG8_SCHED; PG8_LDA(At, 1, 0); PG8_STAGE(PG8_SA(0, 1), a2 + hstep, voffA);
            PG8_WAIT_V(8); PG8_WAIT_L(0); PG8_BAR; PG8_MMA(0, 0, At, B0); PG8_MMA(0, 1, At, B1); PG8_BAR; PG8_SCHED;
            PG8_LDA(At, 1, 1); PG8_STAGE(PG8_SB(1, 0), b3, voffB); PG8_STAGE(PG8_SB(1, 1), b3 + hstep, voffB); PG8_STAGE(PG8_SA(1, 0), a3, voffA);
            PG8_WAIT_V(8); PG8_WAIT_L(0); PG8_BAR; PG8_MMA(1, 0, At, B0); PG8_MMA(1, 1, At, B1); PG8_BAR; PG8_SCHED;
            } else {
            PG8_LDB(B0, 0, 0); PG8_SCHED; PG8_LDA(At, 0, 0); PG8_STAGE(PG8_SA(1, 1), a1 + hstep, voffA);
            PG8_WAIT_L(8); PG8_BAR; PG8_WAIT_L(0); PG8_MMA(0, 0, At, B0); PG8_BAR; PG8_SCHED;
            PG8_LDB(B1, 0, 1); PG8_STAGE(PG8_SB(0, 0), b2, voffB);
            PG8_BAR; PG8_WAIT_L(0); PG8_MMA(0, 1, At, B1); PG8_BAR;
            PG8_LDA(At, 0, 1); PG8_STAGE(PG8_SA(0, 0), a2, voffA);
            PG8_BAR; PG8_WAIT_L(0); PG8_MMA(1, 0, At, B0); PG8_BAR; PG8_SCHED;
            PG8_STAGE(PG8_SB(0, 1), b2 + hstep, voffB);
            PG8_WAIT_V(6); PG8_BAR; PG8_MMA(1, 1, At, B1); PG8_BAR;
            PG8_LDB(B0, 1, 0); PG8_SCHED; PG8_LDA(At, 1, 0); PG8_STAGE(PG8_SA(0, 1), a2 + hstep, voffA);
            PG8_WAIT_L(8); PG8_BAR; PG8_WAIT_L(0); PG8_MMA(0, 0, At, B0); PG8_BAR; PG8_SCHED;
            PG8_LDB(B1, 1, 1); PG8_STAGE(PG8_SB(1, 0), b3, voffB);
            PG8_BAR; PG8_WAIT_L(0); PG8_MMA(0, 1, At, B1); PG8_BAR;
            PG8_LDA(At, 1, 1); PG8_STAGE(PG8_SA(1, 0), a3, voffA);
            PG8_BAR; PG8_WAIT_L(0); PG8_MMA(1, 0, At, B0); PG8_BAR; PG8_SCHED;
            PG8_STAGE(PG8_SB(1, 1), b3 + hstep, voffB);
            PG8_WAIT_V(6); PG8_BAR; PG8_MMA(1, 1, At, B1); PG8_BAR;
            }
        }
        if constexpr (ALIGN_EPI) { if (wr == 0) PG8_BAR; }
        if constexpr (!Epi::AFTER_DRAIN) { E(acc, cur, wr, wc, fr, fq); S.done(cur); }
        if (!has_next) break;
#pragma unroll
        for (int a = 0; a < 2; ++a)
#pragma unroll
            for (int b = 0; b < 2; ++b)
#pragma unroll
                for (int m = 0; m < 4; ++m)
#pragma unroll
                    for (int n = 0; n < 2; ++n) acc[a][b][m][n] = (f32x4){0.f, 0.f, 0.f, 0.f};
        cur = nxt; cA = nA; cB = nB; ++ui;
        if constexpr (ALIGN_EPI) { if (wr == 1) PG8_BAR; }
    }
    PG8_WAIT_V(0);
    if constexpr (!ALIGN_EPI) { if (wr == 0) PG8_BAR; }
    PG8_BAR;
    if constexpr (Epi::AFTER_DRAIN) { E.fused(acc, cur, wr, wc, fr, fq, lds, wid, lane); S.done(cur); }
#undef PG8_SA
#undef PG8_SB
#undef PG8_STAGE
#undef PG8_LDA
#undef PG8_LDB
#undef PG8_MMA
#undef PG8_WAIT_V
#undef PG8_WAIT_L
#undef PG8_BAR
#undef PG8_SCHED
}
}


__device__ __forceinline__ void unpack8(u32x4 v, float* f) {
    f[0] = __uint_as_float(v.x << 16); f[1] = __uint_as_float(v.x & 0xffff0000u); f[2] = __uint_as_float(v.y << 16); f[3] = __uint_as_float(v.y & 0xffff0000u);
    f[4] = __uint_as_float(v.z << 16); f[5] = __uint_as_float(v.z & 0xffff0000u); f[6] = __uint_as_float(v.w << 16); f[7] = __uint_as_float(v.w & 0xffff0000u);
}
struct AttnP { const bf16_t* PROJ; const float *cache_k, *cache_v, *qn, *kn, *sinks; bf16_t* YMIX; float *ko_p, *ko_s, *vo_p, *vo_s; };
constexpr int KN_STRIDE = 72, VT_STRIDE = 200, ATT_VT_OFF = 192 * KN_STRIDE * 2;
__device__ __forceinline__ void attn_unit(unsigned char* lds, int unit, const AttnP& a) {
    int tid_ = threadIdx.x; asm volatile("" : "+v"(tid_));
    const int tid = tid_, lane = tid & 63, w = __builtin_amdgcn_readfirstlane(tid >> 6), fr = lane & 15, fq = lane >> 4;
    int sq, chunk, hkv; if (unit < 512) { sq = unit >> 7; chunk = (unit & 127) >> 1; hkv = unit & 1; } else { sq = 4 + ((unit - 512) >> 1); chunk = 0; hkv = unit & 1; }
    const Seq s = seq_of(sq);
    int nk, ncache, ktok0;
    if (s.sample) { nk = 160; ncache = 128; ktok0 = s.base; }
    else { const int back = chunk < 2 ? chunk : 2; nk = 64 * (back + 1); ncache = 0; ktok0 = s.base + (chunk - back) * 64; }
    bf16_t* Kn = (bf16_t*)lds; bf16_t* Vt = (bf16_t*)(lds + ATT_VT_OFF);
    for (int p = tid; p < nk * 8; p += 512) {
        const int j = p >> 3, ch = p & 7;
        float kf[8], vf[8];
        if (j < ncache) {
            const float* kp = a.cache_k + (((size_t)s.b * 128 + j) * 2 + hkv) * 64 + ch * 8; const float* vp = a.cache_v + (((size_t)s.b * 128 + j) * 2 + hkv) * 64 + ch * 8;
            const f32x4 k0 = *(const f32x4*)kp, k1 = *(const f32x4*)(kp + 4), v0 = *(const f32x4*)vp, v1 = *(const f32x4*)(vp + 4);
            kf[0] = k0.x; kf[1] = k0.y; kf[2] = k0.z; kf[3] = k0.w; kf[4] = k1.x; kf[5] = k1.y; kf[6] = k1.z; kf[7] = k1.w;
            vf[0] = v0.x; vf[1] = v0.y; vf[2] = v0.z; vf[3] = v0.w; vf[4] = v1.x; vf[5] = v1.y; vf[6] = v1.z; vf[7] = v1.w;
        } else {
            const bf16_t* pp = a.PROJ + (size_t)(ktok0 + j - ncache) * NINP + hkv * 64 + ch * 8;
            unpack8(*(const u32x4*)(pp + C_K), kf); unpack8(*(const u32x4*)(pp + C_V), vf);
            float ss = 0.f;
#pragma unroll
            for (int i = 0; i < 8; ++i) ss += kf[i] * kf[i];
            ss += __shfl_xor(ss, 1); ss += __shfl_xor(ss, 2); ss += __shfl_xor(ss, 4);
            const float rs = rsqrtf(ss * (1.f / 64.f) + 1e-6f);
            const f32x4 g0 = *(const f32x4*)(a.kn + ch * 8), g1 = *(const f32x4*)(a.kn + ch * 8 + 4);
            kf[0] *= rs * g0.x; kf[1] *= rs * g0.y; kf[2] *= rs * g0.z; kf[3] *= rs * g0.w; kf[4] *= rs * g1.x; kf[5] *= rs * g1.y; kf[6] *= rs * g1.z; kf[7] *= rs * g1.w;
        }
        u32x4 ko; ko.x = pk2(kf[0], kf[1]); ko.y = pk2(kf[2], kf[3]); ko.z = pk2(kf[4], kf[5]); ko.w = pk2(kf[6], kf[7]);
        *(u32x4*)(Kn + j * KN_STRIDE + ch * 8) = ko;
#pragma unroll
        for (int i = 0; i < 8; ++i) Vt[(ch * 8 + i) * VT_STRIDE + j] = f2bf(vf[i]);
        float* ko_ = nullptr; float* vo_ = nullptr;
        if (s.sample) { if (j >= 32) { ko_ = a.ko_s + ((size_t)s.b * 128 + (j - 32)) * 128 + hkv * 64 + ch * 8; vo_ = a.vo_s + ((size_t)s.b * 128 + (j - 32)) * 128 + hkv * 64 + ch * 8; } }
        else if (chunk >= 62 && j >= nk - 64) { const int jj = (chunk - 62) * 64 + (j - (nk - 64)); ko_ = a.ko_p + ((size_t)s.b * 128 + jj) * 128 + hkv * 64 + ch * 8; vo_ = a.vo_p + ((size_t)s.b * 128 + jj) * 128 + hkv * 64 + ch * 8; }
        if (ko_) { *(f32x4*)ko_ = (f32x4){kf[0], kf[1], kf[2], kf[3]}; *(f32x4*)(ko_ + 4) = (f32x4){kf[4], kf[5], kf[6], kf[7]}; *(f32x4*)vo_ = (f32x4){vf[0], vf[1], vf[2], vf[3]}; *(f32x4*)(vo_ + 4) = (f32x4){vf[4], vf[5], vf[6], vf[7]}; }
    }
    __syncthreads();
    int g, mt; bool act; if (!s.sample) { g = w >> 2; mt = w & 3; act = true; } else { g = (w >> 1) & 1; mt = w & 1; act = w < 4; }
    if (act) {
        const int qh = hkv * 2 + g, tok = s.base + chunk * 64 + mt * 16 + fr, nkt = nk >> 4, nks = nk >> 5;
        const bf16_t* qp = a.PROJ + (size_t)tok * NINP + C_Q + qh * 64 + 8 * fq;
        float qf[16]; unpack8(*(const u32x4*)qp, qf); unpack8(*(const u32x4*)(qp + 32), qf + 8);
        float ss = 0.f;
#pragma unroll
        for (int i = 0; i < 16; ++i) ss += qf[i] * qf[i];
        ss += __shfl_xor(ss, 16); ss += __shfl_xor(ss, 32);
        const float rs = rsqrtf(ss * (1.f / 64.f) + 1e-6f) * 0.125f;
#pragma unroll
        for (int i = 0; i < 8; ++i) { qf[i] *= rs * a.qn[8 * fq + i]; qf[8 + i] *= rs * a.qn[32 + 8 * fq + i]; }
        union { u32x4 u; bf16x8 v; } qa, qb;
        qa.u.x = pk2(qf[0], qf[1]); qa.u.y = pk2(qf[2], qf[3]); qa.u.z = pk2(qf[4], qf[5]); qa.u.w = pk2(qf[6], qf[7]);
        qb.u.x = pk2(qf[8], qf[9]); qb.u.y = pk2(qf[10], qf[11]); qb.u.z = pk2(qf[12], qf[13]); qb.u.w = pk2(qf[14], qf[15]);
        f32x4 sacc[12];
        const float sink = a.sinks[qh];
        float m = sink;
#pragma unroll
        for (int kt = 0; kt < 12; ++kt) {
            sacc[kt] = (f32x4){0.f, 0.f, 0.f, 0.f};
            if (kt < nkt) {
                const bf16x8 k0 = *(const bf16x8*)(Kn + (kt * 16 + fr) * KN_STRIDE + 8 * fq), k1 = *(const bf16x8*)(Kn + (kt * 16 + fr) * KN_STRIDE + 32 + 8 * fq);
                sacc[kt] = __builtin_amdgcn_mfma_f32_16x16x32_bf16(k0, qa.v, sacc[kt], 0, 0, 0);
                sacc[kt] = __builtin_amdgcn_mfma_f32_16x16x32_bf16(k1, qb.v, sacc[kt], 0, 0, 0);
                m = fmaxf(m, fmaxf(fmaxf(sacc[kt].x, sacc[kt].y), fmaxf(sacc[kt].z, sacc[kt].w)));
            }
        }
        m = fmaxf(m, __shfl_xor(m, 16)); m = fmaxf(m, __shfl_xor(m, 32));
        float lsum = 0.f;
#pragma unroll
        for (int kt = 0; kt < 12; ++kt) if (kt < nkt) {
            sacc[kt].x = __expf(sacc[kt].x - m); sacc[kt].y = __expf(sacc[kt].y - m); sacc[kt].z = __expf(sacc[kt].z - m); sacc[kt].w = __expf(sacc[kt].w - m);
            lsum += (sacc[kt].x + sacc[kt].y) + (sacc[kt].z + sacc[kt].w);
        }
        lsum += __shfl_xor(lsum, 16); lsum += __shfl_xor(lsum, 32);
        lsum += __expf(sink - m);
        f32x4 oacc[4];
#pragma unroll
        for (int dt = 0; dt < 4; ++dt) oacc[dt] = (f32x4){0.f, 0.f, 0.f, 0.f};
#pragma unroll
        for (int ks = 0; ks < 6; ++ks) if (ks < nks) {
            union { u32x4 u; bf16x8 v; } pf;
            pf.u.x = pk2(sacc[2 * ks].x, sacc[2 * ks].y); pf.u.y = pk2(sacc[2 * ks].z, sacc[2 * ks].w); pf.u.z = pk2(sacc[2 * ks + 1].x, sacc[2 * ks + 1].y); pf.u.w = pk2(sacc[2 * ks + 1].z, sacc[2 * ks + 1].w);
#pragma unroll
            for (int dt = 0; dt < 4; ++dt) {
                union { u32x4 u; bf16x8 v; } vf;
                const u32x2 lo = *(const u32x2*)(Vt + (dt * 16 + fr) * VT_STRIDE + 32 * ks + 4 * fq), hi2 = *(const u32x2*)(Vt + (dt * 16 + fr) * VT_STRIDE + 32 * ks + 16 + 4 * fq);
                vf.u.x = lo.x; vf.u.y = lo.y; vf.u.z = hi2.x; vf.u.w = hi2.y;
                oacc[dt] = __builtin_amdgcn_mfma_f32_16x16x32_bf16(vf.v, pf.v, oacc[dt], 0, 0, 0);
            }
        }
        const float inv = 1.f / lsum;
#pragma unroll
        for (int dt = 0; dt < 4; ++dt) { u32x2 o; o.x = pk2(oacc[dt].x * inv, oacc[dt].y * inv); o.y = pk2(oacc[dt].z * inv, oacc[dt].w * inv);
            *(u32x2*)(a.YMIX + (size_t)tok * DM + 768 + qh * 64 + dt * 16 + 4 * fq) = o; }
    }
    __syncthreads();
}

struct ConvPoolP { const bf16_t* PROJ; const float *cache_conv, *cw, *cb, *lg, *lb, *cache_pool, *pw, *psc; bf16_t* YMIX; float *co_p, *co_s, *po_p, *po_s; };
__device__ __forceinline__ void convpool_tile(float* sm, int tile, const ConvPoolP& a) {
    int c = threadIdx.x & 255;
#define RELAUNDER() asm volatile("" : "+v"(c))
    RELAUNDER();
    int sq, t0; if (tile < 1024) { sq = tile >> 8; t0 = (tile & 255) * 16; } else { sq = 4 + ((tile - 1024) >> 1); t0 = ((tile - 1024) & 1) * 16; }
    const Seq s = seq_of(sq);
    float* ext = sm;
    float* yb = sm + 46 * 256;
#pragma unroll 2
    for (int i = 0; i < 46; ++i) {
        const int t = t0 - 30 + i; float e = 0.f;
        if (t >= 0) { const size_t o = (size_t)(s.base + t) * NINP + C_A + c; const float val = bf2f(a.PROJ[o]), gate = bf2f(a.PROJ[o + 256]); e = val * sigmoidf_(gate); }
        else if (s.sample) e = a.cache_conv[((size_t)s.b * 30 + 30 + t) * 256 + c];
        ext[i * 256 + c] = e;
    }
    __syncthreads(); RELAUNDER();
    {
        float w[31];
#pragma unroll
        for (int j = 0; j < 31; ++j) w[j] = a.cw[j * 256 + c];
        const float bias = a.cb[c];
#pragma unroll 1
        for (int i = 0; i < 16; ++i) {
            float y = bias;
#pragma unroll
            for (int j = 0; j < 31; ++j) y += w[j] * ext[(i + j) * 256 + c];
            yb[i * 256 + c] = y;
        }
        float* o = s.sample ? a.co_s + (size_t)s.b * 30 * 256 : a.co_p + (size_t)s.b * 30 * 256;
#pragma unroll 1
        for (int i = 0; i < 16; ++i) { const int t = t0 + i; if (t >= s.L - 30) o[(t - (s.L - 30)) * 256 + c] = ext[(i + 30) * 256 + c]; }
    }
    __syncthreads(); RELAUNDER();
    {
        const int wv = c >> 6, lane = c & 63;
        const f32x4 g4 = ((const f32x4*)a.lg)[lane], b4 = ((const f32x4*)a.lb)[lane];
#pragma unroll 1
        for (int i = wv; i < 16; i += 4) {
            const f32x4 v = ((const f32x4*)(yb + i * 256))[lane];
            const float mean = wave_sum((v.x + v.y) + (v.z + v.w)) * (1.f / 256.f);
            const f32x4 d = v - mean;
            const float var = wave_sum((d.x * d.x + d.y * d.y) + (d.z * d.z + d.w * d.w)) * (1.f / 256.f);
            const float rstd = rsqrtf(var + 1e-5f);
            f32x4 o = d * rstd * g4 + b4;
            o.x *= sigmoidf_(o.x); o.y *= sigmoidf_(o.y); o.z *= sigmoidf_(o.z); o.w *= sigmoidf_(o.w);
            u32x2 pk; pk.x = pk2(o.x, o.y); pk.y = pk2(o.z, o.w);
            *(u32x2*)(a.YMIX + (size_t)(s.base + t0 + i) * DM + 0 + lane * 4) = pk;
        }
    }
    __syncthreads(); RELAUNDER();
#pragma unroll 2
    for (int i = 0; i < 31; ++i) {
        const int t = t0 - 15 + i; float e = 0.f;
        if (t >= 0) e = bf2f(a.PROJ[(size_t)(s.base + t) * NINP + C_C + c]);
        else if (s.sample) e = a.cache_pool[((size_t)s.b * 15 + 15 + t) * 256 + c];
        ext[i * 256 + c] = e;
    }
    __syncthreads(); RELAUNDER();
    {
        const int g = c >> 6, w = 2 << g;
#pragma unroll 1
        for (int i = 0; i < 16; ++i) {
            float sum = 0.f;
            for (int j = 0; j < w; ++j) sum += ext[(15 + i - j) * 256 + c];
            const int pos = s.pos0 + t0 + i; const int cnt = (pos + 1) < w ? (pos + 1) : w;
            yb[i * 256 + c] = sum / (float)cnt - ext[(15 + i) * 256 + c];
        }
        float* o = s.sample ? a.po_s + (size_t)s.b * 15 * 256 : a.po_p + (size_t)s.b * 15 * 256;
#pragma unroll 1
        for (int i = 0; i < 16; ++i) { const int t = t0 + i; if (t >= s.L - 15) o[(t - (s.L - 15)) * 256 + c] = ext[(i + 15) * 256 + c]; }
    }
    __syncthreads(); RELAUNDER();
    {
        const int g = c >> 6, dch = c & 63;
        float wv[64];
#pragma unroll
        for (int cc = 0; cc < 64; ++cc) wv[cc] = a.pw[((size_t)g * 64 + cc) * 64 + dch];
        const float sc = a.psc[c];
#pragma unroll 1
        for (int i = 0; i < 16; ++i) {
            float acc = 0.f;
#pragma unroll
            for (int cc = 0; cc < 64; ++cc) acc += yb[i * 256 + g * 64 + cc] * wv[cc];
            a.YMIX[(size_t)(s.base + t0 + i) * DM + 512 + c] = f2bf(acc * sc);
        }
    }
    __syncthreads(); RELAUNDER();
}


struct RwkvG { bf16_t *PT, *QQ, *ZZ, *Y0, *SC, *GATE, *BV; const bf16_t* LWT; };
constexpr int RC_HEAD = 30208, RC_MAB = 0, RC_MAK = 4608, RC_MRB = 7168, RC_MRK = 9728, RC_TM = 12288, RC_MAKVT = 14848, RC_GT = 19968, RC_U0T = 25088;
constexpr int RB_BASE = 2 * RC_HEAD, RB_HEAD = 38912, RB_AT = 0, RB_BH = 4608, RB_KH = 9216, RB_RT = 13824, RB_ATT = 18432, RB_BHT = 23552, RB_KHT = 28672, RB_VT = 33792;
constexpr int RA_LAT = 0, RA_WL = 8704, RA_AL = 25088, RA_SCN = 41472, R_WLS = RB_BASE + 2 * RB_HEAD;
constexpr int NS = 72, TS = 40, LATS = 136, MABS = 36;
__device__ __forceinline__ bf16x8 ldf(const bf16_t* base, int row, int stride, int col) { return *(const bf16x8*)(base + row * stride + col); }
__device__ __forceinline__ u32x2 pk4(f32x4 v) { u32x2 o; o.x = pk2(v.x, v.y); o.y = pk2(v.z, v.w); return o; }
#define MFMA16(a, b, c) __builtin_amdgcn_mfma_f32_16x16x32_bf16((a), (b), (c), 0, 0, 0)

__device__ __forceinline__ void rwkv_item(unsigned char* lds, int item, int l, const bf16_t* __restrict__ PROJ, const float* __restrict__ shift_in, const RwkvW& w, const RwkvG& G) {
    int tid = threadIdx.x; asm volatile("" : "+v"(tid));
    const int wv = __builtin_amdgcn_readfirstlane(tid >> 6);
    const int cid = item >> 1, hp = item & 1, tok0 = cid * 32;
    const bool sample = cid >= 512, first = sample || ((cid & 127) == 0);
    const int sb = cid - 512;
    bf16_t* LAT = (bf16_t*)(lds + RA_LAT); float* WLb = (float*)(lds + RA_WL); float* ALb = (float*)(lds + RA_AL); float* SCN = (float*)(lds + RA_SCN); float* WLs = (float*)(lds + R_WLS);
    {
        const int t = tid >> 4, j8 = (tid & 15) * 8, col = 768 + j8;
        float u[8], pv[8];
        unpack8(*(const u32x4*)(PROJ + (size_t)(tok0 + t) * NINP + C_B + col), u);
        if (t > 0 || !first) unpack8(*(const u32x4*)(PROJ + (size_t)(tok0 + t - 1) * NINP + C_B + col), pv);
        else if (sample) { const f32x4 a = *(const f32x4*)(shift_in + (size_t)sb * 896 + col), b = *(const f32x4*)(shift_in + (size_t)sb * 896 + col + 4); pv[0] = a.x; pv[1] = a.y; pv[2] = a.z; pv[3] = a.w; pv[4] = b.x; pv[5] = b.y; pv[6] = b.z; pv[7] = b.w; }
        else {
#pragma unroll
            for (int i = 0; i < 8; ++i) pv[i] = 0.f; }
        const f32x4 m0 = *(const f32x4*)(w.mu + col), m1 = *(const f32x4*)(w.mu + col + 4);
        const float mu[8] = {m0.x, m0.y, m0.z, m0.w, m1.x, m1.y, m1.z, m1.w};
        float x[8];
#pragma unroll
        for (int i = 0; i < 8; ++i) { const float xs = u[i] + mu[i] * (pv[i] - u[i]); x[i] = j8 < 32 ? tanhf(xs) : (j8 < 64 ? xs : sigmoidf_(xs)); }
        u32x4 o; o.x = pk2(x[0], x[1]); o.y = pk2(x[2], x[3]); o.z = pk2(x[4], x[5]); o.w = pk2(x[6], x[7]);
        *(u32x4*)(LAT + t * LATS + j8) = o;
    }
    __syncthreads();
    {
        asm volatile("" : "+v"(tid)); const int lane = tid & 63, fr = lane & 15, fq = lane >> 4;
        const int c0l = 16 * wv, cg0 = hp * 128 + c0l;
        const bf16_t* lw = G.LWT + ((size_t)l * 256 + cg0 + fr) * 128 + 8 * fq;
        const bf16x8 fw = *(const bf16x8*)(lw), fa = *(const bf16x8*)(lw + 32), fg0 = *(const bf16x8*)(lw + 64), fg1 = *(const bf16x8*)(lw + 96);
        const f32x4 w0v = *(const f32x4*)(w.w0 + cg0 + 4 * fq), a0v = *(const f32x4*)(w.a0 + cg0 + 4 * fq);
#pragma unroll
        for (int tt = 0; tt < 2; ++tt) {
            const int t = 16 * tt + fr;
            const f32x4 z = {0.f, 0.f, 0.f, 0.f};
            f32x4 aw = MFMA16(fw, ldf(LAT, t, LATS, 8 * fq), z);
            f32x4 aa = MFMA16(fa, ldf(LAT, t, LATS, 32 + 8 * fq), z);
            f32x4 ag = MFMA16(fg0, ldf(LAT, t, LATS, 64 + 8 * fq), z);
            ag = MFMA16(fg1, ldf(LAT, t, LATS, 96 + 8 * fq), ag);
            *(f32x4*)(WLb + t * 128 + c0l + 4 * fq) = aw + w0v;
            *(f32x4*)(ALb + t * 128 + c0l + 4 * fq) = aa + a0v;
            *(u32x2*)(G.GATE + (size_t)(tok0 + t) * 256 + cg0 + 4 * fq) = pk4(ag);
        }
    }
    __syncthreads();
    {
        asm volatile("" : "+v"(tid));
        const int c = tid & 127, tq = tid >> 7, hd = c >> 6, c64 = c & 63, cg = hp * 128 + c;
        unsigned char* hb = lds + RB_BASE + hd * RB_HEAD;
        bf16_t *AT = (bf16_t*)(hb + RB_AT), *BH = (bf16_t*)(hb + RB_BH), *KH = (bf16_t*)(hb + RB_KH), *RT = (bf16_t*)(hb + RB_RT);
        bf16_t *ATt = (bf16_t*)(hb + RB_ATT), *BHt = (bf16_t*)(hb + RB_BHT), *KHt = (bf16_t*)(hb + RB_KHT), *Vt = (bf16_t*)(hb + RB_VT);
        float ur[9], uk[9], uv[9];
#pragma unroll
        for (int i = 0; i < 9; ++i) {
            const int t = 8 * tq - 1 + i;
            if (t >= 0 || !first) { const bf16_t* p = PROJ + (size_t)(tok0 + t) * NINP + C_B + cg; ur[i] = bf2f(p[0]); uk[i] = bf2f(p[256]); uv[i] = bf2f(p[512]); }
            else if (sample) { const float* p = shift_in + (size_t)sb * 896 + cg; ur[i] = p[0]; uk[i] = p[256]; uv[i] = p[512]; }
            else { ur[i] = 0.f; uk[i] = 0.f; uv[i] = 0.f; }
        }
        const float mur = w.mu[cg], muk = w.mu[256 + cg], muv = w.mu[512 + cg], kkw = w.k_k[cg], kaw = w.k_a[cg], rkw = w.r_k[cg];
        float lw[8], cl[8];
        float run = 0.f;
#pragma unroll
        for (int i = 0; i < 8; ++i) { lw[i] = -0.60653066f * sigmoidf_(WLb[(8 * tq + i) * 128 + c]); run += lw[i]; cl[i] = run; }
        SCN[tq * 128 + c] = run;
        __syncthreads();
        float pre = 0.f, tot = 0.f;
#pragma unroll
        for (int q = 0; q < 4; ++q) { const float v = SCN[q * 128 + c]; tot += v; if (q < tq) pre += v; }
        if (tq == 0) WLs[c] = __expf(tot);
        float at8[8], bh8[8], kh8[8], vv8[8];
#pragma unroll
        for (int i = 0; i < 8; ++i) {
            const int t = 8 * tq + i;
            const float cum = pre + cl[i];
            const float W = __expf(cum), Wp = __expf(cum - lw[i]), iW = __expf(-cum);
            const float r = ur[i + 1] + mur * (ur[i] - ur[i + 1]), k = uk[i + 1] + muk * (uk[i] - uk[i + 1]), v = uv[i + 1] + muv * (uv[i] - uv[i + 1]);
            const float ar = sigmoidf_(ALb[t * 128 + c]);
            const float kk = k * kkw;
            const float ss = wave_sum(kk * kk);
            const float kkn = kk / fmaxf(sqrtf(ss), 1e-12f);
            const float kmod = k * (1.f + (ar - 1.f) * kaw);
            const float bon = wave_sum(r * kmod * rkw);
            const float at = -kkn * Wp, bh = kkn * ar * iW, kh = kmod * iW, rt = r * W;
            AT[t * NS + c64] = f2bf(at); BH[t * NS + c64] = f2bf(bh); KH[t * NS + c64] = f2bf(kh); RT[t * NS + c64] = f2bf(rt);
            at8[i] = at; bh8[i] = bh; kh8[i] = kh; vv8[i] = v;
            G.BV[(size_t)(tok0 + t) * 256 + cg] = f2bf(bon * v);
        }
        u32x4 o;
        o.x = pk2(at8[0], at8[1]); o.y = pk2(at8[2], at8[3]); o.z = pk2(at8[4], at8[5]); o.w = pk2(at8[6], at8[7]); *(u32x4*)(ATt + c64 * TS + 8 * tq) = o;
        o.x = pk2(bh8[0], bh8[1]); o.y = pk2(bh8[2], bh8[3]); o.z = pk2(bh8[4], bh8[5]); o.w = pk2(bh8[6], bh8[7]); *(u32x4*)(BHt + c64 * TS + 8 * tq) = o;
        o.x = pk2(kh8[0], kh8[1]); o.y = pk2(kh8[2], kh8[3]); o.z = pk2(kh8[4], kh8[5]); o.w = pk2(kh8[6], kh8[7]); *(u32x4*)(KHt + c64 * TS + 8 * tq) = o;
        o.x = pk2(vv8[0], vv8[1]); o.y = pk2(vv8[2], vv8[3]); o.z = pk2(vv8[4], vv8[5]); o.w = pk2(vv8[6], vv8[7]); *(u32x4*)(Vt + c64 * TS + 8 * tq) = o;
    }
    __syncthreads();
    asm volatile("" : "+v"(tid)); const int lane = tid & 63, fr = lane & 15, fq = lane >> 4;
    const int hd = wv >> 2, wg = wv & 3, h = hp * 2 + hd; const size_t ch = (size_t)cid * 4 + h;
    unsigned char* hb = lds + RB_BASE + hd * RB_HEAD; unsigned char* cb = lds + hd * RC_HEAD;
    const bf16_t *AT = (const bf16_t*)(hb + RB_AT), *BH = (const bf16_t*)(hb + RB_BH), *KH = (const bf16_t*)(hb + RB_KH), *RT = (const bf16_t*)(hb + RB_RT);
    const bf16_t *ATt = (const bf16_t*)(hb + RB_ATT), *BHt = (const bf16_t*)(hb + RB_BHT), *KHt = (const bf16_t*)(hb + RB_KHT), *Vt = (const bf16_t*)(hb + RB_VT);
    float* Mab = (float*)(cb + RC_MAB);
    bf16_t *Mak = (bf16_t*)(cb + RC_MAK), *Mrb = (bf16_t*)(cb + RC_MRB), *Mrk = (bf16_t*)(cb + RC_MRK), *Tm = (bf16_t*)(cb + RC_TM), *MakVt = (bf16_t*)(cb + RC_MAKVT), *GT = (bf16_t*)(cb + RC_GT), *U0T = (bf16_t*)(cb + RC_U0T);
    const f32x4 z4 = {0.f, 0.f, 0.f, 0.f};
    {
        const bf16_t* rowsrc = (wg >> 1) ? RT : AT; const bf16_t* colsrc = (wg & 1) ? KH : BH;
        bf16_t* Mo = wg == 1 ? Mak : (wg == 2 ? Mrb : Mrk);
#pragma unroll
        for (int tt = 0; tt < 2; ++tt)
#pragma unroll
            for (int st = 0; st < 2; ++st) {
                f32x4 acc = MFMA16(ldf(colsrc, 16 * st + fr, NS, 8 * fq), ldf(rowsrc, 16 * tt + fr, NS, 8 * fq), z4);
                acc = MFMA16(ldf(colsrc, 16 * st + fr, NS, 32 + 8 * fq), ldf(rowsrc, 16 * tt + fr, NS, 32 + 8 * fq), acc);
                const int t = 16 * tt + fr, s0 = 16 * st + 4 * fq, lim = (wg >> 1) ? t + 1 : t;
                acc.x = (s0 + 0 < lim) ? acc.x : 0.f; acc.y = (s0 + 1 < lim) ? acc.y : 0.f; acc.z = (s0 + 2 < lim) ? acc.z : 0.f; acc.w = (s0 + 3 < lim) ? acc.w : 0.f;
                if (wg == 0) *(f32x4*)(Mab + t * MABS + s0) = acc; else *(u32x2*)(Mo + t * TS + s0) = pk4(acc);
            }
    }
    __syncthreads();
    const float* WL = (const float*)(lds + R_WLS) + hd * 64;
    if (wg == 0) {
        {
            const int j = lane & 31;
            float Tc[32];
#pragma unroll
            for (int t = 0; t < 32; ++t) {
                float a0 = (t == j) ? 1.f : 0.f, a1 = 0.f;
#pragma unroll
                for (int s2 = 0; s2 + 1 < t; s2 += 2) { a0 += Mab[t * MABS + s2] * Tc[s2]; a1 += Mab[t * MABS + s2 + 1] * Tc[s2 + 1]; }
                if (t & 1) a0 += Mab[t * MABS + t - 1] * Tc[t - 1];
                Tc[t] = a0 + a1;
            }
            if (lane < 32) {
#pragma unroll
                for (int t = 0; t < 32; ++t) Tm[t * TS + j] = f2bf(Tc[t]);
            }
        }
        __syncthreads();
#pragma unroll
        for (int rt = 0; rt < 2; ++rt)
#pragma unroll
            for (int tt = 0; tt < 2; ++tt) {
                const f32x4 acc = MFMA16(ldf(Tm, 16 * tt + fr, TS, 8 * fq), ldf(ATt, 16 * rt + fr, TS, 8 * fq), z4);
                *(u32x2*)(GT + (16 * rt + fr) * TS + 16 * tt + 4 * fq) = pk4(acc);
            }
        __syncthreads();
#pragma unroll
        for (int tt = 0; tt < 2; ++tt)
#pragma unroll
            for (int kt = 0; kt < 4; ++kt) {
                f32x4 acc = MFMA16(ldf(GT, 16 * kt + fr, TS, 8 * fq), ldf(Mrb, 16 * tt + fr, TS, 8 * fq), z4);
                const int t = 16 * tt + fr, k0 = 16 * kt + 4 * fq;
                const u32x2 rr = *(const u32x2*)(RT + t * NS + k0);
                acc.x += __uint_as_float(rr.x << 16); acc.y += __uint_as_float(rr.x & 0xffff0000u); acc.z += __uint_as_float(rr.y << 16); acc.w += __uint_as_float(rr.y & 0xffff0000u);
                *(u32x2*)(G.ZZ + ch * 2048 + t * 64 + k0) = pk4(acc);
            }
    } else if (wg == 1) {
#pragma unroll
        for (int vt = 0; vt < 4; ++vt)
#pragma unroll
            for (int tt = 0; tt < 2; ++tt) {
                const f32x4 acc = MFMA16(ldf(Mak, 16 * tt + fr, TS, 8 * fq), ldf(Vt, 16 * vt + fr, TS, 8 * fq), z4);
                *(u32x2*)(MakVt + (16 * vt + fr) * TS + 16 * tt + 4 * fq) = pk4(acc);
            }
        __syncthreads();
#pragma unroll
        for (int rt = 2; rt < 4; ++rt)
#pragma unroll
            for (int tt = 0; tt < 2; ++tt) {
                const f32x4 acc = MFMA16(ldf(Tm, 16 * tt + fr, TS, 8 * fq), ldf(ATt, 16 * rt + fr, TS, 8 * fq), z4);
                *(u32x2*)(GT + (16 * rt + fr) * TS + 16 * tt + 4 * fq) = pk4(acc);
            }
        __syncthreads();
#pragma unroll
        for (int kp = 0; kp < 4; ++kp)
#pragma unroll
            for (int kt = 0; kt < 4; ++kt) {
                f32x4 acc = MFMA16(ldf(GT, 16 * kt + fr, TS, 8 * fq), ldf(BHt, 16 * kp + fr, TS, 8 * fq), z4);
                const int kq = 16 * kp + fr, k0 = 16 * kt + 4 * fq; const float wl = WL[kq];
                acc.x = (acc.x + (k0 + 0 == kq ? 1.f : 0.f)) * wl; acc.y = (acc.y + (k0 + 1 == kq ? 1.f : 0.f)) * wl; acc.z = (acc.z + (k0 + 2 == kq ? 1.f : 0.f)) * wl; acc.w = (acc.w + (k0 + 3 == kq ? 1.f : 0.f)) * wl;
                *(u32x2*)(G.PT + ch * 4096 + kq * 64 + k0) = pk4(acc);
            }
    } else if (wg == 2) {
        f32x4 y0acc[2][4];
#pragma unroll
        for (int tt = 0; tt < 2; ++tt)
#pragma unroll
            for (int vt = 0; vt < 4; ++vt) y0acc[tt][vt] = MFMA16(ldf(Vt, 16 * vt + fr, TS, 8 * fq), ldf(Mrk, 16 * tt + fr, TS, 8 * fq), z4);
        __syncthreads();
#pragma unroll
        for (int rt = 0; rt < 2; ++rt)
#pragma unroll
            for (int tt = 0; tt < 2; ++tt) {
                const f32x4 acc = MFMA16(ldf(Tm, 16 * tt + fr, TS, 8 * fq), ldf(MakVt, 16 * rt + fr, TS, 8 * fq), z4);
                *(u32x2*)(U0T + (16 * rt + fr) * TS + 16 * tt + 4 * fq) = pk4(acc);
            }
        __syncthreads();
#pragma unroll
        for (int tt = 0; tt < 2; ++tt)
#pragma unroll
            for (int vt = 0; vt < 4; ++vt) {
                const f32x4 acc = MFMA16(ldf(U0T, 16 * vt + fr, TS, 8 * fq), ldf(Mrb, 16 * tt + fr, TS, 8 * fq), y0acc[tt][vt]);
                *(u32x2*)(G.Y0 + ch * 2048 + (16 * tt + fr) * 64 + 16 * vt + 4 * fq) = pk4(acc);
            }
    } else {
        f32x4 qacc[4][4];
#pragma unroll
        for (int vt = 0; vt < 4; ++vt)
#pragma unroll
            for (int kt = 0; kt < 4; ++kt) qacc[vt][kt] = MFMA16(ldf(KHt, 16 * kt + fr, TS, 8 * fq), ldf(Vt, 16 * vt + fr, TS, 8 * fq), z4);
        __syncthreads();
#pragma unroll
        for (int rt = 2; rt < 4; ++rt)
#pragma unroll
            for (int tt = 0; tt < 2; ++tt) {
                const f32x4 acc = MFMA16(ldf(Tm, 16 * tt + fr, TS, 8 * fq), ldf(MakVt, 16 * rt + fr, TS, 8 * fq), z4);
                *(u32x2*)(U0T + (16 * rt + fr) * TS + 16 * tt + 4 * fq) = pk4(acc);
            }
        __syncthreads();
#pragma unroll
        for (int vt = 0; vt < 4; ++vt)
#pragma unroll
            for (int kt = 0; kt < 4; ++kt) {
                f32x4 acc = MFMA16(ldf(BHt, 16 * kt + fr, TS, 8 * fq), ldf(U0T, 16 * vt + fr, TS, 8 * fq), qacc[vt][kt]);
                const f32x4 wl = *(const f32x4*)(WL + 16 * kt + 4 * fq);
                acc *= wl;
                *(u32x2*)(G.QQ + ch * 4096 + (16 * vt + fr) * 64 + 16 * kt + 4 * fq) = pk4(acc);
            }
    }
    __syncthreads();
}

__device__ __forceinline__ void rwkv_chain(int sq, int h, int wg, const float* __restrict__ state_in, const RwkvG& G, float* __restrict__ st_p, float* __restrict__ st_s) {
    int tid_ = threadIdx.x; asm volatile("" : "+v"(tid_));
    const int lane = tid_ & 63, fr = lane & 15, fq = lane >> 4, j0 = 16 * wg;
    const Seq s = seq_of(sq);
    const int nc = s.L / 32, cid0 = s.base / 32;
    f32x4 acc[4];
    if (s.sample) {
#pragma unroll
        for (int it = 0; it < 4; ++it) acc[it] = *(const f32x4*)(state_in + (((size_t)s.b * 4 + h) * 64 + j0 + fr) * 64 + 16 * it + 4 * fq);
    } else {
#pragma unroll
        for (int it = 0; it < 4; ++it) acc[it] = (f32x4){0.f, 0.f, 0.f, 0.f};
    }
    u32x2 pa[4][2][2], qv[4];
    {
        const size_t ch = (size_t)cid0 * 4 + h;
#pragma unroll
        for (int it = 0; it < 4; ++it) {
            qv[it] = *(const u32x2*)(G.QQ + ch * 4096 + (j0 + fr) * 64 + 16 * it + 4 * fq);
#pragma unroll
            for (int ks = 0; ks < 2; ++ks) { const bf16_t* p = G.PT + ch * 4096 + (16 * it + fr) * 64 + 32 * ks + 4 * fq; pa[it][ks][0] = *(const u32x2*)p; pa[it][ks][1] = *(const u32x2*)(p + 16); }
        }
    }
    for (int c = 0; c < nc; ++c) {
        const size_t ch = (size_t)(cid0 + c) * 4 + h;
        union { u32x4 u; bf16x8 v; } bs[2];
#pragma unroll
        for (int it = 0; it < 4; ++it) *(u32x2*)(G.SC + ch * 4096 + (j0 + fr) * 64 + 16 * it + 4 * fq) = pk4(acc[it]);
        { const u32x2 a = pk4(acc[0]), b = pk4(acc[1]), c2 = pk4(acc[2]), d = pk4(acc[3]); bs[0].u = (u32x4){a.x, a.y, b.x, b.y}; bs[1].u = (u32x4){c2.x, c2.y, d.x, d.y}; }
        union { u32x4 u; bf16x8 v; } fa[4][2];
#pragma unroll
        for (int it = 0; it < 4; ++it) {
            acc[it] = (f32x4){__uint_as_float(qv[it].x << 16), __uint_as_float(qv[it].x & 0xffff0000u), __uint_as_float(qv[it].y << 16), __uint_as_float(qv[it].y & 0xffff0000u)};
#pragma unroll
            for (int ks = 0; ks < 2; ++ks) fa[it][ks].u = (u32x4){pa[it][ks][0].x, pa[it][ks][0].y, pa[it][ks][1].x, pa[it][ks][1].y};
        }
        if (c + 1 < nc) {
            const size_t cn = ch + 4;
#pragma unroll
            for (int it = 0; it < 4; ++it) {
                qv[it] = *(const u32x2*)(G.QQ + cn * 4096 + (j0 + fr) * 64 + 16 * it + 4 * fq);
#pragma unroll
                for (int ks = 0; ks < 2; ++ks) { const bf16_t* p = G.PT + cn * 4096 + (16 * it + fr) * 64 + 32 * ks + 4 * fq; pa[it][ks][0] = *(const u32x2*)p; pa[it][ks][1] = *(const u32x2*)(p + 16); }
            }
        }
#pragma unroll
        for (int it = 0; it < 4; ++it) { acc[it] = MFMA16(fa[it][0].v, bs[0].v, acc[it]); acc[it] = MFMA16(fa[it][1].v, bs[1].v, acc[it]); }
    }
    float* o = (s.sample ? st_s : st_p) + (((size_t)s.b * 4 + h) * 64 + j0 + fr) * 64 + 4 * fq;
#pragma unroll
    for (int it = 0; it < 4; ++it) *(f32x4*)(o + 16 * it) = acc[it];
}

__device__ __forceinline__ void rwkv_out(int wi, const RwkvW& w, const RwkvG& G, bf16_t* __restrict__ YMIX) {
    int tid_ = threadIdx.x; asm volatile("" : "+v"(tid_));
    const int lane = tid_ & 63, fr = lane & 15, fq = lane >> 4;
    const size_t ch = (size_t)(wi >> 1); const int tt = wi & 1, h = (int)(ch & 3), cid = (int)(ch >> 2);
    const int t = 16 * tt + fr, tok = cid * 32 + t;
    const bf16_t* zp = G.ZZ + ch * 2048 + t * 64 + 8 * fq;
    const bf16x8 z0 = *(const bf16x8*)zp, z1 = *(const bf16x8*)(zp + 32);
    f32x4 y[4]; float sum = 0.f;
#pragma unroll
    for (int vt = 0; vt < 4; ++vt) {
        const bf16_t* sp = G.SC + ch * 4096 + (16 * vt + fr) * 64 + 8 * fq;
        const u32x2 y0 = *(const u32x2*)(G.Y0 + ch * 2048 + t * 64 + 16 * vt + 4 * fq);
        f32x4 acc = {__uint_as_float(y0.x << 16), __uint_as_float(y0.x & 0xffff0000u), __uint_as_float(y0.y << 16), __uint_as_float(y0.y & 0xffff0000u)};
        acc = MFMA16(*(const bf16x8*)sp, z0, acc); acc = MFMA16(*(const bf16x8*)(sp + 32), z1, acc);
        y[vt] = acc; sum += (acc.x + acc.y) + (acc.z + acc.w);
    }
    sum += __shfl_xor(sum, 16); sum += __shfl_xor(sum, 32);
    const float mean = sum * (1.f / 64.f); float var = 0.f;
#pragma unroll
    for (int vt = 0; vt < 4; ++vt) { y[vt] -= mean; var += (y[vt].x * y[vt].x + y[vt].y * y[vt].y) + (y[vt].z * y[vt].z + y[vt].w * y[vt].w); }
    var += __shfl_xor(var, 16); var += __shfl_xor(var, 32);
    const float rstd = rsqrtf(var * (1.f / 64.f) + 64e-5f);
#pragma unroll
    for (int vt = 0; vt < 4; ++vt) {
        const int c = h * 64 + 16 * vt + 4 * fq;
        const f32x4 gg = *(const f32x4*)(w.gn_g + c), gb = *(const f32x4*)(w.gn_b + c);
        const u32x2 bv = *(const u32x2*)(G.BV + (size_t)tok * 256 + c), gt = *(const u32x2*)(G.GATE + (size_t)tok * 256 + c);
        f32x4 o = y[vt] * rstd * gg + gb;
        o.x = (o.x + __uint_as_float(bv.x << 16)) * __uint_as_float(gt.x << 16); o.y = (o.y + __uint_as_float(bv.x & 0xffff0000u)) * __uint_as_float(gt.x & 0xffff0000u);
        o.z = (o.z + __uint_as_float(bv.y << 16)) * __uint_as_float(gt.y << 16); o.w = (o.w + __uint_as_float(bv.y & 0xffff0000u)) * __uint_as_float(gt.y & 0xffff0000u);
        *(u32x2*)(YMIX + (size_t)tok * DM + 256 + c) = pk4(o);
    }
}

template <class E2> struct EpiAdapt {
    static constexpr bool PERM = true, AFTER_DRAIN = false; E2 e;
    __device__ __forceinline__ void operator()(const pg8::f32x4 (&acc)[2][2][4][2], const pg8::Unit& u, int wr, int wc, int fr, int fq) const {
#pragma unroll
        for (int ai = 0; ai < 2; ++ai)
#pragma unroll
            for (int m = 0; m < 4; ++m) {
                const int row = u.pm * 256 + ai * 128 + wr * 64 + m * 16 + fr;
                const float rs = e.rowscale(row);
                e(row, u.pn * 256 + wc * 32 + 8 * fq, acc[ai][0][m][0], acc[ai][0][m][1], acc[ai][1][m][0], acc[ai][1][m][1], rs);
            }
    }
};

constexpr int LDS_BYTES = 147456;
struct MP { const float* in[35]; float* out; unsigned char* ws; int ph_lo, ph_hi; };
#define LAS __attribute__((address_space(3)))
__global__ void __launch_bounds__(512, 2) mega(MP p) {
    extern __shared__ __attribute__((aligned(16))) unsigned char lds[];
    cg::grid_group grid = cg::this_grid();
    const float* const* in = p.in; float* out = p.out; unsigned char* ws = p.ws;
    bf16_t* WIN = (bf16_t*)(ws + WS_WIN); bf16_t* WOUT = (bf16_t*)(ws + WS_WOUT); bf16_t* WGU = (bf16_t*)(ws + WS_WGU); bf16_t* WD = (bf16_t*)(ws + WS_WD);
    bf16_t* XB = (bf16_t*)(ws + WS_XB); bf16_t* YMIX = (bf16_t*)(ws + WS_YMIX); float* RSS = (float*)(ws + WS_RSS);
    bf16_t* PROJ = (bf16_t*)(ws + WS_PROJ); bf16_t* H = (bf16_t*)(ws + WS_H);
    const int lo = p.ph_lo, hi = p.ph_hi;
    int tid = threadIdx.x, half = tid >> 8;
#define FRESH() do { asm volatile("" : "+v"(tid)); half = tid >> 8; } while (0)
#ifndef TESTPH
#define TESTPH -1
#endif
#define IN(k) ((TESTPH < 0 || TESTPH == ((k) > 8 ? (k) - 8 : (k))) && lo <= (k) && (k) < hi)
#define SEAM(k) do { if (IN((k) + 1)) grid.sync(); } while (0)
    if (IN(0)) {
        FRESH();
        float* smh = (float*)lds + half * 1088;
        for (int l = 0; l < 2; ++l) {
            for (int i = blockIdx.x; i < (NIN / 32) * (DM / 32) / 2; i += gridDim.x) { const int vb = 2 * i + half; d_transpose(smh, vb % (NIN / 32), vb / (NIN / 32), in[9] + (size_t)l * DM * NIN, DM, NIN, WIN + (size_t)l * NINP * DM, in[8] + l * DM, NIN, 0, 0); __syncthreads(); }
            for (int i = blockIdx.x; i < (DM / 32) * (DM / 32) / 2; i += gridDim.x) { const int vb = 2 * i + half; d_transpose(smh, vb % (DM / 32), vb / (DM / 32), in[30] + (size_t)l * DM * DM, DM, DM, WOUT + (size_t)l * DM * DM, nullptr, DM, 0, 0); __syncthreads(); }
            for (int i = blockIdx.x; i < (DFF / 32) * (DM / 32) / 2; i += gridDim.x) { const int vb = 2 * i + half; d_transpose(smh, vb % (DFF / 32), vb / (DFF / 32), in[32] + (size_t)l * DM * DFF, DM, DFF, WGU + (size_t)l * 2 * DFF * DM, in[31] + l * DM, 4, 8, 0); __syncthreads(); }
            for (int i = blockIdx.x; i < (DFF / 32) * (DM / 32) / 2; i += gridDim.x) { const int vb = 2 * i + half; d_transpose(smh, vb % (DFF / 32), vb / (DFF / 32), in[33] + (size_t)l * DM * DFF, DM, DFF, WGU + (size_t)l * 2 * DFF * DM, in[31] + l * DM, 4, 8, 4); __syncthreads(); }
            for (int i = blockIdx.x; i < (DM / 32) * (DFF / 32) / 2; i += gridDim.x) { const int vb = 2 * i + half; d_transpose(smh, vb % (DM / 32), vb / (DM / 32), in[34] + (size_t)l * DFF * DM, DFF, DM, WD + (size_t)l * DM * DFF, nullptr, DM, 0, 0); __syncthreads(); }
        }
        {
            bf16_t* LWT = (bf16_t*)(ws + WS_LWT);
            for (int i = blockIdx.x * 512 + tid; i < 2 * 256 * 128; i += gridDim.x * 512) {
                const int l2 = i >> 15, c = (i >> 7) & 255, j = i & 127;
                const float v = j < 32 ? in[16][((size_t)l2 * 32 + j) * 256 + c] : (j < 64 ? in[18][((size_t)l2 * 32 + (j - 32)) * 256 + c] : in[19][((size_t)l2 * 64 + (j - 64)) * 256 + c]);
                LWT[i] = f2bf(v);
            }
        }
        for (int i = blockIdx.x; i < T / 8; i += gridDim.x) d_xprep(i * 8 + (tid >> 6), in[0], in[1], XB, RSS);
        SEAM(0);
    }
    for (int l = 0; l < 2; ++l) {
        const int pb = 1 + 8 * l;
        if (IN(pb + 0)) {
            pg8::Gemm g{XB, WIN + (size_t)l * NINP * DM, T, NINP, DM}; pg8::StaticOrder S; S.init(T, NINP, gridDim.x, (int)blockIdx.x);
            EpiAdapt<EpiProj> E{EpiProj{PROJ, RSS}};
            pg8::gemm_phase<EpiAdapt<EpiProj>, pg8::StaticOrder, true, true>((LAS unsigned char*)lds, g, S, E);
            SEAM(pb + 0);
        }
        const RwkvW rw{in[14] + l * 896, in[15] + l * 256, in[16] + l * 32 * 256, in[17] + l * 256, in[18] + l * 32 * 256, in[19] + l * 64 * 256, in[20] + l * 256, in[21] + l * 256, in[22] + l * 256, in[23] + l * 256, in[24] + l * 256};
        const RwkvG rg{(bf16_t*)(ws + WS_PT), (bf16_t*)(ws + WS_QQ), (bf16_t*)(ws + WS_ZZ), (bf16_t*)(ws + WS_Y0), (bf16_t*)(ws + WS_SC), (bf16_t*)(ws + WS_GATE), (bf16_t*)(ws + WS_BV), (const bf16_t*)(ws + WS_LWT)};
        if (IN(pb + 1)) {
            FRESH();
            for (int it = blockIdx.x; it < 2 * NCH; it += gridDim.x) rwkv_item(lds, it, l, PROJ, in[4] + (size_t)l * 16 * 896, rw, rg);
            for (int i = blockIdx.x * 512 + tid; i < 20 * 896; i += gridDim.x * 512) {
                const int sq = i / 896, c = i - sq * 896; const Seq sx = seq_of(sq);
                const float v = bf2f(PROJ[(size_t)(sx.base + sx.L - 1) * NINP + C_B + c]);
                if (sx.sample) out[O_SHIFT_S + ((size_t)l * 16 + sx.b) * 896 + c] = v; else out[O_SHIFT_P + ((size_t)l * 4 + sx.b) * 896 + c] = v;
            }
            SEAM(pb + 1);
        }
        if (IN(pb + 2)) {
            FRESH();
            if (blockIdx.x < 40) {
                const int wv = tid >> 6; int sq, h;
                if (blockIdx.x < 8) { const int bh = blockIdx.x * 2 + (wv >> 2); sq = bh >> 2; h = bh & 3; }
                else { const int idx = (blockIdx.x - 8) * 2 + (wv >> 2); sq = 4 + (idx >> 2); h = idx & 3; }
                rwkv_chain(sq, h, wv & 3, in[3] + (size_t)l * 16 * 4 * 4096, rg, out + O_RWKV_P + (size_t)l * 4 * 4 * 4096, out + O_RWKV_S + (size_t)l * 16 * 4 * 4096);
            } else {
                const int nb2 = gridDim.x - 40, b2 = blockIdx.x - 40;
                const AttnP ap{PROJ, in[6] + (size_t)l * 16 * 128 * 128, in[7] + (size_t)l * 16 * 128 * 128, in[27] + l * 64, in[28] + l * 64, in[29] + l * 4, YMIX,
                               out + O_K_P + (size_t)l * 4 * 128 * 128, out + O_K_S + (size_t)l * 16 * 128 * 128, out + O_V_P + (size_t)l * 4 * 128 * 128, out + O_V_S + (size_t)l * 16 * 128 * 128};
                for (int u = b2; u < 544; u += nb2) attn_unit(lds, u, ap);
                const ConvPoolP cp{PROJ, in[2] + (size_t)l * 16 * 30 * 256, in[10] + l * 31 * 256, in[11] + l * 256, in[12] + l * 256, in[13] + l * 256, in[5] + (size_t)l * 16 * 15 * 256, in[25] + (size_t)l * 4 * 64 * 64, in[26] + l * 256, YMIX,
                                   out + O_CONV_P + (size_t)l * 4 * 30 * 256, out + O_CONV_S + (size_t)l * 16 * 30 * 256, out + O_POOL_P + (size_t)l * 4 * 15 * 256, out + O_POOL_S + (size_t)l * 16 * 15 * 256};
                for (int i = b2; i < 528; i += nb2) convpool_tile((float*)lds + half * (62 * 256), 2 * i + half, cp);
            }
            SEAM(pb + 2);
        }
        if (IN(pb + 3)) {
            FRESH();
            for (int wi = blockIdx.x * 8 + (tid >> 6); wi < 2 * NCHH; wi += gridDim.x * 8) rwkv_out(wi, rw, rg, YMIX);
            SEAM(pb + 3);
        }
        if (IN(pb + 4)) {
            pg8::Gemm g{YMIX, WOUT + (size_t)l * DM * DM, T, DM, DM}; pg8::StaticOrder S; S.init(T, DM, gridDim.x, (int)blockIdx.x);
            EpiAdapt<EpiRes> E{l == 0 ? EpiRes{in[0], in[1], out, XB, RSS} : EpiRes{out, out + (size_t)T_P * DM, out, XB, RSS}};
            pg8::gemm_phase<EpiAdapt<EpiRes>, pg8::StaticOrder, true, true>((LAS unsigned char*)lds, g, S, E);
            SEAM(pb + 4);
        }
        if (IN(pb + 5)) {
            pg8::Gemm g{XB, WGU + (size_t)l * 2 * DFF * DM, T, 2 * DFF, DM}; pg8::StaticOrder S; S.init(T, 2 * DFF, gridDim.x, (int)blockIdx.x);
            EpiAdapt<EpiGU> E{EpiGU{H, RSS}};
            pg8::gemm_phase<EpiAdapt<EpiGU>, pg8::StaticOrder, true, true>((LAS unsigned char*)lds, g, S, E);
            SEAM(pb + 5);
        }
        if (IN(pb + 6)) {
            pg8::Gemm g{H, WD + (size_t)l * DM * DFF, T, DM, DFF}; pg8::StaticOrder S; S.init(T, DM, gridDim.x, (int)blockIdx.x);
            EpiAdapt<EpiRes> E{EpiRes{out, out + (size_t)T_P * DM, out, XB, RSS}};
            pg8::gemm_phase<EpiAdapt<EpiRes>, pg8::StaticOrder, true, true>((LAS unsigned char*)lds, g, S, E);
            if (l == 0) SEAM(pb + 7);
        }
    }
}

static void launch_mega(MP p, int lo, int hi, int grid_blocks, hipStream_t stream) {
    p.ph_lo = lo; p.ph_hi = hi;
    void* args[] = {&p};
    hipError_t e = hipLaunchCooperativeKernel((const void*)mega, dim3(grid_blocks), dim3(512), args, LDS_BYTES, stream);
    if (e != hipSuccess) fprintf(stderr, "cooperative launch failed: %s (grid %d)\n", hipGetErrorString(e), grid_blocks);
}
extern "C" void kernel_launch(void* const* d_in, const int* in_sizes, int n_in, void* d_out, int out_size, void* d_ws, size_t ws_size, hipStream_t stream) {
    static int grid_blocks = 0;
    if (grid_blocks == 0) {
        if (n_in != 35 || (size_t)out_size != O_END || ws_size < WS_END) { fprintf(stderr, "kernel_launch: unexpected sizes n_in %d out %d ws %zu (need %zu)\n", n_in, out_size, ws_size, (size_t)WS_END); grid_blocks = -1; return; }
        int dev = 0, cus = 0, per_cu = 0;
        (void)hipGetDevice(&dev);
        (void)hipDeviceGetAttribute(&cus, hipDeviceAttributeMultiprocessorCount, dev);
        (void)hipFuncSetAttribute((const void*)mega, hipFuncAttributeMaxDynamicSharedMemorySize, LDS_BYTES);
        (void)hipOccupancyMaxActiveBlocksPerMultiprocessor(&per_cu, mega, 512, LDS_BYTES);
        if (per_cu < 1) { fprintf(stderr, "kernel_launch: occupancy query says %d blocks per CU\n", per_cu); grid_blocks = -1; return; }
        grid_blocks = cus;
    }
    if (grid_blocks < 0) return;
    const float* const* in = (const float* const*)d_in;
    float* out = (float*)d_out; unsigned char* ws = (unsigned char*)d_ws;
    MP p{};
    for (int i = 0; i < 35; ++i) p.in[i] = in[i];
    p.out = out; p.ws = ws;
    launch_mega(p, 0, 16, grid_blocks, stream);
}
```

```cpp
#include <hip/hip_runtime.h>
#include <hip/hip_cooperative_groups.h>
namespace cg = cooperative_groups;
#include <cstdint>
#include <cstdio>

typedef unsigned short bf16_t;
typedef short bf16x8 __attribute__((ext_vector_type(8)));
typedef float f32x4 __attribute__((ext_vector_type(4)));
typedef unsigned u32x4 __attribute__((ext_vector_type(4)));
typedef unsigned u32x2 __attribute__((ext_vector_type(2)));

constexpr int T_P = 16384, T_S = 512, T = 16896, DM = 1024;
constexpr int NIN = 2176, NINP = 2304, DFF = 2816;
constexpr int C_A = 0, C_B = 512, C_C = 1408, C_Q = 1664, C_K = 1920, C_V = 2048;

constexpr size_t O_Y = 0, O_CONV_P = 17301504, O_CONV_S = 17362944, O_RWKV_P = 17608704, O_RWKV_S = 17739776,
                 O_SHIFT_P = 18264064, O_SHIFT_S = 18271232, O_POOL_P = 18299904, O_POOL_S = 18330624,
                 O_K_P = 18453504, O_K_S = 18584576, O_V_P = 19108864, O_V_S = 19239936, O_END = 19764224;

constexpr size_t WS_CTL = 0;
constexpr size_t WS_WIN = 16384;
constexpr size_t WS_WOUT = WS_WIN + 2ull * NINP * DM * 2;
constexpr size_t WS_WGU = WS_WOUT + 2ull * DM * DM * 2;
constexpr size_t WS_WD = WS_WGU + 2ull * 2 * DFF * DM * 2;
constexpr size_t WS_LWT = WS_WD + 2ull * DM * DFF * 2;
constexpr size_t WS_XB = WS_LWT + 2ull * 256 * 128 * 2;
constexpr size_t WS_YMIX = WS_XB + (size_t)T * DM * 2;
constexpr size_t WS_RSS = WS_YMIX + (size_t)T * DM * 2;
constexpr size_t WS_R = WS_RSS + (size_t)T * 32 * 4;
constexpr size_t WS_PROJ = WS_R;
constexpr size_t WS_H = WS_R;
constexpr size_t WS_RW = WS_PROJ + (size_t)T * NINP * 2;
constexpr int NCH = T / 32, NCHH = NCH * 4;
constexpr size_t WS_PT = WS_RW;
constexpr size_t WS_QQ = WS_PT + (size_t)NCHH * 4096 * 2;
constexpr size_t WS_ZZ = WS_QQ + (size_t)NCHH * 4096 * 2;
constexpr size_t WS_Y0 = WS_ZZ + (size_t)NCHH * 2048 * 2;
constexpr size_t WS_SC = WS_Y0 + (size_t)NCHH * 2048 * 2;
constexpr size_t WS_GATE = WS_SC + (size_t)NCHH * 4096 * 2;
constexpr size_t WS_BV = WS_GATE + (size_t)T * 256 * 2;
constexpr size_t WS_GLU = WS_BV + (size_t)T * 256 * 2;
constexpr size_t WS_PWT = WS_GLU + (size_t)T * 256 * 2;
constexpr size_t WS_RWEND = WS_PWT + 2ull * 4 * 64 * 64 * 2;
constexpr size_t RW_BF = (size_t)T * 256 * 2;
constexpr size_t WS_RW_R = WS_RWEND, WS_RW_K = WS_RW_R + RW_BF, WS_RW_V = WS_RW_R + 2 * RW_BF, WS_RW_A = WS_RW_R + 3 * RW_BF,
                 WS_RW_B = WS_RW_R + 4 * RW_BF, WS_RW_G = WS_RW_R + 5 * RW_BF, WS_RW_W = WS_RW_R + 6 * RW_BF;
constexpr size_t WS_END = WS_RWEND;

__device__ __forceinline__ float bf2f(bf16_t h) { return __uint_as_float((unsigned)h << 16); }
typedef __bf16 bf16x2_t __attribute__((ext_vector_type(2)));
typedef float f32x2 __attribute__((ext_vector_type(2)));
__device__ __forceinline__ unsigned pk2(float lo, float hi) { const f32x2 v = {lo, hi}; return __builtin_bit_cast(unsigned, __builtin_convertvector(v, bf16x2_t)); }
__device__ __forceinline__ u32x2 pk4(f32x4 v) { u32x2 o; o.x = pk2(v.x, v.y); o.y = pk2(v.z, v.w); return o; }
__device__ __forceinline__ bf16_t f2bf(float f) { return (bf16_t)(pk2(f, 0.f) & 0xffffu); }
__device__ __forceinline__ void unpack8(u32x4 v, float* f) {
    f[0] = __uint_as_float(v.x << 16); f[1] = __uint_as_float(v.x & 0xffff0000u); f[2] = __uint_as_float(v.y << 16); f[3] = __uint_as_float(v.y & 0xffff0000u);
    f[4] = __uint_as_float(v.z << 16); f[5] = __uint_as_float(v.z & 0xffff0000u); f[6] = __uint_as_float(v.w << 16); f[7] = __uint_as_float(v.w & 0xffff0000u);
}
__device__ __forceinline__ float wave_sum(float v) {
#pragma unroll
    for (int o = 1; o < 64; o <<= 1) v += __shfl_xor(v, o);
    return v;
}
__device__ __forceinline__ float sigmoidf_(float x) { return __builtin_amdgcn_rcpf(1.f + __expf(-x)); }

__device__ __forceinline__ void p0_item(const float* __restrict__ W, int K, int N, bf16_t* __restrict__ WT, const float* __restrict__ g, int grp, int stride, int off, float* scr, int item, int lane, bool glu_map = false) {
    const int nblk = N / 32, kb = item / nblk, nb = item - kb * nblk, k0 = 64 * kb, n0 = 32 * nb;
    float v[32];
#pragma unroll
    for (int i = 0; i < 32; ++i) v[i] = W[(size_t)(k0 + 2 * i + (lane >> 5)) * N + n0 + (lane & 31)];
#pragma unroll
    for (int i = 0; i < 32; ++i) { const int kk = 2 * i + (lane >> 5); scr[kk * 33 + (lane & 31)] = g ? v[i] * g[k0 + kk] : v[i]; }
    asm volatile("s_waitcnt lgkmcnt(0)" ::: "memory");
    const int c = lane & 7;
#pragma unroll
    for (int j = 0; j < 4; ++j) {
        const int n = n0 + (lane >> 3) + 8 * j; const float* sp = scr + (8 * c) * 33 + (n - n0);
        u32x4 o; o.x = pk2(sp[0], sp[33]); o.y = pk2(sp[2 * 33], sp[3 * 33]); o.z = pk2(sp[4 * 33], sp[5 * 33]); o.w = pk2(sp[6 * 33], sp[7 * 33]);
        int r = (n / grp) * stride + off + (n % grp);
        if (glu_map && n < 512) { const int n2 = n & 255; r = (n2 >> 2) * 8 + (n >> 8) * 4 + (n2 & 3); }
        *(u32x4*)(WT + (size_t)r * K + k0 + 8 * c) = o;
    }
    asm volatile("s_waitcnt lgkmcnt(0)" ::: "memory");
}

__device__ __forceinline__ void d_xprep(int row, const float* __restrict__ xp, const float* __restrict__ xs, bf16_t* __restrict__ XB, float* __restrict__ RSS) {
    const int lane = threadIdx.x & 63;
    const float* x = row < T_P ? xp + (size_t)row * DM : xs + (size_t)(row - T_P) * DM;
    float ss = 0.f;
#pragma unroll
    for (int j = 0; j < 4; ++j) {
        const f32x4 v = ((const f32x4*)x)[lane + 64 * j];
        ss += v.x * v.x + v.y * v.y + v.z * v.z + v.w * v.w;
        u32x2 o; o.x = pk2(v.x, v.y); o.y = pk2(v.z, v.w);
        *(u32x2*)(XB + (size_t)row * DM + (lane + 64 * j) * 4) = o;
    }
    ss = wave_sum(ss);
    if (lane < 16) RSS[(size_t)row * 16 + lane] = lane == 0 ? ss : 0.f;
}

__device__ __forceinline__ float rss_rstd(const float* RSS, int row) {
    float s = 0.f;
#pragma unroll
    for (int j = 0; j < 4; ++j) { const f32x4 v = ((const f32x4*)(RSS + (size_t)row * 16))[j]; s += (v.x + v.y) + (v.z + v.w); }
    return rsqrtf(s * (1.f / DM) + 1e-6f);
}
struct EpiProj {
    bf16_t* PROJ; const float* RSS; bf16_t* GLU;
    __device__ __forceinline__ float rowscale(int row) const { return rss_rstd(RSS, row); }
    __device__ __forceinline__ void one(int row, int col, f32x4 v0, f32x4 v1, float rs) const {
        v0 *= rs; v1 *= rs;
        if (col < 512) { const f32x4 gl = {v0.x * sigmoidf_(v1.x), v0.y * sigmoidf_(v1.y), v0.z * sigmoidf_(v1.z), v0.w * sigmoidf_(v1.w)}; *(u32x2*)(GLU + (size_t)row * 256 + (col >> 1)) = pk4(gl); }
        else { u32x4 o; o.x = pk2(v0.x, v0.y); o.y = pk2(v0.z, v0.w); o.z = pk2(v1.x, v1.y); o.w = pk2(v1.z, v1.w); *(u32x4*)(PROJ + (size_t)row * NINP + col) = o; }
    }
    __device__ __forceinline__ void operator()(int row, int col, f32x4 v0, f32x4 v1, f32x4 w0, f32x4 w1, float rs) const { one(row, col, v0, v1, rs); one(row, col + 128, w0, w1, rs); }
};
template <int SRC, bool WF32, bool WBF> struct EpiRes {
    const float* xin_p; const float* xin_s; float* xout; bf16_t* XB; float* RSS;
    __device__ __forceinline__ float rowscale(int) const { return 1.f; }
    __device__ __forceinline__ float half8(int row, int col, f32x4 v0, f32x4 v1) const {
        f32x4 a, b;
        if (SRC == 0) { const float* xi = (row < T_P ? xin_p + (size_t)row * DM : xin_s + (size_t)(row - T_P) * DM) + col; a = *(const f32x4*)(xi); b = *(const f32x4*)(xi + 4); }
        else { float f[8]; unpack8(*(const u32x4*)(XB + (size_t)row * DM + col), f); a = (f32x4){f[0], f[1], f[2], f[3]}; b = (f32x4){f[4], f[5], f[6], f[7]}; }
        a += v0; b += v1;
        if (WF32) { *(f32x4*)(xout + (size_t)row * DM + col) = a; *(f32x4*)(xout + (size_t)row * DM + col + 4) = b; }
        if (WBF) { u32x4 o; o.x = pk2(a.x, a.y); o.y = pk2(a.z, a.w); o.z = pk2(b.x, b.y); o.w = pk2(b.z, b.w); *(u32x4*)(XB + (size_t)row * DM + col) = o; }
        return (a.x * a.x + a.y * a.y) + (a.z * a.z + a.w * a.w) + (b.x * b.x + b.y * b.y) + (b.z * b.z + b.w * b.w);
    }
    __device__ __forceinline__ void operator()(int row, int col, f32x4 v0, f32x4 v1, f32x4 w0, f32x4 w1, float) const {
        float ss = half8(row, col, v0, v1);
        ss += half8(row, col + 128, w0, w1);
        if (WBF) {
            ss += __shfl_xor(ss, 16); ss += __shfl_xor(ss, 32);
            if ((threadIdx.x & 63) < 16) RSS[(size_t)row * 16 + (col >> 8) * 4 + ((col >> 5) & 3)] = ss;
        }
    }
};
struct EpiGU {
    bf16_t* H; const float* RSS;
    __device__ __forceinline__ float rowscale(int row) const { return rss_rstd(RSS, row); }
    __device__ __forceinline__ u32x2 gu(f32x4 g, f32x4 u, float rs) const {
        g *= rs; u *= rs;
        const float h0 = g.x * sigmoidf_(g.x) * u.x, h1 = g.y * sigmoidf_(g.y) * u.y, h2 = g.z * sigmoidf_(g.z) * u.z, h3 = g.w * sigmoidf_(g.w) * u.w;
        u32x2 o; o.x = pk2(h0, h1); o.y = pk2(h2, h3); return o;
    }
    __device__ __forceinline__ void operator()(int row, int col, f32x4 g0, f32x4 u0, f32x4 g1, f32x4 u1, float rs) const {
        *(u32x2*)(H + (size_t)row * DFF + (col >> 1)) = gu(g0, u0, rs);
        *(u32x2*)(H + (size_t)row * DFF + (col >> 1) + 64) = gu(g1, u1, rs);
    }
};

struct Seq { int base, L, b, sample, pos0; };
__device__ __forceinline__ Seq seq_of(int sq) { Seq s; if (sq < 4) { s.base = sq * 4096; s.L = 4096; s.b = sq; s.sample = 0; s.pos0 = 0; } else { s.b = sq - 4; s.base = T_P + s.b * 32; s.L = 32; s.sample = 1; s.pos0 = 1024; } return s; }

struct RwkvW { const float *mu, *w0, *w2, *a0, *a2, *g2, *k_k, *k_a, *r_k, *gn_g, *gn_b; };

namespace pg8 {
#define PG8_LAS __attribute__((address_space(3)))
typedef unsigned short bf16_t;
typedef short bf16x8 __attribute__((ext_vector_type(8)));
typedef float f32x4 __attribute__((ext_vector_type(4)));
typedef unsigned u32x4 __attribute__((ext_vector_type(4)));
constexpr int BM = 256, BK = 64, HALF = 128, HTB = HALF * BK * 2  , STAGE_BYTES = 8 * HTB, NXCD = 8, WGM = 8;

__host__ __device__ __forceinline__ int lds_byte(int r, int c) { const int st = (r >> 4) * 2 + (c >> 5), rr = r & 15, cc = c & 31, ob = rr * 64 + cc * 2; return st * 1024 + (ob ^ (((ob >> 9) & 1) << 5)); }
__host__ __device__ __forceinline__ void stage_rc(int b, int& R, int& C) { const int st = b / 1024, sb = b % 1024, swz = sb ^ (((sb >> 9) & 1) << 5); R = (st >> 1) * 16 + swz / 64; C = (st & 1) * 32 + (swz % 64) / 2; }
__host__ __device__ __forceinline__ int perm32(int rho) { const int n = rho >> 4, i = rho & 15; return 8 * (i >> 2) + 4 * n + (i & 3); }

struct Unit { int pm, pn; };
struct Gemm { const bf16_t* A; const bf16_t* Bt; int M, N, K; };

struct StaticOrder {
    int nM, nN, nwg, G, c;
    __host__ __device__ void init(int M, int N, int G_, int c_) { nM = M / BM; nN = N / BM; nwg = nM * nN; G = G_; c = c_; }
    __host__ __device__ bool next(int i, Unit& u) const {
        const long L = (long)i * G + c; if (L >= nwg) return false;
        int wgid = (int)L; { const int q = nwg / NXCD, r = nwg % NXCD, xcd = wgid % NXCD, off = wgid / NXCD; wgid = (xcd < r ? xcd * (q + 1) : r * (q + 1) + (xcd - r) * q) + off; }
        const int nig = WGM * nN, gid = wgid / nig, fm = gid * WGM, gsz = (nM - fm) < WGM ? (nM - fm) : WGM;
        u.pm = fm + ((wgid % nig) % gsz); u.pn = (wgid % nig) / gsz; return true;
    }
    __device__ __forceinline__ void a_ready(const Unit&) const {}
    __device__ __forceinline__ void done(const Unit&) const {}
};


template <class Epi, class Sched, bool ALIGN_EPI = false, bool SP2 = false>
__device__ __forceinline__ void gemm_phase(PG8_LAS unsigned char* lds, const Gemm g, const Sched& S, const Epi& E) {
    int tid_ = threadIdx.x; asm volatile("" : "+v"(tid_));
    const int tid = tid_, wid = __builtin_amdgcn_readfirstlane(tid >> 6), lane = tid & 63, wr = wid >> 2, wc = wid & 3, fr = lane & 15, fq = lane >> 4;
    const int K = g.K, nt = K / BK;
    unsigned voffA[2], voffB[2];
#pragma unroll
    for (int i = 0; i < 2; ++i) { int R, C; stage_rc(tid * 16 + i * 8192, R, C); const int Rb = Epi::PERM ? ((R & ~31) + perm32(R & 31)) : R;
        voffA[i] = (unsigned)(R * K + C) * 2u; voffB[i] = (unsigned)(Rb * K + C) * 2u; }
    const size_t kstep = (size_t)(BK * 2);
    const size_t hstep = (size_t)HALF * K * 2;
    const size_t tstep = 2 * hstep;
    const unsigned ldsw = (unsigned)wid * 1024u;
    const int aoff = lds_byte(wr * 64 + fr, fq * 8), boff = lds_byte(wc * 32 + fr, fq * 8);
#define PG8_SA(b, h) (((b) * 2 + (h)) * HTB)
#define PG8_SB(b, h) ((4 + (b) * 2 + (h)) * HTB)
#define PG8_STAGE(bufoff, gbase, voff) do { _Pragma("unroll") for (int _i = 0; _i < 2; ++_i) \
        __builtin_amdgcn_global_load_lds((const unsigned*)((const char*)(gbase) + (voff)[_i]), (PG8_LAS unsigned*)(lds + (bufoff) + ldsw + _i * 8192), 16, 0, 0); } while (0)
#define PG8_LDA(dst, b, h) do { _Pragma("unroll") for (int m = 0; m < 4; ++m) _Pragma("unroll") for (int k = 0; k < 2; ++k) dst[m][k] = *(const PG8_LAS bf16x8*)(lds + PG8_SA(b, h) + aoff + m * 2048 + k * 1024); } while (0)
#define PG8_LDB(dst, b, h) do { _Pragma("unroll") for (int n = 0; n < 2; ++n) _Pragma("unroll") for (int k = 0; k < 2; ++k) dst[n][k] = *(const PG8_LAS bf16x8*)(lds + PG8_SB(b, h) + boff + n * 2048 + k * 1024); } while (0)
#define PG8_MMA(ai, bj, At, Bt) do { __builtin_amdgcn_s_setprio(1); _Pragma("unroll") for (int m = 0; m < 4; ++m) _Pragma("unroll") for (int n = 0; n < 2; ++n) _Pragma("unroll") for (int k = 0; k < 2; ++k) \
        acc[ai][bj][m][n] = __builtin_amdgcn_mfma_f32_16x16x32_bf16(Bt[n][k], At[m][k], acc[ai][bj][m][n], 0, 0, 0); __builtin_amdgcn_s_setprio(0); } while (0)
#define PG8_WAIT_V(n) asm volatile("s_waitcnt vmcnt(" #n ")" ::: "memory")
#define PG8_WAIT_L(n) asm volatile("s_waitcnt lgkmcnt(" #n ")" ::: "memory")
#define PG8_BAR __builtin_amdgcn_s_barrier()
#define PG8_SCHED __builtin_amdgcn_sched_barrier(0)
    Unit cur, nxt; int ui = 0;
    if (!S.next(0, cur)) return;
    f32x4 acc[2][2][4][2];
#pragma unroll
    for (int a = 0; a < 2; ++a)
#pragma unroll
        for (int b = 0; b < 2; ++b)
#pragma unroll
            for (int m = 0; m < 4; ++m)
#pragma unroll
                for (int n = 0; n < 2; ++n) acc[a][b][m][n] = (f32x4){0.f, 0.f, 0.f, 0.f};
    bf16x8 At[4][2], B0[2][2], B1[2][2];
    const char* cA = (const char*)g.A + (size_t)cur.pm * tstep; const char* cB = (const char*)g.Bt + (size_t)cur.pn * tstep;
    S.a_ready(cur);
    if constexpr (SP2) {
        PG8_STAGE(PG8_SB(0, 0), cB, voffB); PG8_STAGE(PG8_SB(0, 1), cB + hstep, voffB); PG8_STAGE(PG8_SA(0, 0), cA, voffA); PG8_STAGE(PG8_SA(0, 1), cA + hstep, voffA);
        if (wr == 1) PG8_BAR;
        PG8_WAIT_V(2); PG8_BAR;
        PG8_STAGE(PG8_SB(1, 0), cB + kstep, voffB); PG8_STAGE(PG8_SA(1, 0), cA + kstep, voffA); PG8_STAGE(PG8_SB(1, 1), cB + hstep + kstep, voffB);
        PG8_WAIT_V(6); PG8_BAR;
    } else {
        PG8_STAGE(PG8_SB(0, 0), cB, voffB); PG8_STAGE(PG8_SA(0, 0), cA, voffA); PG8_STAGE(PG8_SB(0, 1), cB + hstep, voffB); PG8_STAGE(PG8_SA(0, 1), cA + hstep, voffA);
        if (wr == 1) PG8_BAR;
        PG8_WAIT_V(4); PG8_BAR;
        PG8_STAGE(PG8_SB(1, 0), cB + kstep, voffB); PG8_STAGE(PG8_SA(1, 0), cA + kstep, voffA); PG8_STAGE(PG8_SB(1, 1), cB + hstep + kstep, voffB);
        PG8_WAIT_V(6); PG8_BAR;
    }
    for (;;) {
        const bool has_next = S.next(ui + 1, nxt);
        const char* nA = has_next ? (const char*)g.A + (size_t)nxt.pm * tstep : cA; const char* nB = has_next ? (const char*)g.Bt + (size_t)nxt.pn * tstep : cB;
        for (int t = 0; t < nt; t += 2) {
            const bool last = (t == nt - 2);
            const char* a1 = cA + (size_t)(t + 1) * kstep;
            const char* a2 = last ? nA : cA + (size_t)(t + 2) * kstep; const char* b2 = last ? nB : cB + (size_t)(t + 2) * kstep;
            const char* a3 = a2 + kstep; const char* b3 = b2 + kstep;
            if (last && has_next) S.a_ready(nxt);
            if constexpr (SP2) {
            PG8_LDB(B0, 0, 0); PG8_LDB(B1, 0, 1); PG8_SCHED; PG8_LDA(At, 0, 0); PG8_STAGE(PG8_SA(1, 1), a1 + hstep, voffA);
            PG8_WAIT_V(8); PG8_WAIT_L(0); PG8_BAR; PG8_MMA(0, 0, At, B0); PG8_MMA(0, 1, At, B1); PG8_BAR; PG8_SCHED;
            PG8_LDA(At, 0, 1); PG8_STAGE(PG8_SB(0, 0), b2, voffB); PG8_STAGE(PG8_SB(0, 1), b2 + hstep, voffB); PG8_STAGE(PG8_SA(0, 0), a2, voffA);
            PG8_WAIT_V(8); PG8_WAIT_L(0); PG8_BAR; PG8_MMA(1, 0, At, B0); PG8_MMA(1, 1, At, B1); PG8_BAR; PG8_SCHED;
            PG8_LDB(B0, 1, 0); PG8_LDB(B1, 1, 1); PG8_SCHED; PG8_LDA(At, 1, 0); PG8_STAGE(PG8_SA(0, 1), a2 + hstep, voffA);
            PG8_WAIT_V(8); PG8_WAIT_L(0); PG8_BAR; PG8_MMA(0, 0, At, B0); PG8_MMA(0, 1, At, B1); PG8_BAR; PG8_SCHED;
            PG8_LDA(At, 1, 1); PG8_STAGE(PG8_SB(1, 0), b3, voffB); PG8_STAGE(PG8_SB(1, 1), b3 + hstep, voffB); PG8_STAGE(PG8_SA(1, 0), a3, voffA);
            PG8_WAIT_V(8); PG8_WAIT_L(0); PG8_BAR; PG8_MMA(1, 0, At, B0); PG8_MMA(1, 1, At, B1); PG8_BAR; PG8_SCHED;
            } else {
            PG8_LDB(B0, 0, 0); PG8_SCHED; PG8_LDA(At, 0, 0); PG8_STAGE(PG8_SA(1, 1), a1 + hstep, voffA);
            PG8_WAIT_L(8); PG8_BAR; PG8_WAIT_L(0); PG8_MMA(0, 0, At, B0); PG8_BAR; PG8_SCHED;
            PG8_LDB(B1, 0, 1); PG8_STAGE(PG8_SB(0, 0), b2, voffB);
            PG8_BAR; PG8_WAIT_L(0); PG8_MMA(0, 1, At, B1); PG8_BAR;
            PG8_LDA(At, 0, 1); PG8_STAGE(PG8_SA(0, 0), a2, voffA);
            PG8_BAR; PG8_WAIT_L(0); PG8_MMA(1, 0, At, B0); PG8_BAR; PG8_SCHED;
            PG8_STAGE(PG8_SB(0, 1), b2 + hstep, voffB);
            PG8_WAIT_V(6); PG8_BAR; PG8_MMA(1, 1, At, B1); PG8_BAR;
            PG8_LDB(B0, 1, 0); PG8_SCHED; PG8_LDA(At, 1, 0); PG8_STAGE(PG8_SA(0, 1), a2 + hstep, voffA);
            PG8_WAIT_L(8); PG8_BAR; PG8_WAIT_L(0); PG8_MMA(0, 0, At, B0); PG8_BAR; PG8_SCHED;
            PG8_LDB(B1, 1, 1); PG8_STAGE(PG8_SB(1, 0), b3, voffB);
            PG8_BAR; PG8_WAIT_L(0); PG8_MMA(0, 1, At, B1); PG8_BAR;
            PG8_LDA(At, 1, 1); PG8_STAGE(PG8_SA(1, 0), a3, voffA);
            PG8_BAR; PG8_WAIT_L(0); PG8_MMA(1, 0, At, B0); PG8_BAR; PG8_SCHED;
            PG8_STAGE(PG8_SB(1, 1), b3 + hstep, voffB);
            PG8_WAIT_V(6); PG8_BAR; PG8_MMA(1, 1, At, B1); PG8_BAR;
            }
        }
        if constexpr (ALIGN_EPI) { if (wr == 0) PG8_BAR; }
        if constexpr (!Epi::AFTER_DRAIN) { E(acc, cur, wr, wc, fr, fq); S.done(cur); }
        if (!has_next) break;
#pragma unroll
        for (int a = 0; a < 2; ++a)
#pragma unroll
            for (int b = 0; b < 2; ++b)
#pragma unroll
                for (int m = 0; m < 4; ++m)
#pragma unroll
                    for (int n = 0; n < 2; ++n) acc[a][b][m][n] = (f32x4){0.f, 0.f, 0.f, 0.f};
        cur = nxt; cA = nA; cB = nB; ++ui;
        if constexpr (ALIGN_EPI) { if (wr == 1) PG8_BAR; }
    }
    PG8_WAIT_V(0);
    if constexpr (!ALIGN_EPI) { if (wr == 0) PG8_BAR; }
    PG8_BAR;
    if constexpr (Epi::AFTER_DRAIN) { E.fused(acc, cur, wr, wc, fr, fq, lds, wid, lane); S.done(cur); }
#undef PG8_SA
#undef PG8_SB
#undef PG8_STAGE
#undef PG8_LDA
#undef PG8_LDB
#undef PG8_MMA
#undef PG8_WAIT_V
#undef PG8_WAIT_L
#undef PG8_BAR
#undef PG8_SCHED
}
}


struct AttnP { const bf16_t* PROJ; const float *cache_k, *cache_v, *qn, *kn, *sinks; bf16_t* YMIX; float *ko_p, *ko_s, *vo_p, *vo_s; };
constexpr int KN_STRIDE = 72, VT_STRIDE = 200, ATT_VT_OFF = 192 * KN_STRIDE * 2;
__device__ __forceinline__ void attn_unit(unsigned char* lds, int unit, const AttnP& a) {
    int tid_ = threadIdx.x; asm volatile("" : "+v"(tid_));
    const int tid = tid_, lane = tid & 63, w = __builtin_amdgcn_readfirstlane(tid >> 6), fr = lane & 15, fq = lane >> 4;
    int sq, chunk, hkv; if (unit < 512) { sq = unit >> 7; chunk = (unit & 127) >> 1; hkv = unit & 1; } else { sq = 4 + ((unit - 512) >> 1); chunk = 0; hkv = unit & 1; }
    const Seq s = seq_of(sq);
    int nk, ncache, ktok0;
    if (s.sample) { nk = 160; ncache = 128; ktok0 = s.base; }
    else { const int back = chunk < 2 ? chunk : 2; nk = 64 * (back + 1); ncache = 0; ktok0 = s.base + (chunk - back) * 64; }
    bf16_t* Kn = (bf16_t*)lds; bf16_t* Vt = (bf16_t*)(lds + ATT_VT_OFF);
    int g, mt; bool act; if (!s.sample) { g = w >> 2; mt = w & 3; act = true; } else { g = (w >> 1) & 1; mt = w & 1; act = w < 4; }
    const bf16_t* qp = a.PROJ + (size_t)(s.base + chunk * 64 + mt * 16 + fr) * NINP + C_Q + (hkv * 2 + g) * 64 + 8 * fq;
    u32x4 qr0 = {0u, 0u, 0u, 0u}, qr1 = qr0;
    if (act) { qr0 = *(const u32x4*)qp; qr1 = *(const u32x4*)(qp + 32); }
    u32x4 kraw[3], vraw[3]; f32x4 kc[3][2], vc[3][2];
#pragma unroll
    for (int q = 0; q < 3; ++q) {
        const int p = tid + 512 * q, j = p >> 3, ch = p & 7;
        kraw[q] = (u32x4){0u, 0u, 0u, 0u}; vraw[q] = kraw[q]; kc[q][0] = (f32x4){0.f, 0.f, 0.f, 0.f}; kc[q][1] = kc[q][0]; vc[q][0] = kc[q][0]; vc[q][1] = kc[q][0];
        if (p < nk * 8) {
            if (j < ncache) {
                const float* kp = a.cache_k + (((size_t)s.b * 128 + j) * 2 + hkv) * 64 + ch * 8; const float* vp = a.cache_v + (((size_t)s.b * 128 + j) * 2 + hkv) * 64 + ch * 8;
                kc[q][0] = *(const f32x4*)kp; kc[q][1] = *(const f32x4*)(kp + 4); vc[q][0] = *(const f32x4*)vp; vc[q][1] = *(const f32x4*)(vp + 4);
            } else {
                const bf16_t* pp = a.PROJ + (size_t)(ktok0 + j - ncache) * NINP + hkv * 64 + ch * 8;
                kraw[q] = *(const u32x4*)(pp + C_K); vraw[q] = *(const u32x4*)(pp + C_V);
            }
        }
    }
#pragma unroll
    for (int q = 0; q < 3; ++q) {
        const int p = tid + 512 * q, j = p >> 3, ch = p & 7;
        if (p < nk * 8) {
        float kf[8], vf[8];
        if (j < ncache) {
            kf[0] = kc[q][0].x; kf[1] = kc[q][0].y; kf[2] = kc[q][0].z; kf[3] = kc[q][0].w; kf[4] = kc[q][1].x; kf[5] = kc[q][1].y; kf[6] = kc[q][1].z; kf[7] = kc[q][1].w;
            vf[0] = vc[q][0].x; vf[1] = vc[q][0].y; vf[2] = vc[q][0].z; vf[3] = vc[q][0].w; vf[4] = vc[q][1].x; vf[5] = vc[q][1].y; vf[6] = vc[q][1].z; vf[7] = vc[q][1].w;
        } else {
            unpack8(kraw[q], kf); unpack8(vraw[q], vf);
            float ss = 0.f;
#pragma unroll
            for (int i = 0; i < 8; ++i) ss += kf[i] * kf[i];
            ss += __shfl_xor(ss, 1); ss += __shfl_xor(ss, 2); ss += __shfl_xor(ss, 4);
            const float rs = rsqrtf(ss * (1.f / 64.f) + 1e-6f);
            const f32x4 g0 = *(const f32x4*)(a.kn + ch * 8), g1 = *(const f32x4*)(a.kn + ch * 8 + 4);
            kf[0] *= rs * g0.x; kf[1] *= rs * g0.y; kf[2] *= rs * g0.z; kf[3] *= rs * g0.w; kf[4] *= rs * g1.x; kf[5] *= rs * g1.y; kf[6] *= rs * g1.z; kf[7] *= rs * g1.w;
        }
        u32x4 ko; ko.x = pk2(kf[0], kf[1]); ko.y = pk2(kf[2], kf[3]); ko.z = pk2(kf[4], kf[5]); ko.w = pk2(kf[6], kf[7]);
        *(u32x4*)(Kn + j * KN_STRIDE + ch * 8) = ko;
#pragma unroll
        for (int i = 0; i < 8; ++i) Vt[(ch * 8 + i) * VT_STRIDE + j] = f2bf(vf[i]);
        float* ko_ = nullptr; float* vo_ = nullptr;
        if (s.sample) { if (j >= 32) { ko_ = a.ko_s + ((size_t)s.b * 128 + (j - 32)) * 128 + hkv * 64 + ch * 8; vo_ = a.vo_s + ((size_t)s.b * 128 + (j - 32)) * 128 + hkv * 64 + ch * 8; } }
        else if (chunk >= 62 && j >= nk - 64) { const int jj = (chunk - 62) * 64 + (j - (nk - 64)); ko_ = a.ko_p + ((size_t)s.b * 128 + jj) * 128 + hkv * 64 + ch * 8; vo_ = a.vo_p + ((size_t)s.b * 128 + jj) * 128 + hkv * 64 + ch * 8; }
        if (ko_) { *(f32x4*)ko_ = (f32x4){kf[0], kf[1], kf[2], kf[3]}; *(f32x4*)(ko_ + 4) = (f32x4){kf[4], kf[5], kf[6], kf[7]}; *(f32x4*)vo_ = (f32x4){vf[0], vf[1], vf[2], vf[3]}; *(f32x4*)(vo_ + 4) = (f32x4){vf[4], vf[5], vf[6], vf[7]}; }
        }
    }
    __syncthreads();
    if (act) {
        const int qh = hkv * 2 + g, tok = s.base + chunk * 64 + mt * 16 + fr, nkt = nk >> 4, nks = nk >> 5;
        float qf[16]; unpack8(qr0, qf); unpack8(qr1, qf + 8);
        float ss = 0.f;
#pragma unroll
        for (int i = 0; i < 16; ++i) ss += qf[i] * qf[i];
        ss += __shfl_xor(ss, 16); ss += __shfl_xor(ss, 32);
        const float rs = rsqrtf(ss * (1.f / 64.f) + 1e-6f) * 0.125f;
#pragma unroll
        for (int i = 0; i < 8; ++i) { qf[i] *= rs * a.qn[8 * fq + i]; qf[8 + i] *= rs * a.qn[32 + 8 * fq + i]; }
        union { u32x4 u; bf16x8 v; } qa, qb;
        qa.u.x = pk2(qf[0], qf[1]); qa.u.y = pk2(qf[2], qf[3]); qa.u.z = pk2(qf[4], qf[5]); qa.u.w = pk2(qf[6], qf[7]);
        qb.u.x = pk2(qf[8], qf[9]); qb.u.y = pk2(qf[10], qf[11]); qb.u.z = pk2(qf[12], qf[13]); qb.u.w = pk2(qf[14], qf[15]);
        f32x4 sacc[12];
        const float sink = a.sinks[qh];
        float m = sink;
#pragma unroll
        for (int kt = 0; kt < 12; ++kt) {
            sacc[kt] = (f32x4){0.f, 0.f, 0.f, 0.f};
            if (kt < nkt) {
                const bf16x8 k0 = *(const bf16x8*)(Kn + (kt * 16 + fr) * KN_STRIDE + 8 * fq), k1 = *(const bf16x8*)(Kn + (kt * 16 + fr) * KN_STRIDE + 32 + 8 * fq);
                sacc[kt] = __builtin_amdgcn_mfma_f32_16x16x32_bf16(k0, qa.v, sacc[kt], 0, 0, 0);
                sacc[kt] = __builtin_amdgcn_mfma_f32_16x16x32_bf16(k1, qb.v, sacc[kt], 0, 0, 0);
                m = fmaxf(m, fmaxf(fmaxf(sacc[kt].x, sacc[kt].y), fmaxf(sacc[kt].z, sacc[kt].w)));
            }
        }
        m = fmaxf(m, __shfl_xor(m, 16)); m = fmaxf(m, __shfl_xor(m, 32));
        float lsum = 0.f;
#pragma unroll
        for (int kt = 0; kt < 12; ++kt) if (kt < nkt) {
            sacc[kt].x = __expf(sacc[kt].x - m); sacc[kt].y = __expf(sacc[kt].y - m); sacc[kt].z = __expf(sacc[kt].z - m); sacc[kt].w = __expf(sacc[kt].w - m);
            lsum += (sacc[kt].x + sacc[kt].y) + (sacc[kt].z + sacc[kt].w);
        }
        lsum += __shfl_xor(lsum, 16); lsum += __shfl_xor(lsum, 32);
        lsum += __expf(sink - m);
        f32x4 oacc[4];
#pragma unroll
        for (int dt = 0; dt < 4; ++dt) oacc[dt] = (f32x4){0.f, 0.f, 0.f, 0.f};
#pragma unroll
        for (int ks = 0; ks < 6; ++ks) if (ks < nks) {
            union { u32x4 u; bf16x8 v; } pf;
            pf.u.x = pk2(sacc[2 * ks].x, sacc[2 * ks].y); pf.u.y = pk2(sacc[2 * ks].z, sacc[2 * ks].w); pf.u.z = pk2(sacc[2 * ks + 1].x, sacc[2 * ks + 1].y); pf.u.w = pk2(sacc[2 * ks + 1].z, sacc[2 * ks + 1].w);
#pragma unroll
            for (int dt = 0; dt < 4; ++dt) {
                union { u32x4 u; bf16x8 v; } vf;
                const u32x2 lo = *(const u32x2*)(Vt + (dt * 16 + fr) * VT_STRIDE + 32 * ks + 4 * fq), hi2 = *(const u32x2*)(Vt + (dt * 16 + fr) * VT_STRIDE + 32 * ks + 16 + 4 * fq);
                vf.u.x = lo.x; vf.u.y = lo.y; vf.u.z = hi2.x; vf.u.w = hi2.y;
                oacc[dt] = __builtin_amdgcn_mfma_f32_16x16x32_bf16(vf.v, pf.v, oacc[dt], 0, 0, 0);
            }
        }
        const float inv = 1.f / lsum;
#pragma unroll
        for (int dt = 0; dt < 4; ++dt) { u32x2 o; o.x = pk2(oacc[dt].x * inv, oacc[dt].y * inv); o.y = pk2(oacc[dt].z * inv, oacc[dt].w * inv);
            *(u32x2*)(a.YMIX + (size_t)tok * DM + 768 + qh * 64 + dt * 16 + 4 * fq) = o; }
    }
    __syncthreads();
}

struct ConvPoolP { const bf16_t* PROJ; const float *cache_conv, *cw, *cb, *lg, *lb, *cache_pool, *pw, *psc; bf16_t* YMIX; float *co_p, *co_s, *po_p, *po_s; const bf16_t *GLU, *PWT; };
__device__ __forceinline__ void convpool_tile(float* sm, int tile, const ConvPoolP& a) {
    int tid_ = threadIdx.x; asm volatile("" : "+v"(tid_));
    int c = tid_ & 255;
#define RELAUNDER() asm volatile("" : "+v"(c))
    int sq, t0; if (tile < 1024) { sq = tile >> 8; t0 = (tile & 255) * 16; } else { sq = 4 + ((tile - 1024) >> 1); t0 = ((tile - 1024) & 1) * 16; }
    const Seq s = seq_of(sq);
    float* ext = sm;
    float* yb = sm + 46 * 256;
    bf16_t* db = (bf16_t*)yb;
    {
        u32x4 vv[6]; f32x4 h0[6], h1[6];
#pragma unroll
        for (int q = 0; q < 6; ++q) {
            const int pr = c + 256 * q, i = pr >> 5, cg = pr & 31, t = t0 - 30 + i;
            vv[q] = (u32x4){0u, 0u, 0u, 0u}; h0[q] = (f32x4){0.f, 0.f, 0.f, 0.f}; h1[q] = h0[q];
            if (i < 46) {
                if (t >= 0) vv[q] = *(const u32x4*)(a.GLU + (size_t)(s.base + t) * 256 + cg * 8);
                else if (s.sample) { const float* p = a.cache_conv + ((size_t)s.b * 30 + 30 + t) * 256 + cg * 8; h0[q] = *(const f32x4*)p; h1[q] = *(const f32x4*)(p + 4); }
            }
        }
#pragma unroll
        for (int q = 0; q < 6; ++q) {
            const int pr = c + 256 * q, i = pr >> 5, cg = pr & 31, t = t0 - 30 + i;
            if (i < 46) {
                f32x4 e0 = h0[q], e1 = h1[q];
                if (t >= 0) { float v[8]; unpack8(vv[q], v); e0 = (f32x4){v[0], v[1], v[2], v[3]}; e1 = (f32x4){v[4], v[5], v[6], v[7]}; }
                *(f32x4*)(ext + i * 256 + cg * 8) = e0; *(f32x4*)(ext + i * 256 + cg * 8 + 4) = e1;
            }
        }
    }
    __syncthreads(); RELAUNDER();
    {
        float e[46];
#pragma unroll
        for (int i = 0; i < 46; ++i) e[i] = ext[i * 256 + c];
        float* o = s.sample ? a.co_s + (size_t)s.b * 30 * 256 : a.co_p + (size_t)s.b * 30 * 256;
        if (t0 + 15 >= s.L - 30) {
#pragma unroll
            for (int i = 0; i < 16; ++i) { const int t = t0 + i; if (t >= s.L - 30) o[(t - (s.L - 30)) * 256 + c] = e[i + 30]; }
        }
        float y[16]; const float bias = a.cb[c];
#pragma unroll
        for (int i = 0; i < 16; ++i) y[i] = bias;
#pragma unroll
        for (int j = 0; j < 31; ++j) { const float wj = a.cw[j * 256 + c];
#pragma unroll
            for (int i = 0; i < 16; ++i) y[i] += wj * e[i + j]; }
#pragma unroll
        for (int i = 0; i < 16; ++i) yb[i * 256 + c] = y[i];
    }
    __syncthreads(); RELAUNDER();
    u32x4 pv[4]; f32x4 ph0[4], ph1[4];
#pragma unroll
    for (int q = 0; q < 4; ++q) {
        const int pr = c + 256 * q, i = pr >> 5, cg = pr & 31, t = t0 - 15 + i;
        pv[q] = (u32x4){0u, 0u, 0u, 0u}; ph0[q] = (f32x4){0.f, 0.f, 0.f, 0.f}; ph1[q] = ph0[q];
        if (i < 31) {
            if (t >= 0) pv[q] = *(const u32x4*)(a.PROJ + (size_t)(s.base + t) * NINP + C_C + cg * 8);
            else if (s.sample) { const float* p = a.cache_pool + ((size_t)s.b * 15 + 15 + t) * 256 + cg * 8; ph0[q] = *(const f32x4*)p; ph1[q] = *(const f32x4*)(p + 4); }
        }
    }
    {
        const int wv = c >> 6, lane = c & 63;
        const f32x4 g4 = ((const f32x4*)a.lg)[lane], b4 = ((const f32x4*)a.lb)[lane];
#pragma unroll 1
        for (int i = wv; i < 16; i += 4) {
            const f32x4 v = ((const f32x4*)(yb + i * 256))[lane];
            const float mean = wave_sum((v.x + v.y) + (v.z + v.w)) * (1.f / 256.f);
            const f32x4 d = v - mean;
            const float var = wave_sum((d.x * d.x + d.y * d.y) + (d.z * d.z + d.w * d.w)) * (1.f / 256.f);
            const float rstd = rsqrtf(var + 1e-5f);
            f32x4 o = d * rstd * g4 + b4;
            o.x *= sigmoidf_(o.x); o.y *= sigmoidf_(o.y); o.z *= sigmoidf_(o.z); o.w *= sigmoidf_(o.w);
            *(u32x2*)(a.YMIX + (size_t)(s.base + t0 + i) * DM + 0 + lane * 4) = pk4(o);
        }
    }
    __syncthreads(); RELAUNDER();
#pragma unroll
    for (int q = 0; q < 4; ++q) {
        const int pr = c + 256 * q, i = pr >> 5, cg = pr & 31, t = t0 - 15 + i;
        if (i < 31) {
            f32x4 e0 = ph0[q], e1 = ph1[q];
            if (t >= 0) { float v[8]; unpack8(pv[q], v); e0 = (f32x4){v[0], v[1], v[2], v[3]}; e1 = (f32x4){v[4], v[5], v[6], v[7]}; }
            *(f32x4*)(ext + i * 256 + cg * 8) = e0; *(f32x4*)(ext + i * 256 + cg * 8 + 4) = e1;
        }
    }
    __syncthreads(); RELAUNDER();
    {
        float e[31];
#pragma unroll
        for (int i = 0; i < 31; ++i) e[i] = ext[i * 256 + c];
        float* o = s.sample ? a.po_s + (size_t)s.b * 15 * 256 : a.po_p + (size_t)s.b * 15 * 256;
        if (t0 + 15 >= s.L - 15) {
#pragma unroll
            for (int i = 0; i < 16; ++i) { const int t = t0 + i; if (t >= s.L - 15) o[(t - (s.L - 15)) * 256 + c] = e[i + 15]; }
        }
        const int g = __builtin_amdgcn_readfirstlane(c >> 6), w = 2 << g;
        float w2[16], w4[16], w8[16], w16[16];
#pragma unroll
        for (int i = 0; i < 16; ++i) w2[i] = e[15 + i] + e[14 + i];
        if (g >= 1) {
#pragma unroll
            for (int i = 0; i < 16; ++i) w4[i] = (e[15 + i] + e[14 + i]) + (e[13 + i] + e[12 + i]);
        }
        if (g >= 2) {
#pragma unroll
            for (int i = 0; i < 16; ++i) w8[i] = ((e[15 + i] + e[14 + i]) + (e[13 + i] + e[12 + i])) + ((e[11 + i] + e[10 + i]) + (e[9 + i] + e[8 + i]));
        }
        if (g == 3) {
            float cs[32]; cs[0] = e[0];
#pragma unroll
            for (int k = 1; k < 31; ++k) cs[k] = cs[k - 1] + e[k];
#pragma unroll
            for (int i = 0; i < 16; ++i) w16[i] = i == 0 ? cs[15] : cs[15 + i] - cs[i - 1];
        }
#pragma unroll
        for (int i = 0; i < 16; ++i) {
            const float sum = g == 0 ? w2[i] : (g == 1 ? w4[i] : (g == 2 ? w8[i] : w16[i]));
            const int pos = s.pos0 + t0 + i; const int cnt = (pos + 1) < w ? (pos + 1) : w;
            db[i * 264 + c] = f2bf(sum * __builtin_amdgcn_rcpf((float)cnt) - e[15 + i]);
        }
    }
    __syncthreads(); RELAUNDER();
    {
        const int g = __builtin_amdgcn_readfirstlane(c >> 6), lane = c & 63, fr = lane & 15, fq = lane >> 4;
        const bf16x8 d0 = *(const bf16x8*)(db + fr * 264 + g * 64 + 8 * fq), d1 = *(const bf16x8*)(db + fr * 264 + g * 64 + 32 + 8 * fq);
#pragma unroll
        for (int dt = 0; dt < 4; ++dt) {
            const bf16_t* wp = a.PWT + ((size_t)g * 64 + 16 * dt + fr) * 64 + 8 * fq;
            f32x4 acc = __builtin_amdgcn_mfma_f32_16x16x32_bf16(*(const bf16x8*)wp, d0, (f32x4){0.f, 0.f, 0.f, 0.f}, 0, 0, 0);
            acc = __builtin_amdgcn_mfma_f32_16x16x32_bf16(*(const bf16x8*)(wp + 32), d1, acc, 0, 0, 0);
            acc *= *(const f32x4*)(a.psc + g * 64 + 16 * dt + 4 * fq);
            *(u32x2*)(a.YMIX + (size_t)(s.base + t0 + fr) * DM + 512 + g * 64 + 16 * dt + 4 * fq) = pk4(acc);
        }
    }
    __syncthreads();
#undef RELAUNDER
}

struct RwkvG { bf16_t *PT, *QQ, *ZZ, *Y0, *SC, *GATE, *BV; const bf16_t* LWT; };
constexpr int RC_HEAD = 30208, RC_MAB = 0, RC_MAK = 4608, RC_MRB = 7168, RC_MRK = 9728, RC_TM = 12288, RC_MAKVT = 14848, RC_GT = 19968, RC_U0T = 25088;
constexpr int RB_BASE = 2 * RC_HEAD, RB_HEAD = 38912, RB_AT = 0, RB_BH = 4608, RB_KH = 9216, RB_RT = 13824, RB_ATT = 18432, RB_BHT = 23552, RB_KHT = 28672, RB_VT = 33792;
constexpr int RA_LAT = 0, RA_WL = 8704, RA_AL = 25088, RA_SCN = 41472, R_WLS = RB_BASE + 2 * RB_HEAD;
constexpr int NS = 72, TS = 40, LATS = 136, MABS = 36;
__device__ __forceinline__ bf16x8 ldf(const bf16_t* base, int row, int stride, int col) { return *(const bf16x8*)(base + row * stride + col); }
#define MFMA16(a, b, c) __builtin_amdgcn_mfma_f32_16x16x32_bf16((a), (b), (c), 0, 0, 0)

__device__ __forceinline__ void rwkv_item(unsigned char* lds, int item, int l, const bf16_t* __restrict__ PROJ, const float* __restrict__ shift_in, const RwkvW& w, const RwkvG& G) {
    int tid = threadIdx.x; asm volatile("" : "+v"(tid));
    const int wv = __builtin_amdgcn_readfirstlane(tid >> 6);
    const int cid = item >> 1, hp = item & 1, tok0 = cid * 32;
    const bool sample = cid >= 512, first = sample || ((cid & 127) == 0);
    const int sb = cid - 512;
    bf16_t* LAT = (bf16_t*)(lds + RA_LAT); float* WLb = (float*)(lds + RA_WL); float* ALb = (float*)(lds + RA_AL); float* SCN = (float*)(lds + RA_SCN); float* WLs = (float*)(lds + R_WLS);
    const int lane0 = tid & 63, fr0 = lane0 & 15, fq0 = lane0 >> 4;
    const bf16_t* lwp = G.LWT + ((size_t)l * 256 + hp * 128 + 16 * wv + fr0) * 128 + 8 * fq0;
    const bf16x8 fw = *(const bf16x8*)(lwp), fa = *(const bf16x8*)(lwp + 32), fg0 = *(const bf16x8*)(lwp + 64), fg1 = *(const bf16x8*)(lwp + 96);
    const f32x4 w0v = *(const f32x4*)(w.w0 + hp * 128 + 16 * wv + 4 * fq0), a0v = *(const f32x4*)(w.a0 + hp * 128 + 16 * wv + 4 * fq0);
    const int c3 = tid & 127, tq3 = tid >> 7, cg3 = hp * 128 + c3;
    float ur[9], uk[9], uv[9];
#pragma unroll
    for (int i = 0; i < 9; ++i) {
        const int t = 8 * tq3 - 1 + i;
        if (t >= 0 || !first) { const bf16_t* p = PROJ + (size_t)(tok0 + t) * NINP + C_B + cg3; ur[i] = bf2f(p[0]); uk[i] = bf2f(p[256]); uv[i] = bf2f(p[512]); }
        else if (sample) { const float* p = shift_in + (size_t)sb * 896 + cg3; ur[i] = p[0]; uk[i] = p[256]; uv[i] = p[512]; }
        else { ur[i] = 0.f; uk[i] = 0.f; uv[i] = 0.f; }
    }
    const float mur = w.mu[cg3], muk = w.mu[256 + cg3], muv = w.mu[512 + cg3], kkw = w.k_k[cg3], kaw = w.k_a[cg3], rkw = w.r_k[cg3];
    {
        const int t = tid >> 4, j8 = (tid & 15) * 8, col = 768 + j8;
        float u[8], pv[8];
        unpack8(*(const u32x4*)(PROJ + (size_t)(tok0 + t) * NINP + C_B + col), u);
        if (t > 0 || !first) unpack8(*(const u32x4*)(PROJ + (size_t)(tok0 + t - 1) * NINP + C_B + col), pv);
        else if (sample) { const f32x4 a = *(const f32x4*)(shift_in + (size_t)sb * 896 + col), b = *(const f32x4*)(shift_in + (size_t)sb * 896 + col + 4); pv[0] = a.x; pv[1] = a.y; pv[2] = a.z; pv[3] = a.w; pv[4] = b.x; pv[5] = b.y; pv[6] = b.z; pv[7] = b.w; }
        else {
#pragma unroll
            for (int i = 0; i < 8; ++i) pv[i] = 0.f; }
        const f32x4 m0 = *(const f32x4*)(w.mu + col), m1 = *(const f32x4*)(w.mu + col + 4);
        const float mu[8] = {m0.x, m0.y, m0.z, m0.w, m1.x, m1.y, m1.z, m1.w};
        float x[8];
#pragma unroll
        for (int i = 0; i < 8; ++i) { const float xs = u[i] + mu[i] * (pv[i] - u[i]); x[i] = j8 < 32 ? 1.f - 2.f / (1.f + __expf(2.f * xs)) : (j8 < 64 ? xs : sigmoidf_(xs)); }
        u32x4 o; o.x = pk2(x[0], x[1]); o.y = pk2(x[2], x[3]); o.z = pk2(x[4], x[5]); o.w = pk2(x[6], x[7]);
        *(u32x4*)(LAT + t * LATS + j8) = o;
    }
    __syncthreads();
    {
        asm volatile("" : "+v"(tid)); const int lane = tid & 63, fr = lane & 15, fq = lane >> 4;
        const int c0l = 16 * wv, cg0 = hp * 128 + c0l;
#pragma unroll
        for (int tt = 0; tt < 2; ++tt) {
            const int t = 16 * tt + fr;
            const f32x4 z = {0.f, 0.f, 0.f, 0.f};
            f32x4 aw = MFMA16(fw, ldf(LAT, t, LATS, 8 * fq), z);
            f32x4 aa = MFMA16(fa, ldf(LAT, t, LATS, 32 + 8 * fq), z);
            f32x4 ag = MFMA16(fg0, ldf(LAT, t, LATS, 64 + 8 * fq), z);
            ag = MFMA16(fg1, ldf(LAT, t, LATS, 96 + 8 * fq), ag);
            *(f32x4*)(WLb + t * 128 + c0l + 4 * fq) = aw + w0v;
            *(f32x4*)(ALb + t * 128 + c0l + 4 * fq) = aa + a0v;
            *(u32x2*)(G.GATE + (size_t)(tok0 + t) * 256 + cg0 + 4 * fq) = pk4(ag);
        }
    }
    __syncthreads();
    {
        asm volatile("" : "+v"(tid));
        const int c = tid & 127, tq = tid >> 7, hd = c >> 6, c64 = c & 63, cg = hp * 128 + c;
        unsigned char* hb = lds + RB_BASE + hd * RB_HEAD;
        bf16_t *AT = (bf16_t*)(hb + RB_AT), *BH = (bf16_t*)(hb + RB_BH), *KH = (bf16_t*)(hb + RB_KH), *RT = (bf16_t*)(hb + RB_RT);
        bf16_t *ATt = (bf16_t*)(hb + RB_ATT), *BHt = (bf16_t*)(hb + RB_BHT), *KHt = (bf16_t*)(hb + RB_KHT), *Vt = (bf16_t*)(hb + RB_VT);
        float lw[8], cl[8];
        float run = 0.f;
#pragma unroll
        for (int i = 0; i < 8; ++i) { lw[i] = -0.60653066f * sigmoidf_(WLb[(8 * tq + i) * 128 + c]); run += lw[i]; cl[i] = run; }
        SCN[tq * 128 + c] = run;
        __syncthreads();
        float pre = 0.f, tot = 0.f;
#pragma unroll
        for (int q = 0; q < 4; ++q) { const float v = SCN[q * 128 + c]; tot += v; if (q < tq) pre += v; }
        if (tq == 0) WLs[c] = __expf(tot);
        float at8[8], bh8[8], kh8[8], vv8[8];
        float rr8[8], kk8[8], km8[8], ar8[8], ss8[8], bo8[8];
#pragma unroll
        for (int i = 0; i < 8; ++i) {
            const int t = 8 * tq + i;
            rr8[i] = ur[i + 1] + mur * (ur[i] - ur[i + 1]); const float k = uk[i + 1] + muk * (uk[i] - uk[i + 1]); vv8[i] = uv[i + 1] + muv * (uv[i] - uv[i + 1]);
            ar8[i] = __builtin_amdgcn_rcpf(1.f + __expf(-ALb[t * 128 + c]));
            kk8[i] = k * kkw; km8[i] = k * (1.f + (ar8[i] - 1.f) * kaw);
            ss8[i] = kk8[i] * kk8[i]; bo8[i] = rr8[i] * km8[i] * rkw;
        }
#pragma unroll
        for (int o = 1; o < 64; o <<= 1) {
#pragma unroll
            for (int i = 0; i < 8; ++i) { ss8[i] += __shfl_xor(ss8[i], o); bo8[i] += __shfl_xor(bo8[i], o); }
        }
#pragma unroll
        for (int i = 0; i < 8; ++i) {
            const int t = 8 * tq + i;
            const float cum = pre + cl[i];
            const float W = __expf(cum), Wp = __expf(cum - lw[i]), iW = __expf(-cum);
            const float kkn = kk8[i] * __builtin_amdgcn_rcpf(fmaxf(sqrtf(ss8[i]), 1e-12f));
            const float at = -kkn * Wp, bh = kkn * ar8[i] * iW, kh = km8[i] * iW, rt = rr8[i] * W;
            AT[t * NS + c64] = f2bf(at); BH[t * NS + c64] = f2bf(bh); KH[t * NS + c64] = f2bf(kh); RT[t * NS + c64] = f2bf(rt);
            at8[i] = at; bh8[i] = bh; kh8[i] = kh;
            G.BV[(size_t)(tok0 + t) * 256 + cg] = f2bf(bo8[i] * vv8[i]);
        }
        u32x4 o;
        o.x = pk2(at8[0], at8[1]); o.y = pk2(at8[2], at8[3]); o.z = pk2(at8[4], at8[5]); o.w = pk2(at8[6], at8[7]); *(u32x4*)(ATt + c64 * TS + 8 * tq) = o;
        o.x = pk2(bh8[0], bh8[1]); o.y = pk2(bh8[2], bh8[3]); o.z = pk2(bh8[4], bh8[5]); o.w = pk2(bh8[6], bh8[7]); *(u32x4*)(BHt + c64 * TS + 8 * tq) = o;
        o.x = pk2(kh8[0], kh8[1]); o.y = pk2(kh8[2], kh8[3]); o.z = pk2(kh8[4], kh8[5]); o.w = pk2(kh8[6], kh8[7]); *(u32x4*)(KHt + c64 * TS + 8 * tq) = o;
        o.x = pk2(vv8[0], vv8[1]); o.y = pk2(vv8[2], vv8[3]); o.z = pk2(vv8[4], vv8[5]); o.w = pk2(vv8[6], vv8[7]); *(u32x4*)(Vt + c64 * TS + 8 * tq) = o;
    }
    __syncthreads();
    asm volatile("" : "+v"(tid)); const int lane = tid & 63, fr = lane & 15, fq = lane >> 4;
    const int hd = wv >> 2, wg = wv & 3, h = hp * 2 + hd; const size_t ch = (size_t)cid * 4 + h;
    unsigned char* hb = lds + RB_BASE + hd * RB_HEAD; unsigned char* cb = lds + hd * RC_HEAD;
    const bf16_t *AT = (const bf16_t*)(hb + RB_AT), *BH = (const bf16_t*)(hb + RB_BH), *KH = (const bf16_t*)(hb + RB_KH), *RT = (const bf16_t*)(hb + RB_RT);
    const bf16_t *ATt = (const bf16_t*)(hb + RB_ATT), *BHt = (const bf16_t*)(hb + RB_BHT), *KHt = (const bf16_t*)(hb + RB_KHT), *Vt = (const bf16_t*)(hb + RB_VT);
    float* Mab = (float*)(cb + RC_MAB);
    bf16_t *Mak = (bf16_t*)(cb + RC_MAK), *Mrb = (bf16_t*)(cb + RC_MRB), *Mrk = (bf16_t*)(cb + RC_MRK), *Tm = (bf16_t*)(cb + RC_TM), *MakVt = (bf16_t*)(cb + RC_MAKVT), *GT = (bf16_t*)(cb + RC_GT), *U0T = (bf16_t*)(cb + RC_U0T);
    const f32x4 z4 = {0.f, 0.f, 0.f, 0.f};
    {
        const bf16_t* rowsrc = (wg >> 1) ? RT : AT; const bf16_t* colsrc = (wg & 1) ? KH : BH;
        bf16_t* Mo = wg == 1 ? Mak : (wg == 2 ? Mrb : Mrk);
#pragma unroll
        for (int tt = 0; tt < 2; ++tt)
#pragma unroll
            for (int st = 0; st < 2; ++st) {
                f32x4 acc = MFMA16(ldf(colsrc, 16 * st + fr, NS, 8 * fq), ldf(rowsrc, 16 * tt + fr, NS, 8 * fq), z4);
                acc = MFMA16(ldf(colsrc, 16 * st + fr, NS, 32 + 8 * fq), ldf(rowsrc, 16 * tt + fr, NS, 32 + 8 * fq), acc);
                const int t = 16 * tt + fr, s0 = 16 * st + 4 * fq, lim = (wg >> 1) ? t + 1 : t;
                acc.x = (s0 + 0 < lim) ? acc.x : 0.f; acc.y = (s0 + 1 < lim) ? acc.y : 0.f; acc.z = (s0 + 2 < lim) ? acc.z : 0.f; acc.w = (s0 + 3 < lim) ? acc.w : 0.f;
                if (wg == 0) *(f32x4*)(Mab + t * MABS + s0) = acc; else *(u32x2*)(Mo + t * TS + s0) = pk4(acc);
            }
    }
    __syncthreads();
    const float* WL = (const float*)(lds + R_WLS) + hd * 64;
    if (wg == 0) {
        {
            const int j = lane & 31;
            float Tc[32];
            f32x4 cur[8];
#pragma unroll
            for (int q = 0; q < 8; ++q) cur[q] = (f32x4){0.f, 0.f, 0.f, 0.f};
#pragma unroll
            for (int t = 0; t < 32; ++t) {
                f32x4 nx[8];
#pragma unroll
                for (int q = 0; q < 8; ++q) nx[q] = (t + 1 < 32 && 4 * q < t + 1) ? *(const f32x4*)(Mab + (t + 1) * MABS + 4 * q) : (f32x4){0.f, 0.f, 0.f, 0.f};
                float a0 = (t == j) ? 1.f : 0.f, a1 = 0.f;
#pragma unroll
                for (int s2 = 0; s2 < t; ++s2) { const float nv = cur[s2 >> 2][s2 & 3]; if (s2 & 1) a1 += nv * Tc[s2]; else a0 += nv * Tc[s2]; }
                Tc[t] = a0 + a1;
#pragma unroll
                for (int q = 0; q < 8; ++q) cur[q] = nx[q];
            }
            if (lane < 32) {
#pragma unroll
                for (int t = 0; t < 32; ++t) Tm[t * TS + j] = f2bf(Tc[t]);
            }
        }
        __syncthreads();
#pragma unroll
        for (int rt = 0; rt < 2; ++rt)
#pragma unroll
            for (int tt = 0; tt < 2; ++tt) {
                const f32x4 acc = MFMA16(ldf(Tm, 16 * tt + fr, TS, 8 * fq), ldf(ATt, 16 * rt + fr, TS, 8 * fq), z4);
                *(u32x2*)(GT + (16 * rt + fr) * TS + 16 * tt + 4 * fq) = pk4(acc);
            }
        __syncthreads();
#pragma unroll
        for (int tt = 0; tt < 2; ++tt)
#pragma unroll
            for (int ks = 0; ks < 2; ++ks) {
                u32x2 pc[2];
#pragma unroll
                for (int hf = 0; hf < 2; ++hf) {
                    const int kt = 2 * ks + hf;
                    f32x4 acc = MFMA16(ldf(GT, 16 * kt + fr, TS, 8 * fq), ldf(Mrb, 16 * tt + fr, TS, 8 * fq), z4);
                    const int t = 16 * tt + fr, k0 = 16 * kt + 4 * fq;
                    const u32x2 rr = *(const u32x2*)(RT + t * NS + k0);
                    acc.x += __uint_as_float(rr.x << 16); acc.y += __uint_as_float(rr.x & 0xffff0000u); acc.z += __uint_as_float(rr.y << 16); acc.w += __uint_as_float(rr.y & 0xffff0000u);
                    pc[hf] = pk4(acc);
                }
                *(u32x4*)(G.ZZ + ch * 2048 + ((tt * 2 + ks) * 64 + lane) * 8) = (u32x4){pc[0].x, pc[0].y, pc[1].x, pc[1].y};
            }
    } else if (wg == 1) {
#pragma unroll
        for (int vt = 0; vt < 4; ++vt)
#pragma unroll
            for (int tt = 0; tt < 2; ++tt) {
                const f32x4 acc = MFMA16(ldf(Mak, 16 * tt + fr, TS, 8 * fq), ldf(Vt, 16 * vt + fr, TS, 8 * fq), z4);
                *(u32x2*)(MakVt + (16 * vt + fr) * TS + 16 * tt + 4 * fq) = pk4(acc);
            }
        __syncthreads();
#pragma unroll
        for (int rt = 2; rt < 4; ++rt)
#pragma unroll
            for (int tt = 0; tt < 2; ++tt) {
                const f32x4 acc = MFMA16(ldf(Tm, 16 * tt + fr, TS, 8 * fq), ldf(ATt, 16 * rt + fr, TS, 8 * fq), z4);
                *(u32x2*)(GT + (16 * rt + fr) * TS + 16 * tt + 4 * fq) = pk4(acc);
            }
        __syncthreads();
#pragma unroll
        for (int kp = 0; kp < 4; ++kp)
#pragma unroll
            for (int ks = 0; ks < 2; ++ks) {
                u32x2 pc[2];
#pragma unroll
                for (int hf = 0; hf < 2; ++hf) {
                    const int kt = 2 * ks + hf;
                    f32x4 acc = MFMA16(ldf(GT, 16 * kt + fr, TS, 8 * fq), ldf(BHt, 16 * kp + fr, TS, 8 * fq), z4);
                    const int kq = 16 * kp + fr, k0 = 16 * kt + 4 * fq; const float wl = WL[kq];
                    acc.x = (acc.x + (k0 + 0 == kq ? 1.f : 0.f)) * wl; acc.y = (acc.y + (k0 + 1 == kq ? 1.f : 0.f)) * wl; acc.z = (acc.z + (k0 + 2 == kq ? 1.f : 0.f)) * wl; acc.w = (acc.w + (k0 + 3 == kq ? 1.f : 0.f)) * wl;
                    pc[hf] = pk4(acc);
                }
                *(u32x4*)(G.PT + ch * 4096 + ((kp * 2 + ks) * 64 + lane) * 8) = (u32x4){pc[0].x, pc[0].y, pc[1].x, pc[1].y};
            }
    } else if (wg == 2) {
        f32x4 y0acc[2][4];
#pragma unroll
        for (int tt = 0; tt < 2; ++tt)
#pragma unroll
            for (int vt = 0; vt < 4; ++vt) y0acc[tt][vt] = MFMA16(ldf(Vt, 16 * vt + fr, TS, 8 * fq), ldf(Mrk, 16 * tt + fr, TS, 8 * fq), z4);
        __syncthreads();
#pragma unroll
        for (int rt = 0; rt < 2; ++rt)
#pragma unroll
            for (int tt = 0; tt < 2; ++tt) {
                const f32x4 acc = MFMA16(ldf(Tm, 16 * tt + fr, TS, 8 * fq), ldf(MakVt, 16 * rt + fr, TS, 8 * fq), z4);
                *(u32x2*)(U0T + (16 * rt + fr) * TS + 16 * tt + 4 * fq) = pk4(acc);
            }
        __syncthreads();
#pragma unroll
        for (int tt = 0; tt < 2; ++tt)
#pragma unroll
            for (int vp = 0; vp < 2; ++vp) {
                const f32x4 a0 = MFMA16(ldf(U0T, 16 * (2 * vp) + fr, TS, 8 * fq), ldf(Mrb, 16 * tt + fr, TS, 8 * fq), y0acc[tt][2 * vp]);
                const f32x4 a1 = MFMA16(ldf(U0T, 16 * (2 * vp + 1) + fr, TS, 8 * fq), ldf(Mrb, 16 * tt + fr, TS, 8 * fq), y0acc[tt][2 * vp + 1]);
                const u32x2 p0 = pk4(a0), p1 = pk4(a1);
                *(u32x4*)(G.Y0 + ch * 2048 + ((tt * 2 + vp) * 64 + lane) * 8) = (u32x4){p0.x, p0.y, p1.x, p1.y};
            }
    } else {
        f32x4 qacc[4][4];
#pragma unroll
        for (int vt = 0; vt < 4; ++vt)
#pragma unroll
            for (int kt = 0; kt < 4; ++kt) qacc[vt][kt] = MFMA16(ldf(KHt, 16 * kt + fr, TS, 8 * fq), ldf(Vt, 16 * vt + fr, TS, 8 * fq), z4);
        __syncthreads();
#pragma unroll
        for (int rt = 2; rt < 4; ++rt)
#pragma unroll
            for (int tt = 0; tt < 2; ++tt) {
                const f32x4 acc = MFMA16(ldf(Tm, 16 * tt + fr, TS, 8 * fq), ldf(MakVt, 16 * rt + fr, TS, 8 * fq), z4);
                *(u32x2*)(U0T + (16 * rt + fr) * TS + 16 * tt + 4 * fq) = pk4(acc);
            }
        __syncthreads();
#pragma unroll
        for (int vt = 0; vt < 4; ++vt)
#pragma unroll
            for (int hf2 = 0; hf2 < 2; ++hf2) {
                u32x2 pc[2];
#pragma unroll
                for (int hf = 0; hf < 2; ++hf) {
                    const int kt = 2 * hf2 + hf;
                    f32x4 acc = MFMA16(ldf(BHt, 16 * kt + fr, TS, 8 * fq), ldf(U0T, 16 * vt + fr, TS, 8 * fq), qacc[vt][kt]);
                    acc *= *(const f32x4*)(WL + 16 * kt + 4 * fq);
                    pc[hf] = pk4(acc);
                }
                *(u32x4*)(G.QQ + ch * 4096 + ((vt * 2 + hf2) * 64 + lane) * 8) = (u32x4){pc[0].x, pc[0].y, pc[1].x, pc[1].y};
            }
    }
    __syncthreads();
}

__device__ __forceinline__ void chain_step(f32x4 (&acc)[4], const bf16x8 (&fa)[4][2], u32x4 q01, u32x4 q23, bf16_t* __restrict__ scp) {
    union { u32x4 u; bf16x8 v; } bs[2];
    const u32x2 a = pk4(acc[0]), b = pk4(acc[1]), c2 = pk4(acc[2]), d = pk4(acc[3]);
    *(u32x4*)(scp) = (u32x4){a.x, a.y, b.x, b.y}; *(u32x4*)(scp + 512) = (u32x4){c2.x, c2.y, d.x, d.y};
    bs[0].u = (u32x4){a.x, a.y, b.x, b.y}; bs[1].u = (u32x4){c2.x, c2.y, d.x, d.y};
    acc[0] = (f32x4){__uint_as_float(q01.x << 16), __uint_as_float(q01.x & 0xffff0000u), __uint_as_float(q01.y << 16), __uint_as_float(q01.y & 0xffff0000u)};
    acc[1] = (f32x4){__uint_as_float(q01.z << 16), __uint_as_float(q01.z & 0xffff0000u), __uint_as_float(q01.w << 16), __uint_as_float(q01.w & 0xffff0000u)};
    acc[2] = (f32x4){__uint_as_float(q23.x << 16), __uint_as_float(q23.x & 0xffff0000u), __uint_as_float(q23.y << 16), __uint_as_float(q23.y & 0xffff0000u)};
    acc[3] = (f32x4){__uint_as_float(q23.z << 16), __uint_as_float(q23.z & 0xffff0000u), __uint_as_float(q23.w << 16), __uint_as_float(q23.w & 0xffff0000u)};
#pragma unroll
    for (int it = 0; it < 4; ++it) { acc[it] = MFMA16(fa[it][0], bs[0].v, acc[it]); acc[it] = MFMA16(fa[it][1], bs[1].v, acc[it]); }
}
__device__ __forceinline__ void rwkv_chain1(int sq, int h, int wg, const float* __restrict__ state_in, const RwkvG& G, float* __restrict__ st_s) {
    int tid_ = threadIdx.x; asm volatile("" : "+v"(tid_));
    const int lane = tid_ & 63, fr = lane & 15, fq = lane >> 4, j0 = 16 * wg;
    const Seq s = seq_of(sq);
    const size_t ch = (size_t)(s.base / 32) * 4 + h;
    f32x4 acc[4];
#pragma unroll
    for (int it = 0; it < 4; ++it) acc[it] = *(const f32x4*)(state_in + (((size_t)s.b * 4 + h) * 64 + j0 + fr) * 64 + 16 * it + 4 * fq);
    bf16x8 fa[4][2];
#pragma unroll
    for (int it = 0; it < 4; ++it)
#pragma unroll
        for (int ks = 0; ks < 2; ++ks) fa[it][ks] = *(const bf16x8*)(G.PT + ch * 4096 + ((it * 2 + ks) * 64 + lane) * 8);
    const u32x4 q01 = *(const u32x4*)(G.QQ + ch * 4096 + ((wg * 2) * 64 + lane) * 8), q23 = *(const u32x4*)(G.QQ + ch * 4096 + ((wg * 2 + 1) * 64 + lane) * 8);
    chain_step(acc, fa, q01, q23, G.SC + ch * 4096 + wg * 1024 + lane * 8);
    float* o = st_s + (((size_t)s.b * 4 + h) * 64 + j0 + fr) * 64 + 4 * fq;
#pragma unroll
    for (int it = 0; it < 4; ++it) *(f32x4*)(o + 16 * it) = acc[it];
}
constexpr int CH_RP = 16, CH_RQ = 16, CH_SLOT = 8192  ;
#define CH_BAR() do { __builtin_amdgcn_s_waitcnt(0xc07f); __builtin_amdgcn_s_barrier(); } while (0)
__device__ __forceinline__ void rwkv_chain_lds(unsigned char* lds, int sq, int h, const RwkvG& G, float* __restrict__ st_p) {
    constexpr int nc = 4096 / 32;
    static_assert(nc % CH_RP == 0 && CH_RP % CH_RQ == 0, "ring depths must divide the chunk count");
    int tid_ = threadIdx.x; asm volatile("" : "+v"(tid_));
    const int wv = __builtin_amdgcn_readfirstlane(tid_ >> 6);
    const Seq s = seq_of(sq);
    const size_t ch0 = (size_t)(s.base / 32) * 4 + h;
    if (wv >= 4) {
        int tl_ = threadIdx.x; asm volatile("" : "+v"(tl_)); const int lane = tl_ & 63;
        const int lw = wv - 4;
        const bf16_t* pn = G.PT + ch0 * 4096 + (size_t)(lw * 128 + lane) * 8;
        unsigned char* dst0 = lds + (lw * 128 + lane) * 16;
        u32x4 ld[CH_RP][2];
#pragma unroll
        for (int c = 0; c < CH_RP; ++c) {
#pragma unroll
            for (int i = 0; i < 2; ++i) ld[c][i] = *(const u32x4*)(pn + i * 512);
            pn += 16384; asm volatile("" : "+v"(pn));
        }
#pragma unroll
        for (int i = 0; i < 2; ++i) *(u32x4*)(dst0 + i * 1024) = ld[0][i];
#pragma unroll
        for (int i = 0; i < 2; ++i) ld[0][i] = *(const u32x4*)(pn + i * 512);
        pn += 16384; asm volatile("" : "+v"(pn));
        CH_BAR();
#pragma unroll 1
        for (int s0 = 0; s0 < nc; s0 += CH_RP) {
#pragma unroll
            for (int j = 0; j < CH_RP; ++j) {
                const int nx = s0 + j + 1, set = (j + 1) % CH_RP;
                unsigned char* d = dst0 + (nx & 1) * CH_SLOT;
#pragma unroll
                for (int i = 0; i < 2; ++i) *(u32x4*)(d + i * 1024) = ld[set][i];
#pragma unroll
                for (int i = 0; i < 2; ++i) ld[set][i] = *(const u32x4*)(pn + i * 512);
                pn += (nx + CH_RP + 1 < nc) ? 16384 : 0; asm volatile("" : "+v"(pn));
                CH_BAR();
            }
        }
    } else {
        int tc_ = threadIdx.x; asm volatile("" : "+v"(tc_)); const int lane = tc_ & 63, fr = lane & 15, fq = lane >> 4;
        const int j0 = 16 * wv;
        const bf16_t* qn = G.QQ + ch0 * 4096 + (size_t)((wv * 2) * 64 + lane) * 8;
        u32x4 qr[CH_RQ][2];
#pragma unroll
        for (int c = 0; c < CH_RQ; ++c) { qr[c][0] = *(const u32x4*)(qn); qr[c][1] = *(const u32x4*)(qn + 512); qn += 16384; asm volatile("" : "+v"(qn)); }
        bf16_t* scp = G.SC + ch0 * 4096 + wv * 1024 + lane * 8;
        f32x4 acc[4];
#pragma unroll
        for (int it = 0; it < 4; ++it) acc[it] = (f32x4){0.f, 0.f, 0.f, 0.f};
        CH_BAR();
#pragma unroll 1
        for (int s0 = 0; s0 < nc; s0 += CH_RP) {
#pragma unroll
            for (int j = 0; j < CH_RP; ++j) {
                const int st = s0 + j, qs = j % CH_RQ;
                const unsigned char* sl = lds + (st & 1) * CH_SLOT;
                bf16x8 fa[4][2];
#pragma unroll
                for (int it = 0; it < 4; ++it)
#pragma unroll
                    for (int ks = 0; ks < 2; ++ks) fa[it][ks] = *(const bf16x8*)(sl + ((it * 2 + ks) * 64 + lane) * 16);
                const u32x4 q01 = qr[qs][0], q23 = qr[qs][1];
                qr[qs][0] = *(const u32x4*)(qn); qr[qs][1] = *(const u32x4*)(qn + 512);
                qn += (st + CH_RQ + 1 < nc) ? 16384 : 0; asm volatile("" : "+v"(qn));
                chain_step(acc, fa, q01, q23, scp);
                scp += 16384; asm volatile("" : "+v"(scp));
                CH_BAR();
            }
        }
        int t3 = threadIdx.x; asm volatile("" : "+v"(t3));
        const int l3 = t3 & 63, fr3 = l3 & 15, fq3 = l3 >> 4;
        float* o = st_p + (((size_t)s.b * 4 + h) * 64 + j0 + fr3) * 64 + 4 * fq3;
#pragma unroll
        for (int it = 0; it < 4; ++it) *(f32x4*)(o + 16 * it) = acc[it];
    }
}

__device__ __forceinline__ void rwkv_out(int wi, const RwkvW& w, const RwkvG& G, bf16_t* __restrict__ YMIX) {
    int tid_ = threadIdx.x; asm volatile("" : "+v"(tid_));
    const int lane = tid_ & 63, fr = lane & 15, fq = lane >> 4;
    const size_t ch = (size_t)(wi >> 1); const int tt = wi & 1, h = (int)(ch & 3), cid = (int)(ch >> 2);
    const int t = 16 * tt + fr, tok = cid * 32 + t;
    const bf16x8 z0 = *(const bf16x8*)(G.ZZ + ch * 2048 + ((tt * 2 + 0) * 64 + lane) * 8), z1 = *(const bf16x8*)(G.ZZ + ch * 2048 + ((tt * 2 + 1) * 64 + lane) * 8);
    const u32x4 yp0 = *(const u32x4*)(G.Y0 + ch * 2048 + ((tt * 2 + 0) * 64 + lane) * 8), yp1 = *(const u32x4*)(G.Y0 + ch * 2048 + ((tt * 2 + 1) * 64 + lane) * 8);
    f32x4 y[4]; float sum = 0.f;
#pragma unroll
    for (int vt = 0; vt < 4; ++vt) {
        const bf16_t* sp = G.SC + ch * 4096 + vt * 1024 + lane * 8;
        const u32x4 yp = vt < 2 ? yp0 : yp1; const unsigned ya = (vt & 1) ? yp.z : yp.x, yb2 = (vt & 1) ? yp.w : yp.y;
        f32x4 acc = {__uint_as_float(ya << 16), __uint_as_float(ya & 0xffff0000u), __uint_as_float(yb2 << 16), __uint_as_float(yb2 & 0xffff0000u)};
        acc = MFMA16(*(const bf16x8*)sp, z0, acc); acc = MFMA16(*(const bf16x8*)(sp + 512), z1, acc);
        y[vt] = acc; sum += (acc.x + acc.y) + (acc.z + acc.w);
    }
    sum += __shfl_xor(sum, 16); sum += __shfl_xor(sum, 32);
    const float mean = sum * (1.f / 64.f); float var = 0.f;
#pragma unroll
    for (int vt = 0; vt < 4; ++vt) { y[vt] -= mean; var += (y[vt].x * y[vt].x + y[vt].y * y[vt].y) + (y[vt].z * y[vt].z + y[vt].w * y[vt].w); }
    var += __shfl_xor(var, 16); var += __shfl_xor(var, 32);
    const float rstd = rsqrtf(var * (1.f / 64.f) + 64e-5f);
#pragma unroll
    for (int vt = 0; vt < 4; ++vt) {
        const int c = h * 64 + 16 * vt + 4 * fq;
        const f32x4 gg = *(const f32x4*)(w.gn_g + c), gb = *(const f32x4*)(w.gn_b + c);
        const u32x2 bv = *(const u32x2*)(G.BV + (size_t)tok * 256 + c), gt = *(const u32x2*)(G.GATE + (size_t)tok * 256 + c);
        f32x4 o = y[vt] * rstd * gg + gb;
        o.x = (o.x + __uint_as_float(bv.x << 16)) * __uint_as_float(gt.x << 16); o.y = (o.y + __uint_as_float(bv.x & 0xffff0000u)) * __uint_as_float(gt.x & 0xffff0000u);
        o.z = (o.z + __uint_as_float(bv.y << 16)) * __uint_as_float(gt.y << 16); o.w = (o.w + __uint_as_float(bv.y & 0xffff0000u)) * __uint_as_float(gt.y & 0xffff0000u);
        *(u32x2*)(YMIX + (size_t)tok * DM + 256 + c) = pk4(o);
    }
}


template <int K, int SRC, bool WF32, bool WBF>
__device__ __forceinline__ void gemm_tail(unsigned char* lds, const bf16_t* __restrict__ A, const bf16_t* __restrict__ Bt, const float* __restrict__ xin_s, float* __restrict__ xout, bf16_t* __restrict__ XB, float* __restrict__ RSS) {
    int tid_ = threadIdx.x; asm volatile("" : "+v"(tid_));
    const int lane = tid_ & 63, w = __builtin_amdgcn_readfirstlane(tid_ >> 6), fr = lane & 15, fq = lane >> 4;
    float* part = (float*)lds;
    for (int tb = blockIdx.x; tb < 256; tb += gridDim.x) {
        const int mi = tb >> 4, ni = tb & 15, rt = w >> 2, ct = w & 3;
        const int r0 = 32 * mi + 16 * rt, c0 = 64 * ni + 16 * ct;
        const bf16_t* ap = A + (size_t)(T_P + r0 + fr) * K + 8 * fq; const bf16_t* bp = Bt + (size_t)(c0 + fr) * K + 8 * fq;
        f32x4 acc = {0.f, 0.f, 0.f, 0.f};
#pragma unroll 1
        for (int k0 = 0; k0 + 512 <= K; k0 += 512) {
            bf16x8 av[16], bv[16];
#pragma unroll
            for (int u = 0; u < 16; ++u) { av[u] = *(const bf16x8*)(ap + k0 + 32 * u); bv[u] = *(const bf16x8*)(bp + k0 + 32 * u); }
#pragma unroll
            for (int u = 0; u < 16; ++u) acc = MFMA16(bv[u], av[u], acc);
        }
        if (K % 512) {
            constexpr int k0 = K - (K % 512), NU = (K % 512) / 32;
            bf16x8 av[NU > 0 ? NU : 1], bv[NU > 0 ? NU : 1];
#pragma unroll
            for (int u = 0; u < NU; ++u) { av[u] = *(const bf16x8*)(ap + k0 + 32 * u); bv[u] = *(const bf16x8*)(bp + k0 + 32 * u); }
#pragma unroll
            for (int u = 0; u < NU; ++u) acc = MFMA16(bv[u], av[u], acc);
        }
        const int row = r0 + fr, col = c0 + 4 * fq;
        f32x4 x;
        if (SRC == 0) x = *(const f32x4*)(xin_s + (size_t)row * DM + col);
        else { const u32x2 r = *(const u32x2*)(XB + (size_t)(T_P + row) * DM + col); x = (f32x4){__uint_as_float(r.x << 16), __uint_as_float(r.x & 0xffff0000u), __uint_as_float(r.y << 16), __uint_as_float(r.y & 0xffff0000u)}; }
        x += acc;
        if (WF32) *(f32x4*)(xout + (size_t)(T_P + row) * DM + col) = x;
        if (WBF) {
            *(u32x2*)(XB + (size_t)(T_P + row) * DM + col) = pk4(x);
            float ss = (x.x * x.x + x.y * x.y) + (x.z * x.z + x.w * x.w);
            ss += __shfl_xor(ss, 16); ss += __shfl_xor(ss, 32);
            if (lane < 16) part[(rt * 4 + ct) * 16 + fr] = ss;
            __syncthreads();
            if (tid_ < 32) { const int rr = tid_ >> 4, f = tid_ & 15; RSS[(size_t)(T_P + 32 * mi + 16 * rr + f) * 16 + ni] = (part[(rr * 4 + 0) * 16 + f] + part[(rr * 4 + 1) * 16 + f]) + (part[(rr * 4 + 2) * 16 + f] + part[(rr * 4 + 3) * 16 + f]); }
            __syncthreads();
        }
    }
}

template <class E2> struct EpiAdapt {
    static constexpr bool PERM = true, AFTER_DRAIN = false; E2 e;
    __device__ __forceinline__ void operator()(const pg8::f32x4 (&acc)[2][2][4][2], const pg8::Unit& u, int wr, int wc, int fr, int fq) const {
#pragma unroll
        for (int ai = 0; ai < 2; ++ai)
#pragma unroll
            for (int m = 0; m < 4; ++m) {
                const int row = u.pm * 256 + ai * 128 + wr * 64 + m * 16 + fr;
                const float rs = e.rowscale(row);
                e(row, u.pn * 256 + wc * 32 + 8 * fq, acc[ai][0][m][0], acc[ai][0][m][1], acc[ai][1][m][0], acc[ai][1][m][1], rs);
            }
    }
};

#define LAS __attribute__((address_space(3)))
#define XB_TMO      128
#define XB_XCNT(j)  (256  + 64 * (j))
#define XB_XSUB(j)  (1280 + 64 * (j))
#define XB_XGEN(j)  (2304 + 64 * (j))
#define XB_TOP      3328
#define XB_TOPGEN   3392
#define XCD_BAR_WORDS 3456
#define XB_SPIN_CAP (1u << 18)

__device__ __forceinline__ unsigned xb_ld(unsigned* p)              { return __hip_atomic_load(p, __ATOMIC_RELAXED, __HIP_MEMORY_SCOPE_AGENT); }
__device__ __forceinline__ unsigned xb_add(unsigned* p, unsigned v) { return __hip_atomic_fetch_add(p, v, __ATOMIC_RELAXED, __HIP_MEMORY_SCOPE_AGENT); }
__device__ __forceinline__ unsigned xb_xcc_id() { return (unsigned)__builtin_amdgcn_s_getreg((3 << 11) | 20) & 0xFu; }
#define XB_SPIN(cond, bar) do { unsigned _sp = 0; while (cond) { __builtin_amdgcn_s_sleep(1); \
    if ((++_sp & 255u) == 0u) { if (xb_ld(&(bar)[XB_TMO])) break; if (_sp > XB_SPIN_CAP) { atomicAdd(&(bar)[XB_TMO], 1u); break; } } } } while (0)

struct XcdBarrier {
    unsigned* bar; unsigned x;
    unsigned* psub; unsigned* pgen;
    volatile LAS unsigned* st;
};

__device__ __forceinline__ XcdBarrier xcd_barrier_post(unsigned* bar, volatile LAS unsigned* st) {
    XcdBarrier b; b.bar = bar; b.x = xb_xcc_id(); b.st = st; b.psub = bar + XB_XSUB(b.x); b.pgen = bar + XB_XGEN(b.x);
    if (threadIdx.x == 0) (void)xb_add(&bar[XB_XCNT(b.x)], 1u);
    return b;
}
__device__ __forceinline__ void xcd_barrier_complete(unsigned* bar, unsigned x, unsigned& nloc, unsigned& nx) {
    const unsigned G = gridDim.x * gridDim.y * gridDim.z;
    unsigned sum, cnt, mine, sp = 0u;
    for (;;) {
        sum = 0u; cnt = 0u; mine = 0u;
#pragma unroll
        for (unsigned j = 0; j < 16; ++j) { const unsigned c = xb_ld(&bar[XB_XCNT(j)]); sum += c; cnt += (c > 0u) ? 1u : 0u; mine = (j == x) ? c : mine; }
        if (sum == G) break;
        __builtin_amdgcn_s_sleep(1);
        if ((++sp & 255u) == 0u) { if (xb_ld(&bar[XB_TMO])) break; if (sp > XB_SPIN_CAP) { atomicAdd(&bar[XB_TMO], 1u); break; } }
    }
    nloc = mine > 0u ? mine : 1u; nx = cnt > 0u ? cnt : 1u;
}

__device__ __forceinline__ void xcd_barrier(const XcdBarrier& b) {
    asm volatile("s_waitcnt vmcnt(0)" ::: "memory");
    __syncthreads();
    if (threadIdx.x == 0) {
        unsigned* bar = b.bar;
        __builtin_amdgcn_s_waitcnt(0);
        unsigned nloc = b.st[0], nx = b.st[1];
        const unsigned old = xb_add(b.psub, 1u);
        const unsigned gen = old / nloc;
        if (old + 1u == (gen + 1u) * nloc) {
            __builtin_amdgcn_fence(__ATOMIC_RELEASE, "agent");
            asm volatile("s_waitcnt vmcnt(0)" ::: "memory");
            const unsigned og = xb_add(&bar[XB_TOP], 1u);
            const unsigned tg = og / nx;
            if (og + 1u == (tg + 1u) * nx) xb_add(&bar[XB_TOPGEN], 1u);
            else XB_SPIN(xb_ld(&bar[XB_TOPGEN]) == tg, bar);
            __builtin_amdgcn_fence(__ATOMIC_ACQUIRE, "agent");
            xb_add(b.pgen, 1u);
            asm volatile("s_waitcnt vmcnt(0)" ::: "memory");
        } else {
            XB_SPIN(xb_ld(b.pgen) == gen, bar);
            __builtin_amdgcn_fence(__ATOMIC_ACQUIRE, "agent");
            asm volatile("s_waitcnt vmcnt(0)" ::: "memory");
        }
    }
    __syncthreads();
}


__device__ __forceinline__ void xcd_census(const XcdBarrier& b) { if (threadIdx.x == 0) { unsigned nloc, nx; xcd_barrier_complete(b.bar, b.x, nloc, nx); b.st[0] = nloc; b.st[1] = nx; } __syncthreads(); }

constexpr int LDS_BYTES = 147456;
struct MP { const float* in[35]; float* out; unsigned char* ws; int ph_lo, ph_hi; };
__device__ __forceinline__ const float* inptr_(int k) { const float* const* ka = (const float* const*)__builtin_amdgcn_kernarg_segment_ptr(); asm volatile("" : "+s"(k)); return ka[k]; }
__device__ __forceinline__ int fresh_bx() { int b = blockIdx.x; asm volatile("" : "+s"(b)); return b; }
__global__ void __launch_bounds__(512, 2) mega(MP p) {
    extern __shared__ __attribute__((aligned(16))) unsigned char lds[];
    cg::grid_group grid = cg::this_grid();
    float* out = p.out; unsigned char* ws = p.ws;
#define INP(k) inptr_(k)
#define WIN ((bf16_t*)(ws + WS_WIN))
#define WOUT ((bf16_t*)(ws + WS_WOUT))
#define WGU ((bf16_t*)(ws + WS_WGU))
#define WD ((bf16_t*)(ws + WS_WD))
#define XB ((bf16_t*)(ws + WS_XB))
#define YMIX ((bf16_t*)(ws + WS_YMIX))
#define RSS ((float*)(ws + WS_RSS))
#define PROJ ((bf16_t*)(ws + WS_PROJ))
#define H ((bf16_t*)(ws + WS_H))
    const int lo = p.ph_lo, hi = p.ph_hi;
    int tid = threadIdx.x, half = tid >> 8;
#define FRESH() do { asm volatile("" : "+v"(tid)); half = tid >> 8; asm volatile("" : "+s"(ws), "+s"(out)); } while (0)
#ifndef TESTPH
#define TESTPH -1
#endif
    volatile LAS unsigned* bst = (volatile LAS unsigned*)(lds + LDS_BYTES - 16);
    if (threadIdx.x < 4) bst[threadIdx.x] = 0u;
    __syncthreads();
    const XcdBarrier xbar = xcd_barrier_post((unsigned*)(ws + WS_CTL), bst);
#ifndef PROF
#define PROF 0
#endif
    unsigned long long* tsb = (unsigned long long*)(ws + WS_CTL + 14336);
#ifndef DUP
#define DUP -1
#endif
#define REPS(k) for (int rep_ = 0; rep_ < ((DUP) == (k) ? 2 : 1); ++rep_)
#define REPSYNC(k) do { if ((DUP) == (k) && rep_ == 0) xcd_barrier(xbar); } while (0)
#define STAMP(k) do { if (PROF && blockIdx.x == 0 && threadIdx.x == 0) tsb[k] = __builtin_amdgcn_s_memrealtime(); } while (0)
    STAMP(0);
#define IN(k) ((TESTPH < 0 || TESTPH == ((k) > 8 ? (k) - 8 : (k))) && lo <= (k) && (k) < hi)
#define SEAM(k) do { if (IN((k) + 1)) { if ((k) == 0) { grid.sync(); xcd_census(xbar); } else xcd_barrier(xbar); } } while (0)
    if (IN(0)) REPS(0) {
        FRESH();
        {
            float* scr = (float*)lds + (tid >> 6) * (64 * 33);
            const int gw = blockIdx.x * 8 + (tid >> 6), ngw = gridDim.x * 8, lane = tid & 63;
            constexpr int I_IN = (DM / 64) * (NIN / 32), I_OUT = (DM / 64) * (DM / 32), I_G = (DM / 64) * (DFF / 32), I_D = (DFF / 64) * (DM / 32), I_L = I_IN + I_OUT + 2 * I_G + I_D;
            for (int it = gw; it < 2 * I_L; it += ngw) {
                const int l2 = it / I_L; int r = it - l2 * I_L;
                if (r < I_IN) { p0_item(INP(9) + (size_t)l2 * DM * NIN, DM, NIN, WIN + (size_t)l2 * NINP * DM, INP(8) + l2 * DM, NIN, 0, 0, scr, r, lane, true); continue; } r -= I_IN;
                if (r < I_OUT) { p0_item(INP(30) + (size_t)l2 * DM * DM, DM, DM, WOUT + (size_t)l2 * DM * DM, nullptr, DM, 0, 0, scr, r, lane); continue; } r -= I_OUT;
                if (r < I_G) { p0_item(INP(32) + (size_t)l2 * DM * DFF, DM, DFF, WGU + (size_t)l2 * 2 * DFF * DM, INP(31) + l2 * DM, 4, 8, 0, scr, r, lane); continue; } r -= I_G;
                if (r < I_G) { p0_item(INP(33) + (size_t)l2 * DM * DFF, DM, DFF, WGU + (size_t)l2 * 2 * DFF * DM, INP(31) + l2 * DM, 4, 8, 4, scr, r, lane); continue; } r -= I_G;
                p0_item(INP(34) + (size_t)l2 * DFF * DM, DFF, DM, WD + (size_t)l2 * DM * DFF, nullptr, DM, 0, 0, scr, r, lane);
            }
        }
        {
            bf16_t* PWT = (bf16_t*)(ws + WS_PWT);
            for (int i = blockIdx.x * 512 + tid; i < 2 * 4 * 64 * 64; i += gridDim.x * 512) { const int lg = i >> 12, d = (i >> 6) & 63, cc = i & 63; PWT[i] = f2bf(INP(25)[((size_t)lg * 64 + cc) * 64 + d]); }
        }
        {
            bf16_t* LWT = (bf16_t*)(ws + WS_LWT);
            for (int i = blockIdx.x * 512 + tid; i < 2 * 256 * 128; i += gridDim.x * 512) {
                const int l2 = i >> 15, c = (i >> 7) & 255, j = i & 127;
                const float v = j < 32 ? INP(16)[((size_t)l2 * 32 + j) * 256 + c] : (j < 64 ? INP(18)[((size_t)l2 * 32 + (j - 32)) * 256 + c] : INP(19)[((size_t)l2 * 64 + (j - 64)) * 256 + c]);
                LWT[i] = f2bf(v);
            }
        }
        for (int i = blockIdx.x; i < T / 16; i += gridDim.x) { d_xprep(i * 16 + (tid >> 6), INP(0), INP(1), XB, RSS); d_xprep(i * 16 + 8 + (tid >> 6), INP(0), INP(1), XB, RSS); }
        if (DUP == 0 && rep_ == 0) grid.sync(); else { SEAM(0); STAMP(1); }
    }
    for (int l = 0; l < 2; ++l) {
        const int pb = 1 + 8 * l;
        if (IN(pb + 0)) REPS(1) {
            FRESH();
            pg8::Gemm g{XB, WIN + (size_t)l * NINP * DM, T, NINP, DM}; pg8::StaticOrder S; S.init(T, NINP, gridDim.x, fresh_bx());
            EpiAdapt<EpiProj> E{EpiProj{PROJ, RSS, (bf16_t*)(ws + WS_GLU)}};
            pg8::gemm_phase<EpiAdapt<EpiProj>, pg8::StaticOrder, true, true>((LAS unsigned char*)lds, g, S, E);
            REPSYNC(1); if (!(DUP == 1 && rep_ == 0)) { SEAM(pb + 0); STAMP(pb + 1); }
        }
        if (IN(pb + 1)) REPS(2) {
            FRESH();
            int ll = l; asm volatile("" : "+s"(ll));
            const RwkvW rw{INP(14) + ll * 896, INP(15) + ll * 256, INP(16) + ll * 32 * 256, INP(17) + ll * 256, INP(18) + ll * 32 * 256, INP(19) + ll * 64 * 256, INP(20) + ll * 256, INP(21) + ll * 256, INP(22) + ll * 256, INP(23) + ll * 256, INP(24) + ll * 256};
            const RwkvG rg{(bf16_t*)(ws + WS_PT), (bf16_t*)(ws + WS_QQ), (bf16_t*)(ws + WS_ZZ), (bf16_t*)(ws + WS_Y0), (bf16_t*)(ws + WS_SC), (bf16_t*)(ws + WS_GATE), (bf16_t*)(ws + WS_BV), (const bf16_t*)(ws + WS_LWT)};
            for (int it = blockIdx.x; it < 1024; it += gridDim.x) rwkv_item(lds, it, ll, PROJ, INP(4) + (size_t)ll * 16 * 896, rw, rg);
            for (int i = blockIdx.x * 512 + tid; i < 20 * 896; i += gridDim.x * 512) {
                const int sq = i / 896, c = i - sq * 896; const Seq sx = seq_of(sq);
                const float v = bf2f(PROJ[(size_t)(sx.base + sx.L - 1) * NINP + C_B + c]);
                if (sx.sample) out[O_SHIFT_S + ((size_t)ll * 16 + sx.b) * 896 + c] = v; else out[O_SHIFT_P + ((size_t)ll * 4 + sx.b) * 896 + c] = v;
            }
            REPSYNC(2); if (!(DUP == 2 && rep_ == 0)) { SEAM(pb + 1); STAMP(pb + 2); }
        }
        if (IN(pb + 2)) REPS(3) {
            FRESH();
            int ll = l; asm volatile("" : "+s"(ll));
            const RwkvW rw{INP(14) + ll * 896, INP(15) + ll * 256, INP(16) + ll * 32 * 256, INP(17) + ll * 256, INP(18) + ll * 32 * 256, INP(19) + ll * 64 * 256, INP(20) + ll * 256, INP(21) + ll * 256, INP(22) + ll * 256, INP(23) + ll * 256, INP(24) + ll * 256};
            const RwkvG rg{(bf16_t*)(ws + WS_PT), (bf16_t*)(ws + WS_QQ), (bf16_t*)(ws + WS_ZZ), (bf16_t*)(ws + WS_Y0), (bf16_t*)(ws + WS_SC), (bf16_t*)(ws + WS_GATE), (bf16_t*)(ws + WS_BV), (const bf16_t*)(ws + WS_LWT)};
            if (blockIdx.x < 16) rwkv_chain_lds(lds, (int)blockIdx.x >> 2, (int)blockIdx.x & 3, rg, out + O_RWKV_P + (size_t)ll * 4 * 4 * 4096);
            else if (blockIdx.x < 48) {
                const int sidx = (int)blockIdx.x - 16;
                rwkv_item(lds, 1024 + sidx, ll, PROJ, INP(4) + (size_t)ll * 16 * 896, rw, rg);
                __syncthreads();
                const int wv = tid >> 6;
                rwkv_chain1(4 + (sidx >> 1), (sidx & 1) * 2 + (wv >> 2), wv & 3, INP(3) + (size_t)ll * 16 * 4 * 4096, rg, out + O_RWKV_S + (size_t)ll * 16 * 4 * 4096);
            }
            {
                const AttnP ap{PROJ, INP(6) + (size_t)ll * 16 * 128 * 128, INP(7) + (size_t)ll * 16 * 128 * 128, INP(27) + ll * 64, INP(28) + ll * 64, INP(29) + ll * 4, YMIX,
                               out + O_K_P + (size_t)ll * 4 * 128 * 128, out + O_K_S + (size_t)ll * 16 * 128 * 128, out + O_V_P + (size_t)ll * 4 * 128 * 128, out + O_V_S + (size_t)ll * 16 * 128 * 128};
                const ConvPoolP cp{PROJ, INP(2) + (size_t)ll * 16 * 30 * 256, INP(10) + ll * 31 * 256, INP(11) + ll * 256, INP(12) + ll * 256, INP(13) + ll * 256, INP(5) + (size_t)ll * 16 * 15 * 256, INP(25) + (size_t)ll * 4 * 64 * 64, INP(26) + ll * 256, YMIX,
                                   out + O_CONV_P + (size_t)ll * 4 * 30 * 256, out + O_CONV_S + (size_t)ll * 16 * 30 * 256, out + O_POOL_P + (size_t)ll * 4 * 15 * 256, out + O_POOL_S + (size_t)ll * 16 * 15 * 256, (const bf16_t*)(ws + WS_GLU), (const bf16_t*)(ws + WS_PWT) + (size_t)ll * 4 * 64 * 64};
                unsigned* ctr = (unsigned*)(ws + WS_CTL + 14848) + 64 * ll + 32 * (DUP == 3 ? rep_ : 0);
                volatile LAS unsigned* wsl = (volatile LAS unsigned*)(lds + LDS_BYTES - 32);
                for (;;) {
                    __syncthreads();
                    if (tid == 0) wsl[0] = __hip_atomic_fetch_add(ctr, 1u, __ATOMIC_RELAXED, __HIP_MEMORY_SCOPE_AGENT);
                    __syncthreads();
                    const unsigned idx = wsl[0];
                    if (idx >= 528u + 544u) break;
                    if (idx < 528u) convpool_tile((float*)lds + half * (62 * 256), 2 * (int)idx + half, cp);
                    else attn_unit(lds, (int)idx - 528, ap);
                }
            }
            REPSYNC(3); if (!(DUP == 3 && rep_ == 0)) { SEAM(pb + 2); STAMP(pb + 3); }
        }
        if (IN(pb + 3)) REPS(4) {
            FRESH();
            int ll = l; asm volatile("" : "+s"(ll));
            const RwkvW rw{INP(14) + ll * 896, INP(15) + ll * 256, INP(16) + ll * 32 * 256, INP(17) + ll * 256, INP(18) + ll * 32 * 256, INP(19) + ll * 64 * 256, INP(20) + ll * 256, INP(21) + ll * 256, INP(22) + ll * 256, INP(23) + ll * 256, INP(24) + ll * 256};
            const RwkvG rg{(bf16_t*)(ws + WS_PT), (bf16_t*)(ws + WS_QQ), (bf16_t*)(ws + WS_ZZ), (bf16_t*)(ws + WS_Y0), (bf16_t*)(ws + WS_SC), (bf16_t*)(ws + WS_GATE), (bf16_t*)(ws + WS_BV), (const bf16_t*)(ws + WS_LWT)};
            for (int wi = blockIdx.x * 8 + (tid >> 6); wi < 2 * NCHH; wi += gridDim.x * 8) rwkv_out(wi, rw, rg, YMIX);
            REPSYNC(4); if (!(DUP == 4 && rep_ == 0)) { SEAM(pb + 3); STAMP(pb + 4); }
        }
        if (IN(pb + 4)) {
            FRESH();
            pg8::Gemm g{YMIX, WOUT + (size_t)l * DM * DM, T_P, DM, DM}; pg8::StaticOrder S; S.init(T_P, DM, gridDim.x, fresh_bx());
            if (l == 0) {
                EpiAdapt<EpiRes<0, false, true>> E{EpiRes<0, false, true>{INP(0), INP(1), out, XB, RSS}};
                pg8::gemm_phase<EpiAdapt<EpiRes<0, false, true>>, pg8::StaticOrder, true, true>((LAS unsigned char*)lds, g, S, E);
                gemm_tail<DM, 0, false, true>(lds, YMIX, WOUT + (size_t)l * DM * DM, INP(1), out, XB, RSS);
            } else {
                EpiAdapt<EpiRes<1, false, true>> E{EpiRes<1, false, true>{nullptr, nullptr, out, XB, RSS}};
                pg8::gemm_phase<EpiAdapt<EpiRes<1, false, true>>, pg8::StaticOrder, true, true>((LAS unsigned char*)lds, g, S, E);
                gemm_tail<DM, 1, false, true>(lds, YMIX, WOUT + (size_t)l * DM * DM, nullptr, out, XB, RSS);
            }
            SEAM(pb + 4); STAMP(pb + 5);
        }
        if (IN(pb + 5)) REPS(6) {
            FRESH();
            pg8::Gemm g{XB, WGU + (size_t)l * 2 * DFF * DM, T, 2 * DFF, DM}; pg8::StaticOrder S; S.init(T, 2 * DFF, gridDim.x, fresh_bx());
            EpiAdapt<EpiGU> E{EpiGU{H, RSS}};
            pg8::gemm_phase<EpiAdapt<EpiGU>, pg8::StaticOrder, true, true>((LAS unsigned char*)lds, g, S, E);
            REPSYNC(6); if (!(DUP == 6 && rep_ == 0)) { SEAM(pb + 5); STAMP(pb + 6); }
        }
        if (IN(pb + 6)) {
            FRESH();
            pg8::Gemm g{H, WD + (size_t)l * DM * DFF, T_P, DM, DFF}; pg8::StaticOrder S; S.init(T_P, DM, gridDim.x, fresh_bx());
            if (l == 0) {
                EpiAdapt<EpiRes<1, false, true>> E{EpiRes<1, false, true>{nullptr, nullptr, out, XB, RSS}};
                pg8::gemm_phase<EpiAdapt<EpiRes<1, false, true>>, pg8::StaticOrder, true, true>((LAS unsigned char*)lds, g, S, E);
                gemm_tail<DFF, 1, false, true>(lds, H, WD + (size_t)l * DM * DFF, nullptr, out, XB, RSS);
                SEAM(pb + 7); STAMP(pb + 7);
            } else {
                EpiAdapt<EpiRes<1, true, false>> E{EpiRes<1, true, false>{nullptr, nullptr, out, XB, RSS}};
                pg8::gemm_phase<EpiAdapt<EpiRes<1, true, false>>, pg8::StaticOrder, true, true>((LAS unsigned char*)lds, g, S, E);
                gemm_tail<DFF, 1, true, false>(lds, H, WD + (size_t)l * DM * DFF, nullptr, out, XB, RSS);
            }
        }
    }
    if (PROF) {
        xcd_barrier(xbar); STAMP(16); xcd_barrier(xbar);
        const unsigned long long* t = tsb;
        const unsigned long long d[12] = {t[16] - t[0], t[1] - t[0], t[2] - t[1], t[3] - t[2], t[4] - t[3], t[5] - t[4], t[6] - t[5], t[7] - t[6], t[8] - t[7], t[10] - t[8], t[13] - t[10], t[16] - t[13]};
        const size_t off[12] = {O_Y, O_Y + (size_t)T_P * DM, O_CONV_P, O_CONV_S, O_RWKV_P, O_RWKV_S, O_SHIFT_P, O_SHIFT_S, O_POOL_P, O_POOL_S, O_K_P, O_K_S};
        const unsigned cap[12] = {99999, 99999, 61000, 99999, 99999, 99999, 7000, 28000, 30000, 99999, 99999, 99999};
        for (int k = 0; k < 12; ++k) { unsigned c = (unsigned)(d[k] / 10ull); if (c > cap[k]) c = cap[k]; for (unsigned i = blockIdx.x * 512 + threadIdx.x; i < c; i += gridDim.x * 512) ((unsigned*)out)[off[k] + i] = 0xAAAAAAAAu; }
    }
}

#undef WIN
#undef WOUT
#undef WGU
#undef WD
#undef XB
#undef YMIX
#undef RSS
#undef PROJ
#undef H
static void launch_mega(MP p, int lo, int hi, int grid_blocks, hipStream_t stream) {
    p.ph_lo = lo; p.ph_hi = hi;
    void* args[] = {&p};
    hipError_t e = hipLaunchCooperativeKernel((const void*)mega, dim3(grid_blocks), dim3(512), args, LDS_BYTES, stream);
    if (e != hipSuccess) fprintf(stderr, "cooperative launch failed: %s (grid %d)\n", hipGetErrorString(e), grid_blocks);
}
extern "C" void kernel_launch(void* const* d_in, const int* in_sizes, int n_in, void* d_out, int out_size, void* d_ws, size_t ws_size, hipStream_t stream) {
    static int grid_blocks = 0;
    if (grid_blocks == 0) {
        if (n_in != 35 || (size_t)out_size != O_END || ws_size < WS_END) { fprintf(stderr, "kernel_launch: unexpected sizes n_in %d out %d ws %zu (need %zu)\n", n_in, out_size, ws_size, (size_t)WS_END); grid_blocks = -1; return; }
        int dev = 0, cus = 0, per_cu = 0;
        (void)hipGetDevice(&dev);
        (void)hipDeviceGetAttribute(&cus, hipDeviceAttributeMultiprocessorCount, dev);
        (void)hipFuncSetAttribute((const void*)mega, hipFuncAttributeMaxDynamicSharedMemorySize, LDS_BYTES);
        (void)hipOccupancyMaxActiveBlocksPerMultiprocessor(&per_cu, mega, 512, LDS_BYTES);
        if (per_cu < 1) { fprintf(stderr, "kernel_launch: occupancy query says %d blocks per CU\n", per_cu); grid_blocks = -1; return; }
        grid_blocks = cus;
    }
    if (grid_blocks < 0) return;
    const float* const* in = (const float* const*)d_in;
    float* out = (float*)d_out; unsigned char* ws = (unsigned char*)d_ws;
    MP p{};
    for (int i = 0; i < 35; ++i) p.in[i] = in[i];
    p.out = out; p.ws = ws;
    (void)hipMemsetAsync(ws + WS_CTL, 0, 16384, stream);
    launch_mega(p, 0, 16, grid_blocks, stream);
}
```

```cpp
#include <hip/hip_runtime.h>
#include <hip/hip_cooperative_groups.h>
namespace cg = cooperative_groups;
#include <cstdint>
#include <cstdio>

typedef unsigned short bf16_t;
typedef short bf16x8 __attribute__((ext_vector_type(8)));
typedef float f32x4 __attribute__((ext_vector_type(4)));
typedef unsigned u32x4 __attribute__((ext_vector_type(4)));
typedef unsigned u32x2 __attribute__((ext_vector_type(2)));

constexpr int T_P = 16384, T_S = 512, T = 16896, DM = 1024;
constexpr int NIN = 2176, NINP = 2304, DFF = 2816;
constexpr int C_A = 0, C_B = 512, C_C = 1408, C_Q = 1664, C_K = 1920, C_V = 2048;

constexpr size_t O_Y = 0, O_CONV_P = 17301504, O_CONV_S = 17362944, O_RWKV_P = 17608704, O_RWKV_S = 17739776,
                 O_SHIFT_P = 18264064, O_SHIFT_S = 18271232, O_POOL_P = 18299904, O_POOL_S = 18330624,
                 O_K_P = 18453504, O_K_S = 18584576, O_V_P = 19108864, O_V_S = 19239936, O_END = 19764224;

constexpr size_t WS_CTL = 0;
constexpr size_t WS_WIN = 16384;
constexpr size_t WS_WOUT = WS_WIN + 2ull * NINP * DM * 2;
constexpr size_t WS_WGU = WS_WOUT + 2ull * DM * DM * 2;
constexpr size_t WS_WD = WS_WGU + 2ull * 2 * DFF * DM * 2;
constexpr size_t WS_LWT = WS_WD + 2ull * DM * DFF * 2;
constexpr size_t WS_XB = WS_LWT + 2ull * 256 * 128 * 2;
constexpr size_t WS_YMIX = WS_XB + (size_t)T * DM * 2;
constexpr size_t WS_RSS = WS_YMIX + (size_t)T * DM * 2;
constexpr size_t WS_R = WS_RSS + (size_t)T * 32 * 4;
constexpr size_t WS_PROJ = WS_R;
constexpr size_t WS_H = WS_R;
constexpr size_t WS_RW = WS_PROJ + (size_t)T * NINP * 2;
constexpr int NCH = T / 32, NCHH = NCH * 4;
constexpr size_t WS_PT = WS_RW;
constexpr size_t WS_QQ = WS_PT + (size_t)NCHH * 4096 * 2;
constexpr size_t WS_ZZ = WS_QQ + (size_t)NCHH * 4096 * 2;
constexpr size_t WS_Y0 = WS_ZZ + (size_t)NCHH * 2048 * 2;
constexpr size_t WS_SC = WS_Y0 + (size_t)NCHH * 2048 * 2;
constexpr size_t WS_GATE = WS_SC + (size_t)NCHH * 4096 * 2;
constexpr size_t WS_BV = WS_GATE + (size_t)T * 256 * 2;
constexpr size_t WS_GLU = WS_BV + (size_t)T * 256 * 2;
constexpr size_t WS_PWT = WS_GLU + (size_t)T * 256 * 2;
constexpr size_t WS_RWEND = WS_PWT + 2ull * 4 * 64 * 64 * 2;
constexpr size_t RW_BF = (size_t)T * 256 * 2;
constexpr size_t WS_RW_R = WS_RWEND, WS_RW_K = WS_RW_R + RW_BF, WS_RW_V = WS_RW_R + 2 * RW_BF, WS_RW_A = WS_RW_R + 3 * RW_BF,
                 WS_RW_B = WS_RW_R + 4 * RW_BF, WS_RW_G = WS_RW_R + 5 * RW_BF, WS_RW_W = WS_RW_R + 6 * RW_BF;
constexpr size_t WS_END = WS_RWEND;

__device__ __forceinline__ float bf2f(bf16_t h) { return __uint_as_float((unsigned)h << 16); }
typedef __bf16 bf16x2_t __attribute__((ext_vector_type(2)));
typedef float f32x2 __attribute__((ext_vector_type(2)));
__device__ __forceinline__ unsigned pk2(float lo, float hi) { const f32x2 v = {lo, hi}; return __builtin_bit_cast(unsigned, __builtin_convertvector(v, bf16x2_t)); }
__device__ __forceinline__ u32x2 pk4(f32x4 v) { u32x2 o; o.x = pk2(v.x, v.y); o.y = pk2(v.z, v.w); return o; }
__device__ __forceinline__ bf16_t f2bf(float f) { return (bf16_t)(pk2(f, 0.f) & 0xffffu); }
__device__ __forceinline__ void unpack8(u32x4 v, float* f) {
    f[0] = __uint_as_float(v.x << 16); f[1] = __uint_as_float(v.x & 0xffff0000u); f[2] = __uint_as_float(v.y << 16); f[3] = __uint_as_float(v.y & 0xffff0000u);
    f[4] = __uint_as_float(v.z << 16); f[5] = __uint_as_float(v.z & 0xffff0000u); f[6] = __uint_as_float(v.w << 16); f[7] = __uint_as_float(v.w & 0xffff0000u);
}
__device__ __forceinline__ float wave_sum(float v) {
#pragma unroll
    for (int o = 1; o < 64; o <<= 1) v += __shfl_xor(v, o);
    return v;
}
__device__ __forceinline__ float sigmoidf_(float x) { return __builtin_amdgcn_rcpf(1.f + __expf(-x)); }

__device__ __forceinline__ void p0_item(const float* __restrict__ W, int K, int N, bf16_t* __restrict__ WT, const float* __restrict__ g, int grp, int stride, int off, float* scr, int item, int lane, bool glu_map = false) {
    const int nblk = N / 32, kb = item / nblk, nb = item - kb * nblk, k0 = 64 * kb, n0 = 32 * nb;
    float v[32];
#pragma unroll
    for (int i = 0; i < 32; ++i) v[i] = W[(size_t)(k0 + 2 * i + (lane >> 5)) * N + n0 + (lane & 31)];
#pragma unroll
    for (int i = 0; i < 32; ++i) { const int kk = 2 * i + (lane >> 5); scr[kk * 33 + (lane & 31)] = g ? v[i] * g[k0 + kk] : v[i]; }
    asm volatile("s_waitcnt lgkmcnt(0)" ::: "memory");
    const int c = lane & 7;
#pragma unroll
    for (int j = 0; j < 4; ++j) {
        const int n = n0 + (lane >> 3) + 8 * j; const float* sp = scr + (8 * c) * 33 + (n - n0);
        u32x4 o; o.x = pk2(sp[0], sp[33]); o.y = pk2(sp[2 * 33], sp[3 * 33]); o.z = pk2(sp[4 * 33], sp[5 * 33]); o.w = pk2(sp[6 * 33], sp[7 * 33]);
        int r = (n / grp) * stride + off + (n % grp);
        if (glu_map && n < 512) { const int n2 = n & 255; r = (n2 >> 2) * 8 + (n >> 8) * 4 + (n2 & 3); }
        *(u32x4*)(WT + (size_t)r * K + k0 + 8 * c) = o;
    }
    asm volatile("s_waitcnt lgkmcnt(0)" ::: "memory");
}

__device__ __forceinline__ void d_xprep(int row, const float* __restrict__ xp, const float* __restrict__ xs, bf16_t* __restrict__ XB, float* __restrict__ RSS) {
    const int lane = threadIdx.x & 63;
    const float* x = row < T_P ? xp + (size_t)row * DM : xs + (size_t)(row - T_P) * DM;
    float ss = 0.f;
#pragma unroll
    for (int j = 0; j < 4; ++j) {
        const f32x4 v = ((const f32x4*)x)[lane + 64 * j];
        ss += v.x * v.x + v.y * v.y + v.z * v.z + v.w * v.w;
        u32x2 o; o.x = pk2(v.x, v.y); o.y = pk2(v.z, v.w);
        *(u32x2*)(XB + (size_t)row * DM + (lane + 64 * j) * 4) = o;
    }
    ss = wave_sum(ss);
    if (lane < 16) RSS[(size_t)row * 16 + lane] = lane == 0 ? ss : 0.f;
}

__device__ __forceinline__ float rss_rstd(const float* RSS, int row) {
    float s = 0.f;
#pragma unroll
    for (int j = 0; j < 4; ++j) { const f32x4 v = ((const f32x4*)(RSS + (size_t)row * 16))[j]; s += (v.x + v.y) + (v.z + v.w); }
    return rsqrtf(s * (1.f / DM) + 1e-6f);
}
struct EpiProj {
    bf16_t* PROJ; const float* RSS; bf16_t* GLU;
    __device__ __forceinline__ float rowscale(int row) const { return rss_rstd(RSS, row); }
    __device__ __forceinline__ void one(int row, int col, f32x4 v0, f32x4 v1, float rs) const {
        v0 *= rs; v1 *= rs;
        if (col < 512) { const f32x4 gl = {v0.x * sigmoidf_(v1.x), v0.y * sigmoidf_(v1.y), v0.z * sigmoidf_(v1.z), v0.w * sigmoidf_(v1.w)}; *(u32x2*)(GLU + (size_t)row * 256 + (col >> 1)) = pk4(gl); }
        else { u32x4 o; o.x = pk2(v0.x, v0.y); o.y = pk2(v0.z, v0.w); o.z = pk2(v1.x, v1.y); o.w = pk2(v1.z, v1.w); *(u32x4*)(PROJ + (size_t)row * NINP + col) = o; }
    }
    __device__ __forceinline__ void operator()(int row, int col, f32x4 v0, f32x4 v1, f32x4 w0, f32x4 w1, float rs) const { one(row, col, v0, v1, rs); one(row, col + 128, w0, w1, rs); }
};
template <int SRC, bool WF32, bool WBF> struct EpiRes {
    const float* xin_p; const float* xin_s; float* xout; bf16_t* XB; float* RSS;
    __device__ __forceinline__ float rowscale(int) const { return 1.f; }
    __device__ __forceinline__ float half8(int row, int col, f32x4 v0, f32x4 v1) const {
        f32x4 a, b;
        if (SRC == 0) { const float* xi = (row < T_P ? xin_p + (size_t)row * DM : xin_s + (size_t)(row - T_P) * DM) + col; a = *(const f32x4*)(xi); b = *(const f32x4*)(xi + 4); }
        else { float f[8]; unpack8(*(const u32x4*)(XB + (size_t)row * DM + col), f); a = (f32x4){f[0], f[1], f[2], f[3]}; b = (f32x4){f[4], f[5], f[6], f[7]}; }
        a += v0; b += v1;
        if (WF32) { *(f32x4*)(xout + (size_t)row * DM + col) = a; *(f32x4*)(xout + (size_t)row * DM + col + 4) = b; }
        if (WBF) { u32x4 o; o.x = pk2(a.x, a.y); o.y = pk2(a.z, a.w); o.z = pk2(b.x, b.y); o.w = pk2(b.z, b.w); *(u32x4*)(XB + (size_t)row * DM + col) = o; }
        return (a.x * a.x + a.y * a.y) + (a.z * a.z + a.w * a.w) + (b.x * b.x + b.y * b.y) + (b.z * b.z + b.w * b.w);
    }
    __device__ __forceinline__ void operator()(int row, int col, f32x4 v0, f32x4 v1, f32x4 w0, f32x4 w1, float) const {
        float ss = half8(row, col, v0, v1);
        ss += half8(row, col + 128, w0, w1);
        if (WBF) {
            ss += __shfl_xor(ss, 16); ss += __shfl_xor(ss, 32);
            if ((threadIdx.x & 63) < 16) RSS[(size_t)row * 16 + (col >> 8) * 4 + ((col >> 5) & 3)] = ss;
        }
    }
};
struct EpiGU {
    bf16_t* H; const float* RSS;
    __device__ __forceinline__ float rowscale(int row) const { return rss_rstd(RSS, row); }
    __device__ __forceinline__ u32x2 gu(f32x4 g, f32x4 u, float rs) const {
        g *= rs; u *= rs;
        const float h0 = g.x * sigmoidf_(g.x) * u.x, h1 = g.y * sigmoidf_(g.y) * u.y, h2 = g.z * sigmoidf_(g.z) * u.z, h3 = g.w * sigmoidf_(g.w) * u.w;
        u32x2 o; o.x = pk2(h0, h1); o.y = pk2(h2, h3); return o;
    }
    __device__ __forceinline__ void operator()(int row, int col, f32x4 g0, f32x4 u0, f32x4 g1, f32x4 u1, float rs) const {
        *(u32x2*)(H + (size_t)row * DFF + (col >> 1)) = gu(g0, u0, rs);
        *(u32x2*)(H + (size_t)row * DFF + (col >> 1) + 64) = gu(g1, u1, rs);
    }
};

struct Seq { int base, L, b, sample, pos0; };
__device__ __forceinline__ Seq seq_of(int sq) { Seq s; if (sq < 4) { s.base = sq * 4096; s.L = 4096; s.b = sq; s.sample = 0; s.pos0 = 0; } else { s.b = sq - 4; s.base = T_P + s.b * 32; s.L = 32; s.sample = 1; s.pos0 = 1024; } return s; }

struct RwkvW { const float *mu, *w0, *w2, *a0, *a2, *g2, *k_k, *k_a, *r_k, *gn_g, *gn_b; };

namespace pg8 {
#define PG8_LAS __attribute__((address_space(3)))
typedef unsigned short bf16_t;
typedef short bf16x8 __attribute__((ext_vector_type(8)));
typedef float f32x4 __attribute__((ext_vector_type(4)));
typedef unsigned u32x4 __attribute__((ext_vector_type(4)));
constexpr int BM = 256, BK = 64, HALF = 128, HTB = HALF * BK * 2  , STAGE_BYTES = 8 * HTB, NXCD = 8, WGM = 8;

__host__ __device__ __forceinline__ int lds_byte(int r, int c) { const int st = (r >> 4) * 2 + (c >> 5), rr = r & 15, cc = c & 31, ob = rr * 64 + cc * 2; return st * 1024 + (ob ^ (((ob >> 9) & 1) << 5)); }
__host__ __device__ __forceinline__ void stage_rc(int b, int& R, int& C) { const int st = b / 1024, sb = b % 1024, swz = sb ^ (((sb >> 9) & 1) << 5); R = (st >> 1) * 16 + swz / 64; C = (st & 1) * 32 + (swz % 64) / 2; }
__host__ __device__ __forceinline__ int perm32(int rho) { const int n = rho >> 4, i = rho & 15; return 8 * (i >> 2) + 4 * n + (i & 3); }

struct Unit { int pm, pn; };
struct Gemm { const bf16_t* A; const bf16_t* Bt; int M, N, K; };

struct StaticOrder {
    int nM, nN, nwg, G, c;
    __host__ __device__ void init(int M, int N, int G_, int c_) { nM = M / BM; nN = N / BM; nwg = nM * nN; G = G_; c = c_; }
    __host__ __device__ bool next(int i, Unit& u) const {
        const long L = (long)i * G + c; if (L >= nwg) return false;
        int wgid = (int)L; { const int q = nwg / NXCD, r = nwg % NXCD, xcd = wgid % NXCD, off = wgid / NXCD; wgid = (xcd < r ? xcd * (q + 1) : r * (q + 1) + (xcd - r) * q) + off; }
        const int nig = WGM * nN, gid = wgid / nig, fm = gid * WGM, gsz = (nM - fm) < WGM ? (nM - fm) : WGM;
        u.pm = fm + ((wgid % nig) % gsz); u.pn = (wgid % nig) / gsz; return true;
    }
    __device__ __forceinline__ void a_ready(const Unit&) const {}
    __device__ __forceinline__ void done(const Unit&) const {}
};


template <class Epi, class Sched, bool ALIGN_EPI = false, bool SP2 = false>
__device__ __forceinline__ void gemm_phase(PG8_LAS unsigned char* lds, const Gemm g, const Sched& S, const Epi& E) {
    int tid_ = threadIdx.x; asm volatile("" : "+v"(tid_));
    const int tid = tid_, wid = __builtin_amdgcn_readfirstlane(tid >> 6), lane = tid & 63, wr = wid >> 2, wc = wid & 3, fr = lane & 15, fq = lane >> 4;
    const int K = g.K, nt = K / BK;
    unsigned voffA[2], voffB[2];
#pragma unroll
    for (int i = 0; i < 2; ++i) { int R, C; stage_rc(tid * 16 + i * 8192, R, C); const int Rb = Epi::PERM ? ((R & ~31) + perm32(R & 31)) : R;
        voffA[i] = (unsigned)(R * K + C) * 2u; voffB[i] = (unsigned)(Rb * K + C) * 2u; }
    const size_t kstep = (size_t)(BK * 2);
    const size_t hstep = (size_t)HALF * K * 2;
    const size_t tstep = 2 * hstep;
    const unsigned ldsw = (unsigned)wid * 1024u;
    const int aoff = lds_byte(wr * 64 + fr, fq * 8), boff = lds_byte(wc * 32 + fr, fq * 8);
#define PG8_SA(b, h) (((b) * 2 + (h)) * HTB)
#define PG8_SB(b, h) ((4 + (b) * 2 + (h)) * HTB)
#define PG8_STAGE(bufoff, gbase, voff) do { _Pragma("unroll") for (int _i = 0; _i < 2; ++_i) \
        __builtin_amdgcn_global_load_lds((const unsigned*)((const char*)(gbase) + (voff)[_i]), (PG8_LAS unsigned*)(lds + (bufoff) + ldsw + _i * 8192), 16, 0, 0); } while (0)
#define PG8_LDA(dst, b, h) do { _Pragma("unroll") for (int m = 0; m < 4; ++m) _Pragma("unroll") for (int k = 0; k < 2; ++k) dst[m][k] = *(const PG8_LAS bf16x8*)(lds + PG8_SA(b, h) + aoff + m * 2048 + k * 1024); } while (0)
#define PG8_LDB(dst, b, h) do { _Pragma("unroll") for (int n = 0; n < 2; ++n) _Pragma("unroll") for (int k = 0; k < 2; ++k) dst[n][k] = *(const PG8_LAS bf16x8*)(lds + PG8_SB(b, h) + boff + n * 2048 + k * 1024); } while (0)
#define PG8_MMA(ai, bj, At, Bt) do { __builtin_amdgcn_s_setprio(1); _Pragma("unroll") for (int m = 0; m < 4; ++m) _Pragma("unroll") for (int n = 0; n < 2; ++n) _Pragma("unroll") for (int k = 0; k < 2; ++k) \
        acc[ai][bj][m][n] = __builtin_amdgcn_mfma_f32_16x16x32_bf16(Bt[n][k], At[m][k], acc[ai][bj][m][n], 0, 0, 0); __builtin_amdgcn_s_setprio(0); } while (0)
#define PG8_WAIT_V(n) asm volatile("s_waitcnt vmcnt(" #n ")" ::: "memory")
#define PG8_WAIT_L(n) asm volatile("s_waitcnt lgkmcnt(" #n ")" ::: "memory")
#define PG8_BAR __builtin_amdgcn_s_barrier()
#define PG8_SCHED __builtin_amdgcn_sched_barrier(0)
    Unit cur, nxt; int ui = 0;
    if (!S.next(0, cur)) return;
    f32x4 acc[2][2][4][2];
#pragma unroll
    for (int a = 0; a < 2; ++a)
#pragma unroll
        for (int b = 0; b < 2; ++b)
#pragma unroll
            for (int m = 0; m < 4; ++m)
#pragma unroll
                for (int n = 0; n < 2; ++n) acc[a][b][m][n] = (f32x4){0.f, 0.f, 0.f, 0.f};
    bf16x8 At[4][2], B0[2][2], B1[2][2];
    const char* cA = (const char*)g.A + (size_t)cur.pm * tstep; const char* cB = (const char*)g.Bt + (size_t)cur.pn * tstep;
    S.a_ready(cur);
    if constexpr (SP2) {
        PG8_STAGE(PG8_SB(0, 0), cB, voffB); PG8_STAGE(PG8_SB(0, 1), cB + hstep, voffB); PG8_STAGE(PG8_SA(0, 0), cA, voffA); PG8_STAGE(PG8_SA(0, 1), cA + hstep, voffA);
        if (wr == 1) PG8_BAR;
        PG8_WAIT_V(2); PG8_BAR;
        PG8_STAGE(PG8_SB(1, 0), cB + kstep, voffB); PG8_STAGE(PG8_SA(1, 0), cA + kstep, voffA); PG8_STAGE(PG8_SB(1, 1), cB + hstep + kstep, voffB);
        PG8_WAIT_V(6); PG8_BAR;
    } else {
        PG8_STAGE(PG8_SB(0, 0), cB, voffB); PG8_STAGE(PG8_SA(0, 0), cA, voffA); PG8_STAGE(PG8_SB(0, 1), cB + hstep, voffB); PG8_STAGE(PG8_SA(0, 1), cA + hstep, voffA);
        if (wr == 1) PG8_BAR;
        PG8_WAIT_V(4); PG8_BAR;
        PG8_STAGE(PG8_SB(1, 0), cB + kstep, voffB); PG8_STAGE(PG8_SA(1, 0), cA + kstep, voffA); PG8_STAGE(PG8_SB(1, 1), cB + hstep + kstep, voffB);
        PG8_WAIT_V(6); PG8_BAR;
    }
    for (;;) {
        const bool has_next = S.next(ui + 1, nxt);
        const char* nA = has_next ? (const char*)g.A + (size_t)nxt.pm * tstep : cA; const char* nB = has_next ? (const char*)g.Bt + (size_t)nxt.pn * tstep : cB;
        for (int t = 0; t < nt; t += 2) {
            const bool last = (t == nt - 2);
            const char* a1 = cA + (size_t)(t + 1) * kstep;
            const char* a2 = last ? nA : cA + (size_t)(t + 2) * kstep; const char* b2 = last ? nB : cB + (size_t)(t + 2) * kstep;
            const char* a3 = a2 + kstep; const char* b3 = b2 + kstep;
            if (last && has_next) S.a_ready(nxt);
            if constexpr (SP2) {
            PG8_LDB(B0, 0, 0); PG8_LDB(B1, 0, 1); PG8_SCHED; PG8_LDA(At, 0, 0); PG8_STAGE(PG8_SA(1, 1), a1 + hstep, voffA);
            PG8_WAIT_V(8); PG8_WAIT_L(0); PG8_BAR; PG8_MMA(0, 0, At, B0); PG8_MMA(0, 1, At, B1); PG8_BAR; PG8_SCHED;
            PG8_LDA(At, 0, 1); PG8_STAGE(PG8_SB(0, 0), b2, voffB); PG8_STAGE(PG8_SB(0, 1), b2 + hstep, voffB); PG8_STAGE(PG8_SA(0, 0), a2, voffA);
            PG8_WAIT_V(8); PG8_WAIT_L(0); PG8_BAR; PG8_MMA(1, 0, At, B0); PG8_MMA(1, 1, At, B1); PG8_BAR; PG8_SCHED;
            PG8_LDB(B0, 1, 0); PG8_LDB(B1, 1, 1); PG8_SCHED; PG8_LDA(At, 1, 0); PG8_STAGE(PG8_SA(0, 1), a2 + hstep, voffA);
            PG8_WAIT_V(8); PG8_WAIT_L(0); PG8_BAR; PG8_MMA(0, 0, At, B0); PG8_MMA(0, 1, At, B1); PG8_BAR; PG8_SCHED;
            PG8_LDA(At, 1, 1); PG8_STAGE(PG8_SB(1, 0), b3, voffB); PG8_STAGE(PG8_SB(1, 1), b3 + hstep, voffB); PG8_STAGE(PG8_SA(1, 0), a3, voffA);
            PG8_WAIT_V(8); PG8_WAIT_L(0); PG8_BAR; PG8_MMA(1, 0, At, B0); PG8_MMA(1, 1, At, B1); PG8_BAR; PG8_SCHED;
            } else {
            PG8_LDB(B0, 0, 0); PG8_SCHED; PG8_LDA(At, 0, 0); PG8_STAGE(PG8_SA(1, 1), a1 + hstep, voffA);
            PG8_WAIT_L(8); PG8_BAR; PG8_WAIT_L(0); PG8_MMA(0, 0, At, B0); PG8_BAR; PG8_SCHED;
            PG8_LDB(B1, 0, 1); PG8_STAGE(PG8_SB(0, 0), b2, voffB);
            PG8_BAR; PG8_WAIT_L(0); PG8_MMA(0, 1, At, B1); PG8_BAR;
            PG8_LDA(At, 0, 1); PG8_STAGE(PG8_SA(0, 0), a2, voffA);
            PG8_BAR; PG8_WAIT_L(0); PG8_MMA(1, 0, At, B0); PG8_BAR; PG8_SCHED;
            PG8_STAGE(PG8_SB(0, 1), b2 + hstep, voffB);
            PG8_WAIT_V(6); PG8_BAR; PG8_MMA(1, 1, At, B1); PG8_BAR;
            PG8_LDB(B0, 1, 0); PG8_SCHED; PG8_LDA(At, 1, 0); PG8_STAGE(PG8_SA(0, 1), a2 + hstep, voffA);
            PG8_WAIT_L(8); PG8_BAR; PG8_WAIT_L(0); PG8_MMA(0, 0, At, B0); PG8_BAR; PG8_SCHED;
            PG8_LDB(B1, 1, 1); PG8_STAGE(PG8_SB(1, 0), b3, voffB);
            PG8_BAR; PG8_WAIT_L(0); PG8_MMA(0, 1, At, B1); PG8_BAR;
            PG8_LDA(At, 1, 1); PG8_STAGE(PG8_SA(1, 0), a3, voffA);
            PG8_BAR; PG8_WAIT_L(0); PG8_MMA(1, 0, At, B0); PG8_BAR; PG8_SCHED;
            PG8_STAGE(PG8_SB(1, 1), b3 + hstep, voffB);
            PG8_WAIT_V(6); PG8_BAR; PG8_MMA(1, 1, At, B1); PG8_BAR;
            }
        }
        if constexpr (ALIGN_EPI) { if (wr == 0) PG8_BAR; }
        if constexpr (!Epi::AFTER_DRAIN) { E(acc, cur, wr, wc, fr, fq); S.done(cur); }
        if (!has_next) break;
#pragma unroll
        for (int a = 0; a < 2; ++a)
#pragma unroll
            for (int b = 0; b < 2; ++b)
#pragma unroll
                for (int m = 0; m < 4; ++m)
#pragma unroll
                    for (int n = 0; n < 2; ++n) acc[a][b][m][n] = (f32x4){0.f, 0.f, 0.f, 0.f};
        cur = nxt; cA = nA; cB = nB; ++ui;
        if constexpr (ALIGN_EPI) { if (wr == 1) PG8_BAR; }
    }
    PG8_WAIT_V(0);
    if constexpr (!ALIGN_EPI) { if (wr == 0) PG8_BAR; }
    PG8_BAR;
    if constexpr (Epi::AFTER_DRAIN) { E.fused(acc, cur, wr, wc, fr, fq, lds, wid, lane); S.done(cur); }
#undef PG8_SA
#undef PG8_SB
#undef PG8_STAGE
#undef PG8_LDA
#undef PG8_LDB
#undef PG8_MMA
#undef PG8_WAIT_V
#undef PG8_WAIT_L
#undef PG8_BAR
#undef PG8_SCHED
}
}


struct AttnP { const bf16_t* PROJ; const float *cache_k, *cache_v, *qn, *kn, *sinks; bf16_t* YMIX; float *ko_p, *ko_s, *vo_p, *vo_s; };
constexpr int KN_STRIDE = 72, VT_STRIDE = 200, ATT_VT_OFF = 192 * KN_STRIDE * 2;
__device__ __forceinline__ void attn_unit(unsigned char* lds, int unit, const AttnP& a) {
    int tid_ = threadIdx.x; asm volatile("" : "+v"(tid_));
    const int tid = tid_, lane = tid & 63, w = __builtin_amdgcn_readfirstlane(tid >> 6), fr = lane & 15, fq = lane >> 4;
    int sq, chunk, hkv; if (unit < 512) { sq = unit >> 7; chunk = (unit & 127) >> 1; hkv = unit & 1; } else { sq = 4 + ((unit - 512) >> 1); chunk = 0; hkv = unit & 1; }
    const Seq s = seq_of(sq);
    int nk, ncache, ktok0;
    if (s.sample) { nk = 160; ncache = 128; ktok0 = s.base; }
    else { const int back = chunk < 2 ? chunk : 2; nk = 64 * (back + 1); ncache = 0; ktok0 = s.base + (chunk - back) * 64; }
    bf16_t* Kn = (bf16_t*)lds; bf16_t* Vt = (bf16_t*)(lds + ATT_VT_OFF);
    int g, mt; bool act; if (!s.sample) { g = w >> 2; mt = w & 3; act = true; } else { g = (w >> 1) & 1; mt = w & 1; act = w < 4; }
    const bf16_t* qp = a.PROJ + (size_t)(s.base + chunk * 64 + mt * 16 + fr) * NINP + C_Q + (hkv * 2 + g) * 64 + 8 * fq;
    u32x4 qr0 = {0u, 0u, 0u, 0u}, qr1 = qr0;
    if (act) { qr0 = *(const u32x4*)qp; qr1 = *(const u32x4*)(qp + 32); }
    u32x4 kraw[3], vraw[3]; f32x4 kc[3][2], vc[3][2];
#pragma unroll
    for (int q = 0; q < 3; ++q) {
        const int p = tid + 512 * q, j = p >> 3, ch = p & 7;
        kraw[q] = (u32x4){0u, 0u, 0u, 0u}; vraw[q] = kraw[q]; kc[q][0] = (f32x4){0.f, 0.f, 0.f, 0.f}; kc[q][1] = kc[q][0]; vc[q][0] = kc[q][0]; vc[q][1] = kc[q][0];
        if (p < nk * 8) {
            if (j < ncache) {
                const float* kp = a.cache_k + (((size_t)s.b * 128 + j) * 2 + hkv) * 64 + ch * 8; const float* vp = a.cache_v + (((size_t)s.b * 128 + j) * 2 + hkv) * 64 + ch * 8;
                kc[q][0] = *(const f32x4*)kp; kc[q][1] = *(const f32x4*)(kp + 4); vc[q][0] = *(const f32x4*)vp; vc[q][1] = *(const f32x4*)(vp + 4);
            } else {
                const bf16_t* pp = a.PROJ + (size_t)(ktok0 + j - ncache) * NINP + hkv * 64 + ch * 8;
                kraw[q] = *(const u32x4*)(pp + C_K); vraw[q] = *(const u32x4*)(pp + C_V);
            }
        }
    }
#pragma unroll
    for (int q = 0; q < 3; ++q) {
        const int p = tid + 512 * q, j = p >> 3, ch = p & 7;
        if (p < nk * 8) {
        float kf[8], vf[8];
        if (j < ncache) {
            kf[0] = kc[q][0].x; kf[1] = kc[q][0].y; kf[2] = kc[q][0].z; kf[3] = kc[q][0].w; kf[4] = kc[q][1].x; kf[5] = kc[q][1].y; kf[6] = kc[q][1].z; kf[7] = kc[q][1].w;
            vf[0] = vc[q][0].x; vf[1] = vc[q][0].y; vf[2] = vc[q][0].z; vf[3] = vc[q][0].w; vf[4] = vc[q][1].x; vf[5] = vc[q][1].y; vf[6] = vc[q][1].z; vf[7] = vc[q][1].w;
        } else {
            unpack8(kraw[q], kf); unpack8(vraw[q], vf);
            float ss = 0.f;
#pragma unroll
            for (int i = 0; i < 8; ++i) ss += kf[i] * kf[i];
            ss += __shfl_xor(ss, 1); ss += __shfl_xor(ss, 2); ss += __shfl_xor(ss, 4);
            const float rs = rsqrtf(ss * (1.f / 64.f) + 1e-6f);
            const f32x4 g0 = *(const f32x4*)(a.kn + ch * 8), g1 = *(const f32x4*)(a.kn + ch * 8 + 4);
            kf[0] *= rs * g0.x; kf[1] *= rs * g0.y; kf[2] *= rs * g0.z; kf[3] *= rs * g0.w; kf[4] *= rs * g1.x; kf[5] *= rs * g1.y; kf[6] *= rs * g1.z; kf[7] *= rs * g1.w;
        }
        u32x4 ko; ko.x = pk2(kf[0], kf[1]); ko.y = pk2(kf[2], kf[3]); ko.z = pk2(kf[4], kf[5]); ko.w = pk2(kf[6], kf[7]);
        *(u32x4*)(Kn + j * KN_STRIDE + ch * 8) = ko;
#pragma unroll
        for (int i = 0; i < 8; ++i) Vt[(ch * 8 + i) * VT_STRIDE + j] = f2bf(vf[i]);
        float* ko_ = nullptr; float* vo_ = nullptr;
        if (s.sample) { if (j >= 32) { ko_ = a.ko_s + ((size_t)s.b * 128 + (j - 32)) * 128 + hkv * 64 + ch * 8; vo_ = a.vo_s + ((size_t)s.b * 128 + (j - 32)) * 128 + hkv * 64 + ch * 8; } }
        else if (chunk >= 62 && j >= nk - 64) { const int jj = (chunk - 62) * 64 + (j - (nk - 64)); ko_ = a.ko_p + ((size_t)s.b * 128 + jj) * 128 + hkv * 64 + ch * 8; vo_ = a.vo_p + ((size_t)s.b * 128 + jj) * 128 + hkv * 64 + ch * 8; }
        if (ko_) { *(f32x4*)ko_ = (f32x4){kf[0], kf[1], kf[2], kf[3]}; *(f32x4*)(ko_ + 4) = (f32x4){kf[4], kf[5], kf[6], kf[7]}; *(f32x4*)vo_ = (f32x4){vf[0], vf[1], vf[2], vf[3]}; *(f32x4*)(vo_ + 4) = (f32x4){vf[4], vf[5], vf[6], vf[7]}; }
        }
    }
    __syncthreads();
    if (act) {
        const int qh = hkv * 2 + g, tok = s.base + chunk * 64 + mt * 16 + fr, nkt = nk >> 4, nks = nk >> 5;
        float qf[16]; unpack8(qr0, qf); unpack8(qr1, qf + 8);
        float ss = 0.f;
#pragma unroll
        for (int i = 0; i < 16; ++i) ss += qf[i] * qf[i];
        ss += __shfl_xor(ss, 16); ss += __shfl_xor(ss, 32);
        const float rs = rsqrtf(ss * (1.f / 64.f) + 1e-6f) * 0.125f;
#pragma unroll
        for (int i = 0; i < 8; ++i) { qf[i] *= rs * a.qn[8 * fq + i]; qf[8 + i] *= rs * a.qn[32 + 8 * fq + i]; }
        union { u32x4 u; bf16x8 v; } qa, qb;
        qa.u.x = pk2(qf[0], qf[1]); qa.u.y = pk2(qf[2], qf[3]); qa.u.z = pk2(qf[4], qf[5]); qa.u.w = pk2(qf[6], qf[7]);
        qb.u.x = pk2(qf[8], qf[9]); qb.u.y = pk2(qf[10], qf[11]); qb.u.z = pk2(qf[12], qf[13]); qb.u.w = pk2(qf[14], qf[15]);
        f32x4 sacc[12];
        const float sink = a.sinks[qh];
        float m = sink;
#pragma unroll
        for (int kt = 0; kt < 12; ++kt) {
            sacc[kt] = (f32x4){0.f, 0.f, 0.f, 0.f};
            if (kt < nkt) {
                const bf16x8 k0 = *(const bf16x8*)(Kn + (kt * 16 + fr) * KN_STRIDE + 8 * fq), k1 = *(const bf16x8*)(Kn + (kt * 16 + fr) * KN_STRIDE + 32 + 8 * fq);
                sacc[kt] = __builtin_amdgcn_mfma_f32_16x16x32_bf16(k0, qa.v, sacc[kt], 0, 0, 0);
                sacc[kt] = __builtin_amdgcn_mfma_f32_16x16x32_bf16(k1, qb.v, sacc[kt], 0, 0, 0);
                m = fmaxf(m, fmaxf(fmaxf(sacc[kt].x, sacc[kt].y), fmaxf(sacc[kt].z, sacc[kt].w)));
            }
        }
        m = fmaxf(m, __shfl_xor(m, 16)); m = fmaxf(m, __shfl_xor(m, 32));
        float lsum = 0.f;
#pragma unroll
        for (int kt = 0; kt < 12; ++kt) if (kt < nkt) {
            sacc[kt].x = __expf(sacc[kt].x - m); sacc[kt].y = __expf(sacc[kt].y - m); sacc[kt].z = __expf(sacc[kt].z - m); sacc[kt].w = __expf(sacc[kt].w - m);
            lsum += (sacc[kt].x + sacc[kt].y) + (sacc[kt].z + sacc[kt].w);
        }
        lsum += __shfl_xor(lsum, 16); lsum += __shfl_xor(lsum, 32);
        lsum += __expf(sink - m);
        f32x4 oacc[4];
#pragma unroll
        for (int dt = 0; dt < 4; ++dt) oacc[dt] = (f32x4){0.f, 0.f, 0.f, 0.f};
#pragma unroll
        for (int ks = 0; ks < 6; ++ks) if (ks < nks) {
            union { u32x4 u; bf16x8 v; } pf;
            pf.u.x = pk2(sacc[2 * ks].x, sacc[2 * ks].y); pf.u.y = pk2(sacc[2 * ks].z, sacc[2 * ks].w); pf.u.z = pk2(sacc[2 * ks + 1].x, sacc[2 * ks + 1].y); pf.u.w = pk2(sacc[2 * ks + 1].z, sacc[2 * ks + 1].w);
#pragma unroll
            for (int dt = 0; dt < 4; ++dt) {
                union { u32x4 u; bf16x8 v; } vf;
                const u32x2 lo = *(const u32x2*)(Vt + (dt * 16 + fr) * VT_STRIDE + 32 * ks + 4 * fq), hi2 = *(const u32x2*)(Vt + (dt * 16 + fr) * VT_STRIDE + 32 * ks + 16 + 4 * fq);
                vf.u.x = lo.x; vf.u.y = lo.y; vf.u.z = hi2.x; vf.u.w = hi2.y;
                oacc[dt] = __builtin_amdgcn_mfma_f32_16x16x32_bf16(vf.v, pf.v, oacc[dt], 0, 0, 0);
            }
        }
        const float inv = 1.f / lsum;
#pragma unroll
        for (int dt = 0; dt < 4; ++dt) { u32x2 o; o.x = pk2(oacc[dt].x * inv, oacc[dt].y * inv); o.y = pk2(oacc[dt].z * inv, oacc[dt].w * inv);
            *(u32x2*)(a.YMIX + (size_t)tok * DM + 768 + qh * 64 + dt * 16 + 4 * fq) = o; }
    }
    __syncthreads();
}

struct ConvPoolP { const bf16_t* PROJ; const float *cache_conv, *cw, *cb, *lg, *lb, *cache_pool, *pw, *psc; bf16_t* YMIX; float *co_p, *co_s, *po_p, *po_s; const bf16_t *GLU, *PWT; };
__device__ __forceinline__ void convpool_tile(float* sm, int tile, const ConvPoolP& a) {
    int tid_ = threadIdx.x; asm volatile("" : "+v"(tid_));
    int c = tid_ & 255;
#define RELAUNDER() asm volatile("" : "+v"(c))
    int sq, t0; if (tile < 1024) { sq = tile >> 8; t0 = (tile & 255) * 16; } else { sq = 4 + ((tile - 1024) >> 1); t0 = ((tile - 1024) & 1) * 16; }
    const Seq s = seq_of(sq);
    float* ext = sm;
    float* yb = sm + 46 * 256;
    bf16_t* db = (bf16_t*)yb;
    {
        u32x4 vv[6]; f32x4 h0[6], h1[6];
#pragma unroll
        for (int q = 0; q < 6; ++q) {
            const int pr = c + 256 * q, i = pr >> 5, cg = pr & 31, t = t0 - 30 + i;
            vv[q] = (u32x4){0u, 0u, 0u, 0u}; h0[q] = (f32x4){0.f, 0.f, 0.f, 0.f}; h1[q] = h0[q];
            if (i < 46) {
                if (t >= 0) vv[q] = *(const u32x4*)(a.GLU + (size_t)(s.base + t) * 256 + cg * 8);
                else if (s.sample) { const float* p = a.cache_conv + ((size_t)s.b * 30 + 30 + t) * 256 + cg * 8; h0[q] = *(const f32x4*)p; h1[q] = *(const f32x4*)(p + 4); }
            }
        }
#pragma unroll
        for (int q = 0; q < 6; ++q) {
            const int pr = c + 256 * q, i = pr >> 5, cg = pr & 31, t = t0 - 30 + i;
            if (i < 46) {
                f32x4 e0 = h0[q], e1 = h1[q];
                if (t >= 0) { float v[8]; unpack8(vv[q], v); e0 = (f32x4){v[0], v[1], v[2], v[3]}; e1 = (f32x4){v[4], v[5], v[6], v[7]}; }
                *(f32x4*)(ext + i * 256 + cg * 8) = e0; *(f32x4*)(ext + i * 256 + cg * 8 + 4) = e1;
            }
        }
    }
    __syncthreads(); RELAUNDER();
    {
        float e[46];
#pragma unroll
        for (int i = 0; i < 46; ++i) e[i] = ext[i * 256 + c];
        float* o = s.sample ? a.co_s + (size_t)s.b * 30 * 256 : a.co_p + (size_t)s.b * 30 * 256;
        if (t0 + 15 >= s.L - 30) {
#pragma unroll
            for (int i = 0; i < 16; ++i) { const int t = t0 + i; if (t >= s.L - 30) o[(t - (s.L - 30)) * 256 + c] = e[i + 30]; }
        }
        float y[16]; const float bias = a.cb[c];
#pragma unroll
        for (int i = 0; i < 16; ++i) y[i] = bias;
#pragma unroll
        for (int j = 0; j < 31; ++j) { const float wj = a.cw[j * 256 + c];
#pragma unroll
            for (int i = 0; i < 16; ++i) y[i] += wj * e[i + j]; }
#pragma unroll
        for (int i = 0; i < 16; ++i) yb[i * 256 + c] = y[i];
    }
    __syncthreads(); RELAUNDER();
    u32x4 pv[4]; f32x4 ph0[4], ph1[4];
#pragma unroll
    for (int q = 0; q < 4; ++q) {
        const int pr = c + 256 * q, i = pr >> 5, cg = pr & 31, t = t0 - 15 + i;
        pv[q] = (u32x4){0u, 0u, 0u, 0u}; ph0[q] = (f32x4){0.f, 0.f, 0.f, 0.f}; ph1[q] = ph0[q];
        if (i < 31) {
            if (t >= 0) pv[q] = *(const u32x4*)(a.PROJ + (size_t)(s.base + t) * NINP + C_C + cg * 8);
            else if (s.sample) { const float* p = a.cache_pool + ((size_t)s.b * 15 + 15 + t) * 256 + cg * 8; ph0[q] = *(const f32x4*)p; ph1[q] = *(const f32x4*)(p + 4); }
        }
    }
    {
        const int wv = c >> 6, lane = c & 63;
        const f32x4 g4 = ((const f32x4*)a.lg)[lane], b4 = ((const f32x4*)a.lb)[lane];
#pragma unroll 1
        for (int i = wv; i < 16; i += 4) {
            const f32x4 v = ((const f32x4*)(yb + i * 256))[lane];
            const float mean = wave_sum((v.x + v.y) + (v.z + v.w)) * (1.f / 256.f);
            const f32x4 d = v - mean;
            const float var = wave_sum((d.x * d.x + d.y * d.y) + (d.z * d.z + d.w * d.w)) * (1.f / 256.f);
            const float rstd = rsqrtf(var + 1e-5f);
            f32x4 o = d * rstd * g4 + b4;
            o.x *= sigmoidf_(o.x); o.y *= sigmoidf_(o.y); o.z *= sigmoidf_(o.z); o.w *= sigmoidf_(o.w);
            *(u32x2*)(a.YMIX + (size_t)(s.base + t0 + i) * DM + 0 + lane * 4) = pk4(o);
        }
    }
    __syncthreads(); RELAUNDER();
#pragma unroll
    for (int q = 0; q < 4; ++q) {
        const int pr = c + 256 * q, i = pr >> 5, cg = pr & 31, t = t0 - 15 + i;
        if (i < 31) {
            f32x4 e0 = ph0[q], e1 = ph1[q];
            if (t >= 0) { float v[8]; unpack8(pv[q], v); e0 = (f32x4){v[0], v[1], v[2], v[3]}; e1 = (f32x4){v[4], v[5], v[6], v[7]}; }
            *(f32x4*)(ext + i * 256 + cg * 8) = e0; *(f32x4*)(ext + i * 256 + cg * 8 + 4) = e1;
        }
    }
    __syncthreads(); RELAUNDER();
    {
        float e[31];
#pragma unroll
        for (int i = 0; i < 31; ++i) e[i] = ext[i * 256 + c];
        float* o = s.sample ? a.po_s + (size_t)s.b * 15 * 256 : a.po_p + (size_t)s.b * 15 * 256;
        if (t0 + 15 >= s.L - 15) {
#pragma unroll
            for (int i = 0; i < 16; ++i) { const int t = t0 + i; if (t >= s.L - 15) o[(t - (s.L - 15)) * 256 + c] = e[i + 15]; }
        }
        const int g = __builtin_amdgcn_readfirstlane(c >> 6), w = 2 << g;
        float w2[16], w4[16], w8[16], w16[16];
#pragma unroll
        for (int i = 0; i < 16; ++i) w2[i] = e[15 + i] + e[14 + i];
        if (g >= 1) {
#pragma unroll
            for (int i = 0; i < 16; ++i) w4[i] = (e[15 + i] + e[14 + i]) + (e[13 + i] + e[12 + i]);
        }
        if (g >= 2) {
#pragma unroll
            for (int i = 0; i < 16; ++i) w8[i] = ((e[15 + i] + e[14 + i]) + (e[13 + i] + e[12 + i])) + ((e[11 + i] + e[10 + i]) + (e[9 + i] + e[8 + i]));
        }
        if (g == 3) {
            float cs[32]; cs[0] = e[0];
#pragma unroll
            for (int k = 1; k < 31; ++k) cs[k] = cs[k - 1] + e[k];
#pragma unroll
            for (int i = 0; i < 16; ++i) w16[i] = i == 0 ? cs[15] : cs[15 + i] - cs[i - 1];
        }
#pragma unroll
        for (int i = 0; i < 16; ++i) {
            const float sum = g == 0 ? w2[i] : (g == 1 ? w4[i] : (g == 2 ? w8[i] : w16[i]));
            const int pos = s.pos0 + t0 + i; const int cnt = (pos + 1) < w ? (pos + 1) : w;
            db[i * 264 + c] = f2bf(sum * __builtin_amdgcn_rcpf((float)cnt) - e[15 + i]);
        }
    }
    __syncthreads(); RELAUNDER();
    {
        const int g = __builtin_amdgcn_readfirstlane(c >> 6), lane = c & 63, fr = lane & 15, fq = lane >> 4;
        const bf16x8 d0 = *(const bf16x8*)(db + fr * 264 + g * 64 + 8 * fq), d1 = *(const bf16x8*)(db + fr * 264 + g * 64 + 32 + 8 * fq);
#pragma unroll
        for (int dt = 0; dt < 4; ++dt) {
            const bf16_t* wp = a.PWT + ((size_t)g * 64 + 16 * dt + fr) * 64 + 8 * fq;
            f32x4 acc = __builtin_amdgcn_mfma_f32_16x16x32_bf16(*(const bf16x8*)wp, d0, (f32x4){0.f, 0.f, 0.f, 0.f}, 0, 0, 0);
            acc = __builtin_amdgcn_mfma_f32_16x16x32_bf16(*(const bf16x8*)(wp + 32), d1, acc, 0, 0, 0);
            acc *= *(const f32x4*)(a.psc + g * 64 + 16 * dt + 4 * fq);
            *(u32x2*)(a.YMIX + (size_t)(s.base + t0 + fr) * DM + 512 + g * 64 + 16 * dt + 4 * fq) = pk4(acc);
        }
    }
    __syncthreads();
#undef RELAUNDER
}

struct RwkvG { bf16_t *PT, *QQ, *ZZ, *Y0, *SC, *GATE, *BV; const bf16_t* LWT; };
constexpr int RC_HEAD = 30208, RC_MAB = 0, RC_MAK = 4608, RC_MRB = 7168, RC_MRK = 9728, RC_TM = 12288, RC_MAKVT = 14848, RC_GT = 19968, RC_U0T = 25088;
constexpr int RB_BASE = 2 * RC_HEAD, RB_HEAD = 38912, RB_AT = 0, RB_BH = 4608, RB_KH = 9216, RB_RT = 13824, RB_ATT = 18432, RB_BHT = 23552, RB_KHT = 28672, RB_VT = 33792;
constexpr int RA_LAT = 0, RA_WL = 8704, RA_AL = 25088, RA_SCN = 41472, R_WLS = RB_BASE + 2 * RB_HEAD;
constexpr int NS = 72, TS = 40, LATS = 136, MABS = 36;
__device__ __forceinline__ bf16x8 ldf(const bf16_t* base, int row, int stride, int col) { return *(const bf16x8*)(base + row * stride + col); }
#define MFMA16(a, b, c) __builtin_amdgcn_mfma_f32_16x16x32_bf16((a), (b), (c), 0, 0, 0)

__device__ __forceinline__ void rwkv_item(unsigned char* lds, int item, int l, const bf16_t* __restrict__ PROJ, const float* __restrict__ shift_in, const RwkvW& w, const RwkvG& G) {
    int tid = threadIdx.x; asm volatile("" : "+v"(tid));
    const int wv = __builtin_amdgcn_readfirstlane(tid >> 6);
    const int cid = item >> 1, hp = item & 1, tok0 = cid * 32;
    const bool sample = cid >= 512, first = sample || ((cid & 127) == 0);
    const int sb = cid - 512;
    bf16_t* LAT = (bf16_t*)(lds + RA_LAT); float* WLb = (float*)(lds + RA_WL); float* ALb = (float*)(lds + RA_AL); float* SCN = (float*)(lds + RA_SCN); float* WLs = (float*)(lds + R_WLS);
    const int lane0 = tid & 63, fr0 = lane0 & 15, fq0 = lane0 >> 4;
    const bf16_t* lwp = G.LWT + ((size_t)l * 256 + hp * 128 + 16 * wv + fr0) * 128 + 8 * fq0;
    const bf16x8 fw = *(const bf16x8*)(lwp), fa = *(const bf16x8*)(lwp + 32), fg0 = *(const bf16x8*)(lwp + 64), fg1 = *(const bf16x8*)(lwp + 96);
    const f32x4 w0v = *(const f32x4*)(w.w0 + hp * 128 + 16 * wv + 4 * fq0), a0v = *(const f32x4*)(w.a0 + hp * 128 + 16 * wv + 4 * fq0);
    const int c3 = tid & 127, tq3 = tid >> 7, cg3 = hp * 128 + c3;
    float ur[9], uk[9], uv[9];
#pragma unroll
    for (int i = 0; i < 9; ++i) {
        const int t = 8 * tq3 - 1 + i;
        if (t >= 0 || !first) { const bf16_t* p = PROJ + (size_t)(tok0 + t) * NINP + C_B + cg3; ur[i] = bf2f(p[0]); uk[i] = bf2f(p[256]); uv[i] = bf2f(p[512]); }
        else if (sample) { const float* p = shift_in + (size_t)sb * 896 + cg3; ur[i] = p[0]; uk[i] = p[256]; uv[i] = p[512]; }
        else { ur[i] = 0.f; uk[i] = 0.f; uv[i] = 0.f; }
    }
    const float mur = w.mu[cg3], muk = w.mu[256 + cg3], muv = w.mu[512 + cg3], kkw = w.k_k[cg3], kaw = w.k_a[cg3], rkw = w.r_k[cg3];
    {
        const int t = tid >> 4, j8 = (tid & 15) * 8, col = 768 + j8;
        float u[8], pv[8];
        unpack8(*(const u32x4*)(PROJ + (size_t)(tok0 + t) * NINP + C_B + col), u);
        if (t > 0 || !first) unpack8(*(const u32x4*)(PROJ + (size_t)(tok0 + t - 1) * NINP + C_B + col), pv);
        else if (sample) { const f32x4 a = *(const f32x4*)(shift_in + (size_t)sb * 896 + col), b = *(const f32x4*)(shift_in + (size_t)sb * 896 + col + 4); pv[0] = a.x; pv[1] = a.y; pv[2] = a.z; pv[3] = a.w; pv[4] = b.x; pv[5] = b.y; pv[6] = b.z; pv[7] = b.w; }
        else {
#pragma unroll
            for (int i = 0; i < 8; ++i) pv[i] = 0.f; }
        const f32x4 m0 = *(const f32x4*)(w.mu + col), m1 = *(const f32x4*)(w.mu + col + 4);
        const float mu[8] = {m0.x, m0.y, m0.z, m0.w, m1.x, m1.y, m1.z, m1.w};
        float x[8];
#pragma unroll
        for (int i = 0; i < 8; ++i) { const float xs = u[i] + mu[i] * (pv[i] - u[i]); x[i] = j8 < 32 ? 1.f - 2.f / (1.f + __expf(2.f * xs)) : (j8 < 64 ? xs : sigmoidf_(xs)); }
        u32x4 o; o.x = pk2(x[0], x[1]); o.y = pk2(x[2], x[3]); o.z = pk2(x[4], x[5]); o.w = pk2(x[6], x[7]);
        *(u32x4*)(LAT + t * LATS + j8) = o;
    }
    __syncthreads();
    {
        asm volatile("" : "+v"(tid)); const int lane = tid & 63, fr = lane & 15, fq = lane >> 4;
        const int c0l = 16 * wv, cg0 = hp * 128 + c0l;
#pragma unroll
        for (int tt = 0; tt < 2; ++tt) {
            const int t = 16 * tt + fr;
            const f32x4 z = {0.f, 0.f, 0.f, 0.f};
            f32x4 aw = MFMA16(fw, ldf(LAT, t, LATS, 8 * fq), z);
            f32x4 aa = MFMA16(fa, ldf(LAT, t, LATS, 32 + 8 * fq), z);
            f32x4 ag = MFMA16(fg0, ldf(LAT, t, LATS, 64 + 8 * fq), z);
            ag = MFMA16(fg1, ldf(LAT, t, LATS, 96 + 8 * fq), ag);
            *(f32x4*)(WLb + t * 128 + c0l + 4 * fq) = aw + w0v;
            *(f32x4*)(ALb + t * 128 + c0l + 4 * fq) = aa + a0v;
            *(u32x2*)(G.GATE + (size_t)(tok0 + t) * 256 + cg0 + 4 * fq) = pk4(ag);
        }
    }
    __syncthreads();
    {
        asm volatile("" : "+v"(tid));
        const int c = tid & 127, tq = tid >> 7, hd = c >> 6, c64 = c & 63, cg = hp * 128 + c;
        unsigned char* hb = lds + RB_BASE + hd * RB_HEAD;
        bf16_t *AT = (bf16_t*)(hb + RB_AT), *BH = (bf16_t*)(hb + RB_BH), *KH = (bf16_t*)(hb + RB_KH), *RT = (bf16_t*)(hb + RB_RT);
        bf16_t *ATt = (bf16_t*)(hb + RB_ATT), *BHt = (bf16_t*)(hb + RB_BHT), *KHt = (bf16_t*)(hb + RB_KHT), *Vt = (bf16_t*)(hb + RB_VT);
        float lw[8], cl[8];
        float run = 0.f;
#pragma unroll
        for (int i = 0; i < 8; ++i) { lw[i] = -0.60653066f * sigmoidf_(WLb[(8 * tq + i) * 128 + c]); run += lw[i]; cl[i] = run; }
        SCN[tq * 128 + c] = run;
        __syncthreads();
        float pre = 0.f, tot = 0.f;
#pragma unroll
        for (int q = 0; q < 4; ++q) { const float v = SCN[q * 128 + c]; tot += v; if (q < tq) pre += v; }
        if (tq == 0) WLs[c] = __expf(tot);
        float at8[8], bh8[8], kh8[8], vv8[8];
        float rr8[8], kk8[8], km8[8], ar8[8], ss8[8], bo8[8];
#pragma unroll
        for (int i = 0; i < 8; ++i) {
            const int t = 8 * tq + i;
            rr8[i] = ur[i + 1] + mur * (ur[i] - ur[i + 1]); const float k = uk[i + 1] + muk * (uk[i] - uk[i + 1]); vv8[i] = uv[i + 1] + muv * (uv[i] - uv[i + 1]);
            ar8[i] = __builtin_amdgcn_rcpf(1.f + __expf(-ALb[t * 128 + c]));
            kk8[i] = k * kkw; km8[i] = k * (1.f + (ar8[i] - 1.f) * kaw);
            ss8[i] = kk8[i] * kk8[i]; bo8[i] = rr8[i] * km8[i] * rkw;
        }
#pragma unroll
        for (int o = 1; o < 64; o <<= 1) {
#pragma unroll
            for (int i = 0; i < 8; ++i) { ss8[i] += __shfl_xor(ss8[i], o); bo8[i] += __shfl_xor(bo8[i], o); }
        }
#pragma unroll
        for (int i = 0; i < 8; ++i) {
            const int t = 8 * tq + i;
            const float cum = pre + cl[i];
            const float W = __expf(cum), Wp = __expf(cum - lw[i]), iW = __expf(-cum);
            const float kkn = kk8[i] * __builtin_amdgcn_rcpf(fmaxf(sqrtf(ss8[i]), 1e-12f));
            const float at = -kkn * Wp, bh = kkn * ar8[i] * iW, kh = km8[i] * iW, rt = rr8[i] * W;
            AT[t * NS + c64] = f2bf(at); BH[t * NS + c64] = f2bf(bh); KH[t * NS + c64] = f2bf(kh); RT[t * NS + c64] = f2bf(rt);
            at8[i] = at; bh8[i] = bh; kh8[i] = kh;
            G.BV[(size_t)(tok0 + t) * 256 + cg] = f2bf(bo8[i] * vv8[i]);
        }
        u32x4 o;
        o.x = pk2(at8[0], at8[1]); o.y = pk2(at8[2], at8[3]); o.z = pk2(at8[4], at8[5]); o.w = pk2(at8[6], at8[7]); *(u32x4*)(ATt + c64 * TS + 8 * tq) = o;
        o.x = pk2(bh8[0], bh8[1]); o.y = pk2(bh8[2], bh8[3]); o.z = pk2(bh8[4], bh8[5]); o.w = pk2(bh8[6], bh8[7]); *(u32x4*)(BHt + c64 * TS + 8 * tq) = o;
        o.x = pk2(kh8[0], kh8[1]); o.y = pk2(kh8[2], kh8[3]); o.z = pk2(kh8[4], kh8[5]); o.w = pk2(kh8[6], kh8[7]); *(u32x4*)(KHt + c64 * TS + 8 * tq) = o;
        o.x = pk2(vv8[0], vv8[1]); o.y = pk2(vv8[2], vv8[3]); o.z = pk2(vv8[4], vv8[5]); o.w = pk2(vv8[6], vv8[7]); *(u32x4*)(Vt + c64 * TS + 8 * tq) = o;
    }
    __syncthreads();
    asm volatile("" : "+v"(tid)); const int lane = tid & 63, fr = lane & 15, fq = lane >> 4;
    const int hd = wv >> 2, wg = wv & 3, h = hp * 2 + hd; const size_t ch = (size_t)cid * 4 + h;
    unsigned char* hb = lds + RB_BASE + hd * RB_HEAD; unsigned char* cb = lds + hd * RC_HEAD;
    const bf16_t *AT = (const bf16_t*)(hb + RB_AT), *BH = (const bf16_t*)(hb + RB_BH), *KH = (const bf16_t*)(hb + RB_KH), *RT = (const bf16_t*)(hb + RB_RT);
    const bf16_t *ATt = (const bf16_t*)(hb + RB_ATT), *BHt = (const bf16_t*)(hb + RB_BHT), *KHt = (const bf16_t*)(hb + RB_KHT), *Vt = (const bf16_t*)(hb + RB_VT);
    float* Mab = (float*)(cb + RC_MAB);
    bf16_t *Mak = (bf16_t*)(cb + RC_MAK), *Mrb = (bf16_t*)(cb + RC_MRB), *Mrk = (bf16_t*)(cb + RC_MRK), *Tm = (bf16_t*)(cb + RC_TM), *MakVt = (bf16_t*)(cb + RC_MAKVT), *GT = (bf16_t*)(cb + RC_GT), *U0T = (bf16_t*)(cb + RC_U0T);
    const f32x4 z4 = {0.f, 0.f, 0.f, 0.f};
    {
        const bf16_t* rowsrc = (wg >> 1) ? RT : AT; const bf16_t* colsrc = (wg & 1) ? KH : BH;
        bf16_t* Mo = wg == 1 ? Mak : (wg == 2 ? Mrb : Mrk);
#pragma unroll
        for (int tt = 0; tt < 2; ++tt)
#pragma unroll
            for (int st = 0; st < 2; ++st) {
                f32x4 acc = MFMA16(ldf(colsrc, 16 * st + fr, NS, 8 * fq), ldf(rowsrc, 16 * tt + fr, NS, 8 * fq), z4);
                acc = MFMA16(ldf(colsrc, 16 * st + fr, NS, 32 + 8 * fq), ldf(rowsrc, 16 * tt + fr, NS, 32 + 8 * fq), acc);
                const int t = 16 * tt + fr, s0 = 16 * st + 4 * fq, lim = (wg >> 1) ? t + 1 : t;
                acc.x = (s0 + 0 < lim) ? acc.x : 0.f; acc.y = (s0 + 1 < lim) ? acc.y : 0.f; acc.z = (s0 + 2 < lim) ? acc.z : 0.f; acc.w = (s0 + 3 < lim) ? acc.w : 0.f;
                if (wg == 0) *(f32x4*)(Mab + t * MABS + s0) = acc; else *(u32x2*)(Mo + t * TS + s0) = pk4(acc);
            }
    }
    __syncthreads();
    const float* WL = (const float*)(lds + R_WLS) + hd * 64;
    if (wg == 0) {
        {
            const int j = lane & 31;
            float Tc[32];
            f32x4 cur[8];
#pragma unroll
            for (int q = 0; q < 8; ++q) cur[q] = (f32x4){0.f, 0.f, 0.f, 0.f};
#pragma unroll
            for (int t = 0; t < 32; ++t) {
                f32x4 nx[8];
#pragma unroll
                for (int q = 0; q < 8; ++q) nx[q] = (t + 1 < 32 && 4 * q < t + 1) ? *(const f32x4*)(Mab + (t + 1) * MABS + 4 * q) : (f32x4){0.f, 0.f, 0.f, 0.f};
                float a0 = (t == j) ? 1.f : 0.f, a1 = 0.f;
#pragma unroll
                for (int s2 = 0; s2 < t; ++s2) { const float nv = cur[s2 >> 2][s2 & 3]; if (s2 & 1) a1 += nv * Tc[s2]; else a0 += nv * Tc[s2]; }
                Tc[t] = a0 + a1;
#pragma unroll
                for (int q = 0; q < 8; ++q) cur[q] = nx[q];
            }
            if (lane < 32) {
#pragma unroll
                for (int t = 0; t < 32; ++t) Tm[t * TS + j] = f2bf(Tc[t]);
            }
        }
        __syncthreads();
#pragma unroll
        for (int rt = 0; rt < 2; ++rt)
#pragma unroll
            for (int tt = 0; tt < 2; ++tt) {
                const f32x4 acc = MFMA16(ldf(Tm, 16 * tt + fr, TS, 8 * fq), ldf(ATt, 16 * rt + fr, TS, 8 * fq), z4);
                *(u32x2*)(GT + (16 * rt + fr) * TS + 16 * tt + 4 * fq) = pk4(acc);
            }
        __syncthreads();
#pragma unroll
        for (int tt = 0; tt < 2; ++tt)
#pragma unroll
            for (int ks = 0; ks < 2; ++ks) {
                u32x2 pc[2];
#pragma unroll
                for (int hf = 0; hf < 2; ++hf) {
                    const int kt = 2 * ks + hf;
                    f32x4 acc = MFMA16(ldf(GT, 16 * kt + fr, TS, 8 * fq), ldf(Mrb, 16 * tt + fr, TS, 8 * fq), z4);
                    const int t = 16 * tt + fr, k0 = 16 * kt + 4 * fq;
                    const u32x2 rr = *(const u32x2*)(RT + t * NS + k0);
                    acc.x += __uint_as_float(rr.x << 16); acc.y += __uint_as_float(rr.x & 0xffff0000u); acc.z += __uint_as_float(rr.y << 16); acc.w += __uint_as_float(rr.y & 0xffff0000u);
                    pc[hf] = pk4(acc);
                }
                *(u32x4*)(G.ZZ + ch * 2048 + ((tt * 2 + ks) * 64 + lane) * 8) = (u32x4){pc[0].x, pc[0].y, pc[1].x, pc[1].y};
            }
    } else if (wg == 1) {
#pragma unroll
        for (int vt = 0; vt < 4; ++vt)
#pragma unroll
            for (int tt = 0; tt < 2; ++tt) {
                const f32x4 acc = MFMA16(ldf(Mak, 16 * tt + fr, TS, 8 * fq), ldf(Vt, 16 * vt + fr, TS, 8 * fq), z4);
                *(u32x2*)(MakVt + (16 * vt + fr) * TS + 16 * tt + 4 * fq) = pk4(acc);
            }
        __syncthreads();
#pragma unroll
        for (int rt = 2; rt < 4; ++rt)
#pragma unroll
            for (int tt = 0; tt < 2; ++tt) {
                const f32x4 acc = MFMA16(ldf(Tm, 16 * tt + fr, TS, 8 * fq), ldf(ATt, 16 * rt + fr, TS, 8 * fq), z4);
                *(u32x2*)(GT + (16 * rt + fr) * TS + 16 * tt + 4 * fq) = pk4(acc);
            }
        __syncthreads();
#pragma unroll
        for (int kp = 0; kp < 4; ++kp)
#pragma unroll
            for (int ks = 0; ks < 2; ++ks) {
                u32x2 pc[2];
#pragma unroll
                for (int hf = 0; hf < 2; ++hf) {
                    const int kt = 2 * ks + hf;
                    f32x4 acc = MFMA16(ldf(GT, 16 * kt + fr, TS, 8 * fq), ldf(BHt, 16 * kp + fr, TS, 8 * fq), z4);
                    const int kq = 16 * kp + fr, k0 = 16 * kt + 4 * fq; const float wl = WL[kq];
                    acc.x = (acc.x + (k0 + 0 == kq ? 1.f : 0.f)) * wl; acc.y = (acc.y + (k0 + 1 == kq ? 1.f : 0.f)) * wl; acc.z = (acc.z + (k0 + 2 == kq ? 1.f : 0.f)) * wl; acc.w = (acc.w + (k0 + 3 == kq ? 1.f : 0.f)) * wl;
                    pc[hf] = pk4(acc);
                }
                *(u32x4*)(G.PT + ch * 4096 + ((kp * 2 + ks) * 64 + lane) * 8) = (u32x4){pc[0].x, pc[0].y, pc[1].x, pc[1].y};
            }
    } else if (wg == 2) {
        f32x4 y0acc[2][4];
#pragma unroll
        for (int tt = 0; tt < 2; ++tt)
#pragma unroll
            for (int vt = 0; vt < 4; ++vt) y0acc[tt][vt] = MFMA16(ldf(Vt, 16 * vt + fr, TS, 8 * fq), ldf(Mrk, 16 * tt + fr, TS, 8 * fq), z4);
        __syncthreads();
#pragma unroll
        for (int rt = 0; rt < 2; ++rt)
#pragma unroll
            for (int tt = 0; tt < 2; ++tt) {
                const f32x4 acc = MFMA16(ldf(Tm, 16 * tt + fr, TS, 8 * fq), ldf(MakVt, 16 * rt + fr, TS, 8 * fq), z4);
                *(u32x2*)(U0T + (16 * rt + fr) * TS + 16 * tt + 4 * fq) = pk4(acc);
            }
        __syncthreads();
#pragma unroll
        for (int tt = 0; tt < 2; ++tt)
#pragma unroll
            for (int vp = 0; vp < 2; ++vp) {
                const f32x4 a0 = MFMA16(ldf(U0T, 16 * (2 * vp) + fr, TS, 8 * fq), ldf(Mrb, 16 * tt + fr, TS, 8 * fq), y0acc[tt][2 * vp]);
                const f32x4 a1 = MFMA16(ldf(U0T, 16 * (2 * vp + 1) + fr, TS, 8 * fq), ldf(Mrb, 16 * tt + fr, TS, 8 * fq), y0acc[tt][2 * vp + 1]);
                const u32x2 p0 = pk4(a0), p1 = pk4(a1);
                *(u32x4*)(G.Y0 + ch * 2048 + ((tt * 2 + vp) * 64 + lane) * 8) = (u32x4){p0.x, p0.y, p1.x, p1.y};
            }
    } else {
        f32x4 qacc[4][4];
#pragma unroll
        for (int vt = 0; vt < 4; ++vt)
#pragma unroll
            for (int kt = 0; kt < 4; ++kt) qacc[vt][kt] = MFMA16(ldf(KHt, 16 * kt + fr, TS, 8 * fq), ldf(Vt, 16 * vt + fr, TS, 8 * fq), z4);
        __syncthreads();
#pragma unroll
        for (int rt = 2; rt < 4; ++rt)
#pragma unroll
            for (int tt = 0; tt < 2; ++tt) {
                const f32x4 acc = MFMA16(ldf(Tm, 16 * tt + fr, TS, 8 * fq), ldf(MakVt, 16 * rt + fr, TS, 8 * fq), z4);
                *(u32x2*)(U0T + (16 * rt + fr) * TS + 16 * tt + 4 * fq) = pk4(acc);
            }
        __syncthreads();
#pragma unroll
        for (int vt = 0; vt < 4; ++vt)
#pragma unroll
            for (int hf2 = 0; hf2 < 2; ++hf2) {
                u32x2 pc[2];
#pragma unroll
                for (int hf = 0; hf < 2; ++hf) {
                    const int kt = 2 * hf2 + hf;
                    f32x4 acc = MFMA16(ldf(BHt, 16 * kt + fr, TS, 8 * fq), ldf(U0T, 16 * vt + fr, TS, 8 * fq), qacc[vt][kt]);
                    acc *= *(const f32x4*)(WL + 16 * kt + 4 * fq);
                    pc[hf] = pk4(acc);
                }
                *(u32x4*)(G.QQ + ch * 4096 + ((vt * 2 + hf2) * 64 + lane) * 8) = (u32x4){pc[0].x, pc[0].y, pc[1].x, pc[1].y};
            }
    }
    __syncthreads();
}

__device__ __forceinline__ void chain_step(f32x4 (&acc)[4], const bf16x8 (&fa)[4][2], u32x4 q01, u32x4 q23, bf16_t* __restrict__ scp) {
    union { u32x4 u; bf16x8 v; } bs[2];
    const u32x2 a = pk4(acc[0]), b = pk4(acc[1]), c2 = pk4(acc[2]), d = pk4(acc[3]);
    *(u32x4*)(scp) = (u32x4){a.x, a.y, b.x, b.y}; *(u32x4*)(scp + 512) = (u32x4){c2.x, c2.y, d.x, d.y};
    bs[0].u = (u32x4){a.x, a.y, b.x, b.y}; bs[1].u = (u32x4){c2.x, c2.y, d.x, d.y};
    acc[0] = (f32x4){__uint_as_float(q01.x << 16), __uint_as_float(q01.x & 0xffff0000u), __uint_as_float(q01.y << 16), __uint_as_float(q01.y & 0xffff0000u)};
    acc[1] = (f32x4){__uint_as_float(q01.z << 16), __uint_as_float(q01.z & 0xffff0000u), __uint_as_float(q01.w << 16), __uint_as_float(q01.w & 0xffff0000u)};
    acc[2] = (f32x4){__uint_as_float(q23.x << 16), __uint_as_float(q23.x & 0xffff0000u), __uint_as_float(q23.y << 16), __uint_as_float(q23.y & 0xffff0000u)};
    acc[3] = (f32x4){__uint_as_float(q23.z << 16), __uint_as_float(q23.z & 0xffff0000u), __uint_as_float(q23.w << 16), __uint_as_float(q23.w & 0xffff0000u)};
#pragma unroll
    for (int it = 0; it < 4; ++it) { acc[it] = MFMA16(fa[it][0], bs[0].v, acc[it]); acc[it] = MFMA16(fa[it][1], bs[1].v, acc[it]); }
}
__device__ __forceinline__ void rwkv_chain1(int sq, int h, int wg, const float* __restrict__ state_in, const RwkvG& G, float* __restrict__ st_s) {
    int tid_ = threadIdx.x; asm volatile("" : "+v"(tid_));
    const int lane = tid_ & 63, fr = lane & 15, fq = lane >> 4, j0 = 16 * wg;
    const Seq s = seq_of(sq);
    const size_t ch = (size_t)(s.base / 32) * 4 + h;
    f32x4 acc[4];
#pragma unroll
    for (int it = 0; it < 4; ++it) acc[it] = *(const f32x4*)(state_in + (((size_t)s.b * 4 + h) * 64 + j0 + fr) * 64 + 16 * it + 4 * fq);
    bf16x8 fa[4][2];
#pragma unroll
    for (int it = 0; it < 4; ++it)
#pragma unroll
        for (int ks = 0; ks < 2; ++ks) fa[it][ks] = *(const bf16x8*)(G.PT + ch * 4096 + ((it * 2 + ks) * 64 + lane) * 8);
    const u32x4 q01 = *(const u32x4*)(G.QQ + ch * 4096 + ((wg * 2) * 64 + lane) * 8), q23 = *(const u32x4*)(G.QQ + ch * 4096 + ((wg * 2 + 1) * 64 + lane) * 8);
    chain_step(acc, fa, q01, q23, G.SC + ch * 4096 + wg * 1024 + lane * 8);
    float* o = st_s + (((size_t)s.b * 4 + h) * 64 + j0 + fr) * 64 + 4 * fq;
#pragma unroll
    for (int it = 0; it < 4; ++it) *(f32x4*)(o + 16 * it) = acc[it];
}
constexpr int CH_RP = 16, CH_RQ = 16, CH_SLOT = 8192  ;
#define CH_BAR() do { __builtin_amdgcn_s_waitcnt(0xc07f); __builtin_amdgcn_s_barrier(); } while (0)
__device__ __forceinline__ void rwkv_chain_lds(unsigned char* lds, int sq, int h, const RwkvG& G, float* __restrict__ st_p) {
    constexpr int nc = 4096 / 32;
    static_assert(nc % CH_RP == 0 && CH_RP % CH_RQ == 0, "ring depths must divide the chunk count");
    int tid_ = threadIdx.x; asm volatile("" : "+v"(tid_));
    const int wv = __builtin_amdgcn_readfirstlane(tid_ >> 6);
    const Seq s = seq_of(sq);
    const size_t ch0 = (size_t)(s.base / 32) * 4 + h;
    if (wv >= 4) {
        int tl_ = threadIdx.x; asm volatile("" : "+v"(tl_)); const int lane = tl_ & 63;
        const int lw = wv - 4;
        const bf16_t* pn = G.PT + ch0 * 4096 + (size_t)(lw * 128 + lane) * 8;
        unsigned char* dst0 = lds + (lw * 128 + lane) * 16;
        u32x4 ld[CH_RP][2];
#pragma unroll
        for (int c = 0; c < CH_RP; ++c) {
#pragma unroll
            for (int i = 0; i < 2; ++i) ld[c][i] = *(const u32x4*)(pn + i * 512);
            pn += 16384; asm volatile("" : "+v"(pn));
        }
#pragma unroll
        for (int i = 0; i < 2; ++i) *(u32x4*)(dst0 + i * 1024) = ld[0][i];
#pragma unroll
        for (int i = 0; i < 2; ++i) ld[0][i] = *(const u32x4*)(pn + i * 512);
        pn += 16384; asm volatile("" : "+v"(pn));
        CH_BAR();
#pragma unroll 1
        for (int s0 = 0; s0 < nc; s0 += CH_RP) {
#pragma unroll
            for (int j = 0; j < CH_RP; ++j) {
                const int nx = s0 + j + 1, set = (j + 1) % CH_RP;
                unsigned char* d = dst0 + (nx & 1) * CH_SLOT;
#pragma unroll
                for (int i = 0; i < 2; ++i) *(u32x4*)(d + i * 1024) = ld[set][i];
#pragma unroll
                for (int i = 0; i < 2; ++i) ld[set][i] = *(const u32x4*)(pn + i * 512);
                pn += (nx + CH_RP + 1 < nc) ? 16384 : 0; asm volatile("" : "+v"(pn));
                CH_BAR();
            }
        }
    } else {
        int tc_ = threadIdx.x; asm volatile("" : "+v"(tc_)); const int lane = tc_ & 63, fr = lane & 15, fq = lane >> 4;
        const int j0 = 16 * wv;
        const bf16_t* qn = G.QQ + ch0 * 4096 + (size_t)((wv * 2) * 64 + lane) * 8;
        u32x4 qr[CH_RQ][2];
#pragma unroll
        for (int c = 0; c < CH_RQ; ++c) { qr[c][0] = *(const u32x4*)(qn); qr[c][1] = *(const u32x4*)(qn + 512); qn += 16384; asm volatile("" : "+v"(qn)); }
        bf16_t* scp = G.SC + ch0 * 4096 + wv * 1024 + lane * 8;
        f32x4 acc[4];
#pragma unroll
        for (int it = 0; it < 4; ++it) acc[it] = (f32x4){0.f, 0.f, 0.f, 0.f};
        CH_BAR();
#pragma unroll 1
        for (int s0 = 0; s0 < nc; s0 += CH_RP) {
#pragma unroll
            for (int j = 0; j < CH_RP; ++j) {
                const int st = s0 + j, qs = j % CH_RQ;
                const unsigned char* sl = lds + (st & 1) * CH_SLOT;
                bf16x8 fa[4][2];
#pragma unroll
                for (int it = 0; it < 4; ++it)
#pragma unroll
                    for (int ks = 0; ks < 2; ++ks) fa[it][ks] = *(const bf16x8*)(sl + ((it * 2 + ks) * 64 + lane) * 16);
                const u32x4 q01 = qr[qs][0], q23 = qr[qs][1];
                qr[qs][0] = *(const u32x4*)(qn); qr[qs][1] = *(const u32x4*)(qn + 512);
                qn += (st + CH_RQ + 1 < nc) ? 16384 : 0; asm volatile("" : "+v"(qn));
                chain_step(acc, fa, q01, q23, scp);
                scp += 16384; asm volatile("" : "+v"(scp));
                CH_BAR();
            }
        }
        int t3 = threadIdx.x; asm volatile("" : "+v"(t3));
        const int l3 = t3 & 63, fr3 = l3 & 15, fq3 = l3 >> 4;
        float* o = st_p + (((size_t)s.b * 4 + h) * 64 + j0 + fr3) * 64 + 4 * fq3;
#pragma unroll
        for (int it = 0; it < 4; ++it) *(f32x4*)(o + 16 * it) = acc[it];
    }
}

__device__ __forceinline__ void rwkv_out(int wi, const RwkvW& w, const RwkvG& G, bf16_t* __restrict__ YMIX) {
    int tid_ = threadIdx.x; asm volatile("" : "+v"(tid_));
    const int lane = tid_ & 63, fr = lane & 15, fq = lane >> 4;
    const size_t ch = (size_t)(wi >> 1); const int tt = wi & 1, h = (int)(ch & 3), cid = (int)(ch >> 2);
    const int t = 16 * tt + fr, tok = cid * 32 + t;
    const bf16x8 z0 = *(const bf16x8*)(G.ZZ + ch * 2048 + ((tt * 2 + 0) * 64 + lane) * 8), z1 = *(const bf16x8*)(G.ZZ + ch * 2048 + ((tt * 2 + 1) * 64 + lane) * 8);
    const u32x4 yp0 = *(const u32x4*)(G.Y0 + ch * 2048 + ((tt * 2 + 0) * 64 + lane) * 8), yp1 = *(const u32x4*)(G.Y0 + ch * 2048 + ((tt * 2 + 1) * 64 + lane) * 8);
    f32x4 y[4]; float sum = 0.f;
#pragma unroll
    for (int vt = 0; vt < 4; ++vt) {
        const bf16_t* sp = G.SC + ch * 4096 + vt * 1024 + lane * 8;
        const u32x4 yp = vt < 2 ? yp0 : yp1; const unsigned ya = (vt & 1) ? yp.z : yp.x, yb2 = (vt & 1) ? yp.w : yp.y;
        f32x4 acc = {__uint_as_float(ya << 16), __uint_as_float(ya & 0xffff0000u), __uint_as_float(yb2 << 16), __uint_as_float(yb2 & 0xffff0000u)};
        acc = MFMA16(*(const bf16x8*)sp, z0, acc); acc = MFMA16(*(const bf16x8*)(sp + 512), z1, acc);
        y[vt] = acc; sum += (acc.x + acc.y) + (acc.z + acc.w);
    }
    sum += __shfl_xor(sum, 16); sum += __shfl_xor(sum, 32);
    const float mean = sum * (1.f / 64.f); float var = 0.f;
#pragma unroll
    for (int vt = 0; vt < 4; ++vt) { y[vt] -= mean; var += (y[vt].x * y[vt].x + y[vt].y * y[vt].y) + (y[vt].z * y[vt].z + y[vt].w * y[vt].w); }
    var += __shfl_xor(var, 16); var += __shfl_xor(var, 32);
    const float rstd = rsqrtf(var * (1.f / 64.f) + 64e-5f);
#pragma unroll
    for (int vt = 0; vt < 4; ++vt) {
        const int c = h * 64 + 16 * vt + 4 * fq;
        const f32x4 gg = *(const f32x4*)(w.gn_g + c), gb = *(const f32x4*)(w.gn_b + c);
        const u32x2 bv = *(const u32x2*)(G.BV + (size_t)tok * 256 + c), gt = *(const u32x2*)(G.GATE + (size_t)tok * 256 + c);
        f32x4 o = y[vt] * rstd * gg + gb;
        o.x = (o.x + __uint_as_float(bv.x << 16)) * __uint_as_float(gt.x << 16); o.y = (o.y + __uint_as_float(bv.x & 0xffff0000u)) * __uint_as_float(gt.x & 0xffff0000u);
        o.z = (o.z + __uint_as_float(bv.y << 16)) * __uint_as_float(gt.y << 16); o.w = (o.w + __uint_as_float(bv.y & 0xffff0000u)) * __uint_as_float(gt.y & 0xffff0000u);
        *(u32x2*)(YMIX + (size_t)tok * DM + 256 + c) = pk4(o);
    }
}


template <int K, int SRC, bool WF32, bool WBF>
__device__ __forceinline__ void gemm_tail(unsigned char* lds, const bf16_t* __restrict__ A, const bf16_t* __restrict__ Bt, const float* __restrict__ xin_s, float* __restrict__ xout, bf16_t* __restrict__ XB, float* __restrict__ RSS) {
    int tid_ = threadIdx.x; asm volatile("" : "+v"(tid_));
    const int lane = tid_ & 63, w = __builtin_amdgcn_readfirstlane(tid_ >> 6), fr = lane & 15, fq = lane >> 4;
    float* part = (float*)lds;
    for (int tb = blockIdx.x; tb < 256; tb += gridDim.x) {
        const int mi = tb >> 4, ni = tb & 15, rt = w >> 2, ct = w & 3;
        const int r0 = 32 * mi + 16 * rt, c0 = 64 * ni + 16 * ct;
        const bf16_t* ap = A + (size_t)(T_P + r0 + fr) * K + 8 * fq; const bf16_t* bp = Bt + (size_t)(c0 + fr) * K + 8 * fq;
        f32x4 acc = {0.f, 0.f, 0.f, 0.f};
#pragma unroll 1
        for (int k0 = 0; k0 + 512 <= K; k0 += 512) {
            bf16x8 av[16], bv[16];
#pragma unroll
            for (int u = 0; u < 16; ++u) { av[u] = *(const bf16x8*)(ap + k0 + 32 * u); bv[u] = *(const bf16x8*)(bp + k0 + 32 * u); }
#pragma unroll
            for (int u = 0; u < 16; ++u) acc = MFMA16(bv[u], av[u], acc);
        }
        if (K % 512) {
            constexpr int k0 = K - (K % 512), NU = (K % 512) / 32;
            bf16x8 av[NU > 0 ? NU : 1], bv[NU > 0 ? NU : 1];
#pragma unroll
            for (int u = 0; u < NU; ++u) { av[u] = *(const bf16x8*)(ap + k0 + 32 * u); bv[u] = *(const bf16x8*)(bp + k0 + 32 * u); }
#pragma unroll
            for (int u = 0; u < NU; ++u) acc = MFMA16(bv[u], av[u], acc);
        }
        const int row = r0 + fr, col = c0 + 4 * fq;
        f32x4 x;
        if (SRC == 0) x = *(const f32x4*)(xin_s + (size_t)row * DM + col);
        else { const u32x2 r = *(const u32x2*)(XB + (size_t)(T_P + row) * DM + col); x = (f32x4){__uint_as_float(r.x << 16), __uint_as_float(r.x & 0xffff0000u), __uint_as_float(r.y << 16), __uint_as_float(r.y & 0xffff0000u)}; }
        x += acc;
        if (WF32) *(f32x4*)(xout + (size_t)(T_P + row) * DM + col) = x;
        if (WBF) {
            *(u32x2*)(XB + (size_t)(T_P + row) * DM + col) = pk4(x);
            float ss = (x.x * x.x + x.y * x.y) + (x.z * x.z + x.w * x.w);
            ss += __shfl_xor(ss, 16); ss += __shfl_xor(ss, 32);
            if (lane < 16) part[(rt * 4 + ct) * 16 + fr] = ss;
            __syncthreads();
            if (tid_ < 32) { const int rr = tid_ >> 4, f = tid_ & 15; RSS[(size_t)(T_P + 32 * mi + 16 * rr + f) * 16 + ni] = (part[(rr * 4 + 0) * 16 + f] + part[(rr * 4 + 1) * 16 + f]) + (part[(rr * 4 + 2) * 16 + f] + part[(rr * 4 + 3) * 16 + f]); }
            __syncthreads();
        }
    }
}

template <class E2> struct EpiAdapt {
    static constexpr bool PERM = true, AFTER_DRAIN = false; E2 e;
    __device__ __forceinline__ void operator()(const pg8::f32x4 (&acc)[2][2][4][2], const pg8::Unit& u, int wr, int wc, int fr, int fq) const {
#pragma unroll
        for (int ai = 0; ai < 2; ++ai)
#pragma unroll
            for (int m = 0; m < 4; ++m) {
                const int row = u.pm * 256 + ai * 128 + wr * 64 + m * 16 + fr;
                const float rs = e.rowscale(row);
                e(row, u.pn * 256 + wc * 32 + 8 * fq, acc[ai][0][m][0], acc[ai][0][m][1], acc[ai][1][m][0], acc[ai][1][m][1], rs);
            }
    }
};

#define LAS __attribute__((address_space(3)))
#define XB_TMO      128
#define XB_XCNT(j)  (256  + 64 * (j))
#define XB_XSUB(j)  (1280 + 64 * (j))
#define XB_XGEN(j)  (2304 + 64 * (j))
#define XB_TOP      3328
#define XB_TOPGEN   3392
#define XCD_BAR_WORDS 3456
#define XB_SPIN_CAP (1u << 18)

__device__ __forceinline__ unsigned xb_ld(unsigned* p)              { return __hip_atomic_load(p, __ATOMIC_RELAXED, __HIP_MEMORY_SCOPE_AGENT); }
__device__ __forceinline__ unsigned xb_add(unsigned* p, unsigned v) { return __hip_atomic_fetch_add(p, v, __ATOMIC_RELAXED, __HIP_MEMORY_SCOPE_AGENT); }
__device__ __forceinline__ unsigned xb_xcc_id() { return (unsigned)__builtin_amdgcn_s_getreg((3 << 11) | 20) & 0xFu; }
#define XB_SPIN(cond, bar) do { unsigned _sp = 0; while (cond) { __builtin_amdgcn_s_sleep(1); \
    if ((++_sp & 255u) == 0u) { if (xb_ld(&(bar)[XB_TMO])) break; if (_sp > XB_SPIN_CAP) { atomicAdd(&(bar)[XB_TMO], 1u); break; } } } } while (0)

struct XcdBarrier {
    unsigned* bar; unsigned x;
    unsigned* psub; unsigned* pgen;
    volatile LAS unsigned* st;
};

__device__ __forceinline__ XcdBarrier xcd_barrier_post(unsigned* bar, volatile LAS unsigned* st) {
    XcdBarrier b; b.bar = bar; b.x = xb_xcc_id(); b.st = st; b.psub = bar + XB_XSUB(b.x); b.pgen = bar + XB_XGEN(b.x);
    if (threadIdx.x == 0) (void)xb_add(&bar[XB_XCNT(b.x)], 1u);
    return b;
}
__device__ __forceinline__ void xcd_barrier_complete(unsigned* bar, unsigned x, unsigned& nloc, unsigned& nx) {
    const unsigned G = gridDim.x * gridDim.y * gridDim.z;
    unsigned sum, cnt, mine, sp = 0u;
    for (;;) {
        sum = 0u; cnt = 0u; mine = 0u;
#pragma unroll
        for (unsigned j = 0; j < 16; ++j) { const unsigned c = xb_ld(&bar[XB_XCNT(j)]); sum += c; cnt += (c > 0u) ? 1u : 0u; mine = (j == x) ? c : mine; }
        if (sum == G) break;
        __builtin_amdgcn_s_sleep(1);
        if ((++sp & 255u) == 0u) { if (xb_ld(&bar[XB_TMO])) break; if (sp > XB_SPIN_CAP) { atomicAdd(&bar[XB_TMO], 1u); break; } }
    }
    nloc = mine > 0u ? mine : 1u; nx = cnt > 0u ? cnt : 1u;
}

__device__ __forceinline__ void xcd_barrier(const XcdBarrier& b) {
    asm volatile("s_waitcnt vmcnt(0)" ::: "memory");
    __syncthreads();
    if (threadIdx.x == 0) {
        unsigned* bar = b.bar;
        __builtin_amdgcn_s_waitcnt(0);
        unsigned nloc = b.st[0], nx = b.st[1];
        const unsigned old = xb_add(b.psub, 1u);
        const unsigned gen = old / nloc;
        if (old + 1u == (gen + 1u) * nloc) {
            __builtin_amdgcn_fence(__ATOMIC_RELEASE, "agent");
            asm volatile("s_waitcnt vmcnt(0)" ::: "memory");
            const unsigned og = xb_add(&bar[XB_TOP], 1u);
            const unsigned tg = og / nx;
            if (og + 1u == (tg + 1u) * nx) xb_add(&bar[XB_TOPGEN], 1u);
            else XB_SPIN(xb_ld(&bar[XB_TOPGEN]) == tg, bar);
            __builtin_amdgcn_fence(__ATOMIC_ACQUIRE, "agent");
            xb_add(b.pgen, 1u);
            asm volatile("s_waitcnt vmcnt(0)" ::: "memory");
        } else {
            XB_SPIN(xb_ld(b.pgen) == gen, bar);
            __builtin_amdgcn_fence(__ATOMIC_ACQUIRE, "agent");
            asm volatile("s_waitcnt vmcnt(0)" ::: "memory");
        }
    }
    __syncthreads();
}


__device__ __forceinline__ void xcd_census(const XcdBarrier& b) { if (threadIdx.x == 0) { unsigned nloc, nx; xcd_barrier_complete(b.bar, b.x, nloc, nx); b.st[0] = nloc; b.st[1] = nx; } __syncthreads(); }

constexpr int LDS_BYTES = 147456;
struct MP { const float* in[35]; float* out; unsigned char* ws; int ph_lo, ph_hi; };
constexpr int P0_I_IN = (DM / 64) * (NIN / 32), P0_I_OUT = (DM / 64) * (DM / 32), P0_I_G = (DM / 64) * (DFF / 32), P0_I_D = (DFF / 64) * (DM / 32), P0_IL = P0_I_IN + P0_I_OUT + 2 * P0_I_G + P0_I_D;
__device__ __forceinline__ const float* inptr_(int k);
__device__ __forceinline__ void p0_dispatch(int it, unsigned char* ws, float* scr, int lane) {
    const int l2 = it / P0_IL; int r = it - l2 * P0_IL;
    bf16_t* WIN_ = (bf16_t*)(ws + WS_WIN); bf16_t* WOUT_ = (bf16_t*)(ws + WS_WOUT); bf16_t* WGU_ = (bf16_t*)(ws + WS_WGU); bf16_t* WD_ = (bf16_t*)(ws + WS_WD);
    if (r < P0_I_IN) { p0_item(inptr_(9) + (size_t)l2 * DM * NIN, DM, NIN, WIN_ + (size_t)l2 * NINP * DM, inptr_(8) + l2 * DM, NIN, 0, 0, scr, r, lane, true); return; } r -= P0_I_IN;
    if (r < P0_I_OUT) { p0_item(inptr_(30) + (size_t)l2 * DM * DM, DM, DM, WOUT_ + (size_t)l2 * DM * DM, nullptr, DM, 0, 0, scr, r, lane); return; } r -= P0_I_OUT;
    if (r < P0_I_G) { p0_item(inptr_(32) + (size_t)l2 * DM * DFF, DM, DFF, WGU_ + (size_t)l2 * 2 * DFF * DM, inptr_(31) + l2 * DM, 4, 8, 0, scr, r, lane); return; } r -= P0_I_G;
    if (r < P0_I_G) { p0_item(inptr_(33) + (size_t)l2 * DM * DFF, DM, DFF, WGU_ + (size_t)l2 * 2 * DFF * DM, inptr_(31) + l2 * DM, 4, 8, 4, scr, r, lane); return; } r -= P0_I_G;
    p0_item(inptr_(34) + (size_t)l2 * DFF * DM, DFF, DM, WD_ + (size_t)l2 * DM * DFF, nullptr, DM, 0, 0, scr, r, lane);
}
__device__ __forceinline__ const float* inptr_(int k) { const float* const* ka = (const float* const*)__builtin_amdgcn_kernarg_segment_ptr(); asm volatile("" : "+s"(k)); return ka[k]; }
__device__ __forceinline__ int fresh_bx() { int b = blockIdx.x; asm volatile("" : "+s"(b)); return b; }
__global__ void __launch_bounds__(512, 2) mega(MP p) {
    extern __shared__ __attribute__((aligned(16))) unsigned char lds[];
    cg::grid_group grid = cg::this_grid();
    float* out = p.out; unsigned char* ws = p.ws;
#define INP(k) inptr_(k)
#define WIN ((bf16_t*)(ws + WS_WIN))
#define WOUT ((bf16_t*)(ws + WS_WOUT))
#define WGU ((bf16_t*)(ws + WS_WGU))
#define WD ((bf16_t*)(ws + WS_WD))
#define XB ((bf16_t*)(ws + WS_XB))
#define YMIX ((bf16_t*)(ws + WS_YMIX))
#define RSS ((float*)(ws + WS_RSS))
#define PROJ ((bf16_t*)(ws + WS_PROJ))
#define H ((bf16_t*)(ws + WS_H))
    const int lo = p.ph_lo, hi = p.ph_hi;
    int tid = threadIdx.x, half = tid >> 8;
#define FRESH() do { asm volatile("" : "+v"(tid)); half = tid >> 8; asm volatile("" : "+s"(ws), "+s"(out)); } while (0)
#ifndef TESTPH
#define TESTPH -1
#endif
    volatile LAS unsigned* bst = (volatile LAS unsigned*)(lds + LDS_BYTES - 16);
    if (threadIdx.x < 4) bst[threadIdx.x] = 0u;
    __syncthreads();
    const XcdBarrier xbar = xcd_barrier_post((unsigned*)(ws + WS_CTL), bst);
#ifndef PROF
#define PROF 0
#endif
    unsigned long long* tsb = (unsigned long long*)(ws + WS_CTL + 14336);
#ifndef DUP
#define DUP -1
#endif
#define REPS(k) for (int rep_ = 0; rep_ < ((DUP) == (k) ? 2 : 1); ++rep_)
#define REPSYNC(k) do { if ((DUP) == (k) && rep_ == 0) xcd_barrier(xbar); } while (0)
#define STAMP(k) do { if (PROF && blockIdx.x == 0 && threadIdx.x == 0) tsb[k] = __builtin_amdgcn_s_memrealtime(); } while (0)
    STAMP(0);
#define IN(k) ((TESTPH < 0 || TESTPH == ((k) > 8 ? (k) - 8 : (k))) && lo <= (k) && (k) < hi)
#define SEAM(k) do { if (IN((k) + 1)) { if ((k) == 0) { grid.sync(); xcd_census(xbar); } else xcd_barrier(xbar); } } while (0)
    if (IN(0)) REPS(0) {
        FRESH();
        {
            float* scr = (float*)lds + (tid >> 6) * (64 * 33);
            const int gw = blockIdx.x * 8 + (tid >> 6), ngw = gridDim.x * 8, lane = tid & 63;
            for (int it = gw; it < P0_IL; it += ngw) p0_dispatch(it, ws, scr, lane);
        }
        {
            bf16_t* PWT = (bf16_t*)(ws + WS_PWT);
            for (int i = blockIdx.x * 512 + tid; i < 2 * 4 * 64 * 64; i += gridDim.x * 512) { const int lg = i >> 12, d = (i >> 6) & 63, cc = i & 63; PWT[i] = f2bf(INP(25)[((size_t)lg * 64 + cc) * 64 + d]); }
        }
        {
            bf16_t* LWT = (bf16_t*)(ws + WS_LWT);
            for (int i = blockIdx.x * 512 + tid; i < 2 * 256 * 128; i += gridDim.x * 512) {
                const int l2 = i >> 15, c = (i >> 7) & 255, j = i & 127;
                const float v = j < 32 ? INP(16)[((size_t)l2 * 32 + j) * 256 + c] : (j < 64 ? INP(18)[((size_t)l2 * 32 + (j - 32)) * 256 + c] : INP(19)[((size_t)l2 * 64 + (j - 64)) * 256 + c]);
                LWT[i] = f2bf(v);
            }
        }
        for (int i = blockIdx.x; i < T / 16; i += gridDim.x) { d_xprep(i * 16 + (tid >> 6), INP(0), INP(1), XB, RSS); d_xprep(i * 16 + 8 + (tid >> 6), INP(0), INP(1), XB, RSS); }
        if (DUP == 0 && rep_ == 0) grid.sync(); else { SEAM(0); STAMP(1); }
    }
    for (int l = 0; l < 2; ++l) {
        const int pb = 1 + 8 * l;
        if (IN(pb + 0)) REPS(1) {
            FRESH();
            pg8::Gemm g{XB, WIN + (size_t)l * NINP * DM, T, NINP, DM}; pg8::StaticOrder S; S.init(T, NINP, gridDim.x, fresh_bx());
            EpiAdapt<EpiProj> E{EpiProj{PROJ, RSS, (bf16_t*)(ws + WS_GLU)}};
            pg8::gemm_phase<EpiAdapt<EpiProj>, pg8::StaticOrder, true, true>((LAS unsigned char*)lds, g, S, E);
            if (l == 0) {
                constexpr int NU1 = (T / 256) * (NINP / 256), NBUSY = NU1 % 256;
                if ((int)blockIdx.x >= NBUSY && gridDim.x == 256) {
                    float* scr = (float*)lds + (tid >> 6) * (64 * 33);
                    for (int it = P0_IL + ((int)blockIdx.x - NBUSY) * 8 + (tid >> 6); it < 2 * P0_IL; it += (256 - NBUSY) * 8) p0_dispatch(it, ws, scr, tid & 63);
                } else if (gridDim.x != 256) {
                    float* scr = (float*)lds + (tid >> 6) * (64 * 33);
                    for (int it = P0_IL + (int)blockIdx.x * 8 + (tid >> 6); it < 2 * P0_IL; it += (int)gridDim.x * 8) p0_dispatch(it, ws, scr, tid & 63);
                }
            }
            REPSYNC(1); if (!(DUP == 1 && rep_ == 0)) { SEAM(pb + 0); STAMP(pb + 1); }
        }
        if (IN(pb + 1)) REPS(2) {
            FRESH();
            int ll = l; asm volatile("" : "+s"(ll));
            const RwkvW rw{INP(14) + ll * 896, INP(15) + ll * 256, INP(16) + ll * 32 * 256, INP(17) + ll * 256, INP(18) + ll * 32 * 256, INP(19) + ll * 64 * 256, INP(20) + ll * 256, INP(21) + ll * 256, INP(22) + ll * 256, INP(23) + ll * 256, INP(24) + ll * 256};
            const RwkvG rg{(bf16_t*)(ws + WS_PT), (bf16_t*)(ws + WS_QQ), (bf16_t*)(ws + WS_ZZ), (bf16_t*)(ws + WS_Y0), (bf16_t*)(ws + WS_SC), (bf16_t*)(ws + WS_GATE), (bf16_t*)(ws + WS_BV), (const bf16_t*)(ws + WS_LWT)};
            for (int it = blockIdx.x; it < 1024; it += gridDim.x) rwkv_item(lds, it, ll, PROJ, INP(4) + (size_t)ll * 16 * 896, rw, rg);
            for (int i = blockIdx.x * 512 + tid; i < 20 * 896; i += gridDim.x * 512) {
                const int sq = i / 896, c = i - sq * 896; const Seq sx = seq_of(sq);
                const float v = bf2f(PROJ[(size_t)(sx.base + sx.L - 1) * NINP + C_B + c]);
                if (sx.sample) out[O_SHIFT_S + ((size_t)ll * 16 + sx.b) * 896 + c] = v; else out[O_SHIFT_P + ((size_t)ll * 4 + sx.b) * 896 + c] = v;
            }
            REPSYNC(2); if (!(DUP == 2 && rep_ == 0)) { SEAM(pb + 1); STAMP(pb + 2); }
        }
        if (IN(pb + 2)) REPS(3) {
            FRESH();
            int ll = l; asm volatile("" : "+s"(ll));
            const RwkvW rw{INP(14) + ll * 896, INP(15) + ll * 256, INP(16) + ll * 32 * 256, INP(17) + ll * 256, INP(18) + ll * 32 * 256, INP(19) + ll * 64 * 256, INP(20) + ll * 256, INP(21) + ll * 256, INP(22) + ll * 256, INP(23) + ll * 256, INP(24) + ll * 256};
            const RwkvG rg{(bf16_t*)(ws + WS_PT), (bf16_t*)(ws + WS_QQ), (bf16_t*)(ws + WS_ZZ), (bf16_t*)(ws + WS_Y0), (bf16_t*)(ws + WS_SC), (bf16_t*)(ws + WS_GATE), (bf16_t*)(ws + WS_BV), (const bf16_t*)(ws + WS_LWT)};
            if (blockIdx.x < 16) rwkv_chain_lds(lds, (int)blockIdx.x >> 2, (int)blockIdx.x & 3, rg, out + O_RWKV_P + (size_t)ll * 4 * 4 * 4096);
            else if (blockIdx.x < 48) {
                const int sidx = (int)blockIdx.x - 16;
                rwkv_item(lds, 1024 + sidx, ll, PROJ, INP(4) + (size_t)ll * 16 * 896, rw, rg);
                __syncthreads();
                const int wv = tid >> 6;
                rwkv_chain1(4 + (sidx >> 1), (sidx & 1) * 2 + (wv >> 2), wv & 3, INP(3) + (size_t)ll * 16 * 4 * 4096, rg, out + O_RWKV_S + (size_t)ll * 16 * 4 * 4096);
            }
            {
                const AttnP ap{PROJ, INP(6) + (size_t)ll * 16 * 128 * 128, INP(7) + (size_t)ll * 16 * 128 * 128, INP(27) + ll * 64, INP(28) + ll * 64, INP(29) + ll * 4, YMIX,
                               out + O_K_P + (size_t)ll * 4 * 128 * 128, out + O_K_S + (size_t)ll * 16 * 128 * 128, out + O_V_P + (size_t)ll * 4 * 128 * 128, out + O_V_S + (size_t)ll * 16 * 128 * 128};
                const ConvPoolP cp{PROJ, INP(2) + (size_t)ll * 16 * 30 * 256, INP(10) + ll * 31 * 256, INP(11) + ll * 256, INP(12) + ll * 256, INP(13) + ll * 256, INP(5) + (size_t)ll * 16 * 15 * 256, INP(25) + (size_t)ll * 4 * 64 * 64, INP(26) + ll * 256, YMIX,
                                   out + O_CONV_P + (size_t)ll * 4 * 30 * 256, out + O_CONV_S + (size_t)ll * 16 * 30 * 256, out + O_POOL_P + (size_t)ll * 4 * 15 * 256, out + O_POOL_S + (size_t)ll * 16 * 15 * 256, (const bf16_t*)(ws + WS_GLU), (const bf16_t*)(ws + WS_PWT) + (size_t)ll * 4 * 64 * 64};
                unsigned* ctr = (unsigned*)(ws + WS_CTL + 14848) + 64 * ll + 32 * (DUP == 3 ? rep_ : 0);
                volatile LAS unsigned* wsl = (volatile LAS unsigned*)(lds + LDS_BYTES - 32);
                for (;;) {
                    __syncthreads();
                    if (tid == 0) wsl[0] = __hip_atomic_fetch_add(ctr, 1u, __ATOMIC_RELAXED, __HIP_MEMORY_SCOPE_AGENT);
                    __syncthreads();
                    const unsigned idx = wsl[0];
                    if (idx >= 528u + 544u) break;
                    if (idx < 528u) convpool_tile((float*)lds + half * (62 * 256), 2 * (int)idx + half, cp);
                    else attn_unit(lds, (int)idx - 528, ap);
                }
            }
            REPSYNC(3); if (!(DUP == 3 && rep_ == 0)) { SEAM(pb + 2); STAMP(pb + 3); }
        }
        if (IN(pb + 3)) REPS(4) {
            FRESH();
            int ll = l; asm volatile("" : "+s"(ll));
            const RwkvW rw{INP(14) + ll * 896, INP(15) + ll * 256, INP(16) + ll * 32 * 256, INP(17) + ll * 256, INP(18) + ll * 32 * 256, INP(19) + ll * 64 * 256, INP(20) + ll * 256, INP(21) + ll * 256, INP(22) + ll * 256, INP(23) + ll * 256, INP(24) + ll * 256};
            const RwkvG rg{(bf16_t*)(ws + WS_PT), (bf16_t*)(ws + WS_QQ), (bf16_t*)(ws + WS_ZZ), (bf16_t*)(ws + WS_Y0), (bf16_t*)(ws + WS_SC), (bf16_t*)(ws + WS_GATE), (bf16_t*)(ws + WS_BV), (const bf16_t*)(ws + WS_LWT)};
            for (int wi = blockIdx.x * 8 + (tid >> 6); wi < 2 * NCHH; wi += gridDim.x * 8) rwkv_out(wi, rw, rg, YMIX);
            REPSYNC(4); if (!(DUP == 4 && rep_ == 0)) { SEAM(pb + 3); STAMP(pb + 4); }
        }
        if (IN(pb + 4)) {
            FRESH();
            pg8::Gemm g{YMIX, WOUT + (size_t)l * DM * DM, T_P, DM, DM}; pg8::StaticOrder S; S.init(T_P, DM, gridDim.x, fresh_bx());
            if (l == 0) {
                EpiAdapt<EpiRes<0, false, true>> E{EpiRes<0, false, true>{INP(0), INP(1), out, XB, RSS}};
                pg8::gemm_phase<EpiAdapt<EpiRes<0, false, true>>, pg8::StaticOrder, true, true>((LAS unsigned char*)lds, g, S, E);
                gemm_tail<DM, 0, false, true>(lds, YMIX, WOUT + (size_t)l * DM * DM, INP(1), out, XB, RSS);
            } else {
                EpiAdapt<EpiRes<1, false, true>> E{EpiRes<1, false, true>{nullptr, nullptr, out, XB, RSS}};
                pg8::gemm_phase<EpiAdapt<EpiRes<1, false, true>>, pg8::StaticOrder, true, true>((LAS unsigned char*)lds, g, S, E);
                gemm_tail<DM, 1, false, true>(lds, YMIX, WOUT + (size_t)l * DM * DM, nullptr, out, XB, RSS);
            }
            SEAM(pb + 4); STAMP(pb + 5);
        }
        if (IN(pb + 5)) REPS(6) {
            FRESH();
            pg8::Gemm g{XB, WGU + (size_t)l * 2 * DFF * DM, T, 2 * DFF, DM}; pg8::StaticOrder S; S.init(T, 2 * DFF, gridDim.x, fresh_bx());
            EpiAdapt<EpiGU> E{EpiGU{H, RSS}};
            pg8::gemm_phase<EpiAdapt<EpiGU>, pg8::StaticOrder, true, true>((LAS unsigned char*)lds, g, S, E);
            REPSYNC(6); if (!(DUP == 6 && rep_ == 0)) { SEAM(pb + 5); STAMP(pb + 6); }
        }
        if (IN(pb + 6)) {
            FRESH();
            pg8::Gemm g{H, WD + (size_t)l * DM * DFF, T_P, DM, DFF}; pg8::StaticOrder S; S.init(T_P, DM, gridDim.x, fresh_bx());
            if (l == 0) {
                EpiAdapt<EpiRes<1, false, true>> E{EpiRes<1, false, true>{nullptr, nullptr, out, XB, RSS}};
                pg8::gemm_phase<EpiAdapt<EpiRes<1, false, true>>, pg8::StaticOrder, true, true>((LAS unsigned char*)lds, g, S, E);
                gemm_tail<DFF, 1, false, true>(lds, H, WD + (size_t)l * DM * DFF, nullptr, out, XB, RSS);
                SEAM(pb + 7); STAMP(pb + 7);
            } else {
                EpiAdapt<EpiRes<1, true, false>> E{EpiRes<1, true, false>{nullptr, nullptr, out, XB, RSS}};
                pg8::gemm_phase<EpiAdapt<EpiRes<1, true, false>>, pg8::StaticOrder, true, true>((LAS unsigned char*)lds, g, S, E);
                gemm_tail<DFF, 1, true, false>(lds, H, WD + (size_t)l * DM * DFF, nullptr, out, XB, RSS);
            }
        }
    }
    if (PROF) {
        xcd_barrier(xbar); STAMP(16); xcd_barrier(xbar);
        const unsigned long long* t = tsb;
        const unsigned long long d[12] = {t[16] - t[0], t[1] - t[0], t[2] - t[1], t[3] - t[2], t[4] - t[3], t[5] - t[4], t[6] - t[5], t[7] - t[6], t[8] - t[7], t[10] - t[8], t[13] - t[10], t[16] - t[13]};
        const size_t off[12] = {O_Y, O_Y + (size_t)T_P * DM, O_CONV_P, O_CONV_S, O_RWKV_P, O_RWKV_S, O_SHIFT_P, O_SHIFT_S, O_POOL_P, O_POOL_S, O_K_P, O_K_S};
        const unsigned cap[12] = {99999, 99999, 61000, 99999, 99999, 99999, 7000, 28000, 30000, 99999, 99999, 99999};
        for (int k = 0; k < 12; ++k) { unsigned c = (unsigned)(d[k] / 10ull); if (c > cap[k]) c = cap[k]; for (unsigned i = blockIdx.x * 512 + threadIdx.x; i < c; i += gridDim.x * 512) ((unsigned*)out)[off[k] + i] = 0xAAAAAAAAu; }
    }
}

#undef WIN
#undef WOUT
#undef WGU
#undef WD
#undef XB
#undef YMIX
#undef RSS
#undef PROJ
#undef H
static void launch_mega(MP p, int lo, int hi, int grid_blocks, hipStream_t stream) {
    p.ph_lo = lo; p.ph_hi = hi;
    void* args[] = {&p};
    hipError_t e = hipLaunchCooperativeKernel((const void*)mega, dim3(grid_blocks), dim3(512), args, LDS_BYTES, stream);
    if (e != hipSuccess) fprintf(stderr, "cooperative launch failed: %s (grid %d)\n", hipGetErrorString(e), grid_blocks);
}
extern "C" void kernel_launch(void* const* d_in, const int* in_sizes, int n_in, void* d_out, int out_size, void* d_ws, size_t ws_size, hipStream_t stream) {
    static int grid_blocks = 0;
    if (grid_blocks == 0) {
        if (n_in != 35 || (size_t)out_size != O_END || ws_size < WS_END) { fprintf(stderr, "kernel_launch: unexpected sizes n_in %d out %d ws %zu (need %zu)\n", n_in, out_size, ws_size, (size_t)WS_END); grid_blocks = -1; return; }
        int dev = 0, cus = 0, per_cu = 0;
        (void)hipGetDevice(&dev);
        (void)hipDeviceGetAttribute(&cus, hipDeviceAttributeMultiprocessorCount, dev);
        (void)hipFuncSetAttribute((const void*)mega, hipFuncAttributeMaxDynamicSharedMemorySize, LDS_BYTES);
        (void)hipOccupancyMaxActiveBlocksPerMultiprocessor(&per_cu, mega, 512, LDS_BYTES);
        if (per_cu < 1) { fprintf(stderr, "kernel_launch: occupancy query says %d blocks per CU\n", per_cu); grid_blocks = -1; return; }
        grid_blocks = cus;
    }
    if (grid_blocks < 0) return;
    const float* const* in = (const float* const*)d_in;
    float* out = (float*)d_out; unsigned char* ws = (unsigned char*)d_ws;
    MP p{};
    for (int i = 0; i < 35; ++i) p.in[i] = in[i];
    p.out = out; p.ws = ws;
    (void)hipMemsetAsync(ws + WS_CTL, 0, 16384, stream);
    launch_mega(p, 0, 16, grid_blocks, stream);
}
```

```cpp
#include <hip/hip_runtime.h>
#include <hip/hip_cooperative_groups.h>
namespace cg = cooperative_groups;
#include <cstdint>
#include <cstdio>

typedef unsigned short bf16_t;
typedef short bf16x8 __attribute__((ext_vector_type(8)));
typedef float f32x4 __attribute__((ext_vector_type(4)));
typedef unsigned u32x4 __attribute__((ext_vector_type(4)));
typedef unsigned u32x2 __attribute__((ext_vector_type(2)));

constexpr int T_P = 16384, T_S = 512, T = 16896, DM = 1024;
constexpr int NIN = 2176, NINP = 2304, DFF = 2816;
constexpr int C_A = 0, C_B = 512, C_C = 1408, C_Q = 1664, C_K = 1920, C_V = 2048;

constexpr size_t O_Y = 0, O_CONV_P = 17301504, O_CONV_S = 17362944, O_RWKV_P = 17608704, O_RWKV_S = 17739776,
                 O_SHIFT_P = 18264064, O_SHIFT_S = 18271232, O_POOL_P = 18299904, O_POOL_S = 18330624,
                 O_K_P = 18453504, O_K_S = 18584576, O_V_P = 19108864, O_V_S = 19239936, O_END = 19764224;

constexpr size_t WS_CTL = 0;
constexpr size_t WS_WIN = 16384;
constexpr size_t WS_WOUT = WS_WIN + 2ull * NINP * DM * 2;
constexpr size_t WS_WGU = WS_WOUT + 2ull * DM * DM * 2;
constexpr size_t WS_WD = WS_WGU + 2ull * 2 * DFF * DM * 2;
constexpr size_t WS_LWT = WS_WD + 2ull * DM * DFF * 2;
constexpr size_t WS_XB = WS_LWT + 2ull * 256 * 128 * 2;
constexpr size_t WS_YMIX = WS_XB + (size_t)T * DM * 2;
constexpr size_t WS_RSS = WS_YMIX + (size_t)T * DM * 2;
constexpr size_t WS_R = WS_RSS + (size_t)T * 32 * 4;
constexpr size_t WS_PROJ = WS_R;
constexpr size_t WS_H = WS_R;
constexpr size_t WS_RW = WS_PROJ + (size_t)T * NINP * 2;
constexpr int NCH = T / 32, NCHH = NCH * 4;
constexpr size_t WS_PT = WS_RW;
constexpr size_t WS_QQ = WS_PT + (size_t)NCHH * 4096 * 2;
constexpr size_t WS_ZZ = WS_QQ + (size_t)NCHH * 4096 * 2;
constexpr size_t WS_Y0 = WS_ZZ + (size_t)NCHH * 2048 * 2;
constexpr size_t WS_SC = WS_Y0 + (size_t)NCHH * 2048 * 2;
constexpr size_t WS_GATE = WS_SC + (size_t)NCHH * 4096 * 2;
constexpr size_t WS_BV = WS_GATE + (size_t)T * 256 * 2;
constexpr size_t WS_GLU = WS_BV + (size_t)T * 256 * 2;
constexpr size_t WS_PWT = WS_GLU + (size_t)T * 256 * 2;
constexpr size_t WS_RWEND = WS_PWT + 2ull * 4 * 64 * 64 * 2;
constexpr size_t RW_BF = (size_t)T * 256 * 2;
constexpr size_t WS_RW_R = WS_RWEND, WS_RW_K = WS_RW_R + RW_BF, WS_RW_V = WS_RW_R + 2 * RW_BF, WS_RW_A = WS_RW_R + 3 * RW_BF,
                 WS_RW_B = WS_RW_R + 4 * RW_BF, WS_RW_G = WS_RW_R + 5 * RW_BF, WS_RW_W = WS_RW_R + 6 * RW_BF;
constexpr size_t WS_END = WS_RWEND;

__device__ __forceinline__ float bf2f(bf16_t h) { return __uint_as_float((unsigned)h << 16); }
typedef __bf16 bf16x2_t __attribute__((ext_vector_type(2)));
typedef float f32x2 __attribute__((ext_vector_type(2)));
__device__ __forceinline__ unsigned pk2(float lo, float hi) { const f32x2 v = {lo, hi}; return __builtin_bit_cast(unsigned, __builtin_convertvector(v, bf16x2_t)); }
__device__ __forceinline__ u32x2 pk4(f32x4 v) { u32x2 o; o.x = pk2(v.x, v.y); o.y = pk2(v.z, v.w); return o; }
__device__ __forceinline__ bf16_t f2bf(float f) { return (bf16_t)(pk2(f, 0.f) & 0xffffu); }
__device__ __forceinline__ void unpack8(u32x4 v, float* f) {
    f[0] = __uint_as_float(v.x << 16); f[1] = __uint_as_float(v.x & 0xffff0000u); f[2] = __uint_as_float(v.y << 16); f[3] = __uint_as_float(v.y & 0xffff0000u);
    f[4] = __uint_as_float(v.z << 16); f[5] = __uint_as_float(v.z & 0xffff0000u); f[6] = __uint_as_float(v.w << 16); f[7] = __uint_as_float(v.w & 0xffff0000u);
}
__device__ __forceinline__ float wave_sum(float v) {
#pragma unroll
    for (int o = 1; o < 64; o <<= 1) v += __shfl_xor(v, o);
    return v;
}
__device__ __forceinline__ float sigmoidf_(float x) { return __builtin_amdgcn_rcpf(1.f + __expf(-x)); }

__device__ __forceinline__ void p0_item(const float* __restrict__ W, int K, int N, bf16_t* __restrict__ WT, const float* __restrict__ g, int grp, int stride, int off, float* scr, int item, int lane, bool glu_map = false) {
    const int nblk = N / 32, kb = item / nblk, nb = item - kb * nblk, k0 = 64 * kb, n0 = 32 * nb;
    float v[32];
#pragma unroll
    for (int i = 0; i < 32; ++i) v[i] = W[(size_t)(k0 + 2 * i + (lane >> 5)) * N + n0 + (lane & 31)];
#pragma unroll
    for (int i = 0; i < 32; ++i) { const int kk = 2 * i + (lane >> 5); scr[kk * 33 + (lane & 31)] = g ? v[i] * g[k0 + kk] : v[i]; }
    asm volatile("s_waitcnt lgkmcnt(0)" ::: "memory");
    const int c = lane & 7;
#pragma unroll
    for (int j = 0; j < 4; ++j) {
        const int n = n0 + (lane >> 3) + 8 * j; const float* sp = scr + (8 * c) * 33 + (n - n0);
        u32x4 o; o.x = pk2(sp[0], sp[33]); o.y = pk2(sp[2 * 33], sp[3 * 33]); o.z = pk2(sp[4 * 33], sp[5 * 33]); o.w = pk2(sp[6 * 33], sp[7 * 33]);
        int r = (n / grp) * stride + off + (n % grp);
        if (glu_map && n < 512) { const int n2 = n & 255; r = (n2 >> 2) * 8 + (n >> 8) * 4 + (n2 & 3); }
        *(u32x4*)(WT + (size_t)r * K + k0 + 8 * c) = o;
    }
    asm volatile("s_waitcnt lgkmcnt(0)" ::: "memory");
}

__device__ __forceinline__ void d_xprep(int row, const float* __restrict__ xp, const float* __restrict__ xs, bf16_t* __restrict__ XB, float* __restrict__ RSS) {
    const int lane = threadIdx.x & 63;
    const float* x = row < T_P ? xp + (size_t)row * DM : xs + (size_t)(row - T_P) * DM;
    float ss = 0.f;
#pragma unroll
    for (int j = 0; j < 4; ++j) {
        const f32x4 v = ((const f32x4*)x)[lane + 64 * j];
        ss += v.x * v.x + v.y * v.y + v.z * v.z + v.w * v.w;
        u32x2 o; o.x = pk2(v.x, v.y); o.y = pk2(v.z, v.w);
        *(u32x2*)(XB + (size_t)row * DM + (lane + 64 * j) * 4) = o;
    }
    ss = wave_sum(ss);
    if (lane < 16) RSS[(size_t)row * 16 + lane] = lane == 0 ? ss : 0.f;
}

__device__ __forceinline__ float rss_rstd(const float* RSS, int row) {
    float s = 0.f;
#pragma unroll
    for (int j = 0; j < 4; ++j) { const f32x4 v = ((const f32x4*)(RSS + (size_t)row * 16))[j]; s += (v.x + v.y) + (v.z + v.w); }
    return rsqrtf(s * (1.f / DM) + 1e-6f);
}
struct EpiProj {
    bf16_t* PROJ; const float* RSS; bf16_t* GLU;
    __device__ __forceinline__ float rowscale(int row) const { return rss_rstd(RSS, row); }
    __device__ __forceinline__ void one(int row, int col, f32x4 v0, f32x4 v1, float rs) const {
        v0 *= rs; v1 *= rs;
        if (col < 512) { const f32x4 gl = {v0.x * sigmoidf_(v1.x), v0.y * sigmoidf_(v1.y), v0.z * sigmoidf_(v1.z), v0.w * sigmoidf_(v1.w)}; *(u32x2*)(GLU + (size_t)row * 256 + (col >> 1)) = pk4(gl); }
        else { u32x4 o; o.x = pk2(v0.x, v0.y); o.y = pk2(v0.z, v0.w); o.z = pk2(v1.x, v1.y); o.w = pk2(v1.z, v1.w); *(u32x4*)(PROJ + (size_t)row * NINP + col) = o; }
    }
    __device__ __forceinline__ void operator()(int row, int col, f32x4 v0, f32x4 v1, f32x4 w0, f32x4 w1, float rs) const { one(row, col, v0, v1, rs); one(row, col + 128, w0, w1, rs); }
};
template <int SRC, bool WF32, bool WBF> struct EpiRes {
    const float* xin_p; const float* xin_s; float* xout; bf16_t* XB; float* RSS;
    __device__ __forceinline__ float rowscale(int) const { return 1.f; }
    __device__ __forceinline__ float half8(int row, int col, f32x4 v0, f32x4 v1) const {
        f32x4 a, b;
        if (SRC == 0) { const float* xi = (row < T_P ? xin_p + (size_t)row * DM : xin_s + (size_t)(row - T_P) * DM) + col; a = *(const f32x4*)(xi); b = *(const f32x4*)(xi + 4); }
        else { float f[8]; unpack8(*(const u32x4*)(XB + (size_t)row * DM + col), f); a = (f32x4){f[0], f[1], f[2], f[3]}; b = (f32x4){f[4], f[5], f[6], f[7]}; }
        a += v0; b += v1;
        if (WF32) { *(f32x4*)(xout + (size_t)row * DM + col) = a; *(f32x4*)(xout + (size_t)row * DM + col + 4) = b; }
        if (WBF) { u32x4 o; o.x = pk2(a.x, a.y); o.y = pk2(a.z, a.w); o.z = pk2(b.x, b.y); o.w = pk2(b.z, b.w); *(u32x4*)(XB + (size_t)row * DM + col) = o; }
        return (a.x * a.x + a.y * a.y) + (a.z * a.z + a.w * a.w) + (b.x * b.x + b.y * b.y) + (b.z * b.z + b.w * b.w);
    }
    __device__ __forceinline__ void operator()(int row, int col, f32x4 v0, f32x4 v1, f32x4 w0, f32x4 w1, float) const {
        float ss = half8(row, col, v0, v1);
        ss += half8(row, col + 128, w0, w1);
        if (WBF) {
            ss += __shfl_xor(ss, 16); ss += __shfl_xor(ss, 32);
            if ((threadIdx.x & 63) < 16) RSS[(size_t)row * 16 + (col >> 8) * 4 + ((col >> 5) & 3)] = ss;
        }
    }
};
struct EpiGU {
    bf16_t* H; const float* RSS;
    __device__ __forceinline__ float rowscale(int row) const { return rss_rstd(RSS, row); }
    __device__ __forceinline__ u32x2 gu(f32x4 g, f32x4 u, float rs) const {
        g *= rs; u *= rs;
        const float h0 = g.x * sigmoidf_(g.x) * u.x, h1 = g.y * sigmoidf_(g.y) * u.y, h2 = g.z * sigmoidf_(g.z) * u.z, h3 = g.w * sigmoidf_(g.w) * u.w;
        u32x2 o; o.x = pk2(h0, h1); o.y = pk2(h2, h3); return o;
    }
    __device__ __forceinline__ void operator()(int row, int col, f32x4 g0, f32x4 u0, f32x4 g1, f32x4 u1, float rs) const {
        *(u32x2*)(H + (size_t)row * DFF + (col >> 1)) = gu(g0, u0, rs);
        *(u32x2*)(H + (size_t)row * DFF + (col >> 1) + 64) = gu(g1, u1, rs);
    }
};

struct Seq { int base, L, b, sample, pos0; };
__device__ __forceinline__ Seq seq_of(int sq) { Seq s; if (sq < 4) { s.base = sq * 4096; s.L = 4096; s.b = sq; s.sample = 0; s.pos0 = 0; } else { s.b = sq - 4; s.base = T_P + s.b * 32; s.L = 32; s.sample = 1; s.pos0 = 1024; } return s; }

struct RwkvW { const float *mu, *w0, *w2, *a0, *a2, *g2, *k_k, *k_a, *r_k, *gn_g, *gn_b; };

namespace pg8 {
#define PG8_LAS __attribute__((address_space(3)))
typedef unsigned short bf16_t;
typedef short bf16x8 __attribute__((ext_vector_type(8)));
typedef float f32x4 __attribute__((ext_vector_type(4)));
typedef unsigned u32x4 __attribute__((ext_vector_type(4)));
constexpr int BM = 256, BK = 64, HALF = 128, HTB = HALF * BK * 2  , STAGE_BYTES = 8 * HTB, NXCD = 8, WGM = 8;

__host__ __device__ __forceinline__ int lds_byte(int r, int c) { const int st = (r >> 4) * 2 + (c >> 5), rr = r & 15, cc = c & 31, ob = rr * 64 + cc * 2; return st * 1024 + (ob ^ (((ob >> 9) & 1) << 5)); }
__host__ __device__ __forceinline__ void stage_rc(int b, int& R, int& C) { const int st = b / 1024, sb = b % 1024, swz = sb ^ (((sb >> 9) & 1) << 5); R = (st >> 1) * 16 + swz / 64; C = (st & 1) * 32 + (swz % 64) / 2; }
__host__ __device__ __forceinline__ int perm32(int rho) { const int n = rho >> 4, i = rho & 15; return 8 * (i >> 2) + 4 * n + (i & 3); }

struct Unit { int pm, pn; };
struct Gemm { const bf16_t* A; const bf16_t* Bt; int M, N, K; };

struct StaticOrder {
    int nM, nN, nwg, G, c;
    __host__ __device__ void init(int M, int N, int G_, int c_) { nM = M / BM; nN = N / BM; nwg = nM * nN; G = G_; c = c_; }
    __host__ __device__ bool next(int i, Unit& u) const {
        const long L = (long)i * G + c; if (L >= nwg) return false;
        int wgid = (int)L; { const int q = nwg / NXCD, r = nwg % NXCD, xcd = wgid % NXCD, off = wgid / NXCD; wgid = (xcd < r ? xcd * (q + 1) : r * (q + 1) + (xcd - r) * q) + off; }
        const int nig = WGM * nN, gid = wgid / nig, fm = gid * WGM, gsz = (nM - fm) < WGM ? (nM - fm) : WGM;
        u.pm = fm + ((wgid % nig) % gsz); u.pn = (wgid % nig) / gsz; return true;
    }
    __device__ __forceinline__ void a_ready(const Unit&) const {}
    __device__ __forceinline__ void done(const Unit&) const {}
};


template <class Epi, class Sched, bool ALIGN_EPI = false, bool SP2 = false>
__device__ __forceinline__ void gemm_phase(PG8_LAS unsigned char* lds, const Gemm g, const Sched& S, const Epi& E) {
    int tid_ = threadIdx.x; asm volatile("" : "+v"(tid_));
    const int tid = tid_, wid = __builtin_amdgcn_readfirstlane(tid >> 6), lane = tid & 63, wr = wid >> 2, wc = wid & 3, fr = lane & 15, fq = lane >> 4;
    const int K = g.K, nt = K / BK;
    unsigned voffA[2], voffB[2];
#pragma unroll
    for (int i = 0; i < 2; ++i) { int R, C; stage_rc(tid * 16 + i * 8192, R, C); const int Rb = Epi::PERM ? ((R & ~31) + perm32(R & 31)) : R;
        voffA[i] = (unsigned)(R * K + C) * 2u; voffB[i] = (unsigned)(Rb * K + C) * 2u; }
    const size_t kstep = (size_t)(BK * 2);
    const size_t hstep = (size_t)HALF * K * 2;
    const size_t tstep = 2 * hstep;
    const unsigned ldsw = (unsigned)wid * 1024u;
    const int aoff = lds_byte(wr * 64 + fr, fq * 8), boff = lds_byte(wc * 32 + fr, fq * 8);
#define PG8_SA(b, h) (((b) * 2 + (h)) * HTB)
#define PG8_SB(b, h) ((4 + (b) * 2 + (h)) * HTB)
#define PG8_STAGE(bufoff, gbase, voff) do { _Pragma("unroll") for (int _i = 0; _i < 2; ++_i) \
        __builtin_amdgcn_global_load_lds((const unsigned*)((const char*)(gbase) + (voff)[_i]), (PG8_LAS unsigned*)(lds + (bufoff) + ldsw + _i * 8192), 16, 0, 0); } while (0)
#define PG8_LDA(dst, b, h) do { _Pragma("unroll") for (int m = 0; m < 4; ++m) _Pragma("unroll") for (int k = 0; k < 2; ++k) dst[m][k] = *(const PG8_LAS bf16x8*)(lds + PG8_SA(b, h) + aoff + m * 2048 + k * 1024); } while (0)
#define PG8_LDB(dst, b, h) do { _Pragma("unroll") for (int n = 0; n < 2; ++n) _Pragma("unroll") for (int k = 0; k < 2; ++k) dst[n][k] = *(const PG8_LAS bf16x8*)(lds + PG8_SB(b, h) + boff + n * 2048 + k * 1024); } while (0)
#define PG8_MMA(ai, bj, At, Bt) do { __builtin_amdgcn_s_setprio(1); _Pragma("unroll") for (int m = 0; m < 4; ++m) _Pragma("unroll") for (int n = 0; n < 2; ++n) _Pragma("unroll") for (int k = 0; k < 2; ++k) \
        acc[ai][bj][m][n] = __builtin_amdgcn_mfma_f32_16x16x32_bf16(Bt[n][k], At[m][k], acc[ai][bj][m][n], 0, 0, 0); __builtin_amdgcn_s_setprio(0); } while (0)
#define PG8_WAIT_V(n) asm volatile("s_waitcnt vmcnt(" #n ")" ::: "memory")
#define PG8_WAIT_L(n) asm volatile("s_waitcnt lgkmcnt(" #n ")" ::: "memory")
#define PG8_BAR __builtin_amdgcn_s_barrier()
#define PG8_SCHED __builtin_amdgcn_sched_barrier(0)
    Unit cur, nxt; int ui = 0;
    if (!S.next(0, cur)) return;
    f32x4 acc[2][2][4][2];
#pragma unroll
    for (int a = 0; a < 2; ++a)
#pragma unroll
        for (int b = 0; b < 2; ++b)
#pragma unroll
            for (int m = 0; m < 4; ++m)
#pragma unroll
                for (int n = 0; n < 2; ++n) acc[a][b][m][n] = (f32x4){0.f, 0.f, 0.f, 0.f};
    bf16x8 At[4][2], B0[2][2], B1[2][2];
    const char* cA = (const char*)g.A + (size_t)cur.pm * tstep; const char* cB = (const char*)g.Bt + (size_t)cur.pn * tstep;
    S.a_ready(cur);
    if constexpr (SP2) {
        PG8_STAGE(PG8_SB(0, 0), cB, voffB); PG8_STAGE(PG8_SB(0, 1), cB + hstep, voffB); PG8_STAGE(PG8_SA(0, 0), cA, voffA); PG8_STAGE(PG8_SA(0, 1), cA + hstep, voffA);
        if (wr == 1) PG8_BAR;
        PG8_WAIT_V(2); PG8_BAR;
        PG8_STAGE(PG8_SB(1, 0), cB + kstep, voffB); PG8_STAGE(PG8_SA(1, 0), cA + kstep, voffA); PG8_STAGE(PG8_SB(1, 1), cB + hstep + kstep, voffB);
        PG8_WAIT_V(6); PG8_BAR;
    } else {
        PG8_STAGE(PG8_SB(0, 0), cB, voffB); PG8_STAGE(PG8_SA(0, 0), cA, voffA); PG8_STAGE(PG8_SB(0, 1), cB + hstep, voffB); PG8_STAGE(PG8_SA(0, 1), cA + hstep, voffA);
        if (wr == 1) PG8_BAR;
        PG8_WAIT_V(4); PG8_BAR;
        PG8_STAGE(PG8_SB(1, 0), cB + kstep, voffB); PG8_STAGE(PG8_SA(1, 0), cA + kstep, voffA); PG8_STAGE(PG8_SB(1, 1), cB + hstep + kstep, voffB);
        PG8_WAIT_V(6); PG8_BAR;
    }
    for (;;) {
        const bool has_next = S.next(ui + 1, nxt);
        const char* nA = has_next ? (const char*)g.A + (size_t)nxt.pm * tstep : cA; const char* nB = has_next ? (const char*)g.Bt + (size_t)nxt.pn * tstep : cB;
        for (int t = 0; t < nt; t += 2) {
            const bool last = (t == nt - 2);
            const char* a1 = cA + (size_t)(t + 1) * kstep;
            const char* a2 = last ? nA : cA + (size_t)(t + 2) * kstep; const char* b2 = last ? nB : cB + (size_t)(t + 2) * kstep;
            const char* a3 = a2 + kstep; const char* b3 = b2 + kstep;
            if (last && has_next) S.a_ready(nxt);
            if constexpr (SP2) {
            PG8_LDB(B0, 0, 0); PG8_LDB(B1, 0, 1); PG8_SCHED; PG8_LDA(At, 0, 0); PG8_STAGE(PG8_SA(1, 1), a1 + hstep, voffA);
            PG8_WAIT_V(8); PG8_WAIT_L(0); PG8_BAR; PG8_MMA(0, 0, At, B0); PG8_MMA(0, 1, At, B1); PG8_BAR; PG8_SCHED;
            PG8_LDA(At, 0, 1); PG8_STAGE(PG8_SB(0, 0), b2, voffB); PG8_STAGE(PG8_SB(0, 1), b2 + hstep, voffB); PG8_STAGE(PG8_SA(0, 0), a2, voffA);
            PG8_WAIT_V(8); PG8_WAIT_L(0); PG8_BAR; PG8_MMA(1, 0, At, B0); PG8_MMA(1, 1, At, B1); PG8_BAR; PG8_SCHED;
            PG8_LDB(B0, 1, 0); PG8_LDB(B1, 1, 1); PG8_SCHED; PG8_LDA(At, 1, 0); PG8_STAGE(PG8_SA(0, 1), a2 + hstep, voffA);
            PG8_WAIT_V(8); PG8_WAIT_L(0); PG8_BAR; PG8_MMA(0, 0, At, B0); PG8_MMA(0, 1, At, B1); PG8_BAR; PG8_SCHED;
            PG8_LDA(At, 1, 1); PG8_STAGE(PG8_SB(1, 0), b3, voffB); PG8_STAGE(PG8_SB(1, 1), b3 + hstep, voffB); PG8_STAGE(PG8_SA(1, 0), a3, voffA);
            PG8_WAIT_V(8); PG8_WAIT_L(0); PG8_BAR; PG8_MMA(1, 0, At, B0); PG8_MMA(1, 1, At, B1); PG8_BAR; PG8_SCHED;
            } else {
            PG8_LDB(B0, 0, 0); PG8_SCHED; PG8_LDA(At, 0, 0); PG8_STAGE(PG8_SA(1, 1), a1 + hstep, voffA);
            PG8_WAIT_L(8); PG8_BAR; PG8_WAIT_L(0); PG8_MMA(0, 0, At, B0); PG8_BAR; PG8_SCHED;
            PG8_LDB(B1, 0, 1); PG8_STAGE(PG8_SB(0, 0), b2, voffB);
            PG8_BAR; PG8_WAIT_L(0); PG8_MMA(0, 1, At, B1); PG8_BAR;
            PG8_LDA(At, 0, 1); PG8_STAGE(PG8_SA(0, 0), a2, voffA);
            PG8_BAR; PG8_WAIT_L(0); PG8_MMA(1, 0, At, B0); PG8_BAR; PG8_SCHED;
            PG8_STAGE(PG8_SB(0, 1), b2 + hstep, voffB);
            PG8_WAIT_V(6); PG8_BAR; PG8_MMA(1, 1, At, B1); PG8_BAR;
            PG8_LDB(B0, 1, 0); PG8_SCHED; PG8_LDA(At, 1, 0); PG8_STAGE(PG8_SA(0, 1), a2 + hstep, voffA);
            PG8_WAIT_L(8); PG8_BAR; PG8_WAIT_L(0); PG8_MMA(0, 0, At, B0); PG8_BAR; PG8_SCHED;
            PG8_LDB(B1, 1, 1); PG8_STAGE(PG8_SB(1, 0), b3, voffB);
            PG8_BAR; PG8_WAIT_L(0); PG8_MMA(0, 1, At, B1); PG8_BAR;
            PG8_LDA(At, 1, 1); PG8_STAGE(PG8_SA(1, 0), a3, voffA);
            PG8_BAR; PG8_WAIT_L(0); PG8_MMA(1, 0, At, B0); PG8_BAR; PG8_SCHED;
            PG8_STAGE(PG8_SB(1, 1), b3 + hstep, voffB);
            PG8_WAIT_V(6); PG8_BAR; PG8_MMA(1, 1, At, B1); PG8_BAR;
            }
        }
        if constexpr (ALIGN_EPI) { if (wr == 0) PG8_BAR; }
        if constexpr (!Epi::AFTER_DRAIN) { E(acc, cur, wr, wc, fr, fq); S.done(cur); }
        if (!has_next) break;
#pragma unroll
        for (int a = 0; a < 2; ++a)
#pragma unroll
            for (int b = 0; b < 2; ++b)
#pragma unroll
                for (int m = 0; m < 4; ++m)
#pragma unroll
                    for (int n = 0; n < 2; ++n) acc[a][b][m][n] = (f32x4){0.f, 0.f, 0.f, 0.f};
        cur = nxt; cA = nA; cB = nB; ++ui;
        if constexpr (ALIGN_EPI) { if (wr == 1) PG8_BAR; }
    }
    PG8_WAIT_V(0);
    if constexpr (!ALIGN_EPI) { if (wr == 0) PG8_BAR; }
    PG8_BAR;
    if constexpr (Epi::AFTER_DRAIN) { E.fused(acc, cur, wr, wc, fr, fq, lds, wid, lane); S.done(cur); }
#undef PG8_SA
#undef PG8_SB
#undef PG8_STAGE
#undef PG8_LDA
#undef PG8_LDB
#undef PG8_MMA
#undef PG8_WAIT_V
#undef PG8_WAIT_L
#undef PG8_BAR
#undef PG8_SCHED
}
}


struct AttnP { const bf16_t* PROJ; const float *cache_k, *cache_v, *qn, *kn, *sinks; bf16_t* YMIX; float *ko_p, *ko_s, *vo_p, *vo_s; };
constexpr int KN_STRIDE = 72, VT_STRIDE = 200, ATT_VT_OFF = 192 * KN_STRIDE * 2;
__device__ __forceinline__ void attn_unit(unsigned char* lds, int unit, const AttnP& a) {
    int tid_ = threadIdx.x; asm volatile("" : "+v"(tid_));
    const int tid = tid_, lane = tid & 63, w = __builtin_amdgcn_readfirstlane(tid >> 6), fr = lane & 15, fq = lane >> 4;
    int sq, chunk, hkv; if (unit < 512) { sq = unit >> 7; chunk = (unit & 127) >> 1; hkv = unit & 1; } else { sq = 4 + ((unit - 512) >> 1); chunk = 0; hkv = unit & 1; }
    const Seq s = seq_of(sq);
    int nk, ncache, ktok0;
    if (s.sample) { nk = 160; ncache = 128; ktok0 = s.base; }
    else { const int back = chunk < 2 ? chunk : 2; nk = 64 * (back + 1); ncache = 0; ktok0 = s.base + (chunk - back) * 64; }
    bf16_t* Kn = (bf16_t*)lds; bf16_t* Vt = (bf16_t*)(lds + ATT_VT_OFF);
    int g, mt; bool act; if (!s.sample) { g = w >> 2; mt = w & 3; act = true; } else { g = (w >> 1) & 1; mt = w & 1; act = w < 4; }
    const bf16_t* qp = a.PROJ + (size_t)(s.base + chunk * 64 + mt * 16 + fr) * NINP + C_Q + (hkv * 2 + g) * 64 + 8 * fq;
    u32x4 qr0 = {0u, 0u, 0u, 0u}, qr1 = qr0;
    if (act) { qr0 = *(const u32x4*)qp; qr1 = *(const u32x4*)(qp + 32); }
    u32x4 kraw[3], vraw[3]; f32x4 kc[3][2], vc[3][2];
#pragma unroll
    for (int q = 0; q < 3; ++q) {
        const int p = tid + 512 * q, j = p >> 3, ch = p & 7;
        kraw[q] = (u32x4){0u, 0u, 0u, 0u}; vraw[q] = kraw[q]; kc[q][0] = (f32x4){0.f, 0.f, 0.f, 0.f}; kc[q][1] = kc[q][0]; vc[q][0] = kc[q][0]; vc[q][1] = kc[q][0];
        if (p < nk * 8) {
            if (j < ncache) {
                const float* kp = a.cache_k + (((size_t)s.b * 128 + j) * 2 + hkv) * 64 + ch * 8; const float* vp = a.cache_v + (((size_t)s.b * 128 + j) * 2 + hkv) * 64 + ch * 8;
                kc[q][0] = *(const f32x4*)kp; kc[q][1] = *(const f32x4*)(kp + 4); vc[q][0] = *(const f32x4*)vp; vc[q][1] = *(const f32x4*)(vp + 4);
            } else {
                const bf16_t* pp = a.PROJ + (size_t)(ktok0 + j - ncache) * NINP + hkv * 64 + ch * 8;
                kraw[q] = *(const u32x4*)(pp + C_K); vraw[q] = *(const u32x4*)(pp + C_V);
            }
        }
    }
#pragma unroll
    for (int q = 0; q < 3; ++q) {
        const int p = tid + 512 * q, j = p >> 3, ch = p & 7;
        if (p < nk * 8) {
        float kf[8], vf[8];
        if (j < ncache) {
            kf[0] = kc[q][0].x; kf[1] = kc[q][0].y; kf[2] = kc[q][0].z; kf[3] = kc[q][0].w; kf[4] = kc[q][1].x; kf[5] = kc[q][1].y; kf[6] = kc[q][1].z; kf[7] = kc[q][1].w;
            vf[0] = vc[q][0].x; vf[1] = vc[q][0].y; vf[2] = vc[q][0].z; vf[3] = vc[q][0].w; vf[4] = vc[q][1].x; vf[5] = vc[q][1].y; vf[6] = vc[q][1].z; vf[7] = vc[q][1].w;
        } else {
            unpack8(kraw[q], kf); unpack8(vraw[q], vf);
            float ss = 0.f;
#pragma unroll
            for (int i = 0; i < 8; ++i) ss += kf[i] * kf[i];
            ss += __shfl_xor(ss, 1); ss += __shfl_xor(ss, 2); ss += __shfl_xor(ss, 4);
            const float rs = rsqrtf(ss * (1.f / 64.f) + 1e-6f);
            const f32x4 g0 = *(const f32x4*)(a.kn + ch * 8), g1 = *(const f32x4*)(a.kn + ch * 8 + 4);
            kf[0] *= rs * g0.x; kf[1] *= rs * g0.y; kf[2] *= rs * g0.z; kf[3] *= rs * g0.w; kf[4] *= rs * g1.x; kf[5] *= rs * g1.y; kf[6] *= rs * g1.z; kf[7] *= rs * g1.w;
        }
        u32x4 ko; ko.x = pk2(kf[0], kf[1]); ko.y = pk2(kf[2], kf[3]); ko.z = pk2(kf[4], kf[5]); ko.w = pk2(kf[6], kf[7]);
        *(u32x4*)(Kn + j * KN_STRIDE + ch * 8) = ko;
#pragma unroll
        for (int i = 0; i < 8; ++i) Vt[(ch * 8 + i) * VT_STRIDE + j] = f2bf(vf[i]);
        float* ko_ = nullptr; float* vo_ = nullptr;
        if (s.sample) { if (j >= 32) { ko_ = a.ko_s + ((size_t)s.b * 128 + (j - 32)) * 128 + hkv * 64 + ch * 8; vo_ = a.vo_s + ((size_t)s.b * 128 + (j - 32)) * 128 + hkv * 64 + ch * 8; } }
        else if (chunk >= 62 && j >= nk - 64) { const int jj = (chunk - 62) * 64 + (j - (nk - 64)); ko_ = a.ko_p + ((size_t)s.b * 128 + jj) * 128 + hkv * 64 + ch * 8; vo_ = a.vo_p + ((size_t)s.b * 128 + jj) * 128 + hkv * 64 + ch * 8; }
        if (ko_) { *(f32x4*)ko_ = (f32x4){kf[0], kf[1], kf[2], kf[3]}; *(f32x4*)(ko_ + 4) = (f32x4){kf[4], kf[5], kf[6], kf[7]}; *(f32x4*)vo_ = (f32x4){vf[0], vf[1], vf[2], vf[3]}; *(f32x4*)(vo_ + 4) = (f32x4){vf[4], vf[5], vf[6], vf[7]}; }
        }
    }
    __syncthreads();
    if (act) {
        const int qh = hkv * 2 + g, tok = s.base + chunk * 64 + mt * 16 + fr, nkt = nk >> 4, nks = nk >> 5;
        float qf[16]; unpack8(qr0, qf); unpack8(qr1, qf + 8);
        float ss = 0.f;
#pragma unroll
        for (int i = 0; i < 16; ++i) ss += qf[i] * qf[i];
        ss += __shfl_xor(ss, 16); ss += __shfl_xor(ss, 32);
        const float rs = rsqrtf(ss * (1.f / 64.f) + 1e-6f) * 0.125f;
#pragma unroll
        for (int i = 0; i < 8; ++i) { qf[i] *= rs * a.qn[8 * fq + i]; qf[8 + i] *= rs * a.qn[32 + 8 * fq + i]; }
        union { u32x4 u; bf16x8 v; } qa, qb;
        qa.u.x = pk2(qf[0], qf[1]); qa.u.y = pk2(qf[2], qf[3]); qa.u.z = pk2(qf[4], qf[5]); qa.u.w = pk2(qf[6], qf[7]);
        qb.u.x = pk2(qf[8], qf[9]); qb.u.y = pk2(qf[10], qf[11]); qb.u.z = pk2(qf[12], qf[13]); qb.u.w = pk2(qf[14], qf[15]);
        f32x4 sacc[12];
        const float sink = a.sinks[qh];
        float m = sink;
#pragma unroll
        for (int kt = 0; kt < 12; ++kt) {
            sacc[kt] = (f32x4){0.f, 0.f, 0.f, 0.f};
            if (kt < nkt) {
                const bf16x8 k0 = *(const bf16x8*)(Kn + (kt * 16 + fr) * KN_STRIDE + 8 * fq), k1 = *(const bf16x8*)(Kn + (kt * 16 + fr) * KN_STRIDE + 32 + 8 * fq);
                sacc[kt] = __builtin_amdgcn_mfma_f32_16x16x32_bf16(k0, qa.v, sacc[kt], 0, 0, 0);
                sacc[kt] = __builtin_amdgcn_mfma_f32_16x16x32_bf16(k1, qb.v, sacc[kt], 0, 0, 0);
                m = fmaxf(m, fmaxf(fmaxf(sacc[kt].x, sacc[kt].y), fmaxf(sacc[kt].z, sacc[kt].w)));
            }
        }
        m = fmaxf(m, __shfl_xor(m, 16)); m = fmaxf(m, __shfl_xor(m, 32));
        float lsum = 0.f;
#pragma unroll
        for (int kt = 0; kt < 12; ++kt) if (kt < nkt) {
            sacc[kt].x = __expf(sacc[kt].x - m); sacc[kt].y = __expf(sacc[kt].y - m); sacc[kt].z = __expf(sacc[kt].z - m); sacc[kt].w = __expf(sacc[kt].w - m);
            lsum += (sacc[kt].x + sacc[kt].y) + (sacc[kt].z + sacc[kt].w);
        }
        lsum += __shfl_xor(lsum, 16); lsum += __shfl_xor(lsum, 32);
        lsum += __expf(sink - m);
        f32x4 oacc[4];
#pragma unroll
        for (int dt = 0; dt < 4; ++dt) oacc[dt] = (f32x4){0.f, 0.f, 0.f, 0.f};
#pragma unroll
        for (int ks = 0; ks < 6; ++ks) if (ks < nks) {
            union { u32x4 u; bf16x8 v; } pf;
            pf.u.x = pk2(sacc[2 * ks].x, sacc[2 * ks].y); pf.u.y = pk2(sacc[2 * ks].z, sacc[2 * ks].w); pf.u.z = pk2(sacc[2 * ks + 1].x, sacc[2 * ks + 1].y); pf.u.w = pk2(sacc[2 * ks + 1].z, sacc[2 * ks + 1].w);
#pragma unroll
            for (int dt = 0; dt < 4; ++dt) {
                union { u32x4 u; bf16x8 v; } vf;
                const u32x2 lo = *(const u32x2*)(Vt + (dt * 16 + fr) * VT_STRIDE + 32 * ks + 4 * fq), hi2 = *(const u32x2*)(Vt + (dt * 16 + fr) * VT_STRIDE + 32 * ks + 16 + 4 * fq);
                vf.u.x = lo.x; vf.u.y = lo.y; vf.u.z = hi2.x; vf.u.w = hi2.y;
                oacc[dt] = __builtin_amdgcn_mfma_f32_16x16x32_bf16(vf.v, pf.v, oacc[dt], 0, 0, 0);
            }
        }
        const float inv = 1.f / lsum;
#pragma unroll
        for (int dt = 0; dt < 4; ++dt) { u32x2 o; o.x = pk2(oacc[dt].x * inv, oacc[dt].y * inv); o.y = pk2(oacc[dt].z * inv, oacc[dt].w * inv);
            *(u32x2*)(a.YMIX + (size_t)tok * DM + 768 + qh * 64 + dt * 16 + 4 * fq) = o; }
    }
    __syncthreads();
}

struct ConvPoolP { const bf16_t* PROJ; const float *cache_conv, *cw, *cb, *lg, *lb, *cache_pool, *pw, *psc; bf16_t* YMIX; float *co_p, *co_s, *po_p, *po_s; const bf16_t *GLU, *PWT; };
__device__ __forceinline__ void convpool_tile(float* sm, int tile, const ConvPoolP& a) {
    int tid_ = threadIdx.x; asm volatile("" : "+v"(tid_));
    int c = tid_ & 255;
#define RELAUNDER() asm volatile("" : "+v"(c))
    int sq, t0; if (tile < 1024) { sq = tile >> 8; t0 = (tile & 255) * 16; } else { sq = 4 + ((tile - 1024) >> 1); t0 = ((tile - 1024) & 1) * 16; }
    const Seq s = seq_of(sq);
    float* ext = sm;
    float* yb = sm + 46 * 256;
    bf16_t* db = (bf16_t*)yb;
    {
        u32x4 vv[6]; f32x4 h0[6], h1[6];
#pragma unroll
        for (int q = 0; q < 6; ++q) {
            const int pr = c + 256 * q, i = pr >> 5, cg = pr & 31, t = t0 - 30 + i;
            vv[q] = (u32x4){0u, 0u, 0u, 0u}; h0[q] = (f32x4){0.f, 0.f, 0.f, 0.f}; h1[q] = h0[q];
            if (i < 46) {
                if (t >= 0) vv[q] = *(const u32x4*)(a.GLU + (size_t)(s.base + t) * 256 + cg * 8);
                else if (s.sample) { const float* p = a.cache_conv + ((size_t)s.b * 30 + 30 + t) * 256 + cg * 8; h0[q] = *(const f32x4*)p; h1[q] = *(const f32x4*)(p + 4); }
            }
        }
#pragma unroll
        for (int q = 0; q < 6; ++q) {
            const int pr = c + 256 * q, i = pr >> 5, cg = pr & 31, t = t0 - 30 + i;
            if (i < 46) {
                f32x4 e0 = h0[q], e1 = h1[q];
                if (t >= 0) { float v[8]; unpack8(vv[q], v); e0 = (f32x4){v[0], v[1], v[2], v[3]}; e1 = (f32x4){v[4], v[5], v[6], v[7]}; }
                *(f32x4*)(ext + i * 256 + cg * 8) = e0; *(f32x4*)(ext + i * 256 + cg * 8 + 4) = e1;
            }
        }
    }
    __syncthreads(); RELAUNDER();
    {
        float e[46];
#pragma unroll
        for (int i = 0; i < 46; ++i) e[i] = ext[i * 256 + c];
        float* o = s.sample ? a.co_s + (size_t)s.b * 30 * 256 : a.co_p + (size_t)s.b * 30 * 256;
        if (t0 + 15 >= s.L - 30) {
#pragma unroll
            for (int i = 0; i < 16; ++i) { const int t = t0 + i; if (t >= s.L - 30) o[(t - (s.L - 30)) * 256 + c] = e[i + 30]; }
        }
        float y[16]; const float bias = a.cb[c];
#pragma unroll
        for (int i = 0; i < 16; ++i) y[i] = bias;
#pragma unroll
        for (int j = 0; j < 31; ++j) { const float wj = a.cw[j * 256 + c];
#pragma unroll
            for (int i = 0; i < 16; ++i) y[i] += wj * e[i + j]; }
#pragma unroll
        for (int i = 0; i < 16; ++i) yb[i * 256 + c] = y[i];
    }
    __syncthreads(); RELAUNDER();
    u32x4 pv[4]; f32x4 ph0[4], ph1[4];
#pragma unroll
    for (int q = 0; q < 4; ++q) {
        const int pr = c + 256 * q, i = pr >> 5, cg = pr & 31, t = t0 - 15 + i;
        pv[q] = (u32x4){0u, 0u, 0u, 0u}; ph0[q] = (f32x4){0.f, 0.f, 0.f, 0.f}; ph1[q] = ph0[q];
        if (i < 31) {
            if (t >= 0) pv[q] = *(const u32x4*)(a.PROJ + (size_t)(s.base + t) * NINP + C_C + cg * 8);
            else if (s.sample) { const float* p = a.cache_pool + ((size_t)s.b * 15 + 15 + t) * 256 + cg * 8; ph0[q] = *(const f32x4*)p; ph1[q] = *(const f32x4*)(p + 4); }
        }
    }
    {
        const int wv = c >> 6, lane = c & 63;
        const f32x4 g4 = ((const f32x4*)a.lg)[lane], b4 = ((const f32x4*)a.lb)[lane];
#pragma unroll 1
        for (int i = wv; i < 16; i += 4) {
            const f32x4 v = ((const f32x4*)(yb + i * 256))[lane];
            const float mean = wave_sum((v.x + v.y) + (v.z + v.w)) * (1.f / 256.f);
            const f32x4 d = v - mean;
            const float var = wave_sum((d.x * d.x + d.y * d.y) + (d.z * d.z + d.w * d.w)) * (1.f / 256.f);
            const float rstd = rsqrtf(var + 1e-5f);
            f32x4 o = d * rstd * g4 + b4;
            o.x *= sigmoidf_(o.x); o.y *= sigmoidf_(o.y); o.z *= sigmoidf_(o.z); o.w *= sigmoidf_(o.w);
            *(u32x2*)(a.YMIX + (size_t)(s.base + t0 + i) * DM + 0 + lane * 4) = pk4(o);
        }
    }
    __syncthreads(); RELAUNDER();
#pragma unroll
    for (int q = 0; q < 4; ++q) {
        const int pr = c + 256 * q, i = pr >> 5, cg = pr & 31, t = t0 - 15 + i;
        if (i < 31) {
            f32x4 e0 = ph0[q], e1 = ph1[q];
            if (t >= 0) { float v[8]; unpack8(pv[q], v); e0 = (f32x4){v[0], v[1], v[2], v[3]}; e1 = (f32x4){v[4], v[5], v[6], v[7]}; }
            *(f32x4*)(ext + i * 256 + cg * 8) = e0; *(f32x4*)(ext + i * 256 + cg * 8 + 4) = e1;
        }
    }
    __syncthreads(); RELAUNDER();
    {
        float e[31];
#pragma unroll
        for (int i = 0; i < 31; ++i) e[i] = ext[i * 256 + c];
        float* o = s.sample ? a.po_s + (size_t)s.b * 15 * 256 : a.po_p + (size_t)s.b * 15 * 256;
        if (t0 + 15 >= s.L - 15) {
#pragma unroll
            for (int i = 0; i < 16; ++i) { const int t = t0 + i; if (t >= s.L - 15) o[(t - (s.L - 15)) * 256 + c] = e[i + 15]; }
        }
        const int g = __builtin_amdgcn_readfirstlane(c >> 6), w = 2 << g;
        float w2[16], w4[16], w8[16], w16[16];
#pragma unroll
        for (int i = 0; i < 16; ++i) w2[i] = e[15 + i] + e[14 + i];
        if (g >= 1) {
#pragma unroll
            for (int i = 0; i < 16; ++i) w4[i] = (e[15 + i] + e[14 + i]) + (e[13 + i] + e[12 + i]);
        }
        if (g >= 2) {
#pragma unroll
            for (int i = 0; i < 16; ++i) w8[i] = ((e[15 + i] + e[14 + i]) + (e[13 + i] + e[12 + i])) + ((e[11 + i] + e[10 + i]) + (e[9 + i] + e[8 + i]));
        }
        if (g == 3) {
            float cs[32]; cs[0] = e[0];
#pragma unroll
            for (int k = 1; k < 31; ++k) cs[k] = cs[k - 1] + e[k];
#pragma unroll
            for (int i = 0; i < 16; ++i) w16[i] = i == 0 ? cs[15] : cs[15 + i] - cs[i - 1];
        }
#pragma unroll
        for (int i = 0; i < 16; ++i) {
            const float sum = g == 0 ? w2[i] : (g == 1 ? w4[i] : (g == 2 ? w8[i] : w16[i]));
            const int pos = s.pos0 + t0 + i; const int cnt = (pos + 1) < w ? (pos + 1) : w;
            db[i * 264 + c] = f2bf(sum * __builtin_amdgcn_rcpf((float)cnt) - e[15 + i]);
        }
    }
    __syncthreads(); RELAUNDER();
    {
        const int g = __builtin_amdgcn_readfirstlane(c >> 6), lane = c & 63, fr = lane & 15, fq = lane >> 4;
        const bf16x8 d0 = *(const bf16x8*)(db + fr * 264 + g * 64 + 8 * fq), d1 = *(const bf16x8*)(db + fr * 264 + g * 64 + 32 + 8 * fq);
#pragma unroll
        for (int dt = 0; dt < 4; ++dt) {
            const bf16_t* wp = a.PWT + ((size_t)g * 64 + 16 * dt + fr) * 64 + 8 * fq;
            f32x4 acc = __builtin_amdgcn_mfma_f32_16x16x32_bf16(*(const bf16x8*)wp, d0, (f32x4){0.f, 0.f, 0.f, 0.f}, 0, 0, 0);
            acc = __builtin_amdgcn_mfma_f32_16x16x32_bf16(*(const bf16x8*)(wp + 32), d1, acc, 0, 0, 0);
            acc *= *(const f32x4*)(a.psc + g * 64 + 16 * dt + 4 * fq);
            *(u32x2*)(a.YMIX + (size_t)(s.base + t0 + fr) * DM + 512 + g * 64 + 16 * dt + 4 * fq) = pk4(acc);
        }
    }
    __syncthreads();
#undef RELAUNDER
}

struct RwkvG { bf16_t *PT, *QQ, *ZZ, *Y0, *SC, *GATE, *BV; const bf16_t* LWT; };
constexpr int RC_HEAD = 30208, RC_MAB = 0, RC_MAK = 4608, RC_MRB = 7168, RC_MRK = 9728, RC_TM = 12288, RC_MAKVT = 14848, RC_GT = 19968, RC_U0T = 25088;
constexpr int RB_BASE = 2 * RC_HEAD, RB_HEAD = 38912, RB_AT = 0, RB_BH = 4608, RB_KH = 9216, RB_RT = 13824, RB_ATT = 18432, RB_BHT = 23552, RB_KHT = 28672, RB_VT = 33792;
constexpr int RA_LAT = 0, RA_WL = 8704, RA_AL = 25088, RA_SCN = 41472, R_WLS = RB_BASE + 2 * RB_HEAD;
constexpr int NS = 72, TS = 40, LATS = 136, MABS = 36;
__device__ __forceinline__ bf16x8 ldf(const bf16_t* base, int row, int stride, int col) { return *(const bf16x8*)(base + row * stride + col); }
#define MFMA16(a, b, c) __builtin_amdgcn_mfma_f32_16x16x32_bf16((a), (b), (c), 0, 0, 0)

__device__ __forceinline__ void rwkv_item(unsigned char* lds, int item, int l, const bf16_t* __restrict__ PROJ, const float* __restrict__ shift_in, const RwkvW& w, const RwkvG& G) {
    int tid = threadIdx.x; asm volatile("" : "+v"(tid));
    const int wv = __builtin_amdgcn_readfirstlane(tid >> 6);
    const int cid = item >> 1, hp = item & 1, tok0 = cid * 32;
    const bool sample = cid >= 512, first = sample || ((cid & 127) == 0);
    const int sb = cid - 512;
    bf16_t* LAT = (bf16_t*)(lds + RA_LAT); float* WLb = (float*)(lds + RA_WL); float* ALb = (float*)(lds + RA_AL); float* SCN = (float*)(lds + RA_SCN); float* WLs = (float*)(lds + R_WLS);
    const int lane0 = tid & 63, fr0 = lane0 & 15, fq0 = lane0 >> 4;
    const bf16_t* lwp = G.LWT + ((size_t)l * 256 + hp * 128 + 16 * wv + fr0) * 128 + 8 * fq0;
    const bf16x8 fw = *(const bf16x8*)(lwp), fa = *(const bf16x8*)(lwp + 32), fg0 = *(const bf16x8*)(lwp + 64), fg1 = *(const bf16x8*)(lwp + 96);
    const f32x4 w0v = *(const f32x4*)(w.w0 + hp * 128 + 16 * wv + 4 * fq0), a0v = *(const f32x4*)(w.a0 + hp * 128 + 16 * wv + 4 * fq0);
    const int c3 = tid & 127, tq3 = tid >> 7, cg3 = hp * 128 + c3;
    float ur[9], uk[9], uv[9];
#pragma unroll
    for (int i = 0; i < 9; ++i) {
        const int t = 8 * tq3 - 1 + i;
        if (t >= 0 || !first) { const bf16_t* p = PROJ + (size_t)(tok0 + t) * NINP + C_B + cg3; ur[i] = bf2f(p[0]); uk[i] = bf2f(p[256]); uv[i] = bf2f(p[512]); }
        else if (sample) { const float* p = shift_in + (size_t)sb * 896 + cg3; ur[i] = p[0]; uk[i] = p[256]; uv[i] = p[512]; }
        else { ur[i] = 0.f; uk[i] = 0.f; uv[i] = 0.f; }
    }
    const float mur = w.mu[cg3], muk = w.mu[256 + cg3], muv = w.mu[512 + cg3], kkw = w.k_k[cg3], kaw = w.k_a[cg3], rkw = w.r_k[cg3];
    {
        const int t = tid >> 4, j8 = (tid & 15) * 8, col = 768 + j8;
        float u[8], pv[8];
        unpack8(*(const u32x4*)(PROJ + (size_t)(tok0 + t) * NINP + C_B + col), u);
        if (t > 0 || !first) unpack8(*(const u32x4*)(PROJ + (size_t)(tok0 + t - 1) * NINP + C_B + col), pv);
        else if (sample) { const f32x4 a = *(const f32x4*)(shift_in + (size_t)sb * 896 + col), b = *(const f32x4*)(shift_in + (size_t)sb * 896 + col + 4); pv[0] = a.x; pv[1] = a.y; pv[2] = a.z; pv[3] = a.w; pv[4] = b.x; pv[5] = b.y; pv[6] = b.z; pv[7] = b.w; }
        else {
#pragma unroll
            for (int i = 0; i < 8; ++i) pv[i] = 0.f; }
        const f32x4 m0 = *(const f32x4*)(w.mu + col), m1 = *(const f32x4*)(w.mu + col + 4);
        const float mu[8] = {m0.x, m0.y, m0.z, m0.w, m1.x, m1.y, m1.z, m1.w};
        float x[8];
#pragma unroll
        for (int i = 0; i < 8; ++i) { const float xs = u[i] + mu[i] * (pv[i] - u[i]); x[i] = j8 < 32 ? 1.f - 2.f / (1.f + __expf(2.f * xs)) : (j8 < 64 ? xs : sigmoidf_(xs)); }
        u32x4 o; o.x = pk2(x[0], x[1]); o.y = pk2(x[2], x[3]); o.z = pk2(x[4], x[5]); o.w = pk2(x[6], x[7]);
        *(u32x4*)(LAT + t * LATS + j8) = o;
    }
    __syncthreads();
    {
        asm volatile("" : "+v"(tid)); const int lane = tid & 63, fr = lane & 15, fq = lane >> 4;
        const int c0l = 16 * wv, cg0 = hp * 128 + c0l;
#pragma unroll
        for (int tt = 0; tt < 2; ++tt) {
            const int t = 16 * tt + fr;
            const f32x4 z = {0.f, 0.f, 0.f, 0.f};
            f32x4 aw = MFMA16(fw, ldf(LAT, t, LATS, 8 * fq), z);
            f32x4 aa = MFMA16(fa, ldf(LAT, t, LATS, 32 + 8 * fq), z);
            f32x4 ag = MFMA16(fg0, ldf(LAT, t, LATS, 64 + 8 * fq), z);
            ag = MFMA16(fg1, ldf(LAT, t, LATS, 96 + 8 * fq), ag);
            *(f32x4*)(WLb + t * 128 + c0l + 4 * fq) = aw + w0v;
            *(f32x4*)(ALb + t * 128 + c0l + 4 * fq) = aa + a0v;
            *(u32x2*)(G.GATE + (size_t)(tok0 + t) * 256 + cg0 + 4 * fq) = pk4(ag);
        }
    }
    __syncthreads();
    {
        asm volatile("" : "+v"(tid));
        const int c = tid & 127, tq = tid >> 7, hd = c >> 6, c64 = c & 63, cg = hp * 128 + c;
        unsigned char* hb = lds + RB_BASE + hd * RB_HEAD;
        bf16_t *AT = (bf16_t*)(hb + RB_AT), *BH = (bf16_t*)(hb + RB_BH), *KH = (bf16_t*)(hb + RB_KH), *RT = (bf16_t*)(hb + RB_RT);
        bf16_t *ATt = (bf16_t*)(hb + RB_ATT), *BHt = (bf16_t*)(hb + RB_BHT), *KHt = (bf16_t*)(hb + RB_KHT), *Vt = (bf16_t*)(hb + RB_VT);
        float lw[8], cl[8];
        float run = 0.f;
#pragma unroll
        for (int i = 0; i < 8; ++i) { lw[i] = -0.60653066f * sigmoidf_(WLb[(8 * tq + i) * 128 + c]); run += lw[i]; cl[i] = run; }
        SCN[tq * 128 + c] = run;
        __syncthreads();
        float pre = 0.f, tot = 0.f;
#pragma unroll
        for (int q = 0; q < 4; ++q) { const float v = SCN[q * 128 + c]; tot += v; if (q < tq) pre += v; }
        if (tq == 0) WLs[c] = __expf(tot);
        float at8[8], bh8[8], kh8[8], vv8[8];
        float rr8[8], kk8[8], km8[8], ar8[8], ss8[8], bo8[8];
#pragma unroll
        for (int i = 0; i < 8; ++i) {
            const int t = 8 * tq + i;
            rr8[i] = ur[i + 1] + mur * (ur[i] - ur[i + 1]); const float k = uk[i + 1] + muk * (uk[i] - uk[i + 1]); vv8[i] = uv[i + 1] + muv * (uv[i] - uv[i + 1]);
            ar8[i] = __builtin_amdgcn_rcpf(1.f + __expf(-ALb[t * 128 + c]));
            kk8[i] = k * kkw; km8[i] = k * (1.f + (ar8[i] - 1.f) * kaw);
            ss8[i] = kk8[i] * kk8[i]; bo8[i] = rr8[i] * km8[i] * rkw;
        }
#pragma unroll
        for (int o = 1; o < 64; o <<= 1) {
#pragma unroll
            for (int i = 0; i < 8; ++i) { ss8[i] += __shfl_xor(ss8[i], o); bo8[i] += __shfl_xor(bo8[i], o); }
        }
#pragma unroll
        for (int i = 0; i < 8; ++i) {
            const int t = 8 * tq + i;
            const float cum = pre + cl[i];
            const float W = __expf(cum), Wp = __expf(cum - lw[i]), iW = __expf(-cum);
            const float kkn = kk8[i] * __builtin_amdgcn_rcpf(fmaxf(sqrtf(ss8[i]), 1e-12f));
            const float at = -kkn * Wp, bh = kkn * ar8[i] * iW, kh = km8[i] * iW, rt = rr8[i] * W;
            AT[t * NS + c64] = f2bf(at); BH[t * NS + c64] = f2bf(bh); KH[t * NS + c64] = f2bf(kh); RT[t * NS + c64] = f2bf(rt);
            at8[i] = at; bh8[i] = bh; kh8[i] = kh;
            G.BV[(size_t)(tok0 + t) * 256 + cg] = f2bf(bo8[i] * vv8[i]);
        }
        u32x4 o;
        o.x = pk2(at8[0], at8[1]); o.y = pk2(at8[2], at8[3]); o.z = pk2(at8[4], at8[5]); o.w = pk2(at8[6], at8[7]); *(u32x4*)(ATt + c64 * TS + 8 * tq) = o;
        o.x = pk2(bh8[0], bh8[1]); o.y = pk2(bh8[2], bh8[3]); o.z = pk2(bh8[4], bh8[5]); o.w = pk2(bh8[6], bh8[7]); *(u32x4*)(BHt + c64 * TS + 8 * tq) = o;
        o.x = pk2(kh8[0], kh8[1]); o.y = pk2(kh8[2], kh8[3]); o.z = pk2(kh8[4], kh8[5]); o.w = pk2(kh8[6], kh8[7]); *(u32x4*)(KHt + c64 * TS + 8 * tq) = o;
        o.x = pk2(vv8[0], vv8[1]); o.y = pk2(vv8[2], vv8[3]); o.z = pk2(vv8[4], vv8[5]); o.w = pk2(vv8[6], vv8[7]); *(u32x4*)(Vt + c64 * TS + 8 * tq) = o;
    }
    __syncthreads();
    asm volatile("" : "+v"(tid)); const int lane = tid & 63, fr = lane & 15, fq = lane >> 4;
    const int hd = wv >> 2, wg = wv & 3, h = hp * 2 + hd; const size_t ch = (size_t)cid * 4 + h;
    unsigned char* hb = lds + RB_BASE + hd * RB_HEAD; unsigned char* cb = lds + hd * RC_HEAD;
    const bf16_t *AT = (const bf16_t*)(hb + RB_AT), *BH = (const bf16_t*)(hb + RB_BH), *KH = (const bf16_t*)(hb + RB_KH), *RT = (const bf16_t*)(hb + RB_RT);
    const bf16_t *ATt = (const bf16_t*)(hb + RB_ATT), *BHt = (const bf16_t*)(hb + RB_BHT), *KHt = (const bf16_t*)(hb + RB_KHT), *Vt = (const bf16_t*)(hb + RB_VT);
    float* Mab = (float*)(cb + RC_MAB);
    bf16_t *Mak = (bf16_t*)(cb + RC_MAK), *Mrb = (bf16_t*)(cb + RC_MRB), *Mrk = (bf16_t*)(cb + RC_MRK), *Tm = (bf16_t*)(cb + RC_TM), *MakVt = (bf16_t*)(cb + RC_MAKVT), *GT = (bf16_t*)(cb + RC_GT), *U0T = (bf16_t*)(cb + RC_U0T);
    const f32x4 z4 = {0.f, 0.f, 0.f, 0.f};
    {
        const bf16_t* rowsrc = (wg >> 1) ? RT : AT; const bf16_t* colsrc = (wg & 1) ? KH : BH;
        bf16_t* Mo = wg == 1 ? Mak : (wg == 2 ? Mrb : Mrk);
#pragma unroll
        for (int tt = 0; tt < 2; ++tt)
#pragma unroll
            for (int st = 0; st < 2; ++st) {
                f32x4 acc = MFMA16(ldf(colsrc, 16 * st + fr, NS, 8 * fq), ldf(rowsrc, 16 * tt + fr, NS, 8 * fq), z4);
                acc = MFMA16(ldf(colsrc, 16 * st + fr, NS, 32 + 8 * fq), ldf(rowsrc, 16 * tt + fr, NS, 32 + 8 * fq), acc);
                const int t = 16 * tt + fr, s0 = 16 * st + 4 * fq, lim = (wg >> 1) ? t + 1 : t;
                acc.x = (s0 + 0 < lim) ? acc.x : 0.f; acc.y = (s0 + 1 < lim) ? acc.y : 0.f; acc.z = (s0 + 2 < lim) ? acc.z : 0.f; acc.w = (s0 + 3 < lim) ? acc.w : 0.f;
                if (wg == 0) *(f32x4*)(Mab + t * MABS + s0) = acc; else *(u32x2*)(Mo + t * TS + s0) = pk4(acc);
            }
    }
    __syncthreads();
    const float* WL = (const float*)(lds + R_WLS) + hd * 64;
    if (wg == 0) {
        {
            const int j = lane & 31;
            float Tc[32];
            f32x4 cur[8];
#pragma unroll
            for (int q = 0; q < 8; ++q) cur[q] = (f32x4){0.f, 0.f, 0.f, 0.f};
#pragma unroll
            for (int t = 0; t < 32; ++t) {
                f32x4 nx[8];
#pragma unroll
                for (int q = 0; q < 8; ++q) nx[q] = (t + 1 < 32 && 4 * q < t + 1) ? *(const f32x4*)(Mab + (t + 1) * MABS + 4 * q) : (f32x4){0.f, 0.f, 0.f, 0.f};
                float a0 = (t == j) ? 1.f : 0.f, a1 = 0.f;
#pragma unroll
                for (int s2 = 0; s2 < t; ++s2) { const float nv = cur[s2 >> 2][s2 & 3]; if (s2 & 1) a1 += nv * Tc[s2]; else a0 += nv * Tc[s2]; }
                Tc[t] = a0 + a1;
#pragma unroll
                for (int q = 0; q < 8; ++q) cur[q] = nx[q];
            }
            if (lane < 32) {
#pragma unroll
                for (int t = 0; t < 32; ++t) Tm[t * TS + j] = f2bf(Tc[t]);
            }
        }
        __syncthreads();
#pragma unroll
        for (int rt = 0; rt < 2; ++rt)
#pragma unroll
            for (int tt = 0; tt < 2; ++tt) {
                const f32x4 acc = MFMA16(ldf(Tm, 16 * tt + fr, TS, 8 * fq), ldf(ATt, 16 * rt + fr, TS, 8 * fq), z4);
                *(u32x2*)(GT + (16 * rt + fr) * TS + 16 * tt + 4 * fq) = pk4(acc);
            }
        __syncthreads();
#pragma unroll
        for (int tt = 0; tt < 2; ++tt)
#pragma unroll
            for (int ks = 0; ks < 2; ++ks) {
                u32x2 pc[2];
#pragma unroll
                for (int hf = 0; hf < 2; ++hf) {
                    const int kt = 2 * ks + hf;
                    f32x4 acc = MFMA16(ldf(GT, 16 * kt + fr, TS, 8 * fq), ldf(Mrb, 16 * tt + fr, TS, 8 * fq), z4);
                    const int t = 16 * tt + fr, k0 = 16 * kt + 4 * fq;
                    const u32x2 rr = *(const u32x2*)(RT + t * NS + k0);
                    acc.x += __uint_as_float(rr.x << 16); acc.y += __uint_as_float(rr.x & 0xffff0000u); acc.z += __uint_as_float(rr.y << 16); acc.w += __uint_as_float(rr.y & 0xffff0000u);
                    pc[hf] = pk4(acc);
                }
                *(u32x4*)(G.ZZ + ch * 2048 + ((tt * 2 + ks) * 64 + lane) * 8) = (u32x4){pc[0].x, pc[0].y, pc[1].x, pc[1].y};
            }
    } else if (wg == 1) {
#pragma unroll
        for (int vt = 0; vt < 4; ++vt)
#pragma unroll
            for (int tt = 0; tt < 2; ++tt) {
                const f32x4 acc = MFMA16(ldf(Mak, 16 * tt + fr, TS, 8 * fq), ldf(Vt, 16 * vt + fr, TS, 8 * fq), z4);
                *(u32x2*)(MakVt + (16 * vt + fr) * TS + 16 * tt + 4 * fq) = pk4(acc);
            }
        __syncthreads();
#pragma unroll
        for (int rt = 2; rt < 4; ++rt)
#pragma unroll
            for (int tt = 0; tt < 2; ++tt) {
                const f32x4 acc = MFMA16(ldf(Tm, 16 * tt + fr, TS, 8 * fq), ldf(ATt, 16 * rt + fr, TS, 8 * fq), z4);
                *(u32x2*)(GT + (16 * rt + fr) * TS + 16 * tt + 4 * fq) = pk4(acc);
            }
        __syncthreads();
#pragma unroll
        for (int kp = 0; kp < 4; ++kp)
#pragma unroll
            for (int ks = 0; ks < 2; ++ks) {
                u32x2 pc[2];
#pragma unroll
                for (int hf = 0; hf < 2; ++hf) {
                    const int kt = 2 * ks + hf;
                    f32x4 acc = MFMA16(ldf(GT, 16 * kt + fr, TS, 8 * fq), ldf(BHt, 16 * kp + fr, TS, 8 * fq), z4);
                    const int kq = 16 * kp + fr, k0 = 16 * kt + 4 * fq; const float wl = WL[kq];
                    acc.x = (acc.x + (k0 + 0 == kq ? 1.f : 0.f)) * wl; acc.y = (acc.y + (k0 + 1 == kq ? 1.f : 0.f)) * wl; acc.z = (acc.z + (k0 + 2 == kq ? 1.f : 0.f)) * wl; acc.w = (acc.w + (k0 + 3 == kq ? 1.f : 0.f)) * wl;
                    pc[hf] = pk4(acc);
                }
                *(u32x4*)(G.PT + ch * 4096 + ((kp * 2 + ks) * 64 + lane) * 8) = (u32x4){pc[0].x, pc[0].y, pc[1].x, pc[1].y};
            }
    } else if (wg == 2) {
        f32x4 y0acc[2][4];
#pragma unroll
        for (int tt = 0; tt < 2; ++tt)
#pragma unroll
            for (int vt = 0; vt < 4; ++vt) y0acc[tt][vt] = MFMA16(ldf(Vt, 16 * vt + fr, TS, 8 * fq), ldf(Mrk, 16 * tt + fr, TS, 8 * fq), z4);
        __syncthreads();
#pragma unroll
        for (int rt = 0; rt < 2; ++rt)
#pragma unroll
            for (int tt = 0; tt < 2; ++tt) {
                const f32x4 acc = MFMA16(ldf(Tm, 16 * tt + fr, TS, 8 * fq), ldf(MakVt, 16 * rt + fr, TS, 8 * fq), z4);
                *(u32x2*)(U0T + (16 * rt + fr) * TS + 16 * tt + 4 * fq) = pk4(acc);
            }
        __syncthreads();
#pragma unroll
        for (int tt = 0; tt < 2; ++tt)
#pragma unroll
            for (int vp = 0; vp < 2; ++vp) {
                const f32x4 a0 = MFMA16(ldf(U0T, 16 * (2 * vp) + fr, TS, 8 * fq), ldf(Mrb, 16 * tt + fr, TS, 8 * fq), y0acc[tt][2 * vp]);
                const f32x4 a1 = MFMA16(ldf(U0T, 16 * (2 * vp + 1) + fr, TS, 8 * fq), ldf(Mrb, 16 * tt + fr, TS, 8 * fq), y0acc[tt][2 * vp + 1]);
                const u32x2 p0 = pk4(a0), p1 = pk4(a1);
                *(u32x4*)(G.Y0 + ch * 2048 + ((tt * 2 + vp) * 64 + lane) * 8) = (u32x4){p0.x, p0.y, p1.x, p1.y};
            }
    } else {
        f32x4 qacc[4][4];
#pragma unroll
        for (int vt = 0; vt < 4; ++vt)
#pragma unroll
            for (int kt = 0; kt < 4; ++kt) qacc[vt][kt] = MFMA16(ldf(KHt, 16 * kt + fr, TS, 8 * fq), ldf(Vt, 16 * vt + fr, TS, 8 * fq), z4);
        __syncthreads();
#pragma unroll
        for (int rt = 2; rt < 4; ++rt)
#pragma unroll
            for (int tt = 0; tt < 2; ++tt) {
                const f32x4 acc = MFMA16(ldf(Tm, 16 * tt + fr, TS, 8 * fq), ldf(MakVt, 16 * rt + fr, TS, 8 * fq), z4);
                *(u32x2*)(U0T + (16 * rt + fr) * TS + 16 * tt + 4 * fq) = pk4(acc);
            }
        __syncthreads();
#pragma unroll
        for (int vt = 0; vt < 4; ++vt)
#pragma unroll
            for (int hf2 = 0; hf2 < 2; ++hf2) {
                u32x2 pc[2];
#pragma unroll
                for (int hf = 0; hf < 2; ++hf) {
                    const int kt = 2 * hf2 + hf;
                    f32x4 acc = MFMA16(ldf(BHt, 16 * kt + fr, TS, 8 * fq), ldf(U0T, 16 * vt + fr, TS, 8 * fq), qacc[vt][kt]);
                    acc *= *(const f32x4*)(WL + 16 * kt + 4 * fq);
                    pc[hf] = pk4(acc);
                }
                *(u32x4*)(G.QQ + ch * 4096 + ((vt * 2 + hf2) * 64 + lane) * 8) = (u32x4){pc[0].x, pc[0].y, pc[1].x, pc[1].y};
            }
    }
    __syncthreads();
}

__device__ __forceinline__ void chain_step(f32x4 (&acc)[4], const bf16x8 (&fa)[4][2], u32x4 q01, u32x4 q23, bf16_t* __restrict__ scp) {
    union { u32x4 u; bf16x8 v; } bs[2];
    const u32x2 a = pk4(acc[0]), b = pk4(acc[1]), c2 = pk4(acc[2]), d = pk4(acc[3]);
    *(u32x4*)(scp) = (u32x4){a.x, a.y, b.x, b.y}; *(u32x4*)(scp + 512) = (u32x4){c2.x, c2.y, d.x, d.y};
    bs[0].u = (u32x4){a.x, a.y, b.x, b.y}; bs[1].u = (u32x4){c2.x, c2.y, d.x, d.y};
    acc[0] = (f32x4){__uint_as_float(q01.x << 16), __uint_as_float(q01.x & 0xffff0000u), __uint_as_float(q01.y << 16), __uint_as_float(q01.y & 0xffff0000u)};
    acc[1] = (f32x4){__uint_as_float(q01.z << 16), __uint_as_float(q01.z & 0xffff0000u), __uint_as_float(q01.w << 16), __uint_as_float(q01.w & 0xffff0000u)};
    acc[2] = (f32x4){__uint_as_float(q23.x << 16), __uint_as_float(q23.x & 0xffff0000u), __uint_as_float(q23.y << 16), __uint_as_float(q23.y & 0xffff0000u)};
    acc[3] = (f32x4){__uint_as_float(q23.z << 16), __uint_as_float(q23.z & 0xffff0000u), __uint_as_float(q23.w << 16), __uint_as_float(q23.w & 0xffff0000u)};
#pragma unroll
    for (int it = 0; it < 4; ++it) { acc[it] = MFMA16(fa[it][0], bs[0].v, acc[it]); acc[it] = MFMA16(fa[it][1], bs[1].v, acc[it]); }
}
__device__ __forceinline__ void rwkv_chain1(int sq, int h, int wg, const float* __restrict__ state_in, const RwkvG& G, float* __restrict__ st_s) {
    int tid_ = threadIdx.x; asm volatile("" : "+v"(tid_));
    const int lane = tid_ & 63, fr = lane & 15, fq = lane >> 4, j0 = 16 * wg;
    const Seq s = seq_of(sq);
    const size_t ch = (size_t)(s.base / 32) * 4 + h;
    f32x4 acc[4];
#pragma unroll
    for (int it = 0; it < 4; ++it) acc[it] = *(const f32x4*)(state_in + (((size_t)s.b * 4 + h) * 64 + j0 + fr) * 64 + 16 * it + 4 * fq);
    bf16x8 fa[4][2];
#pragma unroll
    for (int it = 0; it < 4; ++it)
#pragma unroll
        for (int ks = 0; ks < 2; ++ks) fa[it][ks] = *(const bf16x8*)(G.PT + ch * 4096 + ((it * 2 + ks) * 64 + lane) * 8);
    const u32x4 q01 = *(const u32x4*)(G.QQ + ch * 4096 + ((wg * 2) * 64 + lane) * 8), q23 = *(const u32x4*)(G.QQ + ch * 4096 + ((wg * 2 + 1) * 64 + lane) * 8);
    chain_step(acc, fa, q01, q23, G.SC + ch * 4096 + wg * 1024 + lane * 8);
    float* o = st_s + (((size_t)s.b * 4 + h) * 64 + j0 + fr) * 64 + 4 * fq;
#pragma unroll
    for (int it = 0; it < 4; ++it) *(f32x4*)(o + 16 * it) = acc[it];
}
constexpr int CH_RP = 16, CH_RQ = 16, CH_SLOT = 8192  ;
#define CH_BAR() do { __builtin_amdgcn_s_waitcnt(0xc07f); __builtin_amdgcn_s_barrier(); } while (0)
__device__ __forceinline__ void rwkv_chain_lds(unsigned char* lds, int sq, int h, const RwkvG& G, float* __restrict__ st_p) {
    constexpr int nc = 4096 / 32;
    static_assert(nc % CH_RP == 0 && CH_RP % CH_RQ == 0, "ring depths must divide the chunk count");
    int tid_ = threadIdx.x; asm volatile("" : "+v"(tid_));
    const int wv = __builtin_amdgcn_readfirstlane(tid_ >> 6);
    const Seq s = seq_of(sq);
    const size_t ch0 = (size_t)(s.base / 32) * 4 + h;
    if (wv >= 4) {
        int tl_ = threadIdx.x; asm volatile("" : "+v"(tl_)); const int lane = tl_ & 63;
        const int lw = wv - 4;
        const bf16_t* pn = G.PT + ch0 * 4096 + (size_t)(lw * 128 + lane) * 8;
        unsigned char* dst0 = lds + (lw * 128 + lane) * 16;
        u32x4 ld[CH_RP][2];
#pragma unroll
        for (int c = 0; c < CH_RP; ++c) {
#pragma unroll
            for (int i = 0; i < 2; ++i) ld[c][i] = *(const u32x4*)(pn + i * 512);
            pn += 16384; asm volatile("" : "+v"(pn));
        }
#pragma unroll
        for (int i = 0; i < 2; ++i) *(u32x4*)(dst0 + i * 1024) = ld[0][i];
#pragma unroll
        for (int i = 0; i < 2; ++i) ld[0][i] = *(const u32x4*)(pn + i * 512);
        pn += 16384; asm volatile("" : "+v"(pn));
        CH_BAR();
#pragma unroll 1
        for (int s0 = 0; s0 < nc; s0 += CH_RP) {
#pragma unroll
            for (int j = 0; j < CH_RP; ++j) {
                const int nx = s0 + j + 1, set = (j + 1) % CH_RP;
                unsigned char* d = dst0 + (nx & 1) * CH_SLOT;
#pragma unroll
                for (int i = 0; i < 2; ++i) *(u32x4*)(d + i * 1024) = ld[set][i];
#pragma unroll
                for (int i = 0; i < 2; ++i) ld[set][i] = *(const u32x4*)(pn + i * 512);
                pn += (nx + CH_RP + 1 < nc) ? 16384 : 0; asm volatile("" : "+v"(pn));
                CH_BAR();
            }
        }
    } else {
        int tc_ = threadIdx.x; asm volatile("" : "+v"(tc_)); const int lane = tc_ & 63, fr = lane & 15, fq = lane >> 4;
        const int j0 = 16 * wv;
        const bf16_t* qn = G.QQ + ch0 * 4096 + (size_t)((wv * 2) * 64 + lane) * 8;
        u32x4 qr[CH_RQ][2];
#pragma unroll
        for (int c = 0; c < CH_RQ; ++c) { qr[c][0] = *(const u32x4*)(qn); qr[c][1] = *(const u32x4*)(qn + 512); qn += 16384; asm volatile("" : "+v"(qn)); }
        bf16_t* scp = G.SC + ch0 * 4096 + wv * 1024 + lane * 8;
        f32x4 acc[4];
#pragma unroll
        for (int it = 0; it < 4; ++it) acc[it] = (f32x4){0.f, 0.f, 0.f, 0.f};
        CH_BAR();
#pragma unroll 1
        for (int s0 = 0; s0 < nc; s0 += CH_RP) {
#pragma unroll
            for (int j = 0; j < CH_RP; ++j) {
                const int st = s0 + j, qs = j % CH_RQ;
                const unsigned char* sl = lds + (st & 1) * CH_SLOT;
                bf16x8 fa[4][2];
#pragma unroll
                for (int it = 0; it < 4; ++it)
#pragma unroll
                    for (int ks = 0; ks < 2; ++ks) fa[it][ks] = *(const bf16x8*)(sl + ((it * 2 + ks) * 64 + lane) * 16);
                const u32x4 q01 = qr[qs][0], q23 = qr[qs][1];
                qr[qs][0] = *(const u32x4*)(qn); qr[qs][1] = *(const u32x4*)(qn + 512);
                qn += (st + CH_RQ + 1 < nc) ? 16384 : 0; asm volatile("" : "+v"(qn));
                chain_step(acc, fa, q01, q23, scp);
                scp += 16384; asm volatile("" : "+v"(scp));
                CH_BAR();
            }
        }
        int t3 = threadIdx.x; asm volatile("" : "+v"(t3));
        const int l3 = t3 & 63, fr3 = l3 & 15, fq3 = l3 >> 4;
        float* o = st_p + (((size_t)s.b * 4 + h) * 64 + j0 + fr3) * 64 + 4 * fq3;
#pragma unroll
        for (int it = 0; it < 4; ++it) *(f32x4*)(o + 16 * it) = acc[it];
    }
}

__device__ __forceinline__ void rwkv_out(int wi, const RwkvW& w, const RwkvG& G, bf16_t* __restrict__ YMIX) {
    int tid_ = threadIdx.x; asm volatile("" : "+v"(tid_));
    const int lane = tid_ & 63, fr = lane & 15, fq = lane >> 4;
    const size_t ch = (size_t)(wi >> 1); const int tt = wi & 1, h = (int)(ch & 3), cid = (int)(ch >> 2);
    const int t = 16 * tt + fr, tok = cid * 32 + t;
    const bf16x8 z0 = *(const bf16x8*)(G.ZZ + ch * 2048 + ((tt * 2 + 0) * 64 + lane) * 8), z1 = *(const bf16x8*)(G.ZZ + ch * 2048 + ((tt * 2 + 1) * 64 + lane) * 8);
    const u32x4 yp0 = *(const u32x4*)(G.Y0 + ch * 2048 + ((tt * 2 + 0) * 64 + lane) * 8), yp1 = *(const u32x4*)(G.Y0 + ch * 2048 + ((tt * 2 + 1) * 64 + lane) * 8);
    f32x4 y[4]; float sum = 0.f;
#pragma unroll
    for (int vt = 0; vt < 4; ++vt) {
        const bf16_t* sp = G.SC + ch * 4096 + vt * 1024 + lane * 8;
        const u32x4 yp = vt < 2 ? yp0 : yp1; const unsigned ya = (vt & 1) ? yp.z : yp.x, yb2 = (vt & 1) ? yp.w : yp.y;
        f32x4 acc = {__uint_as_float(ya << 16), __uint_as_float(ya & 0xffff0000u), __uint_as_float(yb2 << 16), __uint_as_float(yb2 & 0xffff0000u)};
        acc = MFMA16(*(const bf16x8*)sp, z0, acc); acc = MFMA16(*(const bf16x8*)(sp + 512), z1, acc);
        y[vt] = acc; sum += (acc.x + acc.y) + (acc.z + acc.w);
    }
    sum += __shfl_xor(sum, 16); sum += __shfl_xor(sum, 32);
    const float mean = sum * (1.f / 64.f); float var = 0.f;
#pragma unroll
    for (int vt = 0; vt < 4; ++vt) { y[vt] -= mean; var += (y[vt].x * y[vt].x + y[vt].y * y[vt].y) + (y[vt].z * y[vt].z + y[vt].w * y[vt].w); }
    var += __shfl_xor(var, 16); var += __shfl_xor(var, 32);
    const float rstd = rsqrtf(var * (1.f / 64.f) + 64e-5f);
#pragma unroll
    for (int vt = 0; vt < 4; ++vt) {
        const int c = h * 64 + 16 * vt + 4 * fq;
        const f32x4 gg = *(const f32x4*)(w.gn_g + c), gb = *(const f32x4*)(w.gn_b + c);
        const u32x2 bv = *(const u32x2*)(G.BV + (size_t)tok * 256 + c), gt = *(const u32x2*)(G.GATE + (size_t)tok * 256 + c);
        f32x4 o = y[vt] * rstd * gg + gb;
        o.x = (o.x + __uint_as_float(bv.x << 16)) * __uint_as_float(gt.x << 16); o.y = (o.y + __uint_as_float(bv.x & 0xffff0000u)) * __uint_as_float(gt.x & 0xffff0000u);
        o.z = (o.z + __uint_as_float(bv.y << 16)) * __uint_as_float(gt.y << 16); o.w = (o.w + __uint_as_float(bv.y & 0xffff0000u)) * __uint_as_float(gt.y & 0xffff0000u);
        *(u32x2*)(YMIX + (size_t)tok * DM + 256 + c) = pk4(o);
    }
}


template <int K, int SRC, bool WF32, bool WBF>
__device__ __forceinline__ void gemm_tail(unsigned char* lds, const bf16_t* __restrict__ A, const bf16_t* __restrict__ Bt, const float* __restrict__ xin_s, float* __restrict__ xout, bf16_t* __restrict__ XB, float* __restrict__ RSS) {
    int tid_ = threadIdx.x; asm volatile("" : "+v"(tid_));
    const int lane = tid_ & 63, w = __builtin_amdgcn_readfirstlane(tid_ >> 6), fr = lane & 15, fq = lane >> 4;
    float* part = (float*)lds;
    for (int tb = blockIdx.x; tb < 256; tb += gridDim.x) {
        const int mi = tb >> 4, ni = tb & 15, rt = w >> 2, ct = w & 3;
        const int r0 = 32 * mi + 16 * rt, c0 = 64 * ni + 16 * ct;
        const bf16_t* ap = A + (size_t)(T_P + r0 + fr) * K + 8 * fq; const bf16_t* bp = Bt + (size_t)(c0 + fr) * K + 8 * fq;
        f32x4 acc = {0.f, 0.f, 0.f, 0.f};
#pragma unroll 1
        for (int k0 = 0; k0 + 512 <= K; k0 += 512) {
            bf16x8 av[16], bv[16];
#pragma unroll
            for (int u = 0; u < 16; ++u) { av[u] = *(const bf16x8*)(ap + k0 + 32 * u); bv[u] = *(const bf16x8*)(bp + k0 + 32 * u); }
#pragma unroll
            for (int u = 0; u < 16; ++u) acc = MFMA16(bv[u], av[u], acc);
        }
        if (K % 512) {
            constexpr int k0 = K - (K % 512), NU = (K % 512) / 32;
            bf16x8 av[NU > 0 ? NU : 1], bv[NU > 0 ? NU : 1];
#pragma unroll
            for (int u = 0; u < NU; ++u) { av[u] = *(const bf16x8*)(ap + k0 + 32 * u); bv[u] = *(const bf16x8*)(bp + k0 + 32 * u); }
#pragma unroll
            for (int u = 0; u < NU; ++u) acc = MFMA16(bv[u], av[u], acc);
        }
        const int row = r0 + fr, col = c0 + 4 * fq;
        f32x4 x;
        if (SRC == 0) x = *(const f32x4*)(xin_s + (size_t)row * DM + col);
        else { const u32x2 r = *(const u32x2*)(XB + (size_t)(T_P + row) * DM + col); x = (f32x4){__uint_as_float(r.x << 16), __uint_as_float(r.x & 0xffff0000u), __uint_as_float(r.y << 16), __uint_as_float(r.y & 0xffff0000u)}; }
        x += acc;
        if (WF32) *(f32x4*)(xout + (size_t)(T_P + row) * DM + col) = x;
        if (WBF) {
            *(u32x2*)(XB + (size_t)(T_P + row) * DM + col) = pk4(x);
            float ss = (x.x * x.x + x.y * x.y) + (x.z * x.z + x.w * x.w);
            ss += __shfl_xor(ss, 16); ss += __shfl_xor(ss, 32);
            if (lane < 16) part[(rt * 4 + ct) * 16 + fr] = ss;
            __syncthreads();
            if (tid_ < 32) { const int rr = tid_ >> 4, f = tid_ & 15; RSS[(size_t)(T_P + 32 * mi + 16 * rr + f) * 16 + ni] = (part[(rr * 4 + 0) * 16 + f] + part[(rr * 4 + 1) * 16 + f]) + (part[(rr * 4 + 2) * 16 + f] + part[(rr * 4 + 3) * 16 + f]); }
            __syncthreads();
        }
    }
}

template <class E2> struct EpiAdapt {
    static constexpr bool PERM = true, AFTER_DRAIN = false; E2 e;
    __device__ __forceinline__ void operator()(const pg8::f32x4 (&acc)[2][2][4][2], const pg8::Unit& u, int wr, int wc, int fr, int fq) const {
#pragma unroll
        for (int ai = 0; ai < 2; ++ai)
#pragma unroll
            for (int m = 0; m < 4; ++m) {
                const int row = u.pm * 256 + ai * 128 + wr * 64 + m * 16 + fr;
                const float rs = e.rowscale(row);
                e(row, u.pn * 256 + wc * 32 + 8 * fq, acc[ai][0][m][0], acc[ai][0][m][1], acc[ai][1][m][0], acc[ai][1][m][1], rs);
            }
    }
};

#define LAS __attribute__((address_space(3)))
#define XB_TMO      128
#define XB_XCNT(j)  (256  + 64 * (j))
#define XB_XSUB(j)  (1280 + 64 * (j))
#define XB_XGEN(j)  (2304 + 64 * (j))
#define XB_TOP      3328
#define XB_TOPGEN   3392
#define XCD_BAR_WORDS 3456
#define XB_SPIN_CAP (1u << 18)

__device__ __forceinline__ unsigned xb_ld(unsigned* p)              { return __hip_atomic_load(p, __ATOMIC_RELAXED, __HIP_MEMORY_SCOPE_AGENT); }
__device__ __forceinline__ unsigned xb_add(unsigned* p, unsigned v) { return __hip_atomic_fetch_add(p, v, __ATOMIC_RELAXED, __HIP_MEMORY_SCOPE_AGENT); }
__device__ __forceinline__ unsigned xb_xcc_id() { return (unsigned)__builtin_amdgcn_s_getreg((3 << 11) | 20) & 0xFu; }
#define XB_SPIN(cond, bar) do { unsigned _sp = 0; while (cond) { __builtin_amdgcn_s_sleep(1); \
    if ((++_sp & 255u) == 0u) { if (xb_ld(&(bar)[XB_TMO])) break; if (_sp > XB_SPIN_CAP) { atomicAdd(&(bar)[XB_TMO], 1u); break; } } } } while (0)

struct XcdBarrier {
    unsigned* bar; unsigned x;
    unsigned* psub; unsigned* pgen;
    volatile LAS unsigned* st;
};

__device__ __forceinline__ XcdBarrier xcd_barrier_post(unsigned* bar, volatile LAS unsigned* st) {
    XcdBarrier b; b.bar = bar; b.x = xb_xcc_id(); b.st = st; b.psub = bar + XB_XSUB(b.x); b.pgen = bar + XB_XGEN(b.x);
    if (threadIdx.x == 0) (void)xb_add(&bar[XB_XCNT(b.x)], 1u);
    return b;
}
__device__ __forceinline__ void xcd_barrier_complete(unsigned* bar, unsigned x, unsigned& nloc, unsigned& nx) {
    const unsigned G = gridDim.x * gridDim.y * gridDim.z;
    unsigned sum, cnt, mine, sp = 0u;
    for (;;) {
        sum = 0u; cnt = 0u; mine = 0u;
#pragma unroll
        for (unsigned j = 0; j < 16; ++j) { const unsigned c = xb_ld(&bar[XB_XCNT(j)]); sum += c; cnt += (c > 0u) ? 1u : 0u; mine = (j == x) ? c : mine; }
        if (sum == G) break;
        __builtin_amdgcn_s_sleep(1);
        if ((++sp & 255u) == 0u) { if (xb_ld(&bar[XB_TMO])) break; if (sp > XB_SPIN_CAP) { atomicAdd(&bar[XB_TMO], 1u); break; } }
    }
    nloc = mine > 0u ? mine : 1u; nx = cnt > 0u ? cnt : 1u;
}

__device__ __forceinline__ void xcd_barrier(const XcdBarrier& b) {
    asm volatile("s_waitcnt vmcnt(0)" ::: "memory");
    __syncthreads();
    if (threadIdx.x == 0) {
        unsigned* bar = b.bar;
        __builtin_amdgcn_s_waitcnt(0);
        unsigned nloc = b.st[0], nx = b.st[1];
        const unsigned old = xb_add(b.psub, 1u);
        const unsigned gen = old / nloc;
        if (old + 1u == (gen + 1u) * nloc) {
            __builtin_amdgcn_fence(__ATOMIC_RELEASE, "agent");
            asm volatile("s_waitcnt vmcnt(0)" ::: "memory");
            const unsigned og = xb_add(&bar[XB_TOP], 1u);
            const unsigned tg = og / nx;
            if (og + 1u == (tg + 1u) * nx) xb_add(&bar[XB_TOPGEN], 1u);
            else XB_SPIN(xb_ld(&bar[XB_TOPGEN]) == tg, bar);
            __builtin_amdgcn_fence(__ATOMIC_ACQUIRE, "agent");
            xb_add(b.pgen, 1u);
            asm volatile("s_waitcnt vmcnt(0)" ::: "memory");
        } else {
            XB_SPIN(xb_ld(b.pgen) == gen, bar);
            __builtin_amdgcn_fence(__ATOMIC_ACQUIRE, "agent");
            asm volatile("s_waitcnt vmcnt(0)" ::: "memory");
        }
    }
    __syncthreads();
}


__device__ __forceinline__ void xcd_census(const XcdBarrier& b) { if (threadIdx.x == 0) { unsigned nloc, nx; xcd_barrier_complete(b.bar, b.x, nloc, nx); b.st[0] = nloc; b.st[1] = nx; } __syncthreads(); }

constexpr int LDS_BYTES = 147456;
struct MP { const float* in[35]; float* out; unsigned char* ws; int ph_lo, ph_hi; };
constexpr int P0_I_IN = (DM / 64) * (NIN / 32), P0_I_OUT = (DM / 64) * (DM / 32), P0_I_G = (DM / 64) * (DFF / 32), P0_I_D = (DFF / 64) * (DM / 32), P0_IL = P0_I_IN + P0_I_OUT + 2 * P0_I_G + P0_I_D;
__device__ __forceinline__ const float* inptr_(int k);
__device__ __forceinline__ void p0_dispatch(int it, unsigned char* ws, float* scr, int lane) {
    const int l2 = it / P0_IL; int r = it - l2 * P0_IL;
    bf16_t* WIN_ = (bf16_t*)(ws + WS_WIN); bf16_t* WOUT_ = (bf16_t*)(ws + WS_WOUT); bf16_t* WGU_ = (bf16_t*)(ws + WS_WGU); bf16_t* WD_ = (bf16_t*)(ws + WS_WD);
    if (r < P0_I_IN) { p0_item(inptr_(9) + (size_t)l2 * DM * NIN, DM, NIN, WIN_ + (size_t)l2 * NINP * DM, inptr_(8) + l2 * DM, NIN, 0, 0, scr, r, lane, true); return; } r -= P0_I_IN;
    if (r < P0_I_OUT) { p0_item(inptr_(30) + (size_t)l2 * DM * DM, DM, DM, WOUT_ + (size_t)l2 * DM * DM, nullptr, DM, 0, 0, scr, r, lane); return; } r -= P0_I_OUT;
    if (r < P0_I_G) { p0_item(inptr_(32) + (size_t)l2 * DM * DFF, DM, DFF, WGU_ + (size_t)l2 * 2 * DFF * DM, inptr_(31) + l2 * DM, 4, 8, 0, scr, r, lane); return; } r -= P0_I_G;
    if (r < P0_I_G) { p0_item(inptr_(33) + (size_t)l2 * DM * DFF, DM, DFF, WGU_ + (size_t)l2 * 2 * DFF * DM, inptr_(31) + l2 * DM, 4, 8, 4, scr, r, lane); return; } r -= P0_I_G;
    p0_item(inptr_(34) + (size_t)l2 * DFF * DM, DFF, DM, WD_ + (size_t)l2 * DM * DFF, nullptr, DM, 0, 0, scr, r, lane);
}
__device__ __forceinline__ const float* inptr_(int k) { const float* const* ka = (const float* const*)__builtin_amdgcn_kernarg_segment_ptr(); asm volatile("" : "+s"(k)); return ka[k]; }
__device__ __forceinline__ int fresh_bx() { int b = blockIdx.x; asm volatile("" : "+s"(b)); return b; }
__global__ void __launch_bounds__(512, 2) mega(MP p) {
    extern __shared__ __attribute__((aligned(16))) unsigned char lds[];
    cg::grid_group grid = cg::this_grid();
    float* out = p.out; unsigned char* ws = p.ws;
#define INP(k) inptr_(k)
#define WIN ((bf16_t*)(ws + WS_WIN))
#define WOUT ((bf16_t*)(ws + WS_WOUT))
#define WGU ((bf16_t*)(ws + WS_WGU))
#define WD ((bf16_t*)(ws + WS_WD))
#define XB ((bf16_t*)(ws + WS_XB))
#define YMIX ((bf16_t*)(ws + WS_YMIX))
#define RSS ((float*)(ws + WS_RSS))
#define PROJ ((bf16_t*)(ws + WS_PROJ))
#define H ((bf16_t*)(ws + WS_H))
    const int lo = p.ph_lo, hi = p.ph_hi;
    int tid = threadIdx.x, half = tid >> 8;
#define FRESH() do { asm volatile("" : "+v"(tid)); half = tid >> 8; asm volatile("" : "+s"(ws), "+s"(out)); } while (0)
#ifndef TESTPH
#define TESTPH -1
#endif
    volatile LAS unsigned* bst = (volatile LAS unsigned*)(lds + LDS_BYTES - 16);
    if (threadIdx.x < 4) bst[threadIdx.x] = 0u;
    __syncthreads();
    const XcdBarrier xbar = xcd_barrier_post((unsigned*)(ws + WS_CTL), bst);
#ifndef PROF
#define PROF 0
#endif
    unsigned long long* tsb = (unsigned long long*)(ws + WS_CTL + 14336);
#ifndef DUP
#define DUP -1
#endif
#define REPS(k) for (int rep_ = 0; rep_ < ((DUP) == (k) ? 2 : 1); ++rep_)
#define REPSYNC(k) do { if ((DUP) == (k) && rep_ == 0) xcd_barrier(xbar); } while (0)
#define STAMP(k) do { if (PROF && blockIdx.x == 0 && threadIdx.x == 0) tsb[k] = __builtin_amdgcn_s_memrealtime(); } while (0)
    STAMP(0);
#define IN(k) ((TESTPH < 0 || TESTPH == ((k) > 8 ? (k) - 8 : (k))) && lo <= (k) && (k) < hi)
#define SEAM(k) do { if (IN((k) + 1)) { if ((k) == 0) { grid.sync(); xcd_census(xbar); } else xcd_barrier(xbar); } } while (0)
    if (IN(0)) REPS(0) {
        FRESH();
        {
            float* scr = (float*)lds + (tid >> 6) * (64 * 33);
            const int gw = blockIdx.x * 8 + (tid >> 6), ngw = gridDim.x * 8, lane = tid & 63;
            for (int it = gw; it < P0_IL; it += ngw) p0_dispatch(it, ws, scr, lane);
        }
        {
            bf16_t* PWT = (bf16_t*)(ws + WS_PWT);
            for (int i = blockIdx.x * 512 + tid; i < 2 * 4 * 64 * 64; i += gridDim.x * 512) { const int lg = i >> 12, d = (i >> 6) & 63, cc = i & 63; PWT[i] = f2bf(INP(25)[((size_t)lg * 64 + cc) * 64 + d]); }
        }
        {
            bf16_t* LWT = (bf16_t*)(ws + WS_LWT);
            for (int i = blockIdx.x * 512 + tid; i < 2 * 256 * 128; i += gridDim.x * 512) {
                const int l2 = i >> 15, c = (i >> 7) & 255, j = i & 127;
                const float v = j < 32 ? INP(16)[((size_t)l2 * 32 + j) * 256 + c] : (j < 64 ? INP(18)[((size_t)l2 * 32 + (j - 32)) * 256 + c] : INP(19)[((size_t)l2 * 64 + (j - 64)) * 256 + c]);
                LWT[i] = f2bf(v);
            }
        }
        for (int i = blockIdx.x; i < T / 16; i += gridDim.x) { d_xprep(i * 16 + (tid >> 6), INP(0), INP(1), XB, RSS); d_xprep(i * 16 + 8 + (tid >> 6), INP(0), INP(1), XB, RSS); }
        if (DUP == 0 && rep_ == 0) grid.sync(); else { SEAM(0); STAMP(1); }
    }
    for (int l = 0; l < 2; ++l) {
        const int pb = 1 + 8 * l;
        if (IN(pb + 0)) REPS(1) {
            FRESH();
            pg8::Gemm g{XB, WIN + (size_t)l * NINP * DM, T, NINP, DM}; pg8::StaticOrder S; S.init(T, NINP, gridDim.x, fresh_bx());
            EpiAdapt<EpiProj> E{EpiProj{PROJ, RSS, (bf16_t*)(ws + WS_GLU)}};
            pg8::gemm_phase<EpiAdapt<EpiProj>, pg8::StaticOrder, true, true>((LAS unsigned char*)lds, g, S, E);
            if (l == 0) {
                constexpr int NU1 = (T / 256) * (NINP / 256), NBUSY = NU1 % 256;
                if ((int)blockIdx.x >= NBUSY && gridDim.x == 256) {
                    float* scr = (float*)lds + (tid >> 6) * (64 * 33);
                    for (int it = P0_IL + ((int)blockIdx.x - NBUSY) * 8 + (tid >> 6); it < P0_IL + P0_I_IN + P0_I_OUT; it += (256 - NBUSY) * 8) p0_dispatch(it, ws, scr, tid & 63);
                } else if (gridDim.x != 256) {
                    float* scr = (float*)lds + (tid >> 6) * (64 * 33);
                    for (int it = P0_IL + (int)blockIdx.x * 8 + (tid >> 6); it < 2 * P0_IL; it += (int)gridDim.x * 8) p0_dispatch(it, ws, scr, tid & 63);
                }
            }
            REPSYNC(1); if (!(DUP == 1 && rep_ == 0)) { SEAM(pb + 0); STAMP(pb + 1); }
        }
        if (IN(pb + 1)) REPS(2) {
            FRESH();
            int ll = l; asm volatile("" : "+s"(ll));
            const RwkvW rw{INP(14) + ll * 896, INP(15) + ll * 256, INP(16) + ll * 32 * 256, INP(17) + ll * 256, INP(18) + ll * 32 * 256, INP(19) + ll * 64 * 256, INP(20) + ll * 256, INP(21) + ll * 256, INP(22) + ll * 256, INP(23) + ll * 256, INP(24) + ll * 256};
            const RwkvG rg{(bf16_t*)(ws + WS_PT), (bf16_t*)(ws + WS_QQ), (bf16_t*)(ws + WS_ZZ), (bf16_t*)(ws + WS_Y0), (bf16_t*)(ws + WS_SC), (bf16_t*)(ws + WS_GATE), (bf16_t*)(ws + WS_BV), (const bf16_t*)(ws + WS_LWT)};
            for (int it = blockIdx.x; it < 1024; it += gridDim.x) rwkv_item(lds, it, ll, PROJ, INP(4) + (size_t)ll * 16 * 896, rw, rg);
            for (int i = blockIdx.x * 512 + tid; i < 20 * 896; i += gridDim.x * 512) {
                const int sq = i / 896, c = i - sq * 896; const Seq sx = seq_of(sq);
                const float v = bf2f(PROJ[(size_t)(sx.base + sx.L - 1) * NINP + C_B + c]);
                if (sx.sample) out[O_SHIFT_S + ((size_t)ll * 16 + sx.b) * 896 + c] = v; else out[O_SHIFT_P + ((size_t)ll * 4 + sx.b) * 896 + c] = v;
            }
            REPSYNC(2); if (!(DUP == 2 && rep_ == 0)) { SEAM(pb + 1); STAMP(pb + 2); }
        }
        if (IN(pb + 2)) REPS(3) {
            FRESH();
            int ll = l; asm volatile("" : "+s"(ll));
            const RwkvW rw{INP(14) + ll * 896, INP(15) + ll * 256, INP(16) + ll * 32 * 256, INP(17) + ll * 256, INP(18) + ll * 32 * 256, INP(19) + ll * 64 * 256, INP(20) + ll * 256, INP(21) + ll * 256, INP(22) + ll * 256, INP(23) + ll * 256, INP(24) + ll * 256};
            const RwkvG rg{(bf16_t*)(ws + WS_PT), (bf16_t*)(ws + WS_QQ), (bf16_t*)(ws + WS_ZZ), (bf16_t*)(ws + WS_Y0), (bf16_t*)(ws + WS_SC), (bf16_t*)(ws + WS_GATE), (bf16_t*)(ws + WS_BV), (const bf16_t*)(ws + WS_LWT)};
            if (blockIdx.x < 16) rwkv_chain_lds(lds, (int)blockIdx.x >> 2, (int)blockIdx.x & 3, rg, out + O_RWKV_P + (size_t)ll * 4 * 4 * 4096);
            else if (blockIdx.x < 48) {
                const int sidx = (int)blockIdx.x - 16;
                rwkv_item(lds, 1024 + sidx, ll, PROJ, INP(4) + (size_t)ll * 16 * 896, rw, rg);
                __syncthreads();
                const int wv = tid >> 6;
                rwkv_chain1(4 + (sidx >> 1), (sidx & 1) * 2 + (wv >> 2), wv & 3, INP(3) + (size_t)ll * 16 * 4 * 4096, rg, out + O_RWKV_S + (size_t)ll * 16 * 4 * 4096);
            }
            {
                const AttnP ap{PROJ, INP(6) + (size_t)ll * 16 * 128 * 128, INP(7) + (size_t)ll * 16 * 128 * 128, INP(27) + ll * 64, INP(28) + ll * 64, INP(29) + ll * 4, YMIX,
                               out + O_K_P + (size_t)ll * 4 * 128 * 128, out + O_K_S + (size_t)ll * 16 * 128 * 128, out + O_V_P + (size_t)ll * 4 * 128 * 128, out + O_V_S + (size_t)ll * 16 * 128 * 128};
                const ConvPoolP cp{PROJ, INP(2) + (size_t)ll * 16 * 30 * 256, INP(10) + ll * 31 * 256, INP(11) + ll * 256, INP(12) + ll * 256, INP(13) + ll * 256, INP(5) + (size_t)ll * 16 * 15 * 256, INP(25) + (size_t)ll * 4 * 64 * 64, INP(26) + ll * 256, YMIX,
                                   out + O_CONV_P + (size_t)ll * 4 * 30 * 256, out + O_CONV_S + (size_t)ll * 16 * 30 * 256, out + O_POOL_P + (size_t)ll * 4 * 15 * 256, out + O_POOL_S + (size_t)ll * 16 * 15 * 256, (const bf16_t*)(ws + WS_GLU), (const bf16_t*)(ws + WS_PWT) + (size_t)ll * 4 * 64 * 64};
                unsigned* ctr = (unsigned*)(ws + WS_CTL + 14848) + 64 * ll + 32 * (DUP == 3 ? rep_ : 0);
                volatile LAS unsigned* wsl = (volatile LAS unsigned*)(lds + LDS_BYTES - 32);
                for (;;) {
                    __syncthreads();
                    if (tid == 0) wsl[0] = __hip_atomic_fetch_add(ctr, 1u, __ATOMIC_RELAXED, __HIP_MEMORY_SCOPE_AGENT);
                    __syncthreads();
                    const unsigned idx = wsl[0];
                    if (idx >= 528u + 544u) break;
                    if (idx < 528u) convpool_tile((float*)lds + half * (62 * 256), 2 * (int)idx + half, cp);
                    else attn_unit(lds, (int)idx - 528, ap);
                }
            }
            REPSYNC(3); if (!(DUP == 3 && rep_ == 0)) { SEAM(pb + 2); STAMP(pb + 3); }
        }
        if (IN(pb + 3)) REPS(4) {
            FRESH();
            int ll = l; asm volatile("" : "+s"(ll));
            const RwkvW rw{INP(14) + ll * 896, INP(15) + ll * 256, INP(16) + ll * 32 * 256, INP(17) + ll * 256, INP(18) + ll * 32 * 256, INP(19) + ll * 64 * 256, INP(20) + ll * 256, INP(21) + ll * 256, INP(22) + ll * 256, INP(23) + ll * 256, INP(24) + ll * 256};
            const RwkvG rg{(bf16_t*)(ws + WS_PT), (bf16_t*)(ws + WS_QQ), (bf16_t*)(ws + WS_ZZ), (bf16_t*)(ws + WS_Y0), (bf16_t*)(ws + WS_SC), (bf16_t*)(ws + WS_GATE), (bf16_t*)(ws + WS_BV), (const bf16_t*)(ws + WS_LWT)};
            for (int wi = blockIdx.x * 8 + (tid >> 6); wi < 2 * NCHH; wi += gridDim.x * 8) rwkv_out(wi, rw, rg, YMIX);
            REPSYNC(4); if (!(DUP == 4 && rep_ == 0)) { SEAM(pb + 3); STAMP(pb + 4); }
        }
        if (IN(pb + 4)) {
            FRESH();
            pg8::Gemm g{YMIX, WOUT + (size_t)l * DM * DM, T_P, DM, DM}; pg8::StaticOrder S; S.init(T_P, DM, gridDim.x, fresh_bx());
            if (l == 0) {
                EpiAdapt<EpiRes<0, false, true>> E{EpiRes<0, false, true>{INP(0), INP(1), out, XB, RSS}};
                pg8::gemm_phase<EpiAdapt<EpiRes<0, false, true>>, pg8::StaticOrder, true, true>((LAS unsigned char*)lds, g, S, E);
                gemm_tail<DM, 0, false, true>(lds, YMIX, WOUT + (size_t)l * DM * DM, INP(1), out, XB, RSS);
            } else {
                EpiAdapt<EpiRes<1, false, true>> E{EpiRes<1, false, true>{nullptr, nullptr, out, XB, RSS}};
                pg8::gemm_phase<EpiAdapt<EpiRes<1, false, true>>, pg8::StaticOrder, true, true>((LAS unsigned char*)lds, g, S, E);
                gemm_tail<DM, 1, false, true>(lds, YMIX, WOUT + (size_t)l * DM * DM, nullptr, out, XB, RSS);
            }
            SEAM(pb + 4); STAMP(pb + 5);
        }
        if (IN(pb + 5)) REPS(6) {
            FRESH();
            pg8::Gemm g{XB, WGU + (size_t)l * 2 * DFF * DM, T, 2 * DFF, DM}; pg8::StaticOrder S; S.init(T, 2 * DFF, gridDim.x, fresh_bx());
            EpiAdapt<EpiGU> E{EpiGU{H, RSS}};
            pg8::gemm_phase<EpiAdapt<EpiGU>, pg8::StaticOrder, true, true>((LAS unsigned char*)lds, g, S, E);
            if (l == 0) {
                constexpr int NU3 = (T / 256) * (2 * DFF / 256), NBUSY3 = NU3 % 256;
                float* scr = (float*)lds + (tid >> 6) * (64 * 33);
                if (gridDim.x == 256) { if ((int)blockIdx.x >= NBUSY3) for (int it = P0_IL + P0_I_IN + P0_I_OUT + ((int)blockIdx.x - NBUSY3) * 8 + (tid >> 6); it < 2 * P0_IL; it += (256 - NBUSY3) * 8) p0_dispatch(it, ws, scr, tid & 63); }
                else for (int it = P0_IL + P0_I_IN + P0_I_OUT + (int)blockIdx.x * 8 + (tid >> 6); it < 2 * P0_IL; it += (int)gridDim.x * 8) p0_dispatch(it, ws, scr, tid & 63);
            }
            REPSYNC(6); if (!(DUP == 6 && rep_ == 0)) { SEAM(pb + 5); STAMP(pb + 6); }
        }
        if (IN(pb + 6)) {
            FRESH();
            pg8::Gemm g{H, WD + (size_t)l * DM * DFF, T_P, DM, DFF}; pg8::StaticOrder S; S.init(T_P, DM, gridDim.x, fresh_bx());
            if (l == 0) {
                EpiAdapt<EpiRes<1, false, true>> E{EpiRes<1, false, true>{nullptr, nullptr, out, XB, RSS}};
                pg8::gemm_phase<EpiAdapt<EpiRes<1, false, true>>, pg8::StaticOrder, true, true>((LAS unsigned char*)lds, g, S, E);
                gemm_tail<DFF, 1, false, true>(lds, H, WD + (size_t)l * DM * DFF, nullptr, out, XB, RSS);
                SEAM(pb + 7); STAMP(pb + 7);
            } else {
                EpiAdapt<EpiRes<1, true, false>> E{EpiRes<1, true, false>{nullptr, nullptr, out, XB, RSS}};
                pg8::gemm_phase<EpiAdapt<EpiRes<1, true, false>>, pg8::StaticOrder, true, true>((LAS unsigned char*)lds, g, S, E);
                gemm_tail<DFF, 1, true, false>(lds, H, WD + (size_t)l * DM * DFF, nullptr, out, XB, RSS);
            }
        }
    }
    if (PROF) {
        xcd_barrier(xbar); STAMP(16); xcd_barrier(xbar);
        const unsigned long long* t = tsb;
        const unsigned long long d[12] = {t[16] - t[0], t[1] - t[0], t[2] - t[1], t[3] - t[2], t[4] - t[3], t[5] - t[4], t[6] - t[5], t[7] - t[6], t[8] - t[7], t[10] - t[8], t[13] - t[10], t[16] - t[13]};
        const size_t off[12] = {O_Y, O_Y + (size_t)T_P * DM, O_CONV_P, O_CONV_S, O_RWKV_P, O_RWKV_S, O_SHIFT_P, O_SHIFT_S, O_POOL_P, O_POOL_S, O_K_P, O_K_S};
        const unsigned cap[12] = {99999, 99999, 61000, 99999, 99999, 99999, 7000, 28000, 30000, 99999, 99999, 99999};
        for (int k = 0; k < 12; ++k) { unsigned c = (unsigned)(d[k] / 10ull); if (c > cap[k]) c = cap[k]; for (unsigned i = blockIdx.x * 512 + threadIdx.x; i < c; i += gridDim.x * 512) ((unsigned*)out)[off[k] + i] = 0xAAAAAAAAu; }
    }
}

#undef WIN
#undef WOUT
#undef WGU
#undef WD
#undef XB
#undef YMIX
#undef RSS
#undef PROJ
#undef H
static void launch_mega(MP p, int lo, int hi, int grid_blocks, hipStream_t stream) {
    p.ph_lo = lo; p.ph_hi = hi;
    void* args[] = {&p};
    hipError_t e = hipLaunchCooperativeKernel((const void*)mega, dim3(grid_blocks), dim3(512), args, LDS_BYTES, stream);
    if (e != hipSuccess) fprintf(stderr, "cooperative launch failed: %s (grid %d)\n", hipGetErrorString(e), grid_blocks);
}
extern "C" void kernel_launch(void* const* d_in, const int* in_sizes, int n_in, void* d_out, int out_size, void* d_ws, size_t ws_size, hipStream_t stream) {
    static int grid_blocks = 0;
    if (grid_blocks == 0) {
        if (n_in != 35 || (size_t)out_size != O_END || ws_size < WS_END) { fprintf(stderr, "kernel_launch: unexpected sizes n_in %d out %d ws %zu (need %zu)\n", n_in, out_size, ws_size, (size_t)WS_END); grid_blocks = -1; return; }
        int dev = 0, cus = 0, per_cu = 0;
        (void)hipGetDevice(&dev);
        (void)hipDeviceGetAttribute(&cus, hipDeviceAttributeMultiprocessorCount, dev);
        (void)hipFuncSetAttribute((const void*)mega, hipFuncAttributeMaxDynamicSharedMemorySize, LDS_BYTES);
        (void)hipOccupancyMaxActiveBlocksPerMultiprocessor(&per_cu, mega, 512, LDS_BYTES);
        if (per_cu < 1) { fprintf(stderr, "kernel_launch: occupancy query says %d blocks per CU\n", per_cu); grid_blocks = -1; return; }
        grid_blocks = cus;
    }
    if (grid_blocks < 0) return;
    const float* const* in = (const float* const*)d_in;
    float* out = (float*)d_out; unsigned char* ws = (unsigned char*)d_ws;
    MP p{};
    for (int i = 0; i < 35; ++i) p.in[i] = in[i];
    p.out = out; p.ws = ws;
    (void)hipMemsetAsync(ws + WS_CTL, 0, 16384, stream);
    launch_mega(p, 0, 16, grid_blocks, stream);
}
```

```cpp
#include <hip/hip_runtime.h>
#include <hip/hip_cooperative_groups.h>
namespace cg = cooperative_groups;
#include <cstdint>
#include <cstdio>

typedef unsigned short bf16_t;
typedef short bf16x8 __attribute__((ext_vector_type(8)));
typedef float f32x4 __attribute__((ext_vector_type(4)));
typedef unsigned u32x4 __attribute__((ext_vector_type(4)));
typedef unsigned u32x2 __attribute__((ext_vector_type(2)));

constexpr int T_P = 16384, T_S = 512, T = 16896, DM = 1024;
constexpr int NIN = 2176, NINP = 2304, DFF = 2816;
constexpr int C_A = 0, C_B = 512, C_C = 1408, C_Q = 1664, C_K = 1920, C_V = 2048;

constexpr size_t O_Y = 0, O_CONV_P = 17301504, O_CONV_S = 17362944, O_RWKV_P = 17608704, O_RWKV_S = 17739776,
                 O_SHIFT_P = 18264064, O_SHIFT_S = 18271232, O_POOL_P = 18299904, O_POOL_S = 18330624,
                 O_K_P = 18453504, O_K_S = 18584576, O_V_P = 19108864, O_V_S = 19239936, O_END = 19764224;

constexpr size_t WS_CTL = 0;
constexpr size_t WS_WIN = 16384;
constexpr size_t WS_WOUT = WS_WIN + 2ull * NINP * DM * 2;
constexpr size_t WS_WGU = WS_WOUT + 2ull * DM * DM * 2;
constexpr size_t WS_WD = WS_WGU + 2ull * 2 * DFF * DM * 2;
constexpr size_t WS_LWT = WS_WD + 2ull * DM * DFF * 2;
constexpr size_t WS_XB = WS_LWT + 2ull * 256 * 128 * 2;
constexpr size_t WS_YMIX = WS_XB + (size_t)T * DM * 2;
constexpr size_t WS_RSS = WS_YMIX + (size_t)T * DM * 2;
constexpr size_t WS_R = WS_RSS + (size_t)T * 32 * 4;
constexpr size_t WS_PROJ = WS_R;
constexpr size_t WS_H = WS_R;
constexpr size_t WS_RW = WS_PROJ + (size_t)T * NINP * 2;
constexpr int NCH = T / 32, NCHH = NCH * 4;
constexpr size_t WS_PT = WS_RW;
constexpr size_t WS_QQ = WS_PT + (size_t)NCHH * 4096 * 2;
constexpr size_t WS_ZZ = WS_QQ + (size_t)NCHH * 4096 * 2;
constexpr size_t WS_Y0 = WS_ZZ + (size_t)NCHH * 2048 * 2;
constexpr size_t WS_SC = WS_Y0 + (size_t)NCHH * 2048 * 2;
constexpr size_t WS_GATE = WS_SC + (size_t)NCHH * 4096 * 2;
constexpr size_t WS_BV = WS_GATE + (size_t)T * 256 * 2;
constexpr size_t WS_GLU = WS_BV + (size_t)T * 256 * 2;
constexpr size_t WS_PWT = WS_GLU + (size_t)T * 256 * 2;
constexpr size_t WS_RWEND = WS_PWT + 2ull * 4 * 64 * 64 * 2;
constexpr size_t RW_BF = (size_t)T * 256 * 2;
constexpr size_t WS_RW_R = WS_RWEND, WS_RW_K = WS_RW_R + RW_BF, WS_RW_V = WS_RW_R + 2 * RW_BF, WS_RW_A = WS_RW_R + 3 * RW_BF,
                 WS_RW_B = WS_RW_R + 4 * RW_BF, WS_RW_G = WS_RW_R + 5 * RW_BF, WS_RW_W = WS_RW_R + 6 * RW_BF;
constexpr size_t WS_END = WS_RWEND;

__device__ __forceinline__ float bf2f(bf16_t h) { return __uint_as_float((unsigned)h << 16); }
typedef __bf16 bf16x2_t __attribute__((ext_vector_type(2)));
typedef float f32x2 __attribute__((ext_vector_type(2)));
__device__ __forceinline__ unsigned pk2(float lo, float hi) { const f32x2 v = {lo, hi}; return __builtin_bit_cast(unsigned, __builtin_convertvector(v, bf16x2_t)); }
__device__ __forceinline__ u32x2 pk4(f32x4 v) { u32x2 o; o.x = pk2(v.x, v.y); o.y = pk2(v.z, v.w); return o; }
__device__ __forceinline__ bf16_t f2bf(float f) { return (bf16_t)(pk2(f, 0.f) & 0xffffu); }
__device__ __forceinline__ void unpack8(u32x4 v, float* f) {
    f[0] = __uint_as_float(v.x << 16); f[1] = __uint_as_float(v.x & 0xffff0000u); f[2] = __uint_as_float(v.y << 16); f[3] = __uint_as_float(v.y & 0xffff0000u);
    f[4] = __uint_as_float(v.z << 16); f[5] = __uint_as_float(v.z & 0xffff0000u); f[6] = __uint_as_float(v.w << 16); f[7] = __uint_as_float(v.w & 0xffff0000u);
}
__device__ __forceinline__ float wave_sum(float v) {
#pragma unroll
    for (int o = 1; o < 64; o <<= 1) v += __shfl_xor(v, o);
    return v;
}
__device__ __forceinline__ float sigmoidf_(float x) { return __builtin_amdgcn_rcpf(1.f + __expf(-x)); }

__device__ __forceinline__ void p0_item(const float* __restrict__ W, int K, int N, bf16_t* __restrict__ WT, const float* __restrict__ g, int grp, int stride, int off, float* scr, int item, int lane, bool glu_map = false) {
    const int nblk = N / 32, kb = item / nblk, nb = item - kb * nblk, k0 = 64 * kb, n0 = 32 * nb;
    float v[32];
#pragma unroll
    for (int i = 0; i < 32; ++i) v[i] = W[(size_t)(k0 + 2 * i + (lane >> 5)) * N + n0 + (lane & 31)];
#pragma unroll
    for (int i = 0; i < 32; ++i) { const int kk = 2 * i + (lane >> 5); scr[kk * 33 + (lane & 31)] = g ? v[i] * g[k0 + kk] : v[i]; }
    asm volatile("s_waitcnt lgkmcnt(0)" ::: "memory");
    const int c = lane & 7;
#pragma unroll
    for (int j = 0; j < 4; ++j) {
        const int n = n0 + (lane >> 3) + 8 * j; const float* sp = scr + (8 * c) * 33 + (n - n0);
        u32x4 o; o.x = pk2(sp[0], sp[33]); o.y = pk2(sp[2 * 33], sp[3 * 33]); o.z = pk2(sp[4 * 33], sp[5 * 33]); o.w = pk2(sp[6 * 33], sp[7 * 33]);
        int r = (n / grp) * stride + off + (n % grp);
        if (glu_map && n < 512) { const int n2 = n & 255; r = (n2 >> 2) * 8 + (n >> 8) * 4 + (n2 & 3); }
        *(u32x4*)(WT + (size_t)r * K + k0 + 8 * c) = o;
    }
    asm volatile("s_waitcnt lgkmcnt(0)" ::: "memory");
}

__device__ __forceinline__ void d_xprep(int row, const float* __restrict__ xp, const float* __restrict__ xs, bf16_t* __restrict__ XB, float* __restrict__ RSS) {
    const int lane = threadIdx.x & 63;
    const float* x = row < T_P ? xp + (size_t)row * DM : xs + (size_t)(row - T_P) * DM;
    float ss = 0.f;
#pragma unroll
    for (int j = 0; j < 4; ++j) {
        const f32x4 v = ((const f32x4*)x)[lane + 64 * j];
        ss += v.x * v.x + v.y * v.y + v.z * v.z + v.w * v.w;
        u32x2 o; o.x = pk2(v.x, v.y); o.y = pk2(v.z, v.w);
        *(u32x2*)(XB + (size_t)row * DM + (lane + 64 * j) * 4) = o;
    }
    ss = wave_sum(ss);
    if (lane < 16) RSS[(size_t)row * 16 + lane] = lane == 0 ? ss : 0.f;
}

__device__ __forceinline__ float rss_rstd(const float* RSS, int row) {
    float s = 0.f;
#pragma unroll
    for (int j = 0; j < 4; ++j) { const f32x4 v = ((const f32x4*)(RSS + (size_t)row * 16))[j]; s += (v.x + v.y) + (v.z + v.w); }
    return rsqrtf(s * (1.f / DM) + 1e-6f);
}
struct EpiProj {
    bf16_t* PROJ; const float* RSS; bf16_t* GLU;
    __device__ __forceinline__ float rowscale(int row) const { return rss_rstd(RSS, row); }
    __device__ __forceinline__ void one(int row, int col, f32x4 v0, f32x4 v1, float rs) const {
        v0 *= rs; v1 *= rs;
        if (col < 512) { const f32x4 gl = {v0.x * sigmoidf_(v1.x), v0.y * sigmoidf_(v1.y), v0.z * sigmoidf_(v1.z), v0.w * sigmoidf_(v1.w)}; *(u32x2*)(GLU + (size_t)row * 256 + (col >> 1)) = pk4(gl); }
        else { u32x4 o; o.x = pk2(v0.x, v0.y); o.y = pk2(v0.z, v0.w); o.z = pk2(v1.x, v1.y); o.w = pk2(v1.z, v1.w); *(u32x4*)(PROJ + (size_t)row * NINP + col) = o; }
    }
    __device__ __forceinline__ void operator()(int row, int col, f32x4 v0, f32x4 v1, f32x4 w0, f32x4 w1, float rs) const { one(row, col, v0, v1, rs); one(row, col + 128, w0, w1, rs); }
};
template <int SRC, bool WF32, bool WBF> struct EpiRes {
    const float* xin_p; const float* xin_s; float* xout; bf16_t* XB; float* RSS;
    __device__ __forceinline__ float rowscale(int) const { return 1.f; }
    __device__ __forceinline__ float half8(int row, int col, f32x4 v0, f32x4 v1) const {
        f32x4 a, b;
        if (SRC == 0) { const float* xi = (row < T_P ? xin_p + (size_t)row * DM : xin_s + (size_t)(row - T_P) * DM) + col; a = *(const f32x4*)(xi); b = *(const f32x4*)(xi + 4); }
        else { float f[8]; unpack8(*(const u32x4*)(XB + (size_t)row * DM + col), f); a = (f32x4){f[0], f[1], f[2], f[3]}; b = (f32x4){f[4], f[5], f[6], f[7]}; }
        a += v0; b += v1;
        if (WF32) { *(f32x4*)(xout + (size_t)row * DM + col) = a; *(f32x4*)(xout + (size_t)row * DM + col + 4) = b; }
        if (WBF) { u32x4 o; o.x = pk2(a.x, a.y); o.y = pk2(a.z, a.w); o.z = pk2(b.x, b.y); o.w = pk2(b.z, b.w); *(u32x4*)(XB + (size_t)row * DM + col) = o; }
        return (a.x * a.x + a.y * a.y) + (a.z * a.z + a.w * a.w) + (b.x * b.x + b.y * b.y) + (b.z * b.z + b.w * b.w);
    }
    __device__ __forceinline__ void operator()(int row, int col, f32x4 v0, f32x4 v1, f32x4 w0, f32x4 w1, float) const {
        float ss = half8(row, col, v0, v1);
        ss += half8(row, col + 128, w0, w1);
        if (WBF) {
            ss += __shfl_xor(ss, 16); ss += __shfl_xor(ss, 32);
            if ((threadIdx.x & 63) < 16) RSS[(size_t)row * 16 + (col >> 8) * 4 + ((col >> 5) & 3)] = ss;
        }
    }
};
struct EpiGU {
    bf16_t* H; const float* RSS;
    __device__ __forceinline__ float rowscale(int row) const { return rss_rstd(RSS, row); }
    __device__ __forceinline__ u32x2 gu(f32x4 g, f32x4 u, float rs) const {
        g *= rs; u *= rs;
        const float h0 = g.x * sigmoidf_(g.x) * u.x, h1 = g.y * sigmoidf_(g.y) * u.y, h2 = g.z * sigmoidf_(g.z) * u.z, h3 = g.w * sigmoidf_(g.w) * u.w;
        u32x2 o; o.x = pk2(h0, h1); o.y = pk2(h2, h3); return o;
    }
    __device__ __forceinline__ void operator()(int row, int col, f32x4 g0, f32x4 u0, f32x4 g1, f32x4 u1, float rs) const {
        *(u32x2*)(H + (size_t)row * DFF + (col >> 1)) = gu(g0, u0, rs);
        *(u32x2*)(H + (size_t)row * DFF + (col >> 1) + 64) = gu(g1, u1, rs);
    }
};

struct Seq { int base, L, b, sample, pos0; };
__device__ __forceinline__ Seq seq_of(int sq) { Seq s; if (sq < 4) { s.base = sq * 4096; s.L = 4096; s.b = sq; s.sample = 0; s.pos0 = 0; } else { s.b = sq - 4; s.base = T_P + s.b * 32; s.L = 32; s.sample = 1; s.pos0 = 1024; } return s; }

struct RwkvW { const float *mu, *w0, *w2, *a0, *a2, *g2, *k_k, *k_a, *r_k, *gn_g, *gn_b; };

namespace pg8 {
#define PG8_LAS __attribute__((address_space(3)))
typedef unsigned short bf16_t;
typedef short bf16x8 __attribute__((ext_vector_type(8)));
typedef float f32x4 __attribute__((ext_vector_type(4)));
typedef unsigned u32x4 __attribute__((ext_vector_type(4)));
constexpr int BM = 256, BK = 64, HALF = 128, HTB = HALF * BK * 2  , STAGE_BYTES = 8 * HTB, NXCD = 8, WGM = 8;

__host__ __device__ __forceinline__ int lds_byte(int r, int c) { const int st = (r >> 4) * 2 + (c >> 5), rr = r & 15, cc = c & 31, ob = rr * 64 + cc * 2; return st * 1024 + (ob ^ (((ob >> 9) & 1) << 5)); }
__host__ __device__ __forceinline__ void stage_rc(int b, int& R, int& C) { const int st = b / 1024, sb = b % 1024, swz = sb ^ (((sb >> 9) & 1) << 5); R = (st >> 1) * 16 + swz / 64; C = (st & 1) * 32 + (swz % 64) / 2; }
__host__ __device__ __forceinline__ int perm32(int rho) { const int n = rho >> 4, i = rho & 15; return 8 * (i >> 2) + 4 * n + (i & 3); }

struct Unit { int pm, pn; };
struct Gemm { const bf16_t* A; const bf16_t* Bt; int M, N, K; };

struct StaticOrder {
    int nM, nN, nwg, G, c;
    __host__ __device__ void init(int M, int N, int G_, int c_) { nM = M / BM; nN = N / BM; nwg = nM * nN; G = G_; c = c_; }
    __host__ __device__ bool next(int i, Unit& u) const {
        const long L = (long)i * G + c; if (L >= nwg) return false;
        int wgid = (int)L; { const int q = nwg / NXCD, r = nwg % NXCD, xcd = wgid % NXCD, off = wgid / NXCD; wgid = (xcd < r ? xcd * (q + 1) : r * (q + 1) + (xcd - r) * q) + off; }
        const int nig = WGM * nN, gid = wgid / nig, fm = gid * WGM, gsz = (nM - fm) < WGM ? (nM - fm) : WGM;
        u.pm = fm + ((wgid % nig) % gsz); u.pn = (wgid % nig) / gsz; return true;
    }
    __device__ __forceinline__ void a_ready(const Unit&) const {}
    __device__ __forceinline__ void done(const Unit&) const {}
};


template <class Epi, class Sched, bool ALIGN_EPI = false, bool SP2 = false>
__device__ __forceinline__ void gemm_phase(PG8_LAS unsigned char* lds, const Gemm g, const Sched& S, const Epi& E) {
    int tid_ = threadIdx.x; asm volatile("" : "+v"(tid_));
    const int tid = tid_, wid = __builtin_amdgcn_readfirstlane(tid >> 6), lane = tid & 63, wr = wid >> 2, wc = wid & 3, fr = lane & 15, fq = lane >> 4;
    const int K = g.K, nt = K / BK;
    unsigned voffA[2], voffB[2];
#pragma unroll
    for (int i = 0; i < 2; ++i) { int R, C; stage_rc(tid * 16 + i * 8192, R, C); const int Rb = Epi::PERM ? ((R & ~31) + perm32(R & 31)) : R;
        voffA[i] = (unsigned)(R * K + C) * 2u; voffB[i] = (unsigned)(Rb * K + C) * 2u; }
    const size_t kstep = (size_t)(BK * 2);
    const size_t hstep = (size_t)HALF * K * 2;
    const size_t tstep = 2 * hstep;
    const unsigned ldsw = (unsigned)wid * 1024u;
    const int aoff = lds_byte(wr * 64 + fr, fq * 8), boff = lds_byte(wc * 32 + fr, fq * 8);
#define PG8_SA(b, h) (((b) * 2 + (h)) * HTB)
#define PG8_SB(b, h) ((4 + (b) * 2 + (h)) * HTB)
#define PG8_STAGE(bufoff, gbase, voff) do { _Pragma("unroll") for (int _i = 0; _i < 2; ++_i) \
        __builtin_amdgcn_global_load_lds((const unsigned*)((const char*)(gbase) + (voff)[_i]), (PG8_LAS unsigned*)(lds + (bufoff) + ldsw + _i * 8192), 16, 0, 0); } while (0)
#define PG8_LDA(dst, b, h) do { _Pragma("unroll") for (int m = 0; m < 4; ++m) _Pragma("unroll") for (int k = 0; k < 2; ++k) dst[m][k] = *(const PG8_LAS bf16x8*)(lds + PG8_SA(b, h) + aoff + m * 2048 + k * 1024); } while (0)
#define PG8_LDB(dst, b, h) do { _Pragma("unroll") for (int n = 0; n < 2; ++n) _Pragma("unroll") for (int k = 0; k < 2; ++k) dst[n][k] = *(const PG8_LAS bf16x8*)(lds + PG8_SB(b, h) + boff + n * 2048 + k * 1024); } while (0)
#define PG8_MMA(ai, bj, At, Bt) do { __builtin_amdgcn_s_setprio(1); _Pragma("unroll") for (int m = 0; m < 4; ++m) _Pragma("unroll") for (int n = 0; n < 2; ++n) _Pragma("unroll") for (int k = 0; k < 2; ++k) \
        acc[ai][bj][m][n] = __builtin_amdgcn_mfma_f32_16x16x32_bf16(Bt[n][k], At[m][k], acc[ai][bj][m][n], 0, 0, 0); __builtin_amdgcn_s_setprio(0); } while (0)
#define PG8_WAIT_V(n) asm volatile("s_waitcnt vmcnt(" #n ")" ::: "memory")
#define PG8_WAIT_L(n) asm volatile("s_waitcnt lgkmcnt(" #n ")" ::: "memory")
#define PG8_BAR __builtin_amdgcn_s_barrier()
#define PG8_SCHED __builtin_amdgcn_sched_barrier(0)
    Unit cur, nxt; int ui = 0;
    if (!S.next(0, cur)) return;
    f32x4 acc[2][2][4][2];
#pragma unroll
    for (int a = 0; a < 2; ++a)
#pragma unroll
        for (int b = 0; b < 2; ++b)
#pragma unroll
            for (int m = 0; m < 4; ++m)
#pragma unroll
                for (int n = 0; n < 2; ++n) acc[a][b][m][n] = (f32x4){0.f, 0.f, 0.f, 0.f};
    bf16x8 At[4][2], B0[2][2], B1[2][2];
    const char* cA = (const char*)g.A + (size_t)cur.pm * tstep; const char* cB = (const char*)g.Bt + (size_t)cur.pn * tstep;
    S.a_ready(cur);
    if constexpr (SP2) {
        PG8_STAGE(PG8_SB(0, 0), cB, voffB); PG8_STAGE(PG8_SB(0, 1), cB + hstep, voffB); PG8_STAGE(PG8_SA(0, 0), cA, voffA); PG8_STAGE(PG8_SA(0, 1), cA + hstep, voffA);
        if (wr == 1) PG8_BAR;
        PG8_WAIT_V(2); PG8_BAR;
        PG8_STAGE(PG8_SB(1, 0), cB + kstep, voffB); PG8_STAGE(PG8_SA(1, 0), cA + kstep, voffA); PG8_STAGE(PG8_SB(1, 1), cB + hstep + kstep, voffB);
        PG8_WAIT_V(6); PG8_BAR;
    } else {
        PG8_STAGE(PG8_SB(0, 0), cB, voffB); PG8_STAGE(PG8_SA(0, 0), cA, voffA); PG8_STAGE(PG8_SB(0, 1), cB + hstep, voffB); PG8_STAGE(PG8_SA(0, 1), cA + hstep, voffA);
        if (wr == 1) PG8_BAR;
        PG8_WAIT_V(4); PG8_BAR;
        PG8_STAGE(PG8_SB(1, 0), cB + kstep, voffB); PG8_STAGE(PG8_SA(1, 0), cA + kstep, voffA); PG8_STAGE(PG8_SB(1, 1), cB + hstep + kstep, voffB);
        PG8_WAIT_V(6); PG8_BAR;
    }
    for (;;) {
        const bool has_next = S.next(ui + 1, nxt);
        const char* nA = has_next ? (const char*)g.A + (size_t)nxt.pm * tstep : cA; const char* nB = has_next ? (const char*)g.Bt + (size_t)nxt.pn * tstep : cB;
        for (int t = 0; t < nt; t += 2) {
            const bool last = (t == nt - 2);
            const char* a1 = cA + (size_t)(t + 1) * kstep;
            const char* a2 = last ? nA : cA + (size_t)(t + 2) * kstep; const char* b2 = last ? nB : cB + (size_t)(t + 2) * kstep;
            const char* a3 = a2 + kstep; const char* b3 = b2 + kstep;
            if (last && has_next) S.a_ready(nxt);
            if constexpr (SP2) {
            PG8_LDB(B0, 0, 0); PG8_LDB(B1, 0, 1); PG8_SCHED; PG8_LDA(At, 0, 0); PG8_STAGE(PG8_SA(1, 1), a1 + hstep, voffA);
            PG8_WAIT_V(8); PG8_WAIT_L(0); PG8_BAR; PG8_MMA(0, 0, At, B0); PG8_MMA(0, 1, At, B1); PG8_BAR; PG8_SCHED;
            PG8_LDA(At, 0, 1); PG8_STAGE(PG8_SB(0, 0), b2, voffB); PG8_STAGE(PG8_SB(0, 1), b2 + hstep, voffB); PG8_STAGE(PG8_SA(0, 0), a2, voffA);
            PG8_WAIT_V(8); PG8_WAIT_L(0); PG8_BAR; PG8_MMA(1, 0, At, B0); PG8_MMA(1, 1, At, B1); PG8_BAR; PG8_SCHED;
            PG8_LDB(B0, 1, 0); PG8_LDB(B1, 1, 1); PG8_SCHED; PG8_LDA(At, 1, 0); PG8_STAGE(PG8_SA(0, 1), a2 + hstep, voffA);
            PG8_WAIT_V(8); PG8_WAIT_L(0); PG8_BAR; PG8_MMA(0, 0, At, B0); PG8_MMA(0, 1, At, B1); PG8_BAR; PG8_SCHED;
            PG8_LDA(At, 1, 1); PG8_STAGE(PG8_SB(1, 0), b3, voffB); PG8_STAGE(PG8_SB(1, 1), b3 + hstep, voffB); PG8_STAGE(PG8_SA(1, 0), a3, voffA);
            PG8_WAIT_V(8); PG8_WAIT_L(0); PG8_BAR; PG8_MMA(1, 0, At, B0); PG8_MMA(1, 1, At, B1); PG8_BAR; PG8_SCHED;
            } else {
            PG8_LDB(B0, 0, 0); PG8_SCHED; PG8_LDA(At, 0, 0); PG8_STAGE(PG8_SA(1, 1), a1 + hstep, voffA);
            PG8_WAIT_L(8); PG8_BAR; PG8_WAIT_L(0); PG8_MMA(0, 0, At, B0); PG8_BAR; PG8_SCHED;
            PG8_LDB(B1, 0, 1); PG8_STAGE(PG8_SB(0, 0), b2, voffB);
            PG8_BAR; PG8_WAIT_L(0); PG8_MMA(0, 1, At, B1); PG8_BAR;
            PG8_LDA(At, 0, 1); PG8_STAGE(PG8_SA(0, 0), a2, voffA);
            PG8_BAR; PG8_WAIT_L(0); PG8_MMA(1, 0, At, B0); PG8_BAR; PG8_SCHED;
            PG8_STAGE(PG8_SB(0, 1), b2 + hstep, voffB);
            PG8_WAIT_V(6); PG8_BAR; PG8_MMA(1, 1, At, B1); PG8_BAR;
            PG8_LDB(B0, 1, 0); PG8_SCHED; PG8_LDA(At, 1, 0); PG8_STAGE(PG8_SA(0, 1), a2 + hstep, voffA);
            PG8_WAIT_L(8); PG8_BAR; PG8_WAIT_L(0); PG8_MMA(0, 0, At, B0); PG8_BAR; PG8_SCHED;
            PG8_LDB(B1, 1, 1); PG8_STAGE(PG8_SB(1, 0), b3, voffB);
            PG8_BAR; PG8_WAIT_L(0); PG8_MMA(0, 1, At, B1); PG8_BAR;
            PG8_LDA(At, 1, 1); PG8_STAGE(PG8_SA(1, 0), a3, voffA);
            PG8_BAR; PG8_WAIT_L(0); PG8_MMA(1, 0, At, B0); PG8_BAR; PG8_SCHED;
            PG8_STAGE(PG8_SB(1, 1), b3 + hstep, voffB);
            PG8_WAIT_V(6); PG8_BAR; PG8_MMA(1, 1, At, B1); PG8_BAR;
            }
        }
        if constexpr (ALIGN_EPI) { if (wr == 0) PG8_BAR; }
        if constexpr (!Epi::AFTER_DRAIN) { E(acc, cur, wr, wc, fr, fq); S.done(cur); }
        if (!has_next) break;
#pragma unroll
        for (int a = 0; a < 2; ++a)
#pragma unroll
            for (int b = 0; b < 2; ++b)
#pragma unroll
                for (int m = 0; m < 4; ++m)
#pragma unroll
                    for (int n = 0; n < 2; ++n) acc[a][b][m][n] = (f32x4){0.f, 0.f, 0.f, 0.f};
        cur = nxt; cA = nA; cB = nB; ++ui;
        if constexpr (ALIGN_EPI) { if (wr == 1) PG8_BAR; }
    }
    PG8_WAIT_V(0);
    if constexpr (!ALIGN_EPI) { if (wr == 0) PG8_BAR; }
    PG8_BAR;
    if constexpr (Epi::AFTER_DRAIN) { E.fused(acc, cur, wr, wc, fr, fq, lds, wid, lane); S.done(cur); }
#undef PG8_SA
#undef PG8_SB
#undef PG8_STAGE
#undef PG8_LDA
#undef PG8_LDB
#undef PG8_MMA
#undef PG8_WAIT_V
#undef PG8_WAIT_L
#undef PG8_BAR
#undef PG8_SCHED
}
}


struct AttnP { const bf16_t* PROJ; const float *cache_k, *cache_v, *qn, *kn, *sinks; bf16_t* YMIX; float *ko_p, *ko_s, *vo_p, *vo_s; };
constexpr int KN_STRIDE = 72, VT_STRIDE = 200, ATT_VT_OFF = 192 * KN_STRIDE * 2;
__device__ __forceinline__ void attn_unit(unsigned char* lds, int unit, const AttnP& a) {
    int tid_ = threadIdx.x; asm volatile("" : "+v"(tid_));
    const int tid = tid_, lane = tid & 63, w = __builtin_amdgcn_readfirstlane(tid >> 6), fr = lane & 15, fq = lane >> 4;
    int sq, chunk, hkv; if (unit < 512) { sq = unit >> 7; chunk = (unit & 127) >> 1; hkv = unit & 1; } else { sq = 4 + ((unit - 512) >> 1); chunk = 0; hkv = unit & 1; }
    const Seq s = seq_of(sq);
    int nk, ncache, ktok0;
    if (s.sample) { nk = 160; ncache = 128; ktok0 = s.base; }
    else { const int back = chunk < 2 ? chunk : 2; nk = 64 * (back + 1); ncache = 0; ktok0 = s.base + (chunk - back) * 64; }
    bf16_t* Kn = (bf16_t*)lds; bf16_t* Vt = (bf16_t*)(lds + ATT_VT_OFF);
    int g, mt; bool act; if (!s.sample) { g = w >> 2; mt = w & 3; act = true; } else { g = (w >> 1) & 1; mt = w & 1; act = w < 4; }
    const bf16_t* qp = a.PROJ + (size_t)(s.base + chunk * 64 + mt * 16 + fr) * NINP + C_Q + (hkv * 2 + g) * 64 + 8 * fq;
    u32x4 qr0 = {0u, 0u, 0u, 0u}, qr1 = qr0;
    if (act) { qr0 = *(const u32x4*)qp; qr1 = *(const u32x4*)(qp + 32); }
    u32x4 kraw[3], vraw[3]; f32x4 kc[3][2], vc[3][2];
#pragma unroll
    for (int q = 0; q < 3; ++q) {
        const int p = tid + 512 * q, j = p >> 3, ch = p & 7;
        kraw[q] = (u32x4){0u, 0u, 0u, 0u}; vraw[q] = kraw[q]; kc[q][0] = (f32x4){0.f, 0.f, 0.f, 0.f}; kc[q][1] = kc[q][0]; vc[q][0] = kc[q][0]; vc[q][1] = kc[q][0];
        if (p < nk * 8) {
            if (j < ncache) {
                const float* kp = a.cache_k + (((size_t)s.b * 128 + j) * 2 + hkv) * 64 + ch * 8; const float* vp = a.cache_v + (((size_t)s.b * 128 + j) * 2 + hkv) * 64 + ch * 8;
                kc[q][0] = *(const f32x4*)kp; kc[q][1] = *(const f32x4*)(kp + 4); vc[q][0] = *(const f32x4*)vp; vc[q][1] = *(const f32x4*)(vp + 4);
            } else {
                const bf16_t* pp = a.PROJ + (size_t)(ktok0 + j - ncache) * NINP + hkv * 64 + ch * 8;
                kraw[q] = *(const u32x4*)(pp + C_K); vraw[q] = *(const u32x4*)(pp + C_V);
            }
        }
    }
#pragma unroll
    for (int q = 0; q < 3; ++q) {
        const int p = tid + 512 * q, j = p >> 3, ch = p & 7;
        if (p < nk * 8) {
        float kf[8], vf[8];
        if (j < ncache) {
            kf[0] = kc[q][0].x; kf[1] = kc[q][0].y; kf[2] = kc[q][0].z; kf[3] = kc[q][0].w; kf[4] = kc[q][1].x; kf[5] = kc[q][1].y; kf[6] = kc[q][1].z; kf[7] = kc[q][1].w;
            vf[0] = vc[q][0].x; vf[1] = vc[q][0].y; vf[2] = vc[q][0].z; vf[3] = vc[q][0].w; vf[4] = vc[q][1].x; vf[5] = vc[q][1].y; vf[6] = vc[q][1].z; vf[7] = vc[q][1].w;
        } else {
            unpack8(kraw[q], kf); unpack8(vraw[q], vf);
            float ss = 0.f;
#pragma unroll
            for (int i = 0; i < 8; ++i) ss += kf[i] * kf[i];
            ss += __shfl_xor(ss, 1); ss += __shfl_xor(ss, 2); ss += __shfl_xor(ss, 4);
            const float rs = rsqrtf(ss * (1.f / 64.f) + 1e-6f);
            const f32x4 g0 = *(const f32x4*)(a.kn + ch * 8), g1 = *(const f32x4*)(a.kn + ch * 8 + 4);
            kf[0] *= rs * g0.x; kf[1] *= rs * g0.y; kf[2] *= rs * g0.z; kf[3] *= rs * g0.w; kf[4] *= rs * g1.x; kf[5] *= rs * g1.y; kf[6] *= rs * g1.z; kf[7] *= rs * g1.w;
        }
        u32x4 ko; ko.x = pk2(kf[0], kf[1]); ko.y = pk2(kf[2], kf[3]); ko.z = pk2(kf[4], kf[5]); ko.w = pk2(kf[6], kf[7]);
        *(u32x4*)(Kn + j * KN_STRIDE + ch * 8) = ko;
#pragma unroll
        for (int i = 0; i < 8; ++i) Vt[(ch * 8 + i) * VT_STRIDE + j] = f2bf(vf[i]);
        float* ko_ = nullptr; float* vo_ = nullptr;
        if (s.sample) { if (j >= 32) { ko_ = a.ko_s + ((size_t)s.b * 128 + (j - 32)) * 128 + hkv * 64 + ch * 8; vo_ = a.vo_s + ((size_t)s.b * 128 + (j - 32)) * 128 + hkv * 64 + ch * 8; } }
        else if (chunk >= 62 && j >= nk - 64) { const int jj = (chunk - 62) * 64 + (j - (nk - 64)); ko_ = a.ko_p + ((size_t)s.b * 128 + jj) * 128 + hkv * 64 + ch * 8; vo_ = a.vo_p + ((size_t)s.b * 128 + jj) * 128 + hkv * 64 + ch * 8; }
        if (ko_) { *(f32x4*)ko_ = (f32x4){kf[0], kf[1], kf[2], kf[3]}; *(f32x4*)(ko_ + 4) = (f32x4){kf[4], kf[5], kf[6], kf[7]}; *(f32x4*)vo_ = (f32x4){vf[0], vf[1], vf[2], vf[3]}; *(f32x4*)(vo_ + 4) = (f32x4){vf[4], vf[5], vf[6], vf[7]}; }
        }
    }
    __syncthreads();
    if (act) {
        const int qh = hkv * 2 + g, tok = s.base + chunk * 64 + mt * 16 + fr, nkt = nk >> 4, nks = nk >> 5;
        float qf[16]; unpack8(qr0, qf); unpack8(qr1, qf + 8);
        float ss = 0.f;
#pragma unroll
        for (int i = 0; i < 16; ++i) ss += qf[i] * qf[i];
        ss += __shfl_xor(ss, 16); ss += __shfl_xor(ss, 32);
        const float rs = rsqrtf(ss * (1.f / 64.f) + 1e-6f) * 0.125f;
#pragma unroll
        for (int i = 0; i < 8; ++i) { qf[i] *= rs * a.qn[8 * fq + i]; qf[8 + i] *= rs * a.qn[32 + 8 * fq + i]; }
        union { u32x4 u; bf16x8 v; } qa, qb;
        qa.u.x = pk2(qf[0], qf[1]); qa.u.y = pk2(qf[2], qf[3]); qa.u.z = pk2(qf[4], qf[5]); qa.u.w = pk2(qf[6], qf[7]);
        qb.u.x = pk2(qf[8], qf[9]); qb.u.y = pk2(qf[10], qf[11]); qb.u.z = pk2(qf[12], qf[13]); qb.u.w = pk2(qf[14], qf[15]);
        f32x4 sacc[12];
        const float sink = a.sinks[qh];
        float m = sink;
#pragma unroll
        for (int kt = 0; kt < 12; ++kt) {
            sacc[kt] = (f32x4){0.f, 0.f, 0.f, 0.f};
            if (kt < nkt) {
                const bf16x8 k0 = *(const bf16x8*)(Kn + (kt * 16 + fr) * KN_STRIDE + 8 * fq), k1 = *(const bf16x8*)(Kn + (kt * 16 + fr) * KN_STRIDE + 32 + 8 * fq);
                sacc[kt] = __builtin_amdgcn_mfma_f32_16x16x32_bf16(k0, qa.v, sacc[kt], 0, 0, 0);
                sacc[kt] = __builtin_amdgcn_mfma_f32_16x16x32_bf16(k1, qb.v, sacc[kt], 0, 0, 0);
                m = fmaxf(m, fmaxf(fmaxf(sacc[kt].x, sacc[kt].y), fmaxf(sacc[kt].z, sacc[kt].w)));
            }
        }
        m = fmaxf(m, __shfl_xor(m, 16)); m = fmaxf(m, __shfl_xor(m, 32));
        float lsum = 0.f;
#pragma unroll
        for (int kt = 0; kt < 12; ++kt) if (kt < nkt) {
            sacc[kt].x = __expf(sacc[kt].x - m); sacc[kt].y = __expf(sacc[kt].y - m); sacc[kt].z = __expf(sacc[kt].z - m); sacc[kt].w = __expf(sacc[kt].w - m);
            lsum += (sacc[kt].x + sacc[kt].y) + (sacc[kt].z + sacc[kt].w);
        }
        lsum += __shfl_xor(lsum, 16); lsum += __shfl_xor(lsum, 32);
        lsum += __expf(sink - m);
        f32x4 oacc[4];
#pragma unroll
        for (int dt = 0; dt < 4; ++dt) oacc[dt] = (f32x4){0.f, 0.f, 0.f, 0.f};
#pragma unroll
        for (int ks = 0; ks < 6; ++ks) if (ks < nks) {
            union { u32x4 u; bf16x8 v; } pf;
            pf.u.x = pk2(sacc[2 * ks].x, sacc[2 * ks].y); pf.u.y = pk2(sacc[2 * ks].z, sacc[2 * ks].w); pf.u.z = pk2(sacc[2 * ks + 1].x, sacc[2 * ks + 1].y); pf.u.w = pk2(sacc[2 * ks + 1].z, sacc[2 * ks + 1].w);
#pragma unroll
            for (int dt = 0; dt < 4; ++dt) {
                union { u32x4 u; bf16x8 v; } vf;
                const u32x2 lo = *(const u32x2*)(Vt + (dt * 16 + fr) * VT_STRIDE + 32 * ks + 4 * fq), hi2 = *(const u32x2*)(Vt + (dt * 16 + fr) * VT_STRIDE + 32 * ks + 16 + 4 * fq);
                vf.u.x = lo.x; vf.u.y = lo.y; vf.u.z = hi2.x; vf.u.w = hi2.y;
                oacc[dt] = __builtin_amdgcn_mfma_f32_16x16x32_bf16(vf.v, pf.v, oacc[dt], 0, 0, 0);
            }
        }
        const float inv = 1.f / lsum;
#pragma unroll
        for (int dt = 0; dt < 4; ++dt) { u32x2 o; o.x = pk2(oacc[dt].x * inv, oacc[dt].y * inv); o.y = pk2(oacc[dt].z * inv, oacc[dt].w * inv);
            *(u32x2*)(a.YMIX + (size_t)tok * DM + 768 + qh * 64 + dt * 16 + 4 * fq) = o; }
    }
    __syncthreads();
}

struct ConvPoolP { const bf16_t* PROJ; const float *cache_conv, *cw, *cb, *lg, *lb, *cache_pool, *pw, *psc; bf16_t* YMIX; float *co_p, *co_s, *po_p, *po_s; const bf16_t *GLU, *PWT; };
__device__ __forceinline__ void convpool_tile(float* sm, int tile, const ConvPoolP& a) {
    int tid_ = threadIdx.x; asm volatile("" : "+v"(tid_));
    int c = tid_ & 255;
#define RELAUNDER() asm volatile("" : "+v"(c))
    int sq, t0; if (tile < 1024) { sq = tile >> 8; t0 = (tile & 255) * 16; } else { sq = 4 + ((tile - 1024) >> 1); t0 = ((tile - 1024) & 1) * 16; }
    const Seq s = seq_of(sq);
    float* ext = sm;
    float* yb = sm + 46 * 256;
    bf16_t* db = (bf16_t*)yb;
    {
        u32x4 vv[6]; f32x4 h0[6], h1[6];
#pragma unroll
        for (int q = 0; q < 6; ++q) {
            const int pr = c + 256 * q, i = pr >> 5, cg = pr & 31, t = t0 - 30 + i;
            vv[q] = (u32x4){0u, 0u, 0u, 0u}; h0[q] = (f32x4){0.f, 0.f, 0.f, 0.f}; h1[q] = h0[q];
            if (i < 46) {
                if (t >= 0) vv[q] = *(const u32x4*)(a.GLU + (size_t)(s.base + t) * 256 + cg * 8);
                else if (s.sample) { const float* p = a.cache_conv + ((size_t)s.b * 30 + 30 + t) * 256 + cg * 8; h0[q] = *(const f32x4*)p; h1[q] = *(const f32x4*)(p + 4); }
            }
        }
#pragma unroll
        for (int q = 0; q < 6; ++q) {
            const int pr = c + 256 * q, i = pr >> 5, cg = pr & 31, t = t0 - 30 + i;
            if (i < 46) {
                f32x4 e0 = h0[q], e1 = h1[q];
                if (t >= 0) { float v[8]; unpack8(vv[q], v); e0 = (f32x4){v[0], v[1], v[2], v[3]}; e1 = (f32x4){v[4], v[5], v[6], v[7]}; }
                *(f32x4*)(ext + i * 256 + cg * 8) = e0; *(f32x4*)(ext + i * 256 + cg * 8 + 4) = e1;
            }
        }
    }
    __syncthreads(); RELAUNDER();
    {
        float e[46];
#pragma unroll
        for (int i = 0; i < 46; ++i) e[i] = ext[i * 256 + c];
        float* o = s.sample ? a.co_s + (size_t)s.b * 30 * 256 : a.co_p + (size_t)s.b * 30 * 256;
        if (t0 + 15 >= s.L - 30) {
#pragma unroll
            for (int i = 0; i < 16; ++i) { const int t = t0 + i; if (t >= s.L - 30) o[(t - (s.L - 30)) * 256 + c] = e[i + 30]; }
        }
        float y[16]; const float bias = a.cb[c];
#pragma unroll
        for (int i = 0; i < 16; ++i) y[i] = bias;
#pragma unroll
        for (int j = 0; j < 31; ++j) { const float wj = a.cw[j * 256 + c];
#pragma unroll
            for (int i = 0; i < 16; ++i) y[i] += wj * e[i + j]; }
#pragma unroll
        for (int i = 0; i < 16; ++i) yb[i * 256 + c] = y[i];
    }
    __syncthreads(); RELAUNDER();
    u32x4 pv[4]; f32x4 ph0[4], ph1[4];
#pragma unroll
    for (int q = 0; q < 4; ++q) {
        const int pr = c + 256 * q, i = pr >> 5, cg = pr & 31, t = t0 - 15 + i;
        pv[q] = (u32x4){0u, 0u, 0u, 0u}; ph0[q] = (f32x4){0.f, 0.f, 0.f, 0.f}; ph1[q] = ph0[q];
        if (i < 31) {
            if (t >= 0) pv[q] = *(const u32x4*)(a.PROJ + (size_t)(s.base + t) * NINP + C_C + cg * 8);
            else if (s.sample) { const float* p = a.cache_pool + ((size_t)s.b * 15 + 15 + t) * 256 + cg * 8; ph0[q] = *(const f32x4*)p; ph1[q] = *(const f32x4*)(p + 4); }
        }
    }
    {
        const int wv = c >> 6, lane = c & 63;
        const f32x4 g4 = ((const f32x4*)a.lg)[lane], b4 = ((const f32x4*)a.lb)[lane];
#pragma unroll 1
        for (int i = wv; i < 16; i += 4) {
            const f32x4 v = ((const f32x4*)(yb + i * 256))[lane];
            const float mean = wave_sum((v.x + v.y) + (v.z + v.w)) * (1.f / 256.f);
            const f32x4 d = v - mean;
            const float var = wave_sum((d.x * d.x + d.y * d.y) + (d.z * d.z + d.w * d.w)) * (1.f / 256.f);
            const float rstd = rsqrtf(var + 1e-5f);
            f32x4 o = d * rstd * g4 + b4;
            o.x *= sigmoidf_(o.x); o.y *= sigmoidf_(o.y); o.z *= sigmoidf_(o.z); o.w *= sigmoidf_(o.w);
            *(u32x2*)(a.YMIX + (size_t)(s.base + t0 + i) * DM + 0 + lane * 4) = pk4(o);
        }
    }
    __syncthreads(); RELAUNDER();
#pragma unroll
    for (int q = 0; q < 4; ++q) {
        const int pr = c + 256 * q, i = pr >> 5, cg = pr & 31, t = t0 - 15 + i;
        if (i < 31) {
            f32x4 e0 = ph0[q], e1 = ph1[q];
            if (t >= 0) { float v[8]; unpack8(pv[q], v); e0 = (f32x4){v[0], v[1], v[2], v[3]}; e1 = (f32x4){v[4], v[5], v[6], v[7]}; }
            *(f32x4*)(ext + i * 256 + cg * 8) = e0; *(f32x4*)(ext + i * 256 + cg * 8 + 4) = e1;
        }
    }
    __syncthreads(); RELAUNDER();
    {
        float e[31];
#pragma unroll
        for (int i = 0; i < 31; ++i) e[i] = ext[i * 256 + c];
        float* o = s.sample ? a.po_s + (size_t)s.b * 15 * 256 : a.po_p + (size_t)s.b * 15 * 256;
        if (t0 + 15 >= s.L - 15) {
#pragma unroll
            for (int i = 0; i < 16; ++i) { const int t = t0 + i; if (t >= s.L - 15) o[(t - (s.L - 15)) * 256 + c] = e[i + 15]; }
        }
        const int g = __builtin_amdgcn_readfirstlane(c >> 6), w = 2 << g;
        float w2[16], w4[16], w8[16], w16[16];
#pragma unroll
        for (int i = 0; i < 16; ++i) w2[i] = e[15 + i] + e[14 + i];
        if (g >= 1) {
#pragma unroll
            for (int i = 0; i < 16; ++i) w4[i] = (e[15 + i] + e[14 + i]) + (e[13 + i] + e[12 + i]);
        }
        if (g >= 2) {
#pragma unroll
            for (int i = 0; i < 16; ++i) w8[i] = ((e[15 + i] + e[14 + i]) + (e[13 + i] + e[12 + i])) + ((e[11 + i] + e[10 + i]) + (e[9 + i] + e[8 + i]));
        }
        if (g == 3) {
            float cs[32]; cs[0] = e[0];
#pragma unroll
            for (int k = 1; k < 31; ++k) cs[k] = cs[k - 1] + e[k];
#pragma unroll
            for (int i = 0; i < 16; ++i) w16[i] = i == 0 ? cs[15] : cs[15 + i] - cs[i - 1];
        }
#pragma unroll
        for (int i = 0; i < 16; ++i) {
            const float sum = g == 0 ? w2[i] : (g == 1 ? w4[i] : (g == 2 ? w8[i] : w16[i]));
            const int pos = s.pos0 + t0 + i; const int cnt = (pos + 1) < w ? (pos + 1) : w;
            db[i * 264 + c] = f2bf(sum * __builtin_amdgcn_rcpf((float)cnt) - e[15 + i]);
        }
    }
    __syncthreads(); RELAUNDER();
    {
        const int g = __builtin_amdgcn_readfirstlane(c >> 6), lane = c & 63, fr = lane & 15, fq = lane >> 4;
        const bf16x8 d0 = *(const bf16x8*)(db + fr * 264 + g * 64 + 8 * fq), d1 = *(const bf16x8*)(db + fr * 264 + g * 64 + 32 + 8 * fq);
#pragma unroll
        for (int dt = 0; dt < 4; ++dt) {
            const bf16_t* wp = a.PWT + ((size_t)g * 64 + 16 * dt + fr) * 64 + 8 * fq;
            f32x4 acc = __builtin_amdgcn_mfma_f32_16x16x32_bf16(*(const bf16x8*)wp, d0, (f32x4){0.f, 0.f, 0.f, 0.f}, 0, 0, 0);
            acc = __builtin_amdgcn_mfma_f32_16x16x32_bf16(*(const bf16x8*)(wp + 32), d1, acc, 0, 0, 0);
            acc *= *(const f32x4*)(a.psc + g * 64 + 16 * dt + 4 * fq);
            *(u32x2*)(a.YMIX + (size_t)(s.base + t0 + fr) * DM + 512 + g * 64 + 16 * dt + 4 * fq) = pk4(acc);
        }
    }
    __syncthreads();
#undef RELAUNDER
}

struct RwkvG { bf16_t *PT, *QQ, *ZZ, *Y0, *SC, *GATE, *BV; const bf16_t* LWT; };
constexpr int RC_HEAD = 30208, RC_MAB = 0, RC_MAK = 4608, RC_MRB = 7168, RC_MRK = 9728, RC_TM = 12288, RC_MAKVT = 14848, RC_GT = 19968, RC_U0T = 25088;
constexpr int RB_BASE = 2 * RC_HEAD, RB_HEAD = 38912, RB_AT = 0, RB_BH = 4608, RB_KH = 9216, RB_RT = 13824, RB_ATT = 18432, RB_BHT = 23552, RB_KHT = 28672, RB_VT = 33792;
constexpr int RA_LAT = 0, RA_WL = 8704, RA_AL = 25088, RA_SCN = 41472, R_WLS = RB_BASE + 2 * RB_HEAD;
constexpr int NS = 72, TS = 40, LATS = 136, MABS = 36;
__device__ __forceinline__ bf16x8 ldf(const bf16_t* base, int row, int stride, int col) { return *(const bf16x8*)(base + row * stride + col); }
#define MFMA16(a, b, c) __builtin_amdgcn_mfma_f32_16x16x32_bf16((a), (b), (c), 0, 0, 0)

__device__ __forceinline__ void rwkv_item(unsigned char* lds, int item, int l, const bf16_t* __restrict__ PROJ, const float* __restrict__ shift_in, const RwkvW& w, const RwkvG& G) {
    int tid = threadIdx.x; asm volatile("" : "+v"(tid));
    const int wv = __builtin_amdgcn_readfirstlane(tid >> 6);
    const int cid = item >> 1, hp = item & 1, tok0 = cid * 32;
    const bool sample = cid >= 512, first = sample || ((cid & 127) == 0);
    const int sb = cid - 512;
    bf16_t* LAT = (bf16_t*)(lds + RA_LAT); float* WLb = (float*)(lds + RA_WL); float* ALb = (float*)(lds + RA_AL); float* SCN = (float*)(lds + RA_SCN); float* WLs = (float*)(lds + R_WLS);
    const int lane0 = tid & 63, fr0 = lane0 & 15, fq0 = lane0 >> 4;
    const bf16_t* lwp = G.LWT + ((size_t)l * 256 + hp * 128 + 16 * wv + fr0) * 128 + 8 * fq0;
    const bf16x8 fw = *(const bf16x8*)(lwp), fa = *(const bf16x8*)(lwp + 32), fg0 = *(const bf16x8*)(lwp + 64), fg1 = *(const bf16x8*)(lwp + 96);
    const f32x4 w0v = *(const f32x4*)(w.w0 + hp * 128 + 16 * wv + 4 * fq0), a0v = *(const f32x4*)(w.a0 + hp * 128 + 16 * wv + 4 * fq0);
    const int c3 = tid & 127, tq3 = tid >> 7, cg3 = hp * 128 + c3;
    float ur[9], uk[9], uv[9];
#pragma unroll
    for (int i = 0; i < 9; ++i) {
        const int t = 8 * tq3 - 1 + i;
        if (t >= 0 || !first) { const bf16_t* p = PROJ + (size_t)(tok0 + t) * NINP + C_B + cg3; ur[i] = bf2f(p[0]); uk[i] = bf2f(p[256]); uv[i] = bf2f(p[512]); }
        else if (sample) { const float* p = shift_in + (size_t)sb * 896 + cg3; ur[i] = p[0]; uk[i] = p[256]; uv[i] = p[512]; }
        else { ur[i] = 0.f; uk[i] = 0.f; uv[i] = 0.f; }
    }
    const float mur = w.mu[cg3], muk = w.mu[256 + cg3], muv = w.mu[512 + cg3], kkw = w.k_k[cg3], kaw = w.k_a[cg3], rkw = w.r_k[cg3];
    {
        const int t = tid >> 4, j8 = (tid & 15) * 8, col = 768 + j8;
        float u[8], pv[8];
        unpack8(*(const u32x4*)(PROJ + (size_t)(tok0 + t) * NINP + C_B + col), u);
        if (t > 0 || !first) unpack8(*(const u32x4*)(PROJ + (size_t)(tok0 + t - 1) * NINP + C_B + col), pv);
        else if (sample) { const f32x4 a = *(const f32x4*)(shift_in + (size_t)sb * 896 + col), b = *(const f32x4*)(shift_in + (size_t)sb * 896 + col + 4); pv[0] = a.x; pv[1] = a.y; pv[2] = a.z; pv[3] = a.w; pv[4] = b.x; pv[5] = b.y; pv[6] = b.z; pv[7] = b.w; }
        else {
#pragma unroll
            for (int i = 0; i < 8; ++i) pv[i] = 0.f; }
        const f32x4 m0 = *(const f32x4*)(w.mu + col), m1 = *(const f32x4*)(w.mu + col + 4);
        const float mu[8] = {m0.x, m0.y, m0.z, m0.w, m1.x, m1.y, m1.z, m1.w};
        float x[8];
#pragma unroll
        for (int i = 0; i < 8; ++i) { const float xs = u[i] + mu[i] * (pv[i] - u[i]); x[i] = j8 < 32 ? 1.f - 2.f / (1.f + __expf(2.f * xs)) : (j8 < 64 ? xs : sigmoidf_(xs)); }
        u32x4 o; o.x = pk2(x[0], x[1]); o.y = pk2(x[2], x[3]); o.z = pk2(x[4], x[5]); o.w = pk2(x[6], x[7]);
        *(u32x4*)(LAT + t * LATS + j8) = o;
    }
    __syncthreads();
    {
        asm volatile("" : "+v"(tid)); const int lane = tid & 63, fr = lane & 15, fq = lane >> 4;
        const int c0l = 16 * wv, cg0 = hp * 128 + c0l;
#pragma unroll
        for (int tt = 0; tt < 2; ++tt) {
            const int t = 16 * tt + fr;
            const f32x4 z = {0.f, 0.f, 0.f, 0.f};
            f32x4 aw = MFMA16(fw, ldf(LAT, t, LATS, 8 * fq), z);
            f32x4 aa = MFMA16(fa, ldf(LAT, t, LATS, 32 + 8 * fq), z);
            f32x4 ag = MFMA16(fg0, ldf(LAT, t, LATS, 64 + 8 * fq), z);
            ag = MFMA16(fg1, ldf(LAT, t, LATS, 96 + 8 * fq), ag);
            *(f32x4*)(WLb + t * 128 + c0l + 4 * fq) = aw + w0v;
            *(f32x4*)(ALb + t * 128 + c0l + 4 * fq) = aa + a0v;
            *(u32x2*)(G.GATE + (size_t)(tok0 + t) * 256 + cg0 + 4 * fq) = pk4(ag);
        }
    }
    __syncthreads();
    {
        asm volatile("" : "+v"(tid));
        const int c = tid & 127, tq = tid >> 7, hd = c >> 6, c64 = c & 63, cg = hp * 128 + c;
        unsigned char* hb = lds + RB_BASE + hd * RB_HEAD;
        bf16_t *AT = (bf16_t*)(hb + RB_AT), *BH = (bf16_t*)(hb + RB_BH), *KH = (bf16_t*)(hb + RB_KH), *RT = (bf16_t*)(hb + RB_RT);
        bf16_t *ATt = (bf16_t*)(hb + RB_ATT), *BHt = (bf16_t*)(hb + RB_BHT), *KHt = (bf16_t*)(hb + RB_KHT), *Vt = (bf16_t*)(hb + RB_VT);
        float lw[8], cl[8];
        float run = 0.f;
#pragma unroll
        for (int i = 0; i < 8; ++i) { lw[i] = -0.60653066f * sigmoidf_(WLb[(8 * tq + i) * 128 + c]); run += lw[i]; cl[i] = run; }
        SCN[tq * 128 + c] = run;
        __syncthreads();
        float pre = 0.f, tot = 0.f;
#pragma unroll
        for (int q = 0; q < 4; ++q) { const float v = SCN[q * 128 + c]; tot += v; if (q < tq) pre += v; }
        if (tq == 0) WLs[c] = __expf(tot);
        float at8[8], bh8[8], kh8[8], vv8[8];
        float rr8[8], kk8[8], km8[8], ar8[8], ss8[8], bo8[8];
#pragma unroll
        for (int i = 0; i < 8; ++i) {
            const int t = 8 * tq + i;
            rr8[i] = ur[i + 1] + mur * (ur[i] - ur[i + 1]); const float k = uk[i + 1] + muk * (uk[i] - uk[i + 1]); vv8[i] = uv[i + 1] + muv * (uv[i] - uv[i + 1]);
            ar8[i] = __builtin_amdgcn_rcpf(1.f + __expf(-ALb[t * 128 + c]));
            kk8[i] = k * kkw; km8[i] = k * (1.f + (ar8[i] - 1.f) * kaw);
            ss8[i] = kk8[i] * kk8[i]; bo8[i] = rr8[i] * km8[i] * rkw;
        }
#pragma unroll
        for (int o = 1; o < 64; o <<= 1) {
#pragma unroll
            for (int i = 0; i < 8; ++i) { ss8[i] += __shfl_xor(ss8[i], o); bo8[i] += __shfl_xor(bo8[i], o); }
        }
#pragma unroll
        for (int i = 0; i < 8; ++i) {
            const int t = 8 * tq + i;
            const float cum = pre + cl[i];
            const float W = __expf(cum), Wp = __expf(cum - lw[i]), iW = __expf(-cum);
            const float kkn = kk8[i] * __builtin_amdgcn_rcpf(fmaxf(sqrtf(ss8[i]), 1e-12f));
            const float at = -kkn * Wp, bh = kkn * ar8[i] * iW, kh = km8[i] * iW, rt = rr8[i] * W;
            AT[t * NS + c64] = f2bf(at); BH[t * NS + c64] = f2bf(bh); KH[t * NS + c64] = f2bf(kh); RT[t * NS + c64] = f2bf(rt);
            at8[i] = at; bh8[i] = bh; kh8[i] = kh;
            G.BV[(size_t)(tok0 + t) * 256 + cg] = f2bf(bo8[i] * vv8[i]);
        }
        u32x4 o;
        o.x = pk2(at8[0], at8[1]); o.y = pk2(at8[2], at8[3]); o.z = pk2(at8[4], at8[5]); o.w = pk2(at8[6], at8[7]); *(u32x4*)(ATt + c64 * TS + 8 * tq) = o;
        o.x = pk2(bh8[0], bh8[1]); o.y = pk2(bh8[2], bh8[3]); o.z = pk2(bh8[4], bh8[5]); o.w = pk2(bh8[6], bh8[7]); *(u32x4*)(BHt + c64 * TS + 8 * tq) = o;
        o.x = pk2(kh8[0], kh8[1]); o.y = pk2(kh8[2], kh8[3]); o.z = pk2(kh8[4], kh8[5]); o.w = pk2(kh8[6], kh8[7]); *(u32x4*)(KHt + c64 * TS + 8 * tq) = o;
        o.x = pk2(vv8[0], vv8[1]); o.y = pk2(vv8[2], vv8[3]); o.z = pk2(vv8[4], vv8[5]); o.w = pk2(vv8[6], vv8[7]); *(u32x4*)(Vt + c64 * TS + 8 * tq) = o;
    }
    __syncthreads();
    asm volatile("" : "+v"(tid)); const int lane = tid & 63, fr = lane & 15, fq = lane >> 4;
    const int hd = wv >> 2, wg = wv & 3, h = hp * 2 + hd; const size_t ch = (size_t)cid * 4 + h;
    unsigned char* hb = lds + RB_BASE + hd * RB_HEAD; unsigned char* cb = lds + hd * RC_HEAD;
    const bf16_t *AT = (const bf16_t*)(hb + RB_AT), *BH = (const bf16_t*)(hb + RB_BH), *KH = (const bf16_t*)(hb + RB_KH), *RT = (const bf16_t*)(hb + RB_RT);
    const bf16_t *ATt = (const bf16_t*)(hb + RB_ATT), *BHt = (const bf16_t*)(hb + RB_BHT), *KHt = (const bf16_t*)(hb + RB_KHT), *Vt = (const bf16_t*)(hb + RB_VT);
    float* Mab = (float*)(cb + RC_MAB);
    bf16_t *Mak = (bf16_t*)(cb + RC_MAK), *Mrb = (bf16_t*)(cb + RC_MRB), *Mrk = (bf16_t*)(cb + RC_MRK), *Tm = (bf16_t*)(cb + RC_TM), *MakVt = (bf16_t*)(cb + RC_MAKVT), *GT = (bf16_t*)(cb + RC_GT), *U0T = (bf16_t*)(cb + RC_U0T);
    const f32x4 z4 = {0.f, 0.f, 0.f, 0.f};
    {
        const bf16_t* rowsrc = (wg >> 1) ? RT : AT; const bf16_t* colsrc = (wg & 1) ? KH : BH;
        bf16_t* Mo = wg == 1 ? Mak : (wg == 2 ? Mrb : Mrk);
#pragma unroll
        for (int tt = 0; tt < 2; ++tt)
#pragma unroll
            for (int st = 0; st < 2; ++st) {
                f32x4 acc = MFMA16(ldf(colsrc, 16 * st + fr, NS, 8 * fq), ldf(rowsrc, 16 * tt + fr, NS, 8 * fq), z4);
                acc = MFMA16(ldf(colsrc, 16 * st + fr, NS, 32 + 8 * fq), ldf(rowsrc, 16 * tt + fr, NS, 32 + 8 * fq), acc);
                const int t = 16 * tt + fr, s0 = 16 * st + 4 * fq, lim = (wg >> 1) ? t + 1 : t;
                acc.x = (s0 + 0 < lim) ? acc.x : 0.f; acc.y = (s0 + 1 < lim) ? acc.y : 0.f; acc.z = (s0 + 2 < lim) ? acc.z : 0.f; acc.w = (s0 + 3 < lim) ? acc.w : 0.f;
                if (wg == 0) *(f32x4*)(Mab + t * MABS + s0) = acc; else *(u32x2*)(Mo + t * TS + s0) = pk4(acc);
            }
    }
    __syncthreads();
    const float* WL = (const float*)(lds + R_WLS) + hd * 64;
    if (wg == 0) {
        {
            const int j = lane & 31;
            float Tc[32];
            f32x4 cur[8];
#pragma unroll
            for (int q = 0; q < 8; ++q) cur[q] = (f32x4){0.f, 0.f, 0.f, 0.f};
#pragma unroll
            for (int t = 0; t < 32; ++t) {
                f32x4 nx[8];
#pragma unroll
                for (int q = 0; q < 8; ++q) nx[q] = (t + 1 < 32 && 4 * q < t + 1) ? *(const f32x4*)(Mab + (t + 1) * MABS + 4 * q) : (f32x4){0.f, 0.f, 0.f, 0.f};
                float a0 = (t == j) ? 1.f : 0.f, a1 = 0.f;
#pragma unroll
                for (int s2 = 0; s2 < t; ++s2) { const float nv = cur[s2 >> 2][s2 & 3]; if (s2 & 1) a1 += nv * Tc[s2]; else a0 += nv * Tc[s2]; }
                Tc[t] = a0 + a1;
#pragma unroll
                for (int q = 0; q < 8; ++q) cur[q] = nx[q];
            }
            if (lane < 32) {
#pragma unroll
                for (int t = 0; t < 32; ++t) Tm[t * TS + j] = f2bf(Tc[t]);
            }
        }
        __syncthreads();
#pragma unroll
        for (int rt = 0; rt < 2; ++rt)
#pragma unroll
            for (int tt = 0; tt < 2; ++tt) {
                const f32x4 acc = MFMA16(ldf(Tm, 16 * tt + fr, TS, 8 * fq), ldf(ATt, 16 * rt + fr, TS, 8 * fq), z4);
                *(u32x2*)(GT + (16 * rt + fr) * TS + 16 * tt + 4 * fq) = pk4(acc);
            }
        __syncthreads();
#pragma unroll
        for (int tt = 0; tt < 2; ++tt)
#pragma unroll
            for (int ks = 0; ks < 2; ++ks) {
                u32x2 pc[2];
#pragma unroll
                for (int hf = 0; hf < 2; ++hf) {
                    const int kt = 2 * ks + hf;
                    f32x4 acc = MFMA16(ldf(GT, 16 * kt + fr, TS, 8 * fq), ldf(Mrb, 16 * tt + fr, TS, 8 * fq), z4);
                    const int t = 16 * tt + fr, k0 = 16 * kt + 4 * fq;
                    const u32x2 rr = *(const u32x2*)(RT + t * NS + k0);
                    acc.x += __uint_as_float(rr.x << 16); acc.y += __uint_as_float(rr.x & 0xffff0000u); acc.z += __uint_as_float(rr.y << 16); acc.w += __uint_as_float(rr.y & 0xffff0000u);
                    pc[hf] = pk4(acc);
                }
                *(u32x4*)(G.ZZ + ch * 2048 + ((tt * 2 + ks) * 64 + lane) * 8) = (u32x4){pc[0].x, pc[0].y, pc[1].x, pc[1].y};
            }
    } else if (wg == 1) {
#pragma unroll
        for (int vt = 0; vt < 4; ++vt)
#pragma unroll
            for (int tt = 0; tt < 2; ++tt) {
                const f32x4 acc = MFMA16(ldf(Mak, 16 * tt + fr, TS, 8 * fq), ldf(Vt, 16 * vt + fr, TS, 8 * fq), z4);
                *(u32x2*)(MakVt + (16 * vt + fr) * TS + 16 * tt + 4 * fq) = pk4(acc);
            }
        __syncthreads();
#pragma unroll
        for (int rt = 2; rt < 4; ++rt)
#pragma unroll
            for (int tt = 0; tt < 2; ++tt) {
                const f32x4 acc = MFMA16(ldf(Tm, 16 * tt + fr, TS, 8 * fq), ldf(ATt, 16 * rt + fr, TS, 8 * fq), z4);
                *(u32x2*)(GT + (16 * rt + fr) * TS + 16 * tt + 4 * fq) = pk4(acc);
            }
        __syncthreads();
#pragma unroll
        for (int kp = 0; kp < 4; ++kp)
#pragma unroll
            for (int ks = 0; ks < 2; ++ks) {
                u32x2 pc[2];
#pragma unroll
                for (int hf = 0; hf < 2; ++hf) {
                    const int kt = 2 * ks + hf;
                    f32x4 acc = MFMA16(ldf(GT, 16 * kt + fr, TS, 8 * fq), ldf(BHt, 16 * kp + fr, TS, 8 * fq), z4);
                    const int kq = 16 * kp + fr, k0 = 16 * kt + 4 * fq; const float wl = WL[kq];
                    acc.x = (acc.x + (k0 + 0 == kq ? 1.f : 0.f)) * wl; acc.y = (acc.y + (k0 + 1 == kq ? 1.f : 0.f)) * wl; acc.z = (acc.z + (k0 + 2 == kq ? 1.f : 0.f)) * wl; acc.w = (acc.w + (k0 + 3 == kq ? 1.f : 0.f)) * wl;
                    pc[hf] = pk4(acc);
                }
                *(u32x4*)(G.PT + ch * 4096 + ((kp * 2 + ks) * 64 + lane) * 8) = (u32x4){pc[0].x, pc[0].y, pc[1].x, pc[1].y};
            }
    } else if (wg == 2) {
        f32x4 y0acc[2][4];
#pragma unroll
        for (int tt = 0; tt < 2; ++tt)
#pragma unroll
            for (int vt = 0; vt < 4; ++vt) y0acc[tt][vt] = MFMA16(ldf(Vt, 16 * vt + fr, TS, 8 * fq), ldf(Mrk, 16 * tt + fr, TS, 8 * fq), z4);
        __syncthreads();
#pragma unroll
        for (int rt = 0; rt < 2; ++rt)
#pragma unroll
            for (int tt = 0; tt < 2; ++tt) {
                const f32x4 acc = MFMA16(ldf(Tm, 16 * tt + fr, TS, 8 * fq), ldf(MakVt, 16 * rt + fr, TS, 8 * fq), z4);
                *(u32x2*)(U0T + (16 * rt + fr) * TS + 16 * tt + 4 * fq) = pk4(acc);
            }
        __syncthreads();
#pragma unroll
        for (int tt = 0; tt < 2; ++tt)
#pragma unroll
            for (int vp = 0; vp < 2; ++vp) {
                const f32x4 a0 = MFMA16(ldf(U0T, 16 * (2 * vp) + fr, TS, 8 * fq), ldf(Mrb, 16 * tt + fr, TS, 8 * fq), y0acc[tt][2 * vp]);
                const f32x4 a1 = MFMA16(ldf(U0T, 16 * (2 * vp + 1) + fr, TS, 8 * fq), ldf(Mrb, 16 * tt + fr, TS, 8 * fq), y0acc[tt][2 * vp + 1]);
                const u32x2 p0 = pk4(a0), p1 = pk4(a1);
                *(u32x4*)(G.Y0 + ch * 2048 + ((tt * 2 + vp) * 64 + lane) * 8) = (u32x4){p0.x, p0.y, p1.x, p1.y};
            }
    } else {
        f32x4 qacc[4][4];
#pragma unroll
        for (int vt = 0; vt < 4; ++vt)
#pragma unroll
            for (int kt = 0; kt < 4; ++kt) qacc[vt][kt] = MFMA16(ldf(KHt, 16 * kt + fr, TS, 8 * fq), ldf(Vt, 16 * vt + fr, TS, 8 * fq), z4);
        __syncthreads();
#pragma unroll
        for (int rt = 2; rt < 4; ++rt)
#pragma unroll
            for (int tt = 0; tt < 2; ++tt) {
                const f32x4 acc = MFMA16(ldf(Tm, 16 * tt + fr, TS, 8 * fq), ldf(MakVt, 16 * rt + fr, TS, 8 * fq), z4);
                *(u32x2*)(U0T + (16 * rt + fr) * TS + 16 * tt + 4 * fq) = pk4(acc);
            }
        __syncthreads();
#pragma unroll
        for (int vt = 0; vt < 4; ++vt)
#pragma unroll
            for (int hf2 = 0; hf2 < 2; ++hf2) {
                u32x2 pc[2];
#pragma unroll
                for (int hf = 0; hf < 2; ++hf) {
                    const int kt = 2 * hf2 + hf;
                    f32x4 acc = MFMA16(ldf(BHt, 16 * kt + fr, TS, 8 * fq), ldf(U0T, 16 * vt + fr, TS, 8 * fq), qacc[vt][kt]);
                    acc *= *(const f32x4*)(WL + 16 * kt + 4 * fq);
                    pc[hf] = pk4(acc);
                }
                *(u32x4*)(G.QQ + ch * 4096 + ((vt * 2 + hf2) * 64 + lane) * 8) = (u32x4){pc[0].x, pc[0].y, pc[1].x, pc[1].y};
            }
    }
    __syncthreads();
}

__device__ __forceinline__ void chain_step(f32x4 (&acc)[4], const bf16x8 (&fa)[4][2], u32x4 q01, u32x4 q23, bf16_t* __restrict__ scp) {
    union { u32x4 u; bf16x8 v; } bs[2];
    const u32x2 a = pk4(acc[0]), b = pk4(acc[1]), c2 = pk4(acc[2]), d = pk4(acc[3]);
    *(u32x4*)(scp) = (u32x4){a.x, a.y, b.x, b.y}; *(u32x4*)(scp + 512) = (u32x4){c2.x, c2.y, d.x, d.y};
    bs[0].u = (u32x4){a.x, a.y, b.x, b.y}; bs[1].u = (u32x4){c2.x, c2.y, d.x, d.y};
    acc[0] = (f32x4){__uint_as_float(q01.x << 16), __uint_as_float(q01.x & 0xffff0000u), __uint_as_float(q01.y << 16), __uint_as_float(q01.y & 0xffff0000u)};
    acc[1] = (f32x4){__uint_as_float(q01.z << 16), __uint_as_float(q01.z & 0xffff0000u), __uint_as_float(q01.w << 16), __uint_as_float(q01.w & 0xffff0000u)};
    acc[2] = (f32x4){__uint_as_float(q23.x << 16), __uint_as_float(q23.x & 0xffff0000u), __uint_as_float(q23.y << 16), __uint_as_float(q23.y & 0xffff0000u)};
    acc[3] = (f32x4){__uint_as_float(q23.z << 16), __uint_as_float(q23.z & 0xffff0000u), __uint_as_float(q23.w << 16), __uint_as_float(q23.w & 0xffff0000u)};
#pragma unroll
    for (int it = 0; it < 4; ++it) { acc[it] = MFMA16(fa[it][0], bs[0].v, acc[it]); acc[it] = MFMA16(fa[it][1], bs[1].v, acc[it]); }
}
__device__ __forceinline__ void rwkv_chain1(int sq, int h, int wg, const float* __restrict__ state_in, const RwkvG& G, float* __restrict__ st_s) {
    int tid_ = threadIdx.x; asm volatile("" : "+v"(tid_));
    const int lane = tid_ & 63, fr = lane & 15, fq = lane >> 4, j0 = 16 * wg;
    const Seq s = seq_of(sq);
    const size_t ch = (size_t)(s.base / 32) * 4 + h;
    f32x4 acc[4];
#pragma unroll
    for (int it = 0; it < 4; ++it) acc[it] = *(const f32x4*)(state_in + (((size_t)s.b * 4 + h) * 64 + j0 + fr) * 64 + 16 * it + 4 * fq);
    bf16x8 fa[4][2];
#pragma unroll
    for (int it = 0; it < 4; ++it)
#pragma unroll
        for (int ks = 0; ks < 2; ++ks) fa[it][ks] = *(const bf16x8*)(G.PT + ch * 4096 + ((it * 2 + ks) * 64 + lane) * 8);
    const u32x4 q01 = *(const u32x4*)(G.QQ + ch * 4096 + ((wg * 2) * 64 + lane) * 8), q23 = *(const u32x4*)(G.QQ + ch * 4096 + ((wg * 2 + 1) * 64 + lane) * 8);
    chain_step(acc, fa, q01, q23, G.SC + ch * 4096 + wg * 1024 + lane * 8);
    float* o = st_s + (((size_t)s.b * 4 + h) * 64 + j0 + fr) * 64 + 4 * fq;
#pragma unroll
    for (int it = 0; it < 4; ++it) *(f32x4*)(o + 16 * it) = acc[it];
}
constexpr int CH_RP = 16, CH_RQ = 16, CH_SLOT = 8192  ;
#define CH_BAR() do { __builtin_amdgcn_s_waitcnt(0xc07f); __builtin_amdgcn_s_barrier(); } while (0)
__device__ __forceinline__ void rwkv_chain_lds(unsigned char* lds, int sq, int h, const RwkvG& G, float* __restrict__ st_p) {
    constexpr int nc = 4096 / 32;
    static_assert(nc % CH_RP == 0 && CH_RP % CH_RQ == 0, "ring depths must divide the chunk count");
    int tid_ = threadIdx.x; asm volatile("" : "+v"(tid_));
    const int wv = __builtin_amdgcn_readfirstlane(tid_ >> 6);
    const Seq s = seq_of(sq);
    const size_t ch0 = (size_t)(s.base / 32) * 4 + h;
    if (wv >= 4) {
        int tl_ = threadIdx.x; asm volatile("" : "+v"(tl_)); const int lane = tl_ & 63;
        const int lw = wv - 4;
        const bf16_t* pn = G.PT + ch0 * 4096 + (size_t)(lw * 128 + lane) * 8;
        unsigned char* dst0 = lds + (lw * 128 + lane) * 16;
        u32x4 ld[CH_RP][2];
#pragma unroll
        for (int c = 0; c < CH_RP; ++c) {
#pragma unroll
            for (int i = 0; i < 2; ++i) ld[c][i] = *(const u32x4*)(pn + i * 512);
            pn += 16384; asm volatile("" : "+v"(pn));
        }
#pragma unroll
        for (int i = 0; i < 2; ++i) *(u32x4*)(dst0 + i * 1024) = ld[0][i];
#pragma unroll
        for (int i = 0; i < 2; ++i) ld[0][i] = *(const u32x4*)(pn + i * 512);
        pn += 16384; asm volatile("" : "+v"(pn));
        CH_BAR();
#pragma unroll 1
        for (int s0 = 0; s0 < nc; s0 += CH_RP) {
#pragma unroll
            for (int j = 0; j < CH_RP; ++j) {
                const int nx = s0 + j + 1, set = (j + 1) % CH_RP;
                unsigned char* d = dst0 + (nx & 1) * CH_SLOT;
#pragma unroll
                for (int i = 0; i < 2; ++i) *(u32x4*)(d + i * 1024) = ld[set][i];
#pragma unroll
                for (int i = 0; i < 2; ++i) ld[set][i] = *(const u32x4*)(pn + i * 512);
                pn += (nx + CH_RP + 1 < nc) ? 16384 : 0; asm volatile("" : "+v"(pn));
                CH_BAR();
            }
        }
    } else {
        int tc_ = threadIdx.x; asm volatile("" : "+v"(tc_)); const int lane = tc_ & 63, fr = lane & 15, fq = lane >> 4;
        const int j0 = 16 * wv;
        const bf16_t* qn = G.QQ + ch0 * 4096 + (size_t)((wv * 2) * 64 + lane) * 8;
        u32x4 qr[CH_RQ][2];
#pragma unroll
        for (int c = 0; c < CH_RQ; ++c) { qr[c][0] = *(const u32x4*)(qn); qr[c][1] = *(const u32x4*)(qn + 512); qn += 16384; asm volatile("" : "+v"(qn)); }
        bf16_t* scp = G.SC + ch0 * 4096 + wv * 1024 + lane * 8;
        f32x4 acc[4];
#pragma unroll
        for (int it = 0; it < 4; ++it) acc[it] = (f32x4){0.f, 0.f, 0.f, 0.f};
        CH_BAR();
#pragma unroll 1
        for (int s0 = 0; s0 < nc; s0 += CH_RP) {
#pragma unroll
            for (int j = 0; j < CH_RP; ++j) {
                const int st = s0 + j, qs = j % CH_RQ;
                const unsigned char* sl = lds + (st & 1) * CH_SLOT;
                bf16x8 fa[4][2];
#pragma unroll
                for (int it = 0; it < 4; ++it)
#pragma unroll
                    for (int ks = 0; ks < 2; ++ks) fa[it][ks] = *(const bf16x8*)(sl + ((it * 2 + ks) * 64 + lane) * 16);
                const u32x4 q01 = qr[qs][0], q23 = qr[qs][1];
                qr[qs][0] = *(const u32x4*)(qn); qr[qs][1] = *(const u32x4*)(qn + 512);
                qn += (st + CH_RQ + 1 < nc) ? 16384 : 0; asm volatile("" : "+v"(qn));
                chain_step(acc, fa, q01, q23, scp);
                scp += 16384; asm volatile("" : "+v"(scp));
                CH_BAR();
            }
        }
        int t3 = threadIdx.x; asm volatile("" : "+v"(t3));
        const int l3 = t3 & 63, fr3 = l3 & 15, fq3 = l3 >> 4;
        float* o = st_p + (((size_t)s.b * 4 + h) * 64 + j0 + fr3) * 64 + 4 * fq3;
#pragma unroll
        for (int it = 0; it < 4; ++it) *(f32x4*)(o + 16 * it) = acc[it];
    }
}

__device__ __forceinline__ void rwkv_out(int wi, const RwkvW& w, const RwkvG& G, bf16_t* __restrict__ YMIX) {
    int tid_ = threadIdx.x; asm volatile("" : "+v"(tid_));
    const int lane = tid_ & 63, fr = lane & 15, fq = lane >> 4;
    const size_t ch = (size_t)(wi >> 1); const int tt = wi & 1, h = (int)(ch & 3), cid = (int)(ch >> 2);
    const int t = 16 * tt + fr, tok = cid * 32 + t;
    const bf16x8 z0 = *(const bf16x8*)(G.ZZ + ch * 2048 + ((tt * 2 + 0) * 64 + lane) * 8), z1 = *(const bf16x8*)(G.ZZ + ch * 2048 + ((tt * 2 + 1) * 64 + lane) * 8);
    const u32x4 yp0 = *(const u32x4*)(G.Y0 + ch * 2048 + ((tt * 2 + 0) * 64 + lane) * 8), yp1 = *(const u32x4*)(G.Y0 + ch * 2048 + ((tt * 2 + 1) * 64 + lane) * 8);
    f32x4 y[4]; float sum = 0.f;
#pragma unroll
    for (int vt = 0; vt < 4; ++vt) {
        const bf16_t* sp = G.SC + ch * 4096 + vt * 1024 + lane * 8;
        const u32x4 yp = vt < 2 ? yp0 : yp1; const unsigned ya = (vt & 1) ? yp.z : yp.x, yb2 = (vt & 1) ? yp.w : yp.y;
        f32x4 acc = {__uint_as_float(ya << 16), __uint_as_float(ya & 0xffff0000u), __uint_as_float(yb2 << 16), __uint_as_float(yb2 & 0xffff0000u)};
        acc = MFMA16(*(const bf16x8*)sp, z0, acc); acc = MFMA16(*(const bf16x8*)(sp + 512), z1, acc);
        y[vt] = acc; sum += (acc.x + acc.y) + (acc.z + acc.w);
    }
    sum += __shfl_xor(sum, 16); sum += __shfl_xor(sum, 32);
    const float mean = sum * (1.f / 64.f); float var = 0.f;
#pragma unroll
    for (int vt = 0; vt < 4; ++vt) { y[vt] -= mean; var += (y[vt].x * y[vt].x + y[vt].y * y[vt].y) + (y[vt].z * y[vt].z + y[vt].w * y[vt].w); }
    var += __shfl_xor(var, 16); var += __shfl_xor(var, 32);
    const float rstd = rsqrtf(var * (1.f / 64.f) + 64e-5f);
#pragma unroll
    for (int vt = 0; vt < 4; ++vt) {
        const int c = h * 64 + 16 * vt + 4 * fq;
        const f32x4 gg = *(const f32x4*)(w.gn_g + c), gb = *(const f32x4*)(w.gn_b + c);
        const u32x2 bv = *(const u32x2*)(G.BV + (size_t)tok * 256 + c), gt = *(const u32x2*)(G.GATE + (size_t)tok * 256 + c);
        f32x4 o = y[vt] * rstd * gg + gb;
        o.x = (o.x + __uint_as_float(bv.x << 16)) * __uint_as_float(gt.x << 16); o.y = (o.y + __uint_as_float(bv.x & 0xffff0000u)) * __uint_as_float(gt.x & 0xffff0000u);
        o.z = (o.z + __uint_as_float(bv.y << 16)) * __uint_as_float(gt.y << 16); o.w = (o.w + __uint_as_float(bv.y & 0xffff0000u)) * __uint_as_float(gt.y & 0xffff0000u);
        *(u32x2*)(YMIX + (size_t)tok * DM + 256 + c) = pk4(o);
    }
}


template <int K, int SRC, bool WF32, bool WBF>
__device__ __forceinline__ void gemm_tail(unsigned char* lds, const bf16_t* __restrict__ A, const bf16_t* __restrict__ Bt, const float* __restrict__ xin_s, float* __restrict__ xout, bf16_t* __restrict__ XB, float* __restrict__ RSS) {
    int tid_ = threadIdx.x; asm volatile("" : "+v"(tid_));
    const int lane = tid_ & 63, w = __builtin_amdgcn_readfirstlane(tid_ >> 6), fr = lane & 15, fq = lane >> 4;
    float* part = (float*)lds;
    for (int tb = blockIdx.x; tb < 256; tb += gridDim.x) {
        const int mi = tb >> 4, ni = tb & 15, rt = w >> 2, ct = w & 3;
        const int r0 = 32 * mi + 16 * rt, c0 = 64 * ni + 16 * ct;
        const bf16_t* ap = A + (size_t)(T_P + r0 + fr) * K + 8 * fq; const bf16_t* bp = Bt + (size_t)(c0 + fr) * K + 8 * fq;
        f32x4 acc = {0.f, 0.f, 0.f, 0.f};
#pragma unroll 1
        for (int k0 = 0; k0 + 512 <= K; k0 += 512) {
            bf16x8 av[16], bv[16];
#pragma unroll
            for (int u = 0; u < 16; ++u) { av[u] = *(const bf16x8*)(ap + k0 + 32 * u); bv[u] = *(const bf16x8*)(bp + k0 + 32 * u); }
#pragma unroll
            for (int u = 0; u < 16; ++u) acc = MFMA16(bv[u], av[u], acc);
        }
        if (K % 512) {
            constexpr int k0 = K - (K % 512), NU = (K % 512) / 32;
            bf16x8 av[NU > 0 ? NU : 1], bv[NU > 0 ? NU : 1];
#pragma unroll
            for (int u = 0; u < NU; ++u) { av[u] = *(const bf16x8*)(ap + k0 + 32 * u); bv[u] = *(const bf16x8*)(bp + k0 + 32 * u); }
#pragma unroll
            for (int u = 0; u < NU; ++u) acc = MFMA16(bv[u], av[u], acc);
        }
        const int row = r0 + fr, col = c0 + 4 * fq;
        f32x4 x;
        if (SRC == 0) x = *(const f32x4*)(xin_s + (size_t)row * DM + col);
        else { const u32x2 r = *(const u32x2*)(XB + (size_t)(T_P + row) * DM + col); x = (f32x4){__uint_as_float(r.x << 16), __uint_as_float(r.x & 0xffff0000u), __uint_as_float(r.y << 16), __uint_as_float(r.y & 0xffff0000u)}; }
        x += acc;
        if (WF32) *(f32x4*)(xout + (size_t)(T_P + row) * DM + col) = x;
        if (WBF) {
            *(u32x2*)(XB + (size_t)(T_P + row) * DM + col) = pk4(x);
            float ss = (x.x * x.x + x.y * x.y) + (x.z * x.z + x.w * x.w);
            ss += __shfl_xor(ss, 16); ss += __shfl_xor(ss, 32);
            if (lane < 16) part[(rt * 4 + ct) * 16 + fr] = ss;
            __syncthreads();
            if (tid_ < 32) { const int rr = tid_ >> 4, f = tid_ & 15; RSS[(size_t)(T_P + 32 * mi + 16 * rr + f) * 16 + ni] = (part[(rr * 4 + 0) * 16 + f] + part[(rr * 4 + 1) * 16 + f]) + (part[(rr * 4 + 2) * 16 + f] + part[(rr * 4 + 3) * 16 + f]); }
            __syncthreads();
        }
    }
}

template <class E2> struct EpiAdapt {
    static constexpr bool PERM = true, AFTER_DRAIN = false; E2 e;
    __device__ __forceinline__ void operator()(const pg8::f32x4 (&acc)[2][2][4][2], const pg8::Unit& u, int wr, int wc, int fr, int fq) const {
#pragma unroll
        for (int ai = 0; ai < 2; ++ai)
#pragma unroll
            for (int m = 0; m < 4; ++m) {
                const int row = u.pm * 256 + ai * 128 + wr * 64 + m * 16 + fr;
                const float rs = e.rowscale(row);
                e(row, u.pn * 256 + wc * 32 + 8 * fq, acc[ai][0][m][0], acc[ai][0][m][1], acc[ai][1][m][0], acc[ai][1][m][1], rs);
            }
    }
};

#define LAS __attribute__((address_space(3)))
#define XB_TMO      128
#define XB_XCNT(j)  (256  + 64 * (j))
#define XB_XSUB(j)  (1280 + 64 * (j))
#define XB_XGEN(j)  (2304 + 64 * (j))
#define XB_TOP      3328
#define XB_TOPGEN   3392
#define XCD_BAR_WORDS 3456
#define XB_SPIN_CAP (1u << 18)

__device__ __forceinline__ unsigned xb_ld(unsigned* p)              { return __hip_atomic_load(p, __ATOMIC_RELAXED, __HIP_MEMORY_SCOPE_AGENT); }
__device__ __forceinline__ unsigned xb_add(unsigned* p, unsigned v) { return __hip_atomic_fetch_add(p, v, __ATOMIC_RELAXED, __HIP_MEMORY_SCOPE_AGENT); }
__device__ __forceinline__ unsigned xb_xcc_id() { return (unsigned)__builtin_amdgcn_s_getreg((3 << 11) | 20) & 0xFu; }
#define XB_SPIN(cond, bar) do { unsigned _sp = 0; while (cond) { __builtin_amdgcn_s_sleep(1); \
    if ((++_sp & 255u) == 0u) { if (xb_ld(&(bar)[XB_TMO])) break; if (_sp > XB_SPIN_CAP) { atomicAdd(&(bar)[XB_TMO], 1u); break; } } } } while (0)

struct XcdBarrier {
    unsigned* bar; unsigned x;
    unsigned* psub; unsigned* pgen;
    volatile LAS unsigned* st;
};

__device__ __forceinline__ XcdBarrier xcd_barrier_post(unsigned* bar, volatile LAS unsigned* st) {
    XcdBarrier b; b.bar = bar; b.x = xb_xcc_id(); b.st = st; b.psub = bar + XB_XSUB(b.x); b.pgen = bar + XB_XGEN(b.x);
    if (threadIdx.x == 0) (void)xb_add(&bar[XB_XCNT(b.x)], 1u);
    return b;
}
__device__ __forceinline__ void xcd_barrier_complete(unsigned* bar, unsigned x, unsigned& nloc, unsigned& nx) {
    const unsigned G = gridDim.x * gridDim.y * gridDim.z;
    unsigned sum, cnt, mine, sp = 0u;
    for (;;) {
        sum = 0u; cnt = 0u; mine = 0u;
#pragma unroll
        for (unsigned j = 0; j < 16; ++j) { const unsigned c = xb_ld(&bar[XB_XCNT(j)]); sum += c; cnt += (c > 0u) ? 1u : 0u; mine = (j == x) ? c : mine; }
        if (sum == G) break;
        __builtin_amdgcn_s_sleep(1);
        if ((++sp & 255u) == 0u) { if (xb_ld(&bar[XB_TMO])) break; if (sp > XB_SPIN_CAP) { atomicAdd(&bar[XB_TMO], 1u); break; } }
    }
    nloc = mine > 0u ? mine : 1u; nx = cnt > 0u ? cnt : 1u;
}

__device__ __forceinline__ void xcd_barrier(const XcdBarrier& b) {
    asm volatile("s_waitcnt vmcnt(0)" ::: "memory");
    __syncthreads();
    if (threadIdx.x == 0) {
        unsigned* bar = b.bar;
        __builtin_amdgcn_s_waitcnt(0);
        unsigned nloc = b.st[0], nx = b.st[1];
        const unsigned old = xb_add(b.psub, 1u);
        const unsigned gen = old / nloc;
        if (old + 1u == (gen + 1u) * nloc) {
            __builtin_amdgcn_fence(__ATOMIC_RELEASE, "agent");
            asm volatile("s_waitcnt vmcnt(0)" ::: "memory");
            const unsigned og = xb_add(&bar[XB_TOP], 1u);
            const unsigned tg = og / nx;
            if (og + 1u == (tg + 1u) * nx) xb_add(&bar[XB_TOPGEN], 1u);
            else XB_SPIN(xb_ld(&bar[XB_TOPGEN]) == tg, bar);
            __builtin_amdgcn_fence(__ATOMIC_ACQUIRE, "agent");
            xb_add(b.pgen, 1u);
            asm volatile("s_waitcnt vmcnt(0)" ::: "memory");
        } else {
            XB_SPIN(xb_ld(b.pgen) == gen, bar);
            __builtin_amdgcn_fence(__ATOMIC_ACQUIRE, "agent");
            asm volatile("s_waitcnt vmcnt(0)" ::: "memory");
        }
    }
    __syncthreads();
}


__device__ __forceinline__ void xcd_census(const XcdBarrier& b) { if (threadIdx.x == 0) { unsigned nloc, nx; xcd_barrier_complete(b.bar, b.x, nloc, nx); b.st[0] = nloc; b.st[1] = nx; } __syncthreads(); }

constexpr int LDS_BYTES = 147456;
struct MP { const float* in[35]; float* out; unsigned char* ws; int ph_lo, ph_hi; };
constexpr int P0_I_IN = (DM / 64) * (NIN / 32), P0_I_OUT = (DM / 64) * (DM / 32), P0_I_G = (DM / 64) * (DFF / 32), P0_I_D = (DFF / 64) * (DM / 32), P0_IL = P0_I_IN + P0_I_OUT + 2 * P0_I_G + P0_I_D;
__device__ __forceinline__ const float* inptr_(int k);
__device__ __forceinline__ void p0_dispatch(int it, unsigned char* ws, float* scr, int lane) {
    const int l2 = it / P0_IL; int r = it - l2 * P0_IL;
    bf16_t* WIN_ = (bf16_t*)(ws + WS_WIN); bf16_t* WOUT_ = (bf16_t*)(ws + WS_WOUT); bf16_t* WGU_ = (bf16_t*)(ws + WS_WGU); bf16_t* WD_ = (bf16_t*)(ws + WS_WD);
    if (r < P0_I_IN) { p0_item(inptr_(9) + (size_t)l2 * DM * NIN, DM, NIN, WIN_ + (size_t)l2 * NINP * DM, inptr_(8) + l2 * DM, NIN, 0, 0, scr, r, lane, true); return; } r -= P0_I_IN;
    if (r < P0_I_OUT) { p0_item(inptr_(30) + (size_t)l2 * DM * DM, DM, DM, WOUT_ + (size_t)l2 * DM * DM, nullptr, DM, 0, 0, scr, r, lane); return; } r -= P0_I_OUT;
    if (r < P0_I_G) { p0_item(inptr_(32) + (size_t)l2 * DM * DFF, DM, DFF, WGU_ + (size_t)l2 * 2 * DFF * DM, inptr_(31) + l2 * DM, 4, 8, 0, scr, r, lane); return; } r -= P0_I_G;
    if (r < P0_I_G) { p0_item(inptr_(33) + (size_t)l2 * DM * DFF, DM, DFF, WGU_ + (size_t)l2 * 2 * DFF * DM, inptr_(31) + l2 * DM, 4, 8, 4, scr, r, lane); return; } r -= P0_I_G;
    p0_item(inptr_(34) + (size_t)l2 * DFF * DM, DFF, DM, WD_ + (size_t)l2 * DM * DFF, nullptr, DM, 0, 0, scr, r, lane);
}
__device__ __forceinline__ const float* inptr_(int k) { const float* const* ka = (const float* const*)__builtin_amdgcn_kernarg_segment_ptr(); asm volatile("" : "+s"(k)); return ka[k]; }
__device__ __forceinline__ int fresh_bx() { int b = blockIdx.x; asm volatile("" : "+s"(b)); return b; }
__global__ void __launch_bounds__(512, 2) mega(MP p) {
    extern __shared__ __attribute__((aligned(16))) unsigned char lds[];
    cg::grid_group grid = cg::this_grid();
    float* out = p.out; unsigned char* ws = p.ws;
#define INP(k) inptr_(k)
#define WIN ((bf16_t*)(ws + WS_WIN))
#define WOUT ((bf16_t*)(ws + WS_WOUT))
#define WGU ((bf16_t*)(ws + WS_WGU))
#define WD ((bf16_t*)(ws + WS_WD))
#define XB ((bf16_t*)(ws + WS_XB))
#define YMIX ((bf16_t*)(ws + WS_YMIX))
#define RSS ((float*)(ws + WS_RSS))
#define PROJ ((bf16_t*)(ws + WS_PROJ))
#define H ((bf16_t*)(ws + WS_H))
    const int lo = p.ph_lo, hi = p.ph_hi;
    int tid = threadIdx.x, half = tid >> 8;
#define FRESH() do { asm volatile("" : "+v"(tid)); half = tid >> 8; asm volatile("" : "+s"(ws), "+s"(out)); } while (0)
#ifndef TESTPH
#define TESTPH -1
#endif
    volatile LAS unsigned* bst = (volatile LAS unsigned*)(lds + LDS_BYTES - 16);
    if (threadIdx.x < 4) bst[threadIdx.x] = 0u;
    __syncthreads();
    const XcdBarrier xbar = xcd_barrier_post((unsigned*)(ws + WS_CTL), bst);
#ifndef PROF
#define PROF 0
#endif
    unsigned long long* tsb = (unsigned long long*)(ws + WS_CTL + 14336);
#ifndef DUP
#define DUP -1
#endif
#define REPS(k) for (int rep_ = 0; rep_ < ((DUP) == (k) ? 2 : 1); ++rep_)
#define REPSYNC(k) do { if ((DUP) == (k) && rep_ == 0) xcd_barrier(xbar); } while (0)
#define STAMP(k) do { if (PROF && blockIdx.x == 0 && threadIdx.x == 0) tsb[k] = __builtin_amdgcn_s_memrealtime(); } while (0)
    STAMP(0);
#define IN(k) ((TESTPH < 0 || TESTPH == ((k) > 8 ? (k) - 8 : (k))) && lo <= (k) && (k) < hi)
#define SEAM(k) do { if (IN((k) + 1)) { if ((k) == 0) { grid.sync(); xcd_census(xbar); } else xcd_barrier(xbar); } } while (0)
    if (IN(0)) REPS(0) {
        FRESH();
        {
            float* scr = (float*)lds + (tid >> 6) * (64 * 33);
            const int gw = blockIdx.x * 8 + (tid >> 6), ngw = gridDim.x * 8, lane = tid & 63;
            for (int it = gw; it < P0_I_IN; it += ngw) p0_dispatch(it, ws, scr, lane);
        }
        {
            bf16_t* PWT = (bf16_t*)(ws + WS_PWT);
            for (int i = blockIdx.x * 512 + tid; i < 2 * 4 * 64 * 64; i += gridDim.x * 512) { const int lg = i >> 12, d = (i >> 6) & 63, cc = i & 63; PWT[i] = f2bf(INP(25)[((size_t)lg * 64 + cc) * 64 + d]); }
        }
        {
            bf16_t* LWT = (bf16_t*)(ws + WS_LWT);
            for (int i = blockIdx.x * 512 + tid; i < 2 * 256 * 128; i += gridDim.x * 512) {
                const int l2 = i >> 15, c = (i >> 7) & 255, j = i & 127;
                const float v = j < 32 ? INP(16)[((size_t)l2 * 32 + j) * 256 + c] : (j < 64 ? INP(18)[((size_t)l2 * 32 + (j - 32)) * 256 + c] : INP(19)[((size_t)l2 * 64 + (j - 64)) * 256 + c]);
                LWT[i] = f2bf(v);
            }
        }
        for (int i = blockIdx.x; i < T / 16; i += gridDim.x) { d_xprep(i * 16 + (tid >> 6), INP(0), INP(1), XB, RSS); d_xprep(i * 16 + 8 + (tid >> 6), INP(0), INP(1), XB, RSS); }
        if (DUP == 0 && rep_ == 0) grid.sync(); else { SEAM(0); STAMP(1); }
    }
    for (int l = 0; l < 2; ++l) {
        const int pb = 1 + 8 * l;
        if (IN(pb + 0)) REPS(1) {
            FRESH();
            pg8::Gemm g{XB, WIN + (size_t)l * NINP * DM, T, NINP, DM}; pg8::StaticOrder S; S.init(T, NINP, gridDim.x, fresh_bx());
            EpiAdapt<EpiProj> E{EpiProj{PROJ, RSS, (bf16_t*)(ws + WS_GLU)}};
            pg8::gemm_phase<EpiAdapt<EpiProj>, pg8::StaticOrder, true, true>((LAS unsigned char*)lds, g, S, E);
            if (l == 0) {
                constexpr int NU1 = (T / 256) * (NINP / 256), NBUSY = NU1 % 256;
                if ((int)blockIdx.x >= NBUSY && gridDim.x == 256) {
                    float* scr = (float*)lds + (tid >> 6) * (64 * 33);
                    for (int it = P0_I_IN + ((int)blockIdx.x - NBUSY) * 8 + (tid >> 6); it < P0_IL + P0_I_IN + P0_I_OUT; it += (256 - NBUSY) * 8) p0_dispatch(it, ws, scr, tid & 63);
                } else if (gridDim.x != 256) {
                    float* scr = (float*)lds + (tid >> 6) * (64 * 33);
                    for (int it = P0_I_IN + (int)blockIdx.x * 8 + (tid >> 6); it < P0_IL + P0_I_IN + P0_I_OUT; it += (int)gridDim.x * 8) p0_dispatch(it, ws, scr, tid & 63);
                }
            }
            REPSYNC(1); if (!(DUP == 1 && rep_ == 0)) { SEAM(pb + 0); STAMP(pb + 1); }
        }
        if (IN(pb + 1)) REPS(2) {
            FRESH();
            int ll = l; asm volatile("" : "+s"(ll));
            const RwkvW rw{INP(14) + ll * 896, INP(15) + ll * 256, INP(16) + ll * 32 * 256, INP(17) + ll * 256, INP(18) + ll * 32 * 256, INP(19) + ll * 64 * 256, INP(20) + ll * 256, INP(21) + ll * 256, INP(22) + ll * 256, INP(23) + ll * 256, INP(24) + ll * 256};
            const RwkvG rg{(bf16_t*)(ws + WS_PT), (bf16_t*)(ws + WS_QQ), (bf16_t*)(ws + WS_ZZ), (bf16_t*)(ws + WS_Y0), (bf16_t*)(ws + WS_SC), (bf16_t*)(ws + WS_GATE), (bf16_t*)(ws + WS_BV), (const bf16_t*)(ws + WS_LWT)};
            for (int it = blockIdx.x; it < 1024; it += gridDim.x) rwkv_item(lds, it, ll, PROJ, INP(4) + (size_t)ll * 16 * 896, rw, rg);
            for (int i = blockIdx.x * 512 + tid; i < 20 * 896; i += gridDim.x * 512) {
                const int sq = i / 896, c = i - sq * 896; const Seq sx = seq_of(sq);
                const float v = bf2f(PROJ[(size_t)(sx.base + sx.L - 1) * NINP + C_B + c]);
                if (sx.sample) out[O_SHIFT_S + ((size_t)ll * 16 + sx.b) * 896 + c] = v; else out[O_SHIFT_P + ((size_t)ll * 4 + sx.b) * 896 + c] = v;
            }
            REPSYNC(2); if (!(DUP == 2 && rep_ == 0)) { SEAM(pb + 1); STAMP(pb + 2); }
        }
        if (IN(pb + 2)) REPS(3) {
            FRESH();
            int ll = l; asm volatile("" : "+s"(ll));
            const RwkvW rw{INP(14) + ll * 896, INP(15) + ll * 256, INP(16) + ll * 32 * 256, INP(17) + ll * 256, INP(18) + ll * 32 * 256, INP(19) + ll * 64 * 256, INP(20) + ll * 256, INP(21) + ll * 256, INP(22) + ll * 256, INP(23) + ll * 256, INP(24) + ll * 256};
            const RwkvG rg{(bf16_t*)(ws + WS_PT), (bf16_t*)(ws + WS_QQ), (bf16_t*)(ws + WS_ZZ), (bf16_t*)(ws + WS_Y0), (bf16_t*)(ws + WS_SC), (bf16_t*)(ws + WS_GATE), (bf16_t*)(ws + WS_BV), (const bf16_t*)(ws + WS_LWT)};
            if (blockIdx.x < 16) rwkv_chain_lds(lds, (int)blockIdx.x >> 2, (int)blockIdx.x & 3, rg, out + O_RWKV_P + (size_t)ll * 4 * 4 * 4096);
            else if (blockIdx.x < 48) {
                const int sidx = (int)blockIdx.x - 16;
                rwkv_item(lds, 1024 + sidx, ll, PROJ, INP(4) + (size_t)ll * 16 * 896, rw, rg);
                __syncthreads();
                const int wv = tid >> 6;
                rwkv_chain1(4 + (sidx >> 1), (sidx & 1) * 2 + (wv >> 2), wv & 3, INP(3) + (size_t)ll * 16 * 4 * 4096, rg, out + O_RWKV_S + (size_t)ll * 16 * 4 * 4096);
            }
            {
                const AttnP ap{PROJ, INP(6) + (size_t)ll * 16 * 128 * 128, INP(7) + (size_t)ll * 16 * 128 * 128, INP(27) + ll * 64, INP(28) + ll * 64, INP(29) + ll * 4, YMIX,
                               out + O_K_P + (size_t)ll * 4 * 128 * 128, out + O_K_S + (size_t)ll * 16 * 128 * 128, out + O_V_P + (size_t)ll * 4 * 128 * 128, out + O_V_S + (size_t)ll * 16 * 128 * 128};
                const ConvPoolP cp{PROJ, INP(2) + (size_t)ll * 16 * 30 * 256, INP(10) + ll * 31 * 256, INP(11) + ll * 256, INP(12) + ll * 256, INP(13) + ll * 256, INP(5) + (size_t)ll * 16 * 15 * 256, INP(25) + (size_t)ll * 4 * 64 * 64, INP(26) + ll * 256, YMIX,
                                   out + O_CONV_P + (size_t)ll * 4 * 30 * 256, out + O_CONV_S + (size_t)ll * 16 * 30 * 256, out + O_POOL_P + (size_t)ll * 4 * 15 * 256, out + O_POOL_S + (size_t)ll * 16 * 15 * 256, (const bf16_t*)(ws + WS_GLU), (const bf16_t*)(ws + WS_PWT) + (size_t)ll * 4 * 64 * 64};
                unsigned* ctr = (unsigned*)(ws + WS_CTL + 14848) + 64 * ll + 32 * (DUP == 3 ? rep_ : 0);
                volatile LAS unsigned* wsl = (volatile LAS unsigned*)(lds + LDS_BYTES - 32);
                for (;;) {
                    __syncthreads();
                    if (tid == 0) wsl[0] = __hip_atomic_fetch_add(ctr, 1u, __ATOMIC_RELAXED, __HIP_MEMORY_SCOPE_AGENT);
                    __syncthreads();
                    const unsigned idx = wsl[0];
                    if (idx >= 528u + 544u) break;
                    if (idx < 528u) convpool_tile((float*)lds + half * (62 * 256), 2 * (int)idx + half, cp);
                    else attn_unit(lds, (int)idx - 528, ap);
                }
            }
            REPSYNC(3); if (!(DUP == 3 && rep_ == 0)) { SEAM(pb + 2); STAMP(pb + 3); }
        }
        if (IN(pb + 3)) REPS(4) {
            FRESH();
            int ll = l; asm volatile("" : "+s"(ll));
            const RwkvW rw{INP(14) + ll * 896, INP(15) + ll * 256, INP(16) + ll * 32 * 256, INP(17) + ll * 256, INP(18) + ll * 32 * 256, INP(19) + ll * 64 * 256, INP(20) + ll * 256, INP(21) + ll * 256, INP(22) + ll * 256, INP(23) + ll * 256, INP(24) + ll * 256};
            const RwkvG rg{(bf16_t*)(ws + WS_PT), (bf16_t*)(ws + WS_QQ), (bf16_t*)(ws + WS_ZZ), (bf16_t*)(ws + WS_Y0), (bf16_t*)(ws + WS_SC), (bf16_t*)(ws + WS_GATE), (bf16_t*)(ws + WS_BV), (const bf16_t*)(ws + WS_LWT)};
            for (int wi = blockIdx.x * 8 + (tid >> 6); wi < 2 * NCHH; wi += gridDim.x * 8) rwkv_out(wi, rw, rg, YMIX);
            REPSYNC(4); if (!(DUP == 4 && rep_ == 0)) { SEAM(pb + 3); STAMP(pb + 4); }
        }
        if (IN(pb + 4)) {
            FRESH();
            pg8::Gemm g{YMIX, WOUT + (size_t)l * DM * DM, T_P, DM, DM}; pg8::StaticOrder S; S.init(T_P, DM, gridDim.x, fresh_bx());
            if (l == 0) {
                EpiAdapt<EpiRes<0, false, true>> E{EpiRes<0, false, true>{INP(0), INP(1), out, XB, RSS}};
                pg8::gemm_phase<EpiAdapt<EpiRes<0, false, true>>, pg8::StaticOrder, true, true>((LAS unsigned char*)lds, g, S, E);
                gemm_tail<DM, 0, false, true>(lds, YMIX, WOUT + (size_t)l * DM * DM, INP(1), out, XB, RSS);
            } else {
                EpiAdapt<EpiRes<1, false, true>> E{EpiRes<1, false, true>{nullptr, nullptr, out, XB, RSS}};
                pg8::gemm_phase<EpiAdapt<EpiRes<1, false, true>>, pg8::StaticOrder, true, true>((LAS unsigned char*)lds, g, S, E);
                gemm_tail<DM, 1, false, true>(lds, YMIX, WOUT + (size_t)l * DM * DM, nullptr, out, XB, RSS);
            }
            SEAM(pb + 4); STAMP(pb + 5);
        }
        if (IN(pb + 5)) REPS(6) {
            FRESH();
            pg8::Gemm g{XB, WGU + (size_t)l * 2 * DFF * DM, T, 2 * DFF, DM}; pg8::StaticOrder S; S.init(T, 2 * DFF, gridDim.x, fresh_bx());
            EpiAdapt<EpiGU> E{EpiGU{H, RSS}};
            pg8::gemm_phase<EpiAdapt<EpiGU>, pg8::StaticOrder, true, true>((LAS unsigned char*)lds, g, S, E);
            if (l == 0) {
                constexpr int NU3 = (T / 256) * (2 * DFF / 256), NBUSY3 = NU3 % 256;
                float* scr = (float*)lds + (tid >> 6) * (64 * 33);
                if (gridDim.x == 256) { if ((int)blockIdx.x >= NBUSY3) for (int it = P0_IL + P0_I_IN + P0_I_OUT + ((int)blockIdx.x - NBUSY3) * 8 + (tid >> 6); it < 2 * P0_IL; it += (256 - NBUSY3) * 8) p0_dispatch(it, ws, scr, tid & 63); }
                else for (int it = P0_IL + P0_I_IN + P0_I_OUT + (int)blockIdx.x * 8 + (tid >> 6); it < 2 * P0_IL; it += (int)gridDim.x * 8) p0_dispatch(it, ws, scr, tid & 63);
            }
            REPSYNC(6); if (!(DUP == 6 && rep_ == 0)) { SEAM(pb + 5); STAMP(pb + 6); }
        }
        if (IN(pb + 6)) {
            FRESH();
            pg8::Gemm g{H, WD + (size_t)l * DM * DFF, T_P, DM, DFF}; pg8::StaticOrder S; S.init(T_P, DM, gridDim.x, fresh_bx());
            if (l == 0) {
                EpiAdapt<EpiRes<1, false, true>> E{EpiRes<1, false, true>{nullptr, nullptr, out, XB, RSS}};
                pg8::gemm_phase<EpiAdapt<EpiRes<1, false, true>>, pg8::StaticOrder, true, true>((LAS unsigned char*)lds, g, S, E);
                gemm_tail<DFF, 1, false, true>(lds, H, WD + (size_t)l * DM * DFF, nullptr, out, XB, RSS);
                SEAM(pb + 7); STAMP(pb + 7);
            } else {
                EpiAdapt<EpiRes<1, true, false>> E{EpiRes<1, true, false>{nullptr, nullptr, out, XB, RSS}};
                pg8::gemm_phase<EpiAdapt<EpiRes<1, true, false>>, pg8::StaticOrder, true, true>((LAS unsigned char*)lds, g, S, E);
                gemm_tail<DFF, 1, true, false>(lds, H, WD + (size_t)l * DM * DFF, nullptr, out, XB, RSS);
            }
        }
    }
    if (PROF) {
        xcd_barrier(xbar); STAMP(16); xcd_barrier(xbar);
        const unsigned long long* t = tsb;
        const unsigned long long d[12] = {t[16] - t[0], t[1] - t[0], t[2] - t[1], t[3] - t[2], t[4] - t[3], t[5] - t[4], t[6] - t[5], t[7] - t[6], t[8] - t[7], t[10] - t[8], t[13] - t[10], t[16] - t[13]};
        const size_t off[12] = {O_Y, O_Y + (size_t)T_P * DM, O_CONV_P, O_CONV_S, O_RWKV_P, O_RWKV_S, O_SHIFT_P, O_SHIFT_S, O_POOL_P, O_POOL_S, O_K_P, O_K_S};
        const unsigned cap[12] = {99999, 99999, 61000, 99999, 99999, 99999, 7000, 28000, 30000, 99999, 99999, 99999};
        for (int k = 0; k < 12; ++k) { unsigned c = (unsigned)(d[k] / 10ull); if (c > cap[k]) c = cap[k]; for (unsigned i = blockIdx.x * 512 + threadIdx.x; i < c; i += gridDim.x * 512) ((unsigned*)out)[off[k] + i] = 0xAAAAAAAAu; }
    }
}

#undef WIN
#undef WOUT
#undef WGU
#undef WD
#undef XB
#undef YMIX
#undef RSS
#undef PROJ
#undef H
static void launch_mega(MP p, int lo, int hi, int grid_blocks, hipStream_t stream) {
    p.ph_lo = lo; p.ph_hi = hi;
    void* args[] = {&p};
    hipError_t e = hipLaunchCooperativeKernel((const void*)mega, dim3(grid_blocks), dim3(512), args, LDS_BYTES, stream);
    if (e != hipSuccess) fprintf(stderr, "cooperative launch failed: %s (grid %d)\n", hipGetErrorString(e), grid_blocks);
}
extern "C" void kernel_launch(void* const* d_in, const int* in_sizes, int n_in, void* d_out, int out_size, void* d_ws, size_t ws_size, hipStream_t stream) {
    static int grid_blocks = 0;
    if (grid_blocks == 0) {
        if (n_in != 35 || (size_t)out_size != O_END || ws_size < WS_END) { fprintf(stderr, "kernel_launch: unexpected sizes n_in %d out %d ws %zu (need %zu)\n", n_in, out_size, ws_size, (size_t)WS_END); grid_blocks = -1; return; }
        int dev = 0, cus = 0, per_cu = 0;
        (void)hipGetDevice(&dev);
        (void)hipDeviceGetAttribute(&cus, hipDeviceAttributeMultiprocessorCount, dev);
        (void)hipFuncSetAttribute((const void*)mega, hipFuncAttributeMaxDynamicSharedMemorySize, LDS_BYTES);
        (void)hipOccupancyMaxActiveBlocksPerMultiprocessor(&per_cu, mega, 512, LDS_BYTES);
        if (per_cu < 1) { fprintf(stderr, "kernel_launch: occupancy query says %d blocks per CU\n", per_cu); grid_blocks = -1; return; }
        grid_blocks = cus;
    }
    if (grid_blocks < 0) return;
    const float* const* in = (const float* const*)d_in;
    float* out = (float*)d_out; unsigned char* ws = (unsigned char*)d_ws;
    MP p{};
    for (int i = 0; i < 35; ++i) p.in[i] = in[i];
    p.out = out; p.ws = ws;
    (void)hipMemsetAsync(ws + WS_CTL, 0, 16384, stream);
    launch_mega(p, 0, 16, grid_blocks, stream);
}
```

```cpp
#include <hip/hip_runtime.h>
#include <hip/hip_cooperative_groups.h>
namespace cg = cooperative_groups;
#include <cstdint>
#include <cstdio>

typedef unsigned short bf16_t;
typedef short bf16x8 __attribute__((ext_vector_type(8)));
typedef float f32x4 __attribute__((ext_vector_type(4)));
typedef unsigned u32x4 __attribute__((ext_vector_type(4)));
typedef unsigned u32x2 __attribute__((ext_vector_type(2)));

constexpr int T_P = 16384, T_S = 512, T = 16896, DM = 1024;
constexpr int NIN = 2176, NINP = 2304, DFF = 2816;
constexpr int C_A = 0, C_B = 512, C_C = 1408, C_Q = 1664, C_K = 1920, C_V = 2048;

constexpr size_t O_Y = 0, O_CONV_P = 17301504, O_CONV_S = 17362944, O_RWKV_P = 17608704, O_RWKV_S = 17739776,
                 O_SHIFT_P = 18264064, O_SHIFT_S = 18271232, O_POOL_P = 18299904, O_POOL_S = 18330624,
                 O_K_P = 18453504, O_K_S = 18584576, O_V_P = 19108864, O_V_S = 19239936, O_END = 19764224;

constexpr size_t WS_CTL = 0;
constexpr size_t WS_WIN = 16384;
constexpr size_t WS_WOUT = WS_WIN + 2ull * NINP * DM * 2;
constexpr size_t WS_WGU = WS_WOUT + 2ull * DM * DM * 2;
constexpr size_t WS_WD = WS_WGU + 2ull * 2 * DFF * DM * 2;
constexpr size_t WS_LWT = WS_WD + 2ull * DM * DFF * 2;
constexpr size_t WS_XB = WS_LWT + 2ull * 256 * 128 * 2;
constexpr size_t WS_YMIX = WS_XB + (size_t)T * DM * 2;
constexpr size_t WS_RSS = WS_YMIX + (size_t)T * DM * 2;
constexpr size_t WS_R = WS_RSS + (size_t)T * 32 * 4;
constexpr size_t WS_PROJ = WS_R;
constexpr size_t WS_H = WS_R;
constexpr size_t WS_RW = WS_PROJ + (size_t)T * NINP * 2;
constexpr int NCH = T / 32, NCHH = NCH * 4;
constexpr size_t WS_PT = WS_RW;
constexpr size_t WS_QQ = WS_PT + (size_t)NCHH * 4096 * 2;
constexpr size_t WS_ZZ = WS_QQ + (size_t)NCHH * 4096 * 2;
constexpr size_t WS_Y0 = WS_ZZ + (size_t)NCHH * 2048 * 2;
constexpr size_t WS_SC = WS_Y0 + (size_t)NCHH * 2048 * 2;
constexpr size_t WS_GATE = WS_SC + (size_t)NCHH * 4096 * 2;
constexpr size_t WS_BV = WS_GATE + (size_t)T * 256 * 2;
constexpr size_t WS_GLU = WS_BV + (size_t)T * 256 * 2;
constexpr size_t WS_PWT = WS_GLU + (size_t)T * 256 * 2;
constexpr size_t WS_RWEND = WS_PWT + 2ull * 4 * 64 * 64 * 2;
constexpr size_t RW_BF = (size_t)T * 256 * 2;
constexpr size_t WS_RW_R = WS_RWEND, WS_RW_K = WS_RW_R + RW_BF, WS_RW_V = WS_RW_R + 2 * RW_BF, WS_RW_A = WS_RW_R + 3 * RW_BF,
                 WS_RW_B = WS_RW_R + 4 * RW_BF, WS_RW_G = WS_RW_R + 5 * RW_BF, WS_RW_W = WS_RW_R + 6 * RW_BF;
constexpr size_t WS_END = WS_RWEND;

__device__ __forceinline__ float bf2f(bf16_t h) { return __uint_as_float((unsigned)h << 16); }
typedef __bf16 bf16x2_t __attribute__((ext_vector_type(2)));
typedef float f32x2 __attribute__((ext_vector_type(2)));
__device__ __forceinline__ unsigned pk2(float lo, float hi) { const f32x2 v = {lo, hi}; return __builtin_bit_cast(unsigned, __builtin_convertvector(v, bf16x2_t)); }
__device__ __forceinline__ u32x2 pk4(f32x4 v) { u32x2 o; o.x = pk2(v.x, v.y); o.y = pk2(v.z, v.w); return o; }
__device__ __forceinline__ bf16_t f2bf(float f) { return (bf16_t)(pk2(f, 0.f) & 0xffffu); }
__device__ __forceinline__ void unpack8(u32x4 v, float* f) {
    f[0] = __uint_as_float(v.x << 16); f[1] = __uint_as_float(v.x & 0xffff0000u); f[2] = __uint_as_float(v.y << 16); f[3] = __uint_as_float(v.y & 0xffff0000u);
    f[4] = __uint_as_float(v.z << 16); f[5] = __uint_as_float(v.z & 0xffff0000u); f[6] = __uint_as_float(v.w << 16); f[7] = __uint_as_float(v.w & 0xffff0000u);
}
__device__ __forceinline__ float wave_sum(float v) {
#pragma unroll
    for (int o = 1; o < 64; o <<= 1) v += __shfl_xor(v, o);
    return v;
}
__device__ __forceinline__ float sigmoidf_(float x) { return __builtin_amdgcn_rcpf(1.f + __expf(-x)); }

__device__ __forceinline__ void p0_item(const float* __restrict__ W, int K, int N, bf16_t* __restrict__ WT, const float* __restrict__ g, int grp, int stride, int off, float* scr, int item, int lane, bool glu_map = false) {
    const int nblk = N / 32, kb = item / nblk, nb = item - kb * nblk, k0 = 64 * kb, n0 = 32 * nb;
    float v[32];
#pragma unroll
    for (int i = 0; i < 32; ++i) v[i] = W[(size_t)(k0 + 2 * i + (lane >> 5)) * N + n0 + (lane & 31)];
#pragma unroll
    for (int i = 0; i < 32; ++i) { const int kk = 2 * i + (lane >> 5); scr[kk * 33 + (lane & 31)] = g ? v[i] * g[k0 + kk] : v[i]; }
    asm volatile("s_waitcnt lgkmcnt(0)" ::: "memory");
    const int c = lane & 7;
#pragma unroll
    for (int j = 0; j < 4; ++j) {
        const int n = n0 + (lane >> 3) + 8 * j; const float* sp = scr + (8 * c) * 33 + (n - n0);
        u32x4 o; o.x = pk2(sp[0], sp[33]); o.y = pk2(sp[2 * 33], sp[3 * 33]); o.z = pk2(sp[4 * 33], sp[5 * 33]); o.w = pk2(sp[6 * 33], sp[7 * 33]);
        int r = (n / grp) * stride + off + (n % grp);
        if (glu_map && n < 512) { const int n2 = n & 255; r = (n2 >> 2) * 8 + (n >> 8) * 4 + (n2 & 3); }
        *(u32x4*)(WT + (size_t)r * K + k0 + 8 * c) = o;
    }
    asm volatile("s_waitcnt lgkmcnt(0)" ::: "memory");
}

__device__ __forceinline__ void d_xprep(int row, const float* __restrict__ xp, const float* __restrict__ xs, bf16_t* __restrict__ XB, float* __restrict__ RSS) {
    const int lane = threadIdx.x & 63;
    const float* x = row < T_P ? xp + (size_t)row * DM : xs + (size_t)(row - T_P) * DM;
    float ss = 0.f;
#pragma unroll
    for (int j = 0; j < 4; ++j) {
        const f32x4 v = ((const f32x4*)x)[lane + 64 * j];
        ss += v.x * v.x + v.y * v.y + v.z * v.z + v.w * v.w;
        u32x2 o; o.x = pk2(v.x, v.y); o.y = pk2(v.z, v.w);
        *(u32x2*)(XB + (size_t)row * DM + (lane + 64 * j) * 4) = o;
    }
    ss = wave_sum(ss);
    if (lane < 16) RSS[(size_t)row * 16 + lane] = lane == 0 ? ss : 0.f;
}

__device__ __forceinline__ float rss_rstd(const float* RSS, int row) {
    float s = 0.f;
#pragma unroll
    for (int j = 0; j < 4; ++j) { const f32x4 v = ((const f32x4*)(RSS + (size_t)row * 16))[j]; s += (v.x + v.y) + (v.z + v.w); }
    return rsqrtf(s * (1.f / DM) + 1e-6f);
}
struct EpiProj {
    bf16_t* PROJ; const float* RSS; bf16_t* GLU;
    __device__ __forceinline__ float rowscale(int row) const { return rss_rstd(RSS, row); }
    __device__ __forceinline__ void one(int row, int col, f32x4 v0, f32x4 v1, float rs) const {
        v0 *= rs; v1 *= rs;
        if (col < 512) { const f32x4 gl = {v0.x * sigmoidf_(v1.x), v0.y * sigmoidf_(v1.y), v0.z * sigmoidf_(v1.z), v0.w * sigmoidf_(v1.w)}; *(u32x2*)(GLU + (size_t)row * 256 + (col >> 1)) = pk4(gl); }
        else { u32x4 o; o.x = pk2(v0.x, v0.y); o.y = pk2(v0.z, v0.w); o.z = pk2(v1.x, v1.y); o.w = pk2(v1.z, v1.w); *(u32x4*)(PROJ + (size_t)row * NINP + col) = o; }
    }
    __device__ __forceinline__ void operator()(int row, int col, f32x4 v0, f32x4 v1, f32x4 w0, f32x4 w1, float rs) const { one(row, col, v0, v1, rs); one(row, col + 128, w0, w1, rs); }
};
template <int SRC, bool WF32, bool WBF> struct EpiRes {
    const float* xin_p; const float* xin_s; float* xout; bf16_t* XB; float* RSS;
    __device__ __forceinline__ float rowscale(int) const { return 1.f; }
    __device__ __forceinline__ float half8(int row, int col, f32x4 v0, f32x4 v1) const {
        f32x4 a, b;
        if (SRC == 0) { const float* xi = (row < T_P ? xin_p + (size_t)row * DM : xin_s + (size_t)(row - T_P) * DM) + col; a = *(const f32x4*)(xi); b = *(const f32x4*)(xi + 4); }
        else { float f[8]; unpack8(*(const u32x4*)(XB + (size_t)row * DM + col), f); a = (f32x4){f[0], f[1], f[2], f[3]}; b = (f32x4){f[4], f[5], f[6], f[7]}; }
        a += v0; b += v1;
        if (WF32) { *(f32x4*)(xout + (size_t)row * DM + col) = a; *(f32x4*)(xout + (size_t)row * DM + col + 4) = b; }
        if (WBF) { u32x4 o; o.x = pk2(a.x, a.y); o.y = pk2(a.z, a.w); o.z = pk2(b.x, b.y); o.w = pk2(b.z, b.w); *(u32x4*)(XB + (size_t)row * DM + col) = o; }
        return (a.x * a.x + a.y * a.y) + (a.z * a.z + a.w * a.w) + (b.x * b.x + b.y * b.y) + (b.z * b.z + b.w * b.w);
    }
    __device__ __forceinline__ void operator()(int row, int col, f32x4 v0, f32x4 v1, f32x4 w0, f32x4 w1, float) const {
        float ss = half8(row, col, v0, v1);
        ss += half8(row, col + 128, w0, w1);
        if (WBF) {
            ss += __shfl_xor(ss, 16); ss += __shfl_xor(ss, 32);
            if ((threadIdx.x & 63) < 16) RSS[(size_t)row * 16 + (col >> 8) * 4 + ((col >> 5) & 3)] = ss;
        }
    }
};
struct EpiGU {
    bf16_t* H; const float* RSS;
    __device__ __forceinline__ float rowscale(int row) const { return rss_rstd(RSS, row); }
    __device__ __forceinline__ u32x2 gu(f32x4 g, f32x4 u, float rs) const {
        g *= rs; u *= rs;
        const float h0 = g.x * sigmoidf_(g.x) * u.x, h1 = g.y * sigmoidf_(g.y) * u.y, h2 = g.z * sigmoidf_(g.z) * u.z, h3 = g.w * sigmoidf_(g.w) * u.w;
        u32x2 o; o.x = pk2(h0, h1); o.y = pk2(h2, h3); return o;
    }
    __device__ __forceinline__ void operator()(int row, int col, f32x4 g0, f32x4 u0, f32x4 g1, f32x4 u1, float rs) const {
        *(u32x2*)(H + (size_t)row * DFF + (col >> 1)) = gu(g0, u0, rs);
        *(u32x2*)(H + (size_t)row * DFF + (col >> 1) + 64) = gu(g1, u1, rs);
    }
};

struct Seq { int base, L, b, sample, pos0; };
__device__ __forceinline__ Seq seq_of(int sq) { Seq s; if (sq < 4) { s.base = sq * 4096; s.L = 4096; s.b = sq; s.sample = 0; s.pos0 = 0; } else { s.b = sq - 4; s.base = T_P + s.b * 32; s.L = 32; s.sample = 1; s.pos0 = 1024; } return s; }

struct RwkvW { const float *mu, *w0, *w2, *a0, *a2, *g2, *k_k, *k_a, *r_k, *gn_g, *gn_b; };

namespace pg8 {
#define PG8_LAS __attribute__((address_space(3)))
typedef unsigned short bf16_t;
typedef short bf16x8 __attribute__((ext_vector_type(8)));
typedef float f32x4 __attribute__((ext_vector_type(4)));
typedef unsigned u32x4 __attribute__((ext_vector_type(4)));
constexpr int BM = 256, BK = 64, HALF = 128, HTB = HALF * BK * 2  , STAGE_BYTES = 8 * HTB, NXCD = 8, WGM = 8;

__host__ __device__ __forceinline__ int lds_byte(int r, int c) { const int st = (r >> 4) * 2 + (c >> 5), rr = r & 15, cc = c & 31, ob = rr * 64 + cc * 2; return st * 1024 + (ob ^ (((ob >> 9) & 1) << 5)); }
__host__ __device__ __forceinline__ void stage_rc(int b, int& R, int& C) { const int st = b / 1024, sb = b % 1024, swz = sb ^ (((sb >> 9) & 1) << 5); R = (st >> 1) * 16 + swz / 64; C = (st & 1) * 32 + (swz % 64) / 2; }
__host__ __device__ __forceinline__ int perm32(int rho) { const int n = rho >> 4, i = rho & 15; return 8 * (i >> 2) + 4 * n + (i & 3); }

struct Unit { int pm, pn; };
struct Gemm { const bf16_t* A; const bf16_t* Bt; int M, N, K; };

struct StaticOrder {
    int nM, nN, nwg, G, c;
    __host__ __device__ void init(int M, int N, int G_, int c_) { nM = M / BM; nN = N / BM; nwg = nM * nN; G = G_; c = c_; }
    __host__ __device__ bool next(int i, Unit& u) const {
        const long L = (long)i * G + c; if (L >= nwg) return false;
        int wgid = (int)L; { const int q = nwg / NXCD, r = nwg % NXCD, xcd = wgid % NXCD, off = wgid / NXCD; wgid = (xcd < r ? xcd * (q + 1) : r * (q + 1) + (xcd - r) * q) + off; }
        const int nig = WGM * nN, gid = wgid / nig, fm = gid * WGM, gsz = (nM - fm) < WGM ? (nM - fm) : WGM;
        u.pm = fm + ((wgid % nig) % gsz); u.pn = (wgid % nig) / gsz; return true;
    }
    __device__ __forceinline__ void a_ready(const Unit&) const {}
    __device__ __forceinline__ void done(const Unit&) const {}
};


template <class Epi, class Sched, bool ALIGN_EPI = false, bool SP2 = false>
__device__ __forceinline__ void gemm_phase(PG8_LAS unsigned char* lds, const Gemm g, const Sched& S, const Epi& E) {
    int tid_ = threadIdx.x; asm volatile("" : "+v"(tid_));
    const int tid = tid_, wid = __builtin_amdgcn_readfirstlane(tid >> 6), lane = tid & 63, wr = wid >> 2, wc = wid & 3, fr = lane & 15, fq = lane >> 4;
    const int K = g.K, nt = K / BK;
    unsigned voffA[2], voffB[2];
#pragma unroll
    for (int i = 0; i < 2; ++i) { int R, C; stage_rc(tid * 16 + i * 8192, R, C); const int Rb = Epi::PERM ? ((R & ~31) + perm32(R & 31)) : R;
        voffA[i] = (unsigned)(R * K + C) * 2u; voffB[i] = (unsigned)(Rb * K + C) * 2u; }
    const size_t kstep = (size_t)(BK * 2);
    const size_t hstep = (size_t)HALF * K * 2;
    const size_t tstep = 2 * hstep;
    const unsigned ldsw = (unsigned)wid * 1024u;
    const int aoff = lds_byte(wr * 64 + fr, fq * 8), boff = lds_byte(wc * 32 + fr, fq * 8);
#define PG8_SA(b, h) (((b) * 2 + (h)) * HTB)
#define PG8_SB(b, h) ((4 + (b) * 2 + (h)) * HTB)
#define PG8_STAGE(bufoff, gbase, voff) do { _Pragma("unroll") for (int _i = 0; _i < 2; ++_i) \
        __builtin_amdgcn_global_load_lds((const unsigned*)((const char*)(gbase) + (voff)[_i]), (PG8_LAS unsigned*)(lds + (bufoff) + ldsw + _i * 8192), 16, 0, 0); } while (0)
#define PG8_LDA(dst, b, h) do { _Pragma("unroll") for (int m = 0; m < 4; ++m) _Pragma("unroll") for (int k = 0; k < 2; ++k) dst[m][k] = *(const PG8_LAS bf16x8*)(lds + PG8_SA(b, h) + aoff + m * 2048 + k * 1024); } while (0)
#define PG8_LDB(dst, b, h) do { _Pragma("unroll") for (int n = 0; n < 2; ++n) _Pragma("unroll") for (int k = 0; k < 2; ++k) dst[n][k] = *(const PG8_LAS bf16x8*)(lds + PG8_SB(b, h) + boff + n * 2048 + k * 1024); } while (0)
#define PG8_MMA(ai, bj, At, Bt) do { __builtin_amdgcn_s_setprio(1); _Pragma("unroll") for (int m = 0; m < 4; ++m) _Pragma("unroll") for (int n = 0; n < 2; ++n) _Pragma("unroll") for (int k = 0; k < 2; ++k) \
        acc[ai][bj][m][n] = __builtin_amdgcn_mfma_f32_16x16x32_bf16(Bt[n][k], At[m][k], acc[ai][bj][m][n], 0, 0, 0); __builtin_amdgcn_s_setprio(0); } while (0)
#define PG8_WAIT_V(n) asm volatile("s_waitcnt vmcnt(" #n ")" ::: "memory")
#define PG8_WAIT_L(n) asm volatile("s_waitcnt lgkmcnt(" #n ")" ::: "memory")
#define PG8_BAR __builtin_amdgcn_s_barrier()
#define PG8_SCHED __builtin_amdgcn_sched_barrier(0)
    Unit cur, nxt; int ui = 0;
    if (!S.next(0, cur)) return;
    f32x4 acc[2][2][4][2];
#pragma unroll
    for (int a = 0; a < 2; ++a)
#pragma unroll
        for (int b = 0; b < 2; ++b)
#pragma unroll
            for (int m = 0; m < 4; ++m)
#pragma unroll
                for (int n = 0; n < 2; ++n) acc[a][b][m][n] = (f32x4){0.f, 0.f, 0.f, 0.f};
    bf16x8 At[4][2], B0[2][2], B1[2][2];
    const char* cA = (const char*)g.A + (size_t)cur.pm * tstep; const char* cB = (const char*)g.Bt + (size_t)cur.pn * tstep;
    S.a_ready(cur);
    if constexpr (SP2) {
        PG8_STAGE(PG8_SB(0, 0), cB, voffB); PG8_STAGE(PG8_SB(0, 1), cB + hstep, voffB); PG8_STAGE(PG8_SA(0, 0), cA, voffA); PG8_STAGE(PG8_SA(0, 1), cA + hstep, voffA);
        if (wr == 1) PG8_BAR;
        PG8_WAIT_V(2); PG8_BAR;
        PG8_STAGE(PG8_SB(1, 0), cB + kstep, voffB); PG8_STAGE(PG8_SA(1, 0), cA + kstep, voffA); PG8_STAGE(PG8_SB(1, 1), cB + hstep + kstep, voffB);
        PG8_WAIT_V(6); PG8_BAR;
    } else {
        PG8_STAGE(PG8_SB(0, 0), cB, voffB); PG8_STAGE(PG8_SA(0, 0), cA, voffA); PG8_STAGE(PG8_SB(0, 1), cB + hstep, voffB); PG8_STAGE(PG8_SA(0, 1), cA + hstep, voffA);
        if (wr == 1) PG8_BAR;
        PG8_WAIT_V(4); PG8_BAR;
        PG8_STAGE(PG8_SB(1, 0), cB + kstep, voffB); PG8_STAGE(PG8_SA(1, 0), cA + kstep, voffA); PG8_STAGE(PG8_SB(1, 1), cB + hstep + kstep, voffB);
        PG8_WAIT_V(6); PG8_BAR;
    }
    for (;;) {
        const bool has_next = S.next(ui + 1, nxt);
        const char* nA = has_next ? (const char*)g.A + (size_t)nxt.pm * tstep : cA; const char* nB = has_next ? (const char*)g.Bt + (size_t)nxt.pn * tstep : cB;
        for (int t = 0; t < nt; t += 2) {
            const bool last = (t == nt - 2);
            const char* a1 = cA + (size_t)(t + 1) * kstep;
            const char* a2 = last ? nA : cA + (size_t)(t + 2) * kstep; const char* b2 = last ? nB : cB + (size_t)(t + 2) * kstep;
            const char* a3 = a2 + kstep; const char* b3 = b2 + kstep;
            if (last && has_next) S.a_ready(nxt);
            if constexpr (SP2) {
            PG8_LDB(B0, 0, 0); PG8_LDB(B1, 0, 1); PG8_SCHED; PG8_LDA(At, 0, 0); PG8_STAGE(PG8_SA(1, 1), a1 + hstep, voffA);
            PG8_WAIT_V(8); PG8_WAIT_L(0); PG8_BAR; PG8_MMA(0, 0, At, B0); PG8_MMA(0, 1, At, B1); PG8_BAR; PG8_SCHED;
            PG8_LDA(At, 0, 1); PG8_STAGE(PG8_SB(0, 0), b2, voffB); PG8_STAGE(PG8_SB(0, 1), b2 + hstep, voffB); PG8_STAGE(PG8_SA(0, 0), a2, voffA);
            PG8_WAIT_V(8); PG8_WAIT_L(0); PG8_BAR; PG8_MMA(1, 0, At, B0); PG8_MMA(1, 1, At, B1); PG8_BAR; PG8_SCHED;
            PG8_LDB(B0, 1, 0); PG8_LDB(B1, 1, 1); PG8_SCHED; PG8_LDA(At, 1, 0); PG8_STAGE(PG8_SA(0, 1), a2 + hstep, voffA);
            PG8_WAIT_V(8); PG8_WAIT_L(0); PG8_BAR; PG8_MMA(0, 0, At, B0); PG8_MMA(0, 1, At, B1); PG8_BAR; PG8_SCHED;
            PG8_LDA(At, 1, 1); PG8_STAGE(PG8_SB(1, 0), b3, voffB); PG8_STAGE(PG8_SB(1, 1), b3 + hstep, voffB); PG8_STAGE(PG8_SA(1, 0), a3, voffA);
            PG8_WAIT_V(8); PG8_WAIT_L(0); PG8_BAR; PG8_MMA(1, 0, At, B0); PG8_MMA(1, 1, At, B1); PG8_BAR; PG8_SCHED;
            } else {
            PG8_LDB(B0, 0, 0); PG8_SCHED; PG8_LDA(At, 0, 0); PG8_STAGE(PG8_SA(1, 1), a1 + hstep, voffA);
            PG8_WAIT_L(8); PG8_BAR; PG8_WAIT_L(0); PG8_MMA(0, 0, At, B0); PG8_BAR; PG8_SCHED;
            PG8_LDB(B1, 0, 1); PG8_STAGE(PG8_SB(0, 0), b2, voffB);
            PG8_BAR; PG8_WAIT_L(0); PG8_MMA(0, 1, At, B1); PG8_BAR;
            PG8_LDA(At, 0, 1); PG8_STAGE(PG8_SA(0, 0), a2, voffA);
            PG8_BAR; PG8_WAIT_L(0); PG8_MMA(1, 0, At, B0); PG8_BAR; PG8_SCHED;
            PG8_STAGE(PG8_SB(0, 1), b2 + hstep, voffB);
            PG8_WAIT_V(6); PG8_BAR; PG8_MMA(1, 1, At, B1); PG8_BAR;
            PG8_LDB(B0, 1, 0); PG8_SCHED; PG8_LDA(At, 1, 0); PG8_STAGE(PG8_SA(0, 1), a2 + hstep, voffA);
            PG8_WAIT_L(8); PG8_BAR; PG8_WAIT_L(0); PG8_MMA(0, 0, At, B0); PG8_BAR; PG8_SCHED;
            PG8_LDB(B1, 1, 1); PG8_STAGE(PG8_SB(1, 0), b3, voffB);
            PG8_BAR; PG8_WAIT_L(0); PG8_MMA(0, 1, At, B1); PG8_BAR;
            PG8_LDA(At, 1, 1); PG8_STAGE(PG8_SA(1, 0), a3, voffA);
            PG8_BAR; PG8_WAIT_L(0); PG8_MMA(1, 0, At, B0); PG8_BAR; PG8_SCHED;
            PG8_STAGE(PG8_SB(1, 1), b3 + hstep, voffB);
            PG8_WAIT_V(6); PG8_BAR; PG8_MMA(1, 1, At, B1); PG8_BAR;
            }
        }
        if constexpr (ALIGN_EPI) { if (wr == 0) PG8_BAR; }
        if constexpr (!Epi::AFTER_DRAIN) { E(acc, cur, wr, wc, fr, fq); S.done(cur); }
        if (!has_next) break;
#pragma unroll
        for (int a = 0; a < 2; ++a)
#pragma unroll
            for (int b = 0; b < 2; ++b)
#pragma unroll
                for (int m = 0; m < 4; ++m)
#pragma unroll
                    for (int n = 0; n < 2; ++n) acc[a][b][m][n] = (f32x4){0.f, 0.f, 0.f, 0.f};
        cur = nxt; cA = nA; cB = nB; ++ui;
        if constexpr (ALIGN_EPI) { if (wr == 1) PG8_BAR; }
    }
    PG8_WAIT_V(0);
    if constexpr (!ALIGN_EPI) { if (wr == 0) PG8_BAR; }
    PG8_BAR;
    if constexpr (Epi::AFTER_DRAIN) { E.fused(acc, cur, wr, wc, fr, fq, lds, wid, lane); S.done(cur); }
#undef PG8_SA
#undef PG8_SB
#undef PG8_STAGE
#undef PG8_LDA
#undef PG8_LDB
#undef PG8_MMA
#undef PG8_WAIT_V
#undef PG8_WAIT_L
#undef PG8_BAR
#undef PG8_SCHED
}
}


struct AttnP { const bf16_t* PROJ; const float *cache_k, *cache_v, *qn, *kn, *sinks; bf16_t* YMIX; float *ko_p, *ko_s, *vo_p, *vo_s; };
constexpr int KN_STRIDE = 72, VT_STRIDE = 200, ATT_VT_OFF = 192 * KN_STRIDE * 2;
__device__ __forceinline__ void attn_unit(unsigned char* lds, int unit, const AttnP& a) {
    int tid_ = threadIdx.x; asm volatile("" : "+v"(tid_));
    const int tid = tid_, lane = tid & 63, w = __builtin_amdgcn_readfirstlane(tid >> 6), fr = lane & 15, fq = lane >> 4;
    int sq, chunk, hkv; if (unit < 512) { sq = unit >> 7; chunk = (unit & 127) >> 1; hkv = unit & 1; } else { sq = 4 + ((unit - 512) >> 1); chunk = 0; hkv = unit & 1; }
    const Seq s = seq_of(sq);
    int nk, ncache, ktok0;
    if (s.sample) { nk = 160; ncache = 128; ktok0 = s.base; }
    else { const int back = chunk < 2 ? chunk : 2; nk = 64 * (back + 1); ncache = 0; ktok0 = s.base + (chunk - back) * 64; }
    bf16_t* Kn = (bf16_t*)lds; bf16_t* Vt = (bf16_t*)(lds + ATT_VT_OFF);
    int g, mt; bool act; if (!s.sample) { g = w >> 2; mt = w & 3; act = true; } else { g = (w >> 1) & 1; mt = w & 1; act = w < 4; }
    const bf16_t* qp = a.PROJ + (size_t)(s.base + chunk * 64 + mt * 16 + fr) * NINP + C_Q + (hkv * 2 + g) * 64 + 8 * fq;
    u32x4 qr0 = {0u, 0u, 0u, 0u}, qr1 = qr0;
    if (act) { qr0 = *(const u32x4*)qp; qr1 = *(const u32x4*)(qp + 32); }
    u32x4 kraw[3], vraw[3]; f32x4 kc[3][2], vc[3][2];
#pragma unroll
    for (int q = 0; q < 3; ++q) {
        const int p = tid + 512 * q, j = p >> 3, ch = p & 7;
        kraw[q] = (u32x4){0u, 0u, 0u, 0u}; vraw[q] = kraw[q]; kc[q][0] = (f32x4){0.f, 0.f, 0.f, 0.f}; kc[q][1] = kc[q][0]; vc[q][0] = kc[q][0]; vc[q][1] = kc[q][0];
        if (p < nk * 8) {
            if (j < ncache) {
                const float* kp = a.cache_k + (((size_t)s.b * 128 + j) * 2 + hkv) * 64 + ch * 8; const float* vp = a.cache_v + (((size_t)s.b * 128 + j) * 2 + hkv) * 64 + ch * 8;
                kc[q][0] = *(const f32x4*)kp; kc[q][1] = *(const f32x4*)(kp + 4); vc[q][0] = *(const f32x4*)vp; vc[q][1] = *(const f32x4*)(vp + 4);
            } else {
                const bf16_t* pp = a.PROJ + (size_t)(ktok0 + j - ncache) * NINP + hkv * 64 + ch * 8;
                kraw[q] = *(const u32x4*)(pp + C_K); vraw[q] = *(const u32x4*)(pp + C_V);
            }
        }
    }
#pragma unroll
    for (int q = 0; q < 3; ++q) {
        const int p = tid + 512 * q, j = p >> 3, ch = p & 7;
        if (p < nk * 8) {
        float kf[8], vf[8];
        if (j < ncache) {
            kf[0] = kc[q][0].x; kf[1] = kc[q][0].y; kf[2] = kc[q][0].z; kf[3] = kc[q][0].w; kf[4] = kc[q][1].x; kf[5] = kc[q][1].y; kf[6] = kc[q][1].z; kf[7] = kc[q][1].w;
            vf[0] = vc[q][0].x; vf[1] = vc[q][0].y; vf[2] = vc[q][0].z; vf[3] = vc[q][0].w; vf[4] = vc[q][1].x; vf[5] = vc[q][1].y; vf[6] = vc[q][1].z; vf[7] = vc[q][1].w;
        } else {
            unpack8(kraw[q], kf); unpack8(vraw[q], vf);
            float ss = 0.f;
#pragma unroll
            for (int i = 0; i < 8; ++i) ss += kf[i] * kf[i];
            ss += __shfl_xor(ss, 1); ss += __shfl_xor(ss, 2); ss += __shfl_xor(ss, 4);
            const float rs = rsqrtf(ss * (1.f / 64.f) + 1e-6f);
            const f32x4 g0 = *(const f32x4*)(a.kn + ch * 8), g1 = *(const f32x4*)(a.kn + ch * 8 + 4);
            kf[0] *= rs * g0.x; kf[1] *= rs * g0.y; kf[2] *= rs * g0.z; kf[3] *= rs * g0.w; kf[4] *= rs * g1.x; kf[5] *= rs * g1.y; kf[6] *= rs * g1.z; kf[7] *= rs * g1.w;
        }
        u32x4 ko; ko.x = pk2(kf[0], kf[1]); ko.y = pk2(kf[2], kf[3]); ko.z = pk2(kf[4], kf[5]); ko.w = pk2(kf[6], kf[7]);
        *(u32x4*)(Kn + j * KN_STRIDE + ch * 8) = ko;
#pragma unroll
        for (int i = 0; i < 8; ++i) Vt[(ch * 8 + i) * VT_STRIDE + j] = f2bf(vf[i]);
        float* ko_ = nullptr; float* vo_ = nullptr;
        if (s.sample) { if (j >= 32) { ko_ = a.ko_s + ((size_t)s.b * 128 + (j - 32)) * 128 + hkv * 64 + ch * 8; vo_ = a.vo_s + ((size_t)s.b * 128 + (j - 32)) * 128 + hkv * 64 + ch * 8; } }
        else if (chunk >= 62 && j >= nk - 64) { const int jj = (chunk - 62) * 64 + (j - (nk - 64)); ko_ = a.ko_p + ((size_t)s.b * 128 + jj) * 128 + hkv * 64 + ch * 8; vo_ = a.vo_p + ((size_t)s.b * 128 + jj) * 128 + hkv * 64 + ch * 8; }
        if (ko_) { *(f32x4*)ko_ = (f32x4){kf[0], kf[1], kf[2], kf[3]}; *(f32x4*)(ko_ + 4) = (f32x4){kf[4], kf[5], kf[6], kf[7]}; *(f32x4*)vo_ = (f32x4){vf[0], vf[1], vf[2], vf[3]}; *(f32x4*)(vo_ + 4) = (f32x4){vf[4], vf[5], vf[6], vf[7]}; }
        }
    }
    __syncthreads();
    if (act) {
        const int qh = hkv * 2 + g, tok = s.base + chunk * 64 + mt * 16 + fr, nkt = nk >> 4, nks = nk >> 5;
        float qf[16]; unpack8(qr0, qf); unpack8(qr1, qf + 8);
        float ss = 0.f;
#pragma unroll
        for (int i = 0; i < 16; ++i) ss += qf[i] * qf[i];
        ss += __shfl_xor(ss, 16); ss += __shfl_xor(ss, 32);
        const float rs = rsqrtf(ss * (1.f / 64.f) + 1e-6f) * 0.125f;
#pragma unroll
        for (int i = 0; i < 8; ++i) { qf[i] *= rs * a.qn[8 * fq + i]; qf[8 + i] *= rs * a.qn[32 + 8 * fq + i]; }
        union { u32x4 u; bf16x8 v; } qa, qb;
        qa.u.x = pk2(qf[0], qf[1]); qa.u.y = pk2(qf[2], qf[3]); qa.u.z = pk2(qf[4], qf[5]); qa.u.w = pk2(qf[6], qf[7]);
        qb.u.x = pk2(qf[8], qf[9]); qb.u.y = pk2(qf[10], qf[11]); qb.u.z = pk2(qf[12], qf[13]); qb.u.w = pk2(qf[14], qf[15]);
        f32x4 sacc[12];
        const float sink = a.sinks[qh];
        float m = sink;
#pragma unroll
        for (int kt = 0; kt < 12; ++kt) {
            sacc[kt] = (f32x4){0.f, 0.f, 0.f, 0.f};
            if (kt < nkt) {
                const bf16x8 k0 = *(const bf16x8*)(Kn + (kt * 16 + fr) * KN_STRIDE + 8 * fq), k1 = *(const bf16x8*)(Kn + (kt * 16 + fr) * KN_STRIDE + 32 + 8 * fq);
                sacc[kt] = __builtin_amdgcn_mfma_f32_16x16x32_bf16(k0, qa.v, sacc[kt], 0, 0, 0);
                sacc[kt] = __builtin_amdgcn_mfma_f32_16x16x32_bf16(k1, qb.v, sacc[kt], 0, 0, 0);
                m = fmaxf(m, fmaxf(fmaxf(sacc[kt].x, sacc[kt].y), fmaxf(sacc[kt].z, sacc[kt].w)));
            }
        }
        m = fmaxf(m, __shfl_xor(m, 16)); m = fmaxf(m, __shfl_xor(m, 32));
        float lsum = 0.f;
#pragma unroll
        for (int kt = 0; kt < 12; ++kt) if (kt < nkt) {
            sacc[kt].x = __expf(sacc[kt].x - m); sacc[kt].y = __expf(sacc[kt].y - m); sacc[kt].z = __expf(sacc[kt].z - m); sacc[kt].w = __expf(sacc[kt].w - m);
            lsum += (sacc[kt].x + sacc[kt].y) + (sacc[kt].z + sacc[kt].w);
        }
        lsum += __shfl_xor(lsum, 16); lsum += __shfl_xor(lsum, 32);
        lsum += __expf(sink - m);
        f32x4 oacc[4];
#pragma unroll
        for (int dt = 0; dt < 4; ++dt) oacc[dt] = (f32x4){0.f, 0.f, 0.f, 0.f};
#pragma unroll
        for (int ks = 0; ks < 6; ++ks) if (ks < nks) {
            union { u32x4 u; bf16x8 v; } pf;
            pf.u.x = pk2(sacc[2 * ks].x, sacc[2 * ks].y); pf.u.y = pk2(sacc[2 * ks].z, sacc[2 * ks].w); pf.u.z = pk2(sacc[2 * ks + 1].x, sacc[2 * ks + 1].y); pf.u.w = pk2(sacc[2 * ks + 1].z, sacc[2 * ks + 1].w);
#pragma unroll
            for (int dt = 0; dt < 4; ++dt) {
                union { u32x4 u; bf16x8 v; } vf;
                const u32x2 lo = *(const u32x2*)(Vt + (dt * 16 + fr) * VT_STRIDE + 32 * ks + 4 * fq), hi2 = *(const u32x2*)(Vt + (dt * 16 + fr) * VT_STRIDE + 32 * ks + 16 + 4 * fq);
                vf.u.x = lo.x; vf.u.y = lo.y; vf.u.z = hi2.x; vf.u.w = hi2.y;
                oacc[dt] = __builtin_amdgcn_mfma_f32_16x16x32_bf16(vf.v, pf.v, oacc[dt], 0, 0, 0);
            }
        }
        const float inv = 1.f / lsum;
#pragma unroll
        for (int dt = 0; dt < 4; ++dt) { u32x2 o; o.x = pk2(oacc[dt].x * inv, oacc[dt].y * inv); o.y = pk2(oacc[dt].z * inv, oacc[dt].w * inv);
            *(u32x2*)(a.YMIX + (size_t)tok * DM + 768 + qh * 64 + dt * 16 + 4 * fq) = o; }
    }
    __syncthreads();
}

struct ConvPoolP { const bf16_t* PROJ; const float *cache_conv, *cw, *cb, *lg, *lb, *cache_pool, *pw, *psc; bf16_t* YMIX; float *co_p, *co_s, *po_p, *po_s; const bf16_t *GLU, *PWT; };
__device__ __forceinline__ void convpool_tile(float* sm, int tile, const ConvPoolP& a) {
    int tid_ = threadIdx.x; asm volatile("" : "+v"(tid_));
    int c = tid_ & 255;
#define RELAUNDER() asm volatile("" : "+v"(c))
    int sq, t0; if (tile < 1024) { sq = tile >> 8; t0 = (tile & 255) * 16; } else { sq = 4 + ((tile - 1024) >> 1); t0 = ((tile - 1024) & 1) * 16; }
    const Seq s = seq_of(sq);
    float* ext = sm;
    float* yb = sm + 46 * 256;
    bf16_t* db = (bf16_t*)yb;
    {
        u32x4 vv[6]; f32x4 h0[6], h1[6];
#pragma unroll
        for (int q = 0; q < 6; ++q) {
            const int pr = c + 256 * q, i = pr >> 5, cg = pr & 31, t = t0 - 30 + i;
            vv[q] = (u32x4){0u, 0u, 0u, 0u}; h0[q] = (f32x4){0.f, 0.f, 0.f, 0.f}; h1[q] = h0[q];
            if (i < 46) {
                if (t >= 0) vv[q] = *(const u32x4*)(a.GLU + (size_t)(s.base + t) * 256 + cg * 8);
                else if (s.sample) { const float* p = a.cache_conv + ((size_t)s.b * 30 + 30 + t) * 256 + cg * 8; h0[q] = *(const f32x4*)p; h1[q] = *(const f32x4*)(p + 4); }
            }
        }
#pragma unroll
        for (int q = 0; q < 6; ++q) {
            const int pr = c + 256 * q, i = pr >> 5, cg = pr & 31, t = t0 - 30 + i;
            if (i < 46) {
                f32x4 e0 = h0[q], e1 = h1[q];
                if (t >= 0) { float v[8]; unpack8(vv[q], v); e0 = (f32x4){v[0], v[1], v[2], v[3]}; e1 = (f32x4){v[4], v[5], v[6], v[7]}; }
                *(f32x4*)(ext + i * 256 + cg * 8) = e0; *(f32x4*)(ext + i * 256 + cg * 8 + 4) = e1;
            }
        }
    }
    __syncthreads(); RELAUNDER();
    {
        float e[46];
#pragma unroll
        for (int i = 0; i < 46; ++i) e[i] = ext[i * 256 + c];
        float* o = s.sample ? a.co_s + (size_t)s.b * 30 * 256 : a.co_p + (size_t)s.b * 30 * 256;
        if (t0 + 15 >= s.L - 30) {
#pragma unroll
            for (int i = 0; i < 16; ++i) { const int t = t0 + i; if (t >= s.L - 30) o[(t - (s.L - 30)) * 256 + c] = e[i + 30]; }
        }
        float y[16]; const float bias = a.cb[c];
#pragma unroll
        for (int i = 0; i < 16; ++i) y[i] = bias;
#pragma unroll
        for (int j = 0; j < 31; ++j) { const float wj = a.cw[j * 256 + c];
#pragma unroll
            for (int i = 0; i < 16; ++i) y[i] += wj * e[i + j]; }
#pragma unroll
        for (int i = 0; i < 16; ++i) yb[i * 256 + c] = y[i];
    }
    __syncthreads(); RELAUNDER();
    u32x4 pv[4]; f32x4 ph0[4], ph1[4];
#pragma unroll
    for (int q = 0; q < 4; ++q) {
        const int pr = c + 256 * q, i = pr >> 5, cg = pr & 31, t = t0 - 15 + i;
        pv[q] = (u32x4){0u, 0u, 0u, 0u}; ph0[q] = (f32x4){0.f, 0.f, 0.f, 0.f}; ph1[q] = ph0[q];
        if (i < 31) {
            if (t >= 0) pv[q] = *(const u32x4*)(a.PROJ + (size_t)(s.base + t) * NINP + C_C + cg * 8);
            else if (s.sample) { const float* p = a.cache_pool + ((size_t)s.b * 15 + 15 + t) * 256 + cg * 8; ph0[q] = *(const f32x4*)p; ph1[q] = *(const f32x4*)(p + 4); }
        }
    }
    {
        const int wv = c >> 6, lane = c & 63;
        const f32x4 g4 = ((const f32x4*)a.lg)[lane], b4 = ((const f32x4*)a.lb)[lane];
#pragma unroll 1
        for (int i = wv; i < 16; i += 4) {
            const f32x4 v = ((const f32x4*)(yb + i * 256))[lane];
            const float mean = wave_sum((v.x + v.y) + (v.z + v.w)) * (1.f / 256.f);
            const f32x4 d = v - mean;
            const float var = wave_sum((d.x * d.x + d.y * d.y) + (d.z * d.z + d.w * d.w)) * (1.f / 256.f);
            const float rstd = rsqrtf(var + 1e-5f);
            f32x4 o = d * rstd * g4 + b4;
            o.x *= sigmoidf_(o.x); o.y *= sigmoidf_(o.y); o.z *= sigmoidf_(o.z); o.w *= sigmoidf_(o.w);
            *(u32x2*)(a.YMIX + (size_t)(s.base + t0 + i) * DM + 0 + lane * 4) = pk4(o);
        }
    }
    __syncthreads(); RELAUNDER();
#pragma unroll
    for (int q = 0; q < 4; ++q) {
        const int pr = c + 256 * q, i = pr >> 5, cg = pr & 31, t = t0 - 15 + i;
        if (i < 31) {
            f32x4 e0 = ph0[q], e1 = ph1[q];
            if (t >= 0) { float v[8]; unpack8(pv[q], v); e0 = (f32x4){v[0], v[1], v[2], v[3]}; e1 = (f32x4){v[4], v[5], v[6], v[7]}; }
            *(f32x4*)(ext + i * 256 + cg * 8) = e0; *(f32x4*)(ext + i * 256 + cg * 8 + 4) = e1;
        }
    }
    __syncthreads(); RELAUNDER();
    {
        float e[31];
#pragma unroll
        for (int i = 0; i < 31; ++i) e[i] = ext[i * 256 + c];
        float* o = s.sample ? a.po_s + (size_t)s.b * 15 * 256 : a.po_p + (size_t)s.b * 15 * 256;
        if (t0 + 15 >= s.L - 15) {
#pragma unroll
            for (int i = 0; i < 16; ++i) { const int t = t0 + i; if (t >= s.L - 15) o[(t - (s.L - 15)) * 256 + c] = e[i + 15]; }
        }
        const int g = __builtin_amdgcn_readfirstlane(c >> 6), w = 2 << g;
        float w2[16], w4[16], w8[16], w16[16];
#pragma unroll
        for (int i = 0; i < 16; ++i) w2[i] = e[15 + i] + e[14 + i];
        if (g >= 1) {
#pragma unroll
            for (int i = 0; i < 16; ++i) w4[i] = (e[15 + i] + e[14 + i]) + (e[13 + i] + e[12 + i]);
        }
        if (g >= 2) {
#pragma unroll
            for (int i = 0; i < 16; ++i) w8[i] = ((e[15 + i] + e[14 + i]) + (e[13 + i] + e[12 + i])) + ((e[11 + i] + e[10 + i]) + (e[9 + i] + e[8 + i]));
        }
        if (g == 3) {
            float cs[32]; cs[0] = e[0];
#pragma unroll
            for (int k = 1; k < 31; ++k) cs[k] = cs[k - 1] + e[k];
#pragma unroll
            for (int i = 0; i < 16; ++i) w16[i] = i == 0 ? cs[15] : cs[15 + i] - cs[i - 1];
        }
#pragma unroll
        for (int i = 0; i < 16; ++i) {
            const float sum = g == 0 ? w2[i] : (g == 1 ? w4[i] : (g == 2 ? w8[i] : w16[i]));
            const int pos = s.pos0 + t0 + i; const int cnt = (pos + 1) < w ? (pos + 1) : w;
            db[i * 264 + c] = f2bf(sum * __builtin_amdgcn_rcpf((float)cnt) - e[15 + i]);
        }
    }
    __syncthreads(); RELAUNDER();
    {
        const int g = __builtin_amdgcn_readfirstlane(c >> 6), lane = c & 63, fr = lane & 15, fq = lane >> 4;
        const bf16x8 d0 = *(const bf16x8*)(db + fr * 264 + g * 64 + 8 * fq), d1 = *(const bf16x8*)(db + fr * 264 + g * 64 + 32 + 8 * fq);
#pragma unroll
        for (int dt = 0; dt < 4; ++dt) {
            const bf16_t* wp = a.PWT + ((size_t)g * 64 + 16 * dt + fr) * 64 + 8 * fq;
            f32x4 acc = __builtin_amdgcn_mfma_f32_16x16x32_bf16(*(const bf16x8*)wp, d0, (f32x4){0.f, 0.f, 0.f, 0.f}, 0, 0, 0);
            acc = __builtin_amdgcn_mfma_f32_16x16x32_bf16(*(const bf16x8*)(wp + 32), d1, acc, 0, 0, 0);
            acc *= *(const f32x4*)(a.psc + g * 64 + 16 * dt + 4 * fq);
            *(u32x2*)(a.YMIX + (size_t)(s.base + t0 + fr) * DM + 512 + g * 64 + 16 * dt + 4 * fq) = pk4(acc);
        }
    }
    __syncthreads();
#undef RELAUNDER
}

struct RwkvG { bf16_t *PT, *QQ, *ZZ, *Y0, *SC, *GATE, *BV; const bf16_t* LWT; };
constexpr int RC_HEAD = 30208, RC_MAB = 0, RC_MAK = 4608, RC_MRB = 7168, RC_MRK = 9728, RC_TM = 12288, RC_MAKVT = 14848, RC_GT = 19968, RC_U0T = 25088;
constexpr int RB_BASE = 2 * RC_HEAD, RB_HEAD = 38912, RB_AT = 0, RB_BH = 4608, RB_KH = 9216, RB_RT = 13824, RB_ATT = 18432, RB_BHT = 23552, RB_KHT = 28672, RB_VT = 33792;
constexpr int RA_LAT = 0, RA_WL = 8704, RA_AL = 25088, RA_SCN = 41472, R_WLS = RB_BASE + 2 * RB_HEAD;
constexpr int NS = 72, TS = 40, LATS = 136, MABS = 36;
__device__ __forceinline__ bf16x8 ldf(const bf16_t* base, int row, int stride, int col) { return *(const bf16x8*)(base + row * stride + col); }
#define MFMA16(a, b, c) __builtin_amdgcn_mfma_f32_16x16x32_bf16((a), (b), (c), 0, 0, 0)

__device__ __forceinline__ void rwkv_item(unsigned char* lds, int item, int l, const bf16_t* __restrict__ PROJ, const float* __restrict__ shift_in, const RwkvW& w, const RwkvG& G) {
    int tid = threadIdx.x; asm volatile("" : "+v"(tid));
    const int wv = __builtin_amdgcn_readfirstlane(tid >> 6);
    const int cid = item >> 1, hp = item & 1, tok0 = cid * 32;
    const bool sample = cid >= 512, first = sample || ((cid & 127) == 0);
    const int sb = cid - 512;
    bf16_t* LAT = (bf16_t*)(lds + RA_LAT); float* WLb = (float*)(lds + RA_WL); float* ALb = (float*)(lds + RA_AL); float* SCN = (float*)(lds + RA_SCN); float* WLs = (float*)(lds + R_WLS);
    const int lane0 = tid & 63, fr0 = lane0 & 15, fq0 = lane0 >> 4;
    const bf16_t* lwp = G.LWT + ((size_t)l * 256 + hp * 128 + 16 * wv + fr0) * 128 + 8 * fq0;
    const bf16x8 fw = *(const bf16x8*)(lwp), fa = *(const bf16x8*)(lwp + 32), fg0 = *(const bf16x8*)(lwp + 64), fg1 = *(const bf16x8*)(lwp + 96);
    const f32x4 w0v = *(const f32x4*)(w.w0 + hp * 128 + 16 * wv + 4 * fq0), a0v = *(const f32x4*)(w.a0 + hp * 128 + 16 * wv + 4 * fq0);
    const int c3 = tid & 127, tq3 = tid >> 7, cg3 = hp * 128 + c3;
    float ur[9], uk[9], uv[9];
#pragma unroll
    for (int i = 0; i < 9; ++i) {
        const int t = 8 * tq3 - 1 + i;
        if (t >= 0 || !first) { const bf16_t* p = PROJ + (size_t)(tok0 + t) * NINP + C_B + cg3; ur[i] = bf2f(p[0]); uk[i] = bf2f(p[256]); uv[i] = bf2f(p[512]); }
        else if (sample) { const float* p = shift_in + (size_t)sb * 896 + cg3; ur[i] = p[0]; uk[i] = p[256]; uv[i] = p[512]; }
        else { ur[i] = 0.f; uk[i] = 0.f; uv[i] = 0.f; }
    }
    const float mur = w.mu[cg3], muk = w.mu[256 + cg3], muv = w.mu[512 + cg3], kkw = w.k_k[cg3], kaw = w.k_a[cg3], rkw = w.r_k[cg3];
    {
        const int t = tid >> 4, j8 = (tid & 15) * 8, col = 768 + j8;
        float u[8], pv[8];
        unpack8(*(const u32x4*)(PROJ + (size_t)(tok0 + t) * NINP + C_B + col), u);
        if (t > 0 || !first) unpack8(*(const u32x4*)(PROJ + (size_t)(tok0 + t - 1) * NINP + C_B + col), pv);
        else if (sample) { const f32x4 a = *(const f32x4*)(shift_in + (size_t)sb * 896 + col), b = *(const f32x4*)(shift_in + (size_t)sb * 896 + col + 4); pv[0] = a.x; pv[1] = a.y; pv[2] = a.z; pv[3] = a.w; pv[4] = b.x; pv[5] = b.y; pv[6] = b.z; pv[7] = b.w; }
        else {
#pragma unroll
            for (int i = 0; i < 8; ++i) pv[i] = 0.f; }
        const f32x4 m0 = *(const f32x4*)(w.mu + col), m1 = *(const f32x4*)(w.mu + col + 4);
        const float mu[8] = {m0.x, m0.y, m0.z, m0.w, m1.x, m1.y, m1.z, m1.w};
        float x[8];
#pragma unroll
        for (int i = 0; i < 8; ++i) { const float xs = u[i] + mu[i] * (pv[i] - u[i]); x[i] = j8 < 32 ? 1.f - 2.f / (1.f + __expf(2.f * xs)) : (j8 < 64 ? xs : sigmoidf_(xs)); }
        u32x4 o; o.x = pk2(x[0], x[1]); o.y = pk2(x[2], x[3]); o.z = pk2(x[4], x[5]); o.w = pk2(x[6], x[7]);
        *(u32x4*)(LAT + t * LATS + j8) = o;
    }
    __syncthreads();
    {
        asm volatile("" : "+v"(tid)); const int lane = tid & 63, fr = lane & 15, fq = lane >> 4;
        const int c0l = 16 * wv, cg0 = hp * 128 + c0l;
#pragma unroll
        for (int tt = 0; tt < 2; ++tt) {
            const int t = 16 * tt + fr;
            const f32x4 z = {0.f, 0.f, 0.f, 0.f};
            f32x4 aw = MFMA16(fw, ldf(LAT, t, LATS, 8 * fq), z);
            f32x4 aa = MFMA16(fa, ldf(LAT, t, LATS, 32 + 8 * fq), z);
            f32x4 ag = MFMA16(fg0, ldf(LAT, t, LATS, 64 + 8 * fq), z);
            ag = MFMA16(fg1, ldf(LAT, t, LATS, 96 + 8 * fq), ag);
            *(f32x4*)(WLb + t * 128 + c0l + 4 * fq) = aw + w0v;
            *(f32x4*)(ALb + t * 128 + c0l + 4 * fq) = aa + a0v;
            *(u32x2*)(G.GATE + (size_t)(tok0 + t) * 256 + cg0 + 4 * fq) = pk4(ag);
        }
    }
    __syncthreads();
    {
        asm volatile("" : "+v"(tid));
        const int c = tid & 127, tq = tid >> 7, hd = c >> 6, c64 = c & 63, cg = hp * 128 + c;
        unsigned char* hb = lds + RB_BASE + hd * RB_HEAD;
        bf16_t *AT = (bf16_t*)(hb + RB_AT), *BH = (bf16_t*)(hb + RB_BH), *KH = (bf16_t*)(hb + RB_KH), *RT = (bf16_t*)(hb + RB_RT);
        bf16_t *ATt = (bf16_t*)(hb + RB_ATT), *BHt = (bf16_t*)(hb + RB_BHT), *KHt = (bf16_t*)(hb + RB_KHT), *Vt = (bf16_t*)(hb + RB_VT);
        float lw[8], cl[8];
        float run = 0.f;
#pragma unroll
        for (int i = 0; i < 8; ++i) { lw[i] = -0.60653066f * sigmoidf_(WLb[(8 * tq + i) * 128 + c]); run += lw[i]; cl[i] = run; }
        SCN[tq * 128 + c] = run;
        __syncthreads();
        float pre = 0.f, tot = 0.f;
#pragma unroll
        for (int q = 0; q < 4; ++q) { const float v = SCN[q * 128 + c]; tot += v; if (q < tq) pre += v; }
        if (tq == 0) WLs[c] = __expf(tot);
        float at8[8], bh8[8], kh8[8], vv8[8];
        float rr8[8], kk8[8], km8[8], ar8[8], ss8[8], bo8[8];
#pragma unroll
        for (int i = 0; i < 8; ++i) {
            const int t = 8 * tq + i;
            rr8[i] = ur[i + 1] + mur * (ur[i] - ur[i + 1]); const float k = uk[i + 1] + muk * (uk[i] - uk[i + 1]); vv8[i] = uv[i + 1] + muv * (uv[i] - uv[i + 1]);
            ar8[i] = __builtin_amdgcn_rcpf(1.f + __expf(-ALb[t * 128 + c]));
            kk8[i] = k * kkw; km8[i] = k * (1.f + (ar8[i] - 1.f) * kaw);
            ss8[i] = kk8[i] * kk8[i]; bo8[i] = rr8[i] * km8[i] * rkw;
        }
#pragma unroll
        for (int o = 1; o < 64; o <<= 1) {
#pragma unroll
            for (int i = 0; i < 8; ++i) { ss8[i] += __shfl_xor(ss8[i], o); bo8[i] += __shfl_xor(bo8[i], o); }
        }
#pragma unroll
        for (int i = 0; i < 8; ++i) {
            const int t = 8 * tq + i;
            const float cum = pre + cl[i];
            const float W = __expf(cum), Wp = __expf(cum - lw[i]), iW = __expf(-cum);
            const float kkn = kk8[i] * __builtin_amdgcn_rcpf(fmaxf(sqrtf(ss8[i]), 1e-12f));
            const float at = -kkn * Wp, bh = kkn * ar8[i] * iW, kh = km8[i] * iW, rt = rr8[i] * W;
            AT[t * NS + c64] = f2bf(at); BH[t * NS + c64] = f2bf(bh); KH[t * NS + c64] = f2bf(kh); RT[t * NS + c64] = f2bf(rt);
            at8[i] = at; bh8[i] = bh; kh8[i] = kh;
            G.BV[(size_t)(tok0 + t) * 256 + cg] = f2bf(bo8[i] * vv8[i]);
        }
        u32x4 o;
        o.x = pk2(at8[0], at8[1]); o.y = pk2(at8[2], at8[3]); o.z = pk2(at8[4], at8[5]); o.w = pk2(at8[6], at8[7]); *(u32x4*)(ATt + c64 * TS + 8 * tq) = o;
        o.x = pk2(bh8[0], bh8[1]); o.y = pk2(bh8[2], bh8[3]); o.z = pk2(bh8[4], bh8[5]); o.w = pk2(bh8[6], bh8[7]); *(u32x4*)(BHt + c64 * TS + 8 * tq) = o;
        o.x = pk2(kh8[0], kh8[1]); o.y = pk2(kh8[2], kh8[3]); o.z = pk2(kh8[4], kh8[5]); o.w = pk2(kh8[6], kh8[7]); *(u32x4*)(KHt + c64 * TS + 8 * tq) = o;
        o.x = pk2(vv8[0], vv8[1]); o.y = pk2(vv8[2], vv8[3]); o.z = pk2(vv8[4], vv8[5]); o.w = pk2(vv8[6], vv8[7]); *(u32x4*)(Vt + c64 * TS + 8 * tq) = o;
    }
    __syncthreads();
    asm volatile("" : "+v"(tid)); const int lane = tid & 63, fr = lane & 15, fq = lane >> 4;
    const int hd = wv >> 2, wg = wv & 3, h = hp * 2 + hd; const size_t ch = (size_t)cid * 4 + h;
    unsigned char* hb = lds + RB_BASE + hd * RB_HEAD; unsigned char* cb = lds + hd * RC_HEAD;
    const bf16_t *AT = (const bf16_t*)(hb + RB_AT), *BH = (const bf16_t*)(hb + RB_BH), *KH = (const bf16_t*)(hb + RB_KH), *RT = (const bf16_t*)(hb + RB_RT);
    const bf16_t *ATt = (const bf16_t*)(hb + RB_ATT), *BHt = (const bf16_t*)(hb + RB_BHT), *KHt = (const bf16_t*)(hb + RB_KHT), *Vt = (const bf16_t*)(hb + RB_VT);
    float* Mab = (float*)(cb + RC_MAB);
    bf16_t *Mak = (bf16_t*)(cb + RC_MAK), *Mrb = (bf16_t*)(cb + RC_MRB), *Mrk = (bf16_t*)(cb + RC_MRK), *Tm = (bf16_t*)(cb + RC_TM), *MakVt = (bf16_t*)(cb + RC_MAKVT), *GT = (bf16_t*)(cb + RC_GT), *U0T = (bf16_t*)(cb + RC_U0T);
    const f32x4 z4 = {0.f, 0.f, 0.f, 0.f};
    {
        const bf16_t* rowsrc = (wg >> 1) ? RT : AT; const bf16_t* colsrc = (wg & 1) ? KH : BH;
        bf16_t* Mo = wg == 1 ? Mak : (wg == 2 ? Mrb : Mrk);
#pragma unroll
        for (int tt = 0; tt < 2; ++tt)
#pragma unroll
            for (int st = 0; st < 2; ++st) {
                f32x4 acc = MFMA16(ldf(colsrc, 16 * st + fr, NS, 8 * fq), ldf(rowsrc, 16 * tt + fr, NS, 8 * fq), z4);
                acc = MFMA16(ldf(colsrc, 16 * st + fr, NS, 32 + 8 * fq), ldf(rowsrc, 16 * tt + fr, NS, 32 + 8 * fq), acc);
                const int t = 16 * tt + fr, s0 = 16 * st + 4 * fq, lim = (wg >> 1) ? t + 1 : t;
                acc.x = (s0 + 0 < lim) ? acc.x : 0.f; acc.y = (s0 + 1 < lim) ? acc.y : 0.f; acc.z = (s0 + 2 < lim) ? acc.z : 0.f; acc.w = (s0 + 3 < lim) ? acc.w : 0.f;
                if (wg == 0) *(f32x4*)(Mab + t * MABS + s0) = acc; else *(u32x2*)(Mo + t * TS + s0) = pk4(acc);
            }
    }
    __syncthreads();
    const float* WL = (const float*)(lds + R_WLS) + hd * 64;
    if (wg == 0) {
        {
            const int j = lane & 31;
            float Tc[32];
            f32x4 cur[8];
#pragma unroll
            for (int q = 0; q < 8; ++q) cur[q] = (f32x4){0.f, 0.f, 0.f, 0.f};
#pragma unroll
            for (int t = 0; t < 32; ++t) {
                f32x4 nx[8];
#pragma unroll
                for (int q = 0; q < 8; ++q) nx[q] = (t + 1 < 32 && 4 * q < t + 1) ? *(const f32x4*)(Mab + (t + 1) * MABS + 4 * q) : (f32x4){0.f, 0.f, 0.f, 0.f};
                float a0 = (t == j) ? 1.f : 0.f, a1 = 0.f;
#pragma unroll
                for (int s2 = 0; s2 < t; ++s2) { const float nv = cur[s2 >> 2][s2 & 3]; if (s2 & 1) a1 += nv * Tc[s2]; else a0 += nv * Tc[s2]; }
                Tc[t] = a0 + a1;
#pragma unroll
                for (int q = 0; q < 8; ++q) cur[q] = nx[q];
            }
            if (lane < 32) {
#pragma unroll
                for (int t = 0; t < 32; ++t) Tm[t * TS + j] = f2bf(Tc[t]);
            }
        }
        __syncthreads();
#pragma unroll
        for (int rt = 0; rt < 2; ++rt)
#pragma unroll
            for (int tt = 0; tt < 2; ++tt) {
                const f32x4 acc = MFMA16(ldf(Tm, 16 * tt + fr, TS, 8 * fq), ldf(ATt, 16 * rt + fr, TS, 8 * fq), z4);
                *(u32x2*)(GT + (16 * rt + fr) * TS + 16 * tt + 4 * fq) = pk4(acc);
            }
        __syncthreads();
#pragma unroll
        for (int tt = 0; tt < 2; ++tt)
#pragma unroll
            for (int ks = 0; ks < 2; ++ks) {
                u32x2 pc[2];
#pragma unroll
                for (int hf = 0; hf < 2; ++hf) {
                    const int kt = 2 * ks + hf;
                    f32x4 acc = MFMA16(ldf(GT, 16 * kt + fr, TS, 8 * fq), ldf(Mrb, 16 * tt + fr, TS, 8 * fq), z4);
                    const int t = 16 * tt + fr, k0 = 16 * kt + 4 * fq;
                    const u32x2 rr = *(const u32x2*)(RT + t * NS + k0);
                    acc.x += __uint_as_float(rr.x << 16); acc.y += __uint_as_float(rr.x & 0xffff0000u); acc.z += __uint_as_float(rr.y << 16); acc.w += __uint_as_float(rr.y & 0xffff0000u);
                    pc[hf] = pk4(acc);
                }
                *(u32x4*)(G.ZZ + ch * 2048 + ((tt * 2 + ks) * 64 + lane) * 8) = (u32x4){pc[0].x, pc[0].y, pc[1].x, pc[1].y};
            }
    } else if (wg == 1) {
#pragma unroll
        for (int vt = 0; vt < 4; ++vt)
#pragma unroll
            for (int tt = 0; tt < 2; ++tt) {
                const f32x4 acc = MFMA16(ldf(Mak, 16 * tt + fr, TS, 8 * fq), ldf(Vt, 16 * vt + fr, TS, 8 * fq), z4);
                *(u32x2*)(MakVt + (16 * vt + fr) * TS + 16 * tt + 4 * fq) = pk4(acc);
            }
        __syncthreads();
#pragma unroll
        for (int rt = 2; rt < 4; ++rt)
#pragma unroll
            for (int tt = 0; tt < 2; ++tt) {
                const f32x4 acc = MFMA16(ldf(Tm, 16 * tt + fr, TS, 8 * fq), ldf(ATt, 16 * rt + fr, TS, 8 * fq), z4);
                *(u32x2*)(GT + (16 * rt + fr) * TS + 16 * tt + 4 * fq) = pk4(acc);
            }
        __syncthreads();
#pragma unroll
        for (int kp = 0; kp < 4; ++kp)
#pragma unroll
            for (int ks = 0; ks < 2; ++ks) {
                u32x2 pc[2];
#pragma unroll
                for (int hf = 0; hf < 2; ++hf) {
                    const int kt = 2 * ks + hf;
                    f32x4 acc = MFMA16(ldf(GT, 16 * kt + fr, TS, 8 * fq), ldf(BHt, 16 * kp + fr, TS, 8 * fq), z4);
                    const int kq = 16 * kp + fr, k0 = 16 * kt + 4 * fq; const float wl = WL[kq];
                    acc.x = (acc.x + (k0 + 0 == kq ? 1.f : 0.f)) * wl; acc.y = (acc.y + (k0 + 1 == kq ? 1.f : 0.f)) * wl; acc.z = (acc.z + (k0 + 2 == kq ? 1.f : 0.f)) * wl; acc.w = (acc.w + (k0 + 3 == kq ? 1.f : 0.f)) * wl;
                    pc[hf] = pk4(acc);
                }
                *(u32x4*)(G.PT + ch * 4096 + ((kp * 2 + ks) * 64 + lane) * 8) = (u32x4){pc[0].x, pc[0].y, pc[1].x, pc[1].y};
            }
    } else if (wg == 2) {
        f32x4 y0acc[2][4];
#pragma unroll
        for (int tt = 0; tt < 2; ++tt)
#pragma unroll
            for (int vt = 0; vt < 4; ++vt) y0acc[tt][vt] = MFMA16(ldf(Vt, 16 * vt + fr, TS, 8 * fq), ldf(Mrk, 16 * tt + fr, TS, 8 * fq), z4);
        __syncthreads();
#pragma unroll
        for (int rt = 0; rt < 2; ++rt)
#pragma unroll
            for (int tt = 0; tt < 2; ++tt) {
                const f32x4 acc = MFMA16(ldf(Tm, 16 * tt + fr, TS, 8 * fq), ldf(MakVt, 16 * rt + fr, TS, 8 * fq), z4);
                *(u32x2*)(U0T + (16 * rt + fr) * TS + 16 * tt + 4 * fq) = pk4(acc);
            }
        __syncthreads();
#pragma unroll
        for (int tt = 0; tt < 2; ++tt)
#pragma unroll
            for (int vp = 0; vp < 2; ++vp) {
                const f32x4 a0 = MFMA16(ldf(U0T, 16 * (2 * vp) + fr, TS, 8 * fq), ldf(Mrb, 16 * tt + fr, TS, 8 * fq), y0acc[tt][2 * vp]);
                const f32x4 a1 = MFMA16(ldf(U0T, 16 * (2 * vp + 1) + fr, TS, 8 * fq), ldf(Mrb, 16 * tt + fr, TS, 8 * fq), y0acc[tt][2 * vp + 1]);
                const u32x2 p0 = pk4(a0), p1 = pk4(a1);
                *(u32x4*)(G.Y0 + ch * 2048 + ((tt * 2 + vp) * 64 + lane) * 8) = (u32x4){p0.x, p0.y, p1.x, p1.y};
            }
    } else {
        f32x4 qacc[4][4];
#pragma unroll
        for (int vt = 0; vt < 4; ++vt)
#pragma unroll
            for (int kt = 0; kt < 4; ++kt) qacc[vt][kt] = MFMA16(ldf(KHt, 16 * kt + fr, TS, 8 * fq), ldf(Vt, 16 * vt + fr, TS, 8 * fq), z4);
        __syncthreads();
#pragma unroll
        for (int rt = 2; rt < 4; ++rt)
#pragma unroll
            for (int tt = 0; tt < 2; ++tt) {
                const f32x4 acc = MFMA16(ldf(Tm, 16 * tt + fr, TS, 8 * fq), ldf(MakVt, 16 * rt + fr, TS, 8 * fq), z4);
                *(u32x2*)(U0T + (16 * rt + fr) * TS + 16 * tt + 4 * fq) = pk4(acc);
            }
        __syncthreads();
#pragma unroll
        for (int vt = 0; vt < 4; ++vt)
#pragma unroll
            for (int hf2 = 0; hf2 < 2; ++hf2) {
                u32x2 pc[2];
#pragma unroll
                for (int hf = 0; hf < 2; ++hf) {
                    const int kt = 2 * hf2 + hf;
                    f32x4 acc = MFMA16(ldf(BHt, 16 * kt + fr, TS, 8 * fq), ldf(U0T, 16 * vt + fr, TS, 8 * fq), qacc[vt][kt]);
                    acc *= *(const f32x4*)(WL + 16 * kt + 4 * fq);
                    pc[hf] = pk4(acc);
                }
                *(u32x4*)(G.QQ + ch * 4096 + ((vt * 2 + hf2) * 64 + lane) * 8) = (u32x4){pc[0].x, pc[0].y, pc[1].x, pc[1].y};
            }
    }
    __syncthreads();
}

__device__ __forceinline__ void chain_step(f32x4 (&acc)[4], const bf16x8 (&fa)[4][2], u32x4 q01, u32x4 q23, bf16_t* __restrict__ scp) {
    union { u32x4 u; bf16x8 v; } bs[2];
    const u32x2 a = pk4(acc[0]), b = pk4(acc[1]), c2 = pk4(acc[2]), d = pk4(acc[3]);
    *(u32x4*)(scp) = (u32x4){a.x, a.y, b.x, b.y}; *(u32x4*)(scp + 512) = (u32x4){c2.x, c2.y, d.x, d.y};
    bs[0].u = (u32x4){a.x, a.y, b.x, b.y}; bs[1].u = (u32x4){c2.x, c2.y, d.x, d.y};
    acc[0] = (f32x4){__uint_as_float(q01.x << 16), __uint_as_float(q01.x & 0xffff0000u), __uint_as_float(q01.y << 16), __uint_as_float(q01.y & 0xffff0000u)};
    acc[1] = (f32x4){__uint_as_float(q01.z << 16), __uint_as_float(q01.z & 0xffff0000u), __uint_as_float(q01.w << 16), __uint_as_float(q01.w & 0xffff0000u)};
    acc[2] = (f32x4){__uint_as_float(q23.x << 16), __uint_as_float(q23.x & 0xffff0000u), __uint_as_float(q23.y << 16), __uint_as_float(q23.y & 0xffff0000u)};
    acc[3] = (f32x4){__uint_as_float(q23.z << 16), __uint_as_float(q23.z & 0xffff0000u), __uint_as_float(q23.w << 16), __uint_as_float(q23.w & 0xffff0000u)};
#pragma unroll
    for (int it = 0; it < 4; ++it) { acc[it] = MFMA16(fa[it][0], bs[0].v, acc[it]); acc[it] = MFMA16(fa[it][1], bs[1].v, acc[it]); }
}
__device__ __forceinline__ void rwkv_chain1(int sq, int h, int wg, const float* __restrict__ state_in, const RwkvG& G, float* __restrict__ st_s) {
    int tid_ = threadIdx.x; asm volatile("" : "+v"(tid_));
    const int lane = tid_ & 63, fr = lane & 15, fq = lane >> 4, j0 = 16 * wg;
    const Seq s = seq_of(sq);
    const size_t ch = (size_t)(s.base / 32) * 4 + h;
    f32x4 acc[4];
#pragma unroll
    for (int it = 0; it < 4; ++it) acc[it] = *(const f32x4*)(state_in + (((size_t)s.b * 4 + h) * 64 + j0 + fr) * 64 + 16 * it + 4 * fq);
    bf16x8 fa[4][2];
#pragma unroll
    for (int it = 0; it < 4; ++it)
#pragma unroll
        for (int ks = 0; ks < 2; ++ks) fa[it][ks] = *(const bf16x8*)(G.PT + ch * 4096 + ((it * 2 + ks) * 64 + lane) * 8);
    const u32x4 q01 = *(const u32x4*)(G.QQ + ch * 4096 + ((wg * 2) * 64 + lane) * 8), q23 = *(const u32x4*)(G.QQ + ch * 4096 + ((wg * 2 + 1) * 64 + lane) * 8);
    chain_step(acc, fa, q01, q23, G.SC + ch * 4096 + wg * 1024 + lane * 8);
    float* o = st_s + (((size_t)s.b * 4 + h) * 64 + j0 + fr) * 64 + 4 * fq;
#pragma unroll
    for (int it = 0; it < 4; ++it) *(f32x4*)(o + 16 * it) = acc[it];
}
constexpr int CH_RP = 16, CH_RQ = 16, CH_SLOT = 8192  ;
#define CH_BAR() do { __builtin_amdgcn_s_waitcnt(0xc07f); __builtin_amdgcn_s_barrier(); } while (0)
__device__ __forceinline__ void rwkv_chain_lds(unsigned char* lds, int sq, int h, const RwkvG& G, float* __restrict__ st_p) {
    constexpr int nc = 4096 / 32;
    static_assert(nc % CH_RP == 0 && CH_RP % CH_RQ == 0, "ring depths must divide the chunk count");
    int tid_ = threadIdx.x; asm volatile("" : "+v"(tid_));
    const int wv = __builtin_amdgcn_readfirstlane(tid_ >> 6);
    const Seq s = seq_of(sq);
    const size_t ch0 = (size_t)(s.base / 32) * 4 + h;
    if (wv >= 4) {
        int tl_ = threadIdx.x; asm volatile("" : "+v"(tl_)); const int lane = tl_ & 63;
        const int lw = wv - 4;
        const bf16_t* pn = G.PT + ch0 * 4096 + (size_t)(lw * 128 + lane) * 8;
        unsigned char* dst0 = lds + (lw * 128 + lane) * 16;
        u32x4 ld[CH_RP][2];
#pragma unroll
        for (int c = 0; c < CH_RP; ++c) {
#pragma unroll
            for (int i = 0; i < 2; ++i) ld[c][i] = *(const u32x4*)(pn + i * 512);
            pn += 16384; asm volatile("" : "+v"(pn));
        }
#pragma unroll
        for (int i = 0; i < 2; ++i) *(u32x4*)(dst0 + i * 1024) = ld[0][i];
#pragma unroll
        for (int i = 0; i < 2; ++i) ld[0][i] = *(const u32x4*)(pn + i * 512);
        pn += 16384; asm volatile("" : "+v"(pn));
        CH_BAR();
#pragma unroll 1
        for (int s0 = 0; s0 < nc; s0 += CH_RP) {
#pragma unroll
            for (int j = 0; j < CH_RP; ++j) {
                const int nx = s0 + j + 1, set = (j + 1) % CH_RP;
                unsigned char* d = dst0 + (nx & 1) * CH_SLOT;
#pragma unroll
                for (int i = 0; i < 2; ++i) *(u32x4*)(d + i * 1024) = ld[set][i];
#pragma unroll
                for (int i = 0; i < 2; ++i) ld[set][i] = *(const u32x4*)(pn + i * 512);
                pn += (nx + CH_RP + 1 < nc) ? 16384 : 0; asm volatile("" : "+v"(pn));
                CH_BAR();
            }
        }
    } else {
        int tc_ = threadIdx.x; asm volatile("" : "+v"(tc_)); const int lane = tc_ & 63, fr = lane & 15, fq = lane >> 4;
        const int j0 = 16 * wv;
        const bf16_t* qn = G.QQ + ch0 * 4096 + (size_t)((wv * 2) * 64 + lane) * 8;
        u32x4 qr[CH_RQ][2];
#pragma unroll
        for (int c = 0; c < CH_RQ; ++c) { qr[c][0] = *(const u32x4*)(qn); qr[c][1] = *(const u32x4*)(qn + 512); qn += 16384; asm volatile("" : "+v"(qn)); }
        bf16_t* scp = G.SC + ch0 * 4096 + wv * 1024 + lane * 8;
        f32x4 acc[4];
#pragma unroll
        for (int it = 0; it < 4; ++it) acc[it] = (f32x4){0.f, 0.f, 0.f, 0.f};
        CH_BAR();
#pragma unroll 1
        for (int s0 = 0; s0 < nc; s0 += CH_RP) {
#pragma unroll
            for (int j = 0; j < CH_RP; ++j) {
                const int st = s0 + j, qs = j % CH_RQ;
                const unsigned char* sl = lds + (st & 1) * CH_SLOT;
                bf16x8 fa[4][2];
#pragma unroll
                for (int it = 0; it < 4; ++it)
#pragma unroll
                    for (int ks = 0; ks < 2; ++ks) fa[it][ks] = *(const bf16x8*)(sl + ((it * 2 + ks) * 64 + lane) * 16);
                const u32x4 q01 = qr[qs][0], q23 = qr[qs][1];
                qr[qs][0] = *(const u32x4*)(qn); qr[qs][1] = *(const u32x4*)(qn + 512);
                qn += (st + CH_RQ + 1 < nc) ? 16384 : 0; asm volatile("" : "+v"(qn));
                chain_step(acc, fa, q01, q23, scp);
                scp += 16384; asm volatile("" : "+v"(scp));
                CH_BAR();
            }
        }
        int t3 = threadIdx.x; asm volatile("" : "+v"(t3));
        const int l3 = t3 & 63, fr3 = l3 & 15, fq3 = l3 >> 4;
        float* o = st_p + (((size_t)s.b * 4 + h) * 64 + j0 + fr3) * 64 + 4 * fq3;
#pragma unroll
        for (int it = 0; it < 4; ++it) *(f32x4*)(o + 16 * it) = acc[it];
    }
}

__device__ __forceinline__ void rwkv_out(int wi, const RwkvW& w, const RwkvG& G, bf16_t* __restrict__ YMIX) {
    int tid_ = threadIdx.x; asm volatile("" : "+v"(tid_));
    const int lane = tid_ & 63, fr = lane & 15, fq = lane >> 4;
    const size_t ch = (size_t)(wi >> 1); const int tt = wi & 1, h = (int)(ch & 3), cid = (int)(ch >> 2);
    const int t = 16 * tt + fr, tok = cid * 32 + t;
    const bf16x8 z0 = *(const bf16x8*)(G.ZZ + ch * 2048 + ((tt * 2 + 0) * 64 + lane) * 8), z1 = *(const bf16x8*)(G.ZZ + ch * 2048 + ((tt * 2 + 1) * 64 + lane) * 8);
    const u32x4 yp0 = *(const u32x4*)(G.Y0 + ch * 2048 + ((tt * 2 + 0) * 64 + lane) * 8), yp1 = *(const u32x4*)(G.Y0 + ch * 2048 + ((tt * 2 + 1) * 64 + lane) * 8);
    f32x4 y[4]; float sum = 0.f;
#pragma unroll
    for (int vt = 0; vt < 4; ++vt) {
        const bf16_t* sp = G.SC + ch * 4096 + vt * 1024 + lane * 8;
        const u32x4 yp = vt < 2 ? yp0 : yp1; const unsigned ya = (vt & 1) ? yp.z : yp.x, yb2 = (vt & 1) ? yp.w : yp.y;
        f32x4 acc = {__uint_as_float(ya << 16), __uint_as_float(ya & 0xffff0000u), __uint_as_float(yb2 << 16), __uint_as_float(yb2 & 0xffff0000u)};
        acc = MFMA16(*(const bf16x8*)sp, z0, acc); acc = MFMA16(*(const bf16x8*)(sp + 512), z1, acc);
        y[vt] = acc; sum += (acc.x + acc.y) + (acc.z + acc.w);
    }
    sum += __shfl_xor(sum, 16); sum += __shfl_xor(sum, 32);
    const float mean = sum * (1.f / 64.f); float var = 0.f;
#pragma unroll
    for (int vt = 0; vt < 4; ++vt) { y[vt] -= mean; var += (y[vt].x * y[vt].x + y[vt].y * y[vt].y) + (y[vt].z * y[vt].z + y[vt].w * y[vt].w); }
    var += __shfl_xor(var, 16); var += __shfl_xor(var, 32);
    const float rstd = rsqrtf(var * (1.f / 64.f) + 64e-5f);
#pragma unroll
    for (int vt = 0; vt < 4; ++vt) {
        const int c = h * 64 + 16 * vt + 4 * fq;
        const f32x4 gg = *(const f32x4*)(w.gn_g + c), gb = *(const f32x4*)(w.gn_b + c);
        const u32x2 bv = *(const u32x2*)(G.BV + (size_t)tok * 256 + c), gt = *(const u32x2*)(G.GATE + (size_t)tok * 256 + c);
        f32x4 o = y[vt] * rstd * gg + gb;
        o.x = (o.x + __uint_as_float(bv.x << 16)) * __uint_as_float(gt.x << 16); o.y = (o.y + __uint_as_float(bv.x & 0xffff0000u)) * __uint_as_float(gt.x & 0xffff0000u);
        o.z = (o.z + __uint_as_float(bv.y << 16)) * __uint_as_float(gt.y << 16); o.w = (o.w + __uint_as_float(bv.y & 0xffff0000u)) * __uint_as_float(gt.y & 0xffff0000u);
        *(u32x2*)(YMIX + (size_t)tok * DM + 256 + c) = pk4(o);
    }
}


template <int K, int SRC, bool WF32, bool WBF>
__device__ __forceinline__ void gemm_tail(unsigned char* lds, const bf16_t* __restrict__ A, const bf16_t* __restrict__ Bt, const float* __restrict__ xin_s, float* __restrict__ xout, bf16_t* __restrict__ XB, float* __restrict__ RSS) {
    int tid_ = threadIdx.x; asm volatile("" : "+v"(tid_));
    const int lane = tid_ & 63, w = __builtin_amdgcn_readfirstlane(tid_ >> 6), fr = lane & 15, fq = lane >> 4;
    float* part = (float*)lds;
    for (int tb = blockIdx.x; tb < 256; tb += gridDim.x) {
        const int mi = tb >> 4, ni = tb & 15, rt = w >> 2, ct = w & 3;
        const int r0 = 32 * mi + 16 * rt, c0 = 64 * ni + 16 * ct;
        const bf16_t* ap = A + (size_t)(T_P + r0 + fr) * K + 8 * fq; const bf16_t* bp = Bt + (size_t)(c0 + fr) * K + 8 * fq;
        f32x4 acc = {0.f, 0.f, 0.f, 0.f};
#pragma unroll 1
        for (int k0 = 0; k0 + 512 <= K; k0 += 512) {
            bf16x8 av[16], bv[16];
#pragma unroll
            for (int u = 0; u < 16; ++u) { av[u] = *(const bf16x8*)(ap + k0 + 32 * u); bv[u] = *(const bf16x8*)(bp + k0 + 32 * u); }
#pragma unroll
            for (int u = 0; u < 16; ++u) acc = MFMA16(bv[u], av[u], acc);
        }
        if (K % 512) {
            constexpr int k0 = K - (K % 512), NU = (K % 512) / 32;
            bf16x8 av[NU > 0 ? NU : 1], bv[NU > 0 ? NU : 1];
#pragma unroll
            for (int u = 0; u < NU; ++u) { av[u] = *(const bf16x8*)(ap + k0 + 32 * u); bv[u] = *(const bf16x8*)(bp + k0 + 32 * u); }
#pragma unroll
            for (int u = 0; u < NU; ++u) acc = MFMA16(bv[u], av[u], acc);
        }
        const int row = r0 + fr, col = c0 + 4 * fq;
        f32x4 x;
        if (SRC == 0) x = *(const f32x4*)(xin_s + (size_t)row * DM + col);
        else { const u32x2 r = *(const u32x2*)(XB + (size_t)(T_P + row) * DM + col); x = (f32x4){__uint_as_float(r.x << 16), __uint_as_float(r.x & 0xffff0000u), __uint_as_float(r.y << 16), __uint_as_float(r.y & 0xffff0000u)}; }
        x += acc;
        if (WF32) *(f32x4*)(xout + (size_t)(T_P + row) * DM + col) = x;
        if (WBF) {
            *(u32x2*)(XB + (size_t)(T_P + row) * DM + col) = pk4(x);
            float ss = (x.x * x.x + x.y * x.y) + (x.z * x.z + x.w * x.w);
            ss += __shfl_xor(ss, 16); ss += __shfl_xor(ss, 32);
            if (lane < 16) part[(rt * 4 + ct) * 16 + fr] = ss;
            __syncthreads();
            if (tid_ < 32) { const int rr = tid_ >> 4, f = tid_ & 15; RSS[(size_t)(T_P + 32 * mi + 16 * rr + f) * 16 + ni] = (part[(rr * 4 + 0) * 16 + f] + part[(rr * 4 + 1) * 16 + f]) + (part[(rr * 4 + 2) * 16 + f] + part[(rr * 4 + 3) * 16 + f]); }
            __syncthreads();
        }
    }
}

template <class E2> struct EpiAdapt {
    static constexpr bool PERM = true, AFTER_DRAIN = false; E2 e;
    __device__ __forceinline__ void operator()(const pg8::f32x4 (&acc)[2][2][4][2], const pg8::Unit& u, int wr, int wc, int fr, int fq) const {
#pragma unroll
        for (int ai = 0; ai < 2; ++ai)
#pragma unroll
            for (int m = 0; m < 4; ++m) {
                const int row = u.pm * 256 + ai * 128 + wr * 64 + m * 16 + fr;
                const float rs = e.rowscale(row);
                e(row, u.pn * 256 + wc * 32 + 8 * fq, acc[ai][0][m][0], acc[ai][0][m][1], acc[ai][1][m][0], acc[ai][1][m][1], rs);
            }
    }
};

#define LAS __attribute__((address_space(3)))
#define XB_TMO      128
#define XB_XCNT(j)  (256  + 64 * (j))
#define XB_XSUB(j)  (1280 + 64 * (j))
#define XB_XGEN(j)  (2304 + 64 * (j))
#define XB_TOP      3328
#define XB_TOPGEN   3392
#define XCD_BAR_WORDS 3456
#define XB_SPIN_CAP (1u << 18)

__device__ __forceinline__ unsigned xb_ld(unsigned* p)              { return __hip_atomic_load(p, __ATOMIC_RELAXED, __HIP_MEMORY_SCOPE_AGENT); }
__device__ __forceinline__ unsigned xb_add(unsigned* p, unsigned v) { return __hip_atomic_fetch_add(p, v, __ATOMIC_RELAXED, __HIP_MEMORY_SCOPE_AGENT); }
__device__ __forceinline__ unsigned xb_xcc_id() { return (unsigned)__builtin_amdgcn_s_getreg((3 << 11) | 20) & 0xFu; }
#define XB_SPIN(cond, bar) do { unsigned _sp = 0; while (cond) { __builtin_amdgcn_s_sleep(1); \
    if ((++_sp & 255u) == 0u) { if (xb_ld(&(bar)[XB_TMO])) break; if (_sp > XB_SPIN_CAP) { atomicAdd(&(bar)[XB_TMO], 1u); break; } } } } while (0)

struct XcdBarrier {
    unsigned* bar; unsigned x;
    unsigned* psub; unsigned* pgen;
    volatile LAS unsigned* st;
};

__device__ __forceinline__ XcdBarrier xcd_barrier_post(unsigned* bar, volatile LAS unsigned* st) {
    XcdBarrier b; b.bar = bar; b.x = xb_xcc_id(); b.st = st; b.psub = bar + XB_XSUB(b.x); b.pgen = bar + XB_XGEN(b.x);
    if (threadIdx.x == 0) (void)xb_add(&bar[XB_XCNT(b.x)], 1u);
    return b;
}
__device__ __forceinline__ void xcd_barrier_complete(unsigned* bar, unsigned x, unsigned& nloc, unsigned& nx) {
    const unsigned G = gridDim.x * gridDim.y * gridDim.z;
    unsigned sum, cnt, mine, sp = 0u;
    for (;;) {
        sum = 0u; cnt = 0u; mine = 0u;
#pragma unroll
        for (unsigned j = 0; j < 16; ++j) { const unsigned c = xb_ld(&bar[XB_XCNT(j)]); sum += c; cnt += (c > 0u) ? 1u : 0u; mine = (j == x) ? c : mine; }
        if (sum == G) break;
        __builtin_amdgcn_s_sleep(1);
        if ((++sp & 255u) == 0u) { if (xb_ld(&bar[XB_TMO])) break; if (sp > XB_SPIN_CAP) { atomicAdd(&bar[XB_TMO], 1u); break; } }
    }
    nloc = mine > 0u ? mine : 1u; nx = cnt > 0u ? cnt : 1u;
}

__device__ __forceinline__ void xcd_barrier(const XcdBarrier& b) {
    asm volatile("s_waitcnt vmcnt(0)" ::: "memory");
    __syncthreads();
    if (threadIdx.x == 0) {
        unsigned* bar = b.bar;
        __builtin_amdgcn_s_waitcnt(0);
        unsigned nloc = b.st[0], nx = b.st[1];
        const unsigned old = xb_add(b.psub, 1u);
        const unsigned gen = old / nloc;
        if (old + 1u == (gen + 1u) * nloc) {
            __builtin_amdgcn_fence(__ATOMIC_RELEASE, "agent");
            asm volatile("s_waitcnt vmcnt(0)" ::: "memory");
            const unsigned og = xb_add(&bar[XB_TOP], 1u);
            const unsigned tg = og / nx;
            if (og + 1u == (tg + 1u) * nx) xb_add(&bar[XB_TOPGEN], 1u);
            else XB_SPIN(xb_ld(&bar[XB_TOPGEN]) == tg, bar);
            __builtin_amdgcn_fence(__ATOMIC_ACQUIRE, "agent");
            xb_add(b.pgen, 1u);
            asm volatile("s_waitcnt vmcnt(0)" ::: "memory");
        } else {
            XB_SPIN(xb_ld(b.pgen) == gen, bar);
            __builtin_amdgcn_fence(__ATOMIC_ACQUIRE, "agent");
            asm volatile("s_waitcnt vmcnt(0)" ::: "memory");
        }
    }
    __syncthreads();
}


__device__ __forceinline__ void xcd_census(const XcdBarrier& b) { if (threadIdx.x == 0) { unsigned nloc, nx; xcd_barrier_complete(b.bar, b.x, nloc, nx); b.st[0] = nloc; b.st[1] = nx; } __syncthreads(); }

constexpr int LDS_BYTES = 147456;
struct MP { const float* in[35]; float* out; unsigned char* ws; int ph_lo, ph_hi; };
constexpr int P0_I_IN = (DM / 64) * (NIN / 32), P0_I_OUT = (DM / 64) * (DM / 32), P0_I_G = (DM / 64) * (DFF / 32), P0_I_D = (DFF / 64) * (DM / 32), P0_IL = P0_I_IN + P0_I_OUT + 2 * P0_I_G + P0_I_D;
__device__ __forceinline__ const float* inptr_(int k);
__device__ __forceinline__ void p0_dispatch(int it, unsigned char* ws, float* scr, int lane) {
    const int l2 = it / P0_IL; int r = it - l2 * P0_IL;
    bf16_t* WIN_ = (bf16_t*)(ws + WS_WIN); bf16_t* WOUT_ = (bf16_t*)(ws + WS_WOUT); bf16_t* WGU_ = (bf16_t*)(ws + WS_WGU); bf16_t* WD_ = (bf16_t*)(ws + WS_WD);
    if (r < P0_I_IN) { p0_item(inptr_(9) + (size_t)l2 * DM * NIN, DM, NIN, WIN_ + (size_t)l2 * NINP * DM, inptr_(8) + l2 * DM, NIN, 0, 0, scr, r, lane, true); return; } r -= P0_I_IN;
    if (r < P0_I_OUT) { p0_item(inptr_(30) + (size_t)l2 * DM * DM, DM, DM, WOUT_ + (size_t)l2 * DM * DM, nullptr, DM, 0, 0, scr, r, lane); return; } r -= P0_I_OUT;
    if (r < P0_I_G) { p0_item(inptr_(32) + (size_t)l2 * DM * DFF, DM, DFF, WGU_ + (size_t)l2 * 2 * DFF * DM, inptr_(31) + l2 * DM, 4, 8, 0, scr, r, lane); return; } r -= P0_I_G;
    if (r < P0_I_G) { p0_item(inptr_(33) + (size_t)l2 * DM * DFF, DM, DFF, WGU_ + (size_t)l2 * 2 * DFF * DM, inptr_(31) + l2 * DM, 4, 8, 4, scr, r, lane); return; } r -= P0_I_G;
    p0_item(inptr_(34) + (size_t)l2 * DFF * DM, DFF, DM, WD_ + (size_t)l2 * DM * DFF, nullptr, DM, 0, 0, scr, r, lane);
}
__device__ __forceinline__ const float* inptr_(int k) { const float* const* ka = (const float* const*)__builtin_amdgcn_kernarg_segment_ptr(); asm volatile("" : "+s"(k)); return ka[k]; }
__device__ __forceinline__ int fresh_bx() { int b = blockIdx.x; asm volatile("" : "+s"(b)); return b; }
__global__ void __launch_bounds__(512, 2) mega(MP p) {
    extern __shared__ __attribute__((aligned(16))) unsigned char lds[];
    cg::grid_group grid = cg::this_grid();
    float* out = p.out; unsigned char* ws = p.ws;
#define INP(k) inptr_(k)
#define WIN ((bf16_t*)(ws + WS_WIN))
#define WOUT ((bf16_t*)(ws + WS_WOUT))
#define WGU ((bf16_t*)(ws + WS_WGU))
#define WD ((bf16_t*)(ws + WS_WD))
#define XB ((bf16_t*)(ws + WS_XB))
#define YMIX ((bf16_t*)(ws + WS_YMIX))
#define RSS ((float*)(ws + WS_RSS))
#define PROJ ((bf16_t*)(ws + WS_PROJ))
#define H ((bf16_t*)(ws + WS_H))
    const int lo = p.ph_lo, hi = p.ph_hi;
    int tid = threadIdx.x, half = tid >> 8;
#define FRESH() do { asm volatile("" : "+v"(tid)); half = tid >> 8; asm volatile("" : "+s"(ws), "+s"(out)); } while (0)
#ifndef TESTPH
#define TESTPH -1
#endif
    volatile LAS unsigned* bst = (volatile LAS unsigned*)(lds + LDS_BYTES - 16);
    if (threadIdx.x < 4) bst[threadIdx.x] = 0u;
    __syncthreads();
    const XcdBarrier xbar = xcd_barrier_post((unsigned*)(ws + WS_CTL), bst);
#ifndef PROF
#define PROF 0
#endif
    unsigned long long* tsb = (unsigned long long*)(ws + WS_CTL + 14336);
#ifndef DUP
#define DUP -1
#endif
#define REPS(k) for (int rep_ = 0; rep_ < ((DUP) == (k) ? 2 : 1); ++rep_)
#define REPSYNC(k) do { if ((DUP) == (k) && rep_ == 0) xcd_barrier(xbar); } while (0)
#define STAMP(k) do { if (PROF && blockIdx.x == 0 && threadIdx.x == 0) tsb[k] = __builtin_amdgcn_s_memrealtime(); } while (0)
    STAMP(0);
#define IN(k) ((TESTPH < 0 || TESTPH == ((k) > 8 ? (k) - 8 : (k))) && lo <= (k) && (k) < hi)
#define SEAM(k) do { if (IN((k) + 1)) { if ((k) == 0) { grid.sync(); xcd_census(xbar); } else xcd_barrier(xbar); } } while (0)
    if (IN(0)) REPS(0) {
        FRESH();
        {
            float* scr = (float*)lds + (tid >> 6) * (64 * 33);
            const int gw = blockIdx.x * 8 + (tid >> 6), ngw = gridDim.x * 8, lane = tid & 63;
            for (int it = gw; it < P0_I_IN; it += ngw) p0_dispatch(it, ws, scr, lane);
        }
        {
            bf16_t* PWT = (bf16_t*)(ws + WS_PWT);
            for (int i = blockIdx.x * 512 + tid; i < 2 * 4 * 64 * 64; i += gridDim.x * 512) { const int lg = i >> 12, d = (i >> 6) & 63, cc = i & 63; PWT[i] = f2bf(INP(25)[((size_t)lg * 64 + cc) * 64 + d]); }
        }
        {
            bf16_t* LWT = (bf16_t*)(ws + WS_LWT);
            for (int i = blockIdx.x * 512 + tid; i < 2 * 256 * 128; i += gridDim.x * 512) {
                const int l2 = i >> 15, c = (i >> 7) & 255, j = i & 127;
                const float v = j < 32 ? INP(16)[((size_t)l2 * 32 + j) * 256 + c] : (j < 64 ? INP(18)[((size_t)l2 * 32 + (j - 32)) * 256 + c] : INP(19)[((size_t)l2 * 64 + (j - 64)) * 256 + c]);
                LWT[i] = f2bf(v);
            }
        }
        for (int i = blockIdx.x; i < T / 16; i += gridDim.x) { d_xprep(i * 16 + (tid >> 6), INP(0), INP(1), XB, RSS); d_xprep(i * 16 + 8 + (tid >> 6), INP(0), INP(1), XB, RSS); }
        if (DUP == 0 && rep_ == 0) grid.sync(); else { SEAM(0); STAMP(1); }
    }
    for (int l = 0; l < 2; ++l) {
        const int pb = 1 + 8 * l;
        if (IN(pb + 0)) REPS(1) {
            FRESH();
            pg8::Gemm g{XB, WIN + (size_t)l * NINP * DM, T, NINP, DM}; pg8::StaticOrder S; S.init(T, NINP, gridDim.x, fresh_bx());
            EpiAdapt<EpiProj> E{EpiProj{PROJ, RSS, (bf16_t*)(ws + WS_GLU)}};
            pg8::gemm_phase<EpiAdapt<EpiProj>, pg8::StaticOrder, true, true>((LAS unsigned char*)lds, g, S, E);
            if (l == 0) {
                constexpr int NU1 = (T / 256) * (NINP / 256), NBUSY = NU1 % 256;
                if ((int)blockIdx.x >= NBUSY && gridDim.x == 256) {
                    float* scr = (float*)lds + (tid >> 6) * (64 * 33);
                    for (int it = P0_I_IN + ((int)blockIdx.x - NBUSY) * 8 + (tid >> 6); it < P0_IL + P0_I_IN + P0_I_OUT; it += (256 - NBUSY) * 8) p0_dispatch(it, ws, scr, tid & 63);
                } else if (gridDim.x != 256) {
                    float* scr = (float*)lds + (tid >> 6) * (64 * 33);
                    for (int it = P0_I_IN + (int)blockIdx.x * 8 + (tid >> 6); it < P0_IL + P0_I_IN + P0_I_OUT; it += (int)gridDim.x * 8) p0_dispatch(it, ws, scr, tid & 63);
                }
            }
            REPSYNC(1); if (!(DUP == 1 && rep_ == 0)) { SEAM(pb + 0); STAMP(pb + 1); }
        }
        if (IN(pb + 1)) REPS(2) {
            FRESH();
            int ll = l; asm volatile("" : "+s"(ll));
            const RwkvW rw{INP(14) + ll * 896, INP(15) + ll * 256, INP(16) + ll * 32 * 256, INP(17) + ll * 256, INP(18) + ll * 32 * 256, INP(19) + ll * 64 * 256, INP(20) + ll * 256, INP(21) + ll * 256, INP(22) + ll * 256, INP(23) + ll * 256, INP(24) + ll * 256};
            const RwkvG rg{(bf16_t*)(ws + WS_PT), (bf16_t*)(ws + WS_QQ), (bf16_t*)(ws + WS_ZZ), (bf16_t*)(ws + WS_Y0), (bf16_t*)(ws + WS_SC), (bf16_t*)(ws + WS_GATE), (bf16_t*)(ws + WS_BV), (const bf16_t*)(ws + WS_LWT)};
            for (int it = blockIdx.x; it < 1024; it += gridDim.x) rwkv_item(lds, it, ll, PROJ, INP(4) + (size_t)ll * 16 * 896, rw, rg);
            for (int i = blockIdx.x * 512 + tid; i < 20 * 896; i += gridDim.x * 512) {
                const int sq = i / 896, c = i - sq * 896; const Seq sx = seq_of(sq);
                const float v = bf2f(PROJ[(size_t)(sx.base + sx.L - 1) * NINP + C_B + c]);
                if (sx.sample) out[O_SHIFT_S + ((size_t)ll * 16 + sx.b) * 896 + c] = v; else out[O_SHIFT_P + ((size_t)ll * 4 + sx.b) * 896 + c] = v;
            }
            REPSYNC(2); if (!(DUP == 2 && rep_ == 0)) { SEAM(pb + 1); STAMP(pb + 2); }
        }
        if (IN(pb + 2)) REPS(3) {
            FRESH();
            int ll = l; asm volatile("" : "+s"(ll));
            const RwkvW rw{INP(14) + ll * 896, INP(15) + ll * 256, INP(16) + ll * 32 * 256, INP(17) + ll * 256, INP(18) + ll * 32 * 256, INP(19) + ll * 64 * 256, INP(20) + ll * 256, INP(21) + ll * 256, INP(22) + ll * 256, INP(23) + ll * 256, INP(24) + ll * 256};
            const RwkvG rg{(bf16_t*)(ws + WS_PT), (bf16_t*)(ws + WS_QQ), (bf16_t*)(ws + WS_ZZ), (bf16_t*)(ws + WS_Y0), (bf16_t*)(ws + WS_SC), (bf16_t*)(ws + WS_GATE), (bf16_t*)(ws + WS_BV), (const bf16_t*)(ws + WS_LWT)};
            if (blockIdx.x < 16) rwkv_chain_lds(lds, (int)blockIdx.x >> 2, (int)blockIdx.x & 3, rg, out + O_RWKV_P + (size_t)ll * 4 * 4 * 4096);
            else if (blockIdx.x < 48) {
                const int sidx = (int)blockIdx.x - 16;
                rwkv_item(lds, 1024 + sidx, ll, PROJ, INP(4) + (size_t)ll * 16 * 896, rw, rg);
                __syncthreads();
                const int wv = tid >> 6;
                rwkv_chain1(4 + (sidx >> 1), (sidx & 1) * 2 + (wv >> 2), wv & 3, INP(3) + (size_t)ll * 16 * 4 * 4096, rg, out + O_RWKV_S + (size_t)ll * 16 * 4 * 4096);
                __syncthreads();
                if (wv < 4) rwkv_out((((512 + (sidx >> 1)) * 4 + (sidx & 1) * 2 + (wv >> 1)) << 1) | (wv & 1), rw, rg, YMIX);
            }
            {
                const AttnP ap{PROJ, INP(6) + (size_t)ll * 16 * 128 * 128, INP(7) + (size_t)ll * 16 * 128 * 128, INP(27) + ll * 64, INP(28) + ll * 64, INP(29) + ll * 4, YMIX,
                               out + O_K_P + (size_t)ll * 4 * 128 * 128, out + O_K_S + (size_t)ll * 16 * 128 * 128, out + O_V_P + (size_t)ll * 4 * 128 * 128, out + O_V_S + (size_t)ll * 16 * 128 * 128};
                const ConvPoolP cp{PROJ, INP(2) + (size_t)ll * 16 * 30 * 256, INP(10) + ll * 31 * 256, INP(11) + ll * 256, INP(12) + ll * 256, INP(13) + ll * 256, INP(5) + (size_t)ll * 16 * 15 * 256, INP(25) + (size_t)ll * 4 * 64 * 64, INP(26) + ll * 256, YMIX,
                                   out + O_CONV_P + (size_t)ll * 4 * 30 * 256, out + O_CONV_S + (size_t)ll * 16 * 30 * 256, out + O_POOL_P + (size_t)ll * 4 * 15 * 256, out + O_POOL_S + (size_t)ll * 16 * 15 * 256, (const bf16_t*)(ws + WS_GLU), (const bf16_t*)(ws + WS_PWT) + (size_t)ll * 4 * 64 * 64};
                unsigned* ctr = (unsigned*)(ws + WS_CTL + 14848) + 64 * ll + 32 * (DUP == 3 ? rep_ : 0);
                volatile LAS unsigned* wsl = (volatile LAS unsigned*)(lds + LDS_BYTES - 32);
                for (;;) {
                    __syncthreads();
                    if (tid == 0) wsl[0] = __hip_atomic_fetch_add(ctr, 1u, __ATOMIC_RELAXED, __HIP_MEMORY_SCOPE_AGENT);
                    __syncthreads();
                    const unsigned idx = wsl[0];
                    if (idx >= 528u + 544u) break;
                    if (idx < 528u) convpool_tile((float*)lds + half * (62 * 256), 2 * (int)idx + half, cp);
                    else attn_unit(lds, (int)idx - 528, ap);
                }
            }
            REPSYNC(3); if (!(DUP == 3 && rep_ == 0)) { SEAM(pb + 2); STAMP(pb + 3); }
        }
        if (IN(pb + 3)) REPS(4) {
            FRESH();
            int ll = l; asm volatile("" : "+s"(ll));
            const RwkvW rw{INP(14) + ll * 896, INP(15) + ll * 256, INP(16) + ll * 32 * 256, INP(17) + ll * 256, INP(18) + ll * 32 * 256, INP(19) + ll * 64 * 256, INP(20) + ll * 256, INP(21) + ll * 256, INP(22) + ll * 256, INP(23) + ll * 256, INP(24) + ll * 256};
            const RwkvG rg{(bf16_t*)(ws + WS_PT), (bf16_t*)(ws + WS_QQ), (bf16_t*)(ws + WS_ZZ), (bf16_t*)(ws + WS_Y0), (bf16_t*)(ws + WS_SC), (bf16_t*)(ws + WS_GATE), (bf16_t*)(ws + WS_BV), (const bf16_t*)(ws + WS_LWT)};
            for (int wi = blockIdx.x * 8 + (tid >> 6); wi < 2 * 512 * 4; wi += gridDim.x * 8) rwkv_out(wi, rw, rg, YMIX);
            REPSYNC(4); if (!(DUP == 4 && rep_ == 0)) { SEAM(pb + 3); STAMP(pb + 4); }
        }
        if (IN(pb + 4)) {
            FRESH();
            pg8::Gemm g{YMIX, WOUT + (size_t)l * DM * DM, T_P, DM, DM}; pg8::StaticOrder S; S.init(T_P, DM, gridDim.x, fresh_bx());
            if (l == 0) {
                EpiAdapt<EpiRes<0, false, true>> E{EpiRes<0, false, true>{INP(0), INP(1), out, XB, RSS}};
                pg8::gemm_phase<EpiAdapt<EpiRes<0, false, true>>, pg8::StaticOrder, true, true>((LAS unsigned char*)lds, g, S, E);
                gemm_tail<DM, 0, false, true>(lds, YMIX, WOUT + (size_t)l * DM * DM, INP(1), out, XB, RSS);
            } else {
                EpiAdapt<EpiRes<1, false, true>> E{EpiRes<1, false, true>{nullptr, nullptr, out, XB, RSS}};
                pg8::gemm_phase<EpiAdapt<EpiRes<1, false, true>>, pg8::StaticOrder, true, true>((LAS unsigned char*)lds, g, S, E);
                gemm_tail<DM, 1, false, true>(lds, YMIX, WOUT + (size_t)l * DM * DM, nullptr, out, XB, RSS);
            }
            SEAM(pb + 4); STAMP(pb + 5);
        }
        if (IN(pb + 5)) REPS(6) {
            FRESH();
            pg8::Gemm g{XB, WGU + (size_t)l * 2 * DFF * DM, T, 2 * DFF, DM}; pg8::StaticOrder S; S.init(T, 2 * DFF, gridDim.x, fresh_bx());
            EpiAdapt<EpiGU> E{EpiGU{H, RSS}};
            pg8::gemm_phase<EpiAdapt<EpiGU>, pg8::StaticOrder, true, true>((LAS unsigned char*)lds, g, S, E);
            if (l == 0) {
                constexpr int NU3 = (T / 256) * (2 * DFF / 256), NBUSY3 = NU3 % 256;
                float* scr = (float*)lds + (tid >> 6) * (64 * 33);
                if (gridDim.x == 256) { if ((int)blockIdx.x >= NBUSY3) for (int it = P0_IL + P0_I_IN + P0_I_OUT + ((int)blockIdx.x - NBUSY3) * 8 + (tid >> 6); it < 2 * P0_IL; it += (256 - NBUSY3) * 8) p0_dispatch(it, ws, scr, tid & 63); }
                else for (int it = P0_IL + P0_I_IN + P0_I_OUT + (int)blockIdx.x * 8 + (tid >> 6); it < 2 * P0_IL; it += (int)gridDim.x * 8) p0_dispatch(it, ws, scr, tid & 63);
            }
            REPSYNC(6); if (!(DUP == 6 && rep_ == 0)) { SEAM(pb + 5); STAMP(pb + 6); }
        }
        if (IN(pb + 6)) {
            FRESH();
            pg8::Gemm g{H, WD + (size_t)l * DM * DFF, T_P, DM, DFF}; pg8::StaticOrder S; S.init(T_P, DM, gridDim.x, fresh_bx());
            if (l == 0) {
                EpiAdapt<EpiRes<1, false, true>> E{EpiRes<1, false, true>{nullptr, nullptr, out, XB, RSS}};
                pg8::gemm_phase<EpiAdapt<EpiRes<1, false, true>>, pg8::StaticOrder, true, true>((LAS unsigned char*)lds, g, S, E);
                gemm_tail<DFF, 1, false, true>(lds, H, WD + (size_t)l * DM * DFF, nullptr, out, XB, RSS);
                SEAM(pb + 7); STAMP(pb + 7);
            } else {
                EpiAdapt<EpiRes<1, true, false>> E{EpiRes<1, true, false>{nullptr, nullptr, out, XB, RSS}};
                pg8::gemm_phase<EpiAdapt<EpiRes<1, true, false>>, pg8::StaticOrder, true, true>((LAS unsigned char*)lds, g, S, E);
                gemm_tail<DFF, 1, true, false>(lds, H, WD + (size_t)l * DM * DFF, nullptr, out, XB, RSS);
            }
        }
    }
    if (PROF) {
        xcd_barrier(xbar); STAMP(16); xcd_barrier(xbar);
        const unsigned long long* t = tsb;
        const unsigned long long d[12] = {t[16] - t[0], t[1] - t[0], t[2] - t[1], t[3] - t[2], t[4] - t[3], t[5] - t[4], t[6] - t[5], t[7] - t[6], t[8] - t[7], t[10] - t[8], t[13] - t[10], t[16] - t[13]};
        const size_t off[12] = {O_Y, O_Y + (size_t)T_P * DM, O_CONV_P, O_CONV_S, O_RWKV_P, O_RWKV_S, O_SHIFT_P, O_SHIFT_S, O_POOL_P, O_POOL_S, O_K_P, O_K_S};
        const unsigned cap[12] = {99999, 99999, 61000, 99999, 99999, 99999, 7000, 28000, 30000, 99999, 99999, 99999};
        for (int k = 0; k < 12; ++k) { unsigned c = (unsigned)(d[k] / 10ull); if (c > cap[k]) c = cap[k]; for (unsigned i = blockIdx.x * 512 + threadIdx.x; i < c; i += gridDim.x * 512) ((unsigned*)out)[off[k] + i] = 0xAAAAAAAAu; }
    }
}

#undef WIN
#undef WOUT
#undef WGU
#undef WD
#undef XB
#undef YMIX
#undef RSS
#undef PROJ
#undef H
static void launch_mega(MP p, int lo, int hi, int grid_blocks, hipStream_t stream) {
    p.ph_lo = lo; p.ph_hi = hi;
    void* args[] = {&p};
    hipError_t e = hipLaunchCooperativeKernel((const void*)mega, dim3(grid_blocks), dim3(512), args, LDS_BYTES, stream);
    if (e != hipSuccess) fprintf(stderr, "cooperative launch failed: %s (grid %d)\n", hipGetErrorString(e), grid_blocks);
}
extern "C" void kernel_launch(void* const* d_in, const int* in_sizes, int n_in, void* d_out, int out_size, void* d_ws, size_t ws_size, hipStream_t stream) {
    static int grid_blocks = 0;
    if (grid_blocks == 0) {
        if (n_in != 35 || (size_t)out_size != O_END || ws_size < WS_END) { fprintf(stderr, "kernel_launch: unexpected sizes n_in %d out %d ws %zu (need %zu)\n", n_in, out_size, ws_size, (size_t)WS_END); grid_blocks = -1; return; }
        int dev = 0, cus = 0, per_cu = 0;
        (void)hipGetDevice(&dev);
        (void)hipDeviceGetAttribute(&cus, hipDeviceAttributeMultiprocessorCount, dev);
        (void)hipFuncSetAttribute((const void*)mega, hipFuncAttributeMaxDynamicSharedMemorySize, LDS_BYTES);
        (void)hipOccupancyMaxActiveBlocksPerMultiprocessor(&per_cu, mega, 512, LDS_BYTES);
        if (per_cu < 1) { fprintf(stderr, "kernel_launch: occupancy query says %d blocks per CU\n", per_cu); grid_blocks = -1; return; }
        grid_blocks = cus;
    }
    if (grid_blocks < 0) return;
    const float* const* in = (const float* const*)d_in;
    float* out = (float*)d_out; unsigned char* ws = (unsigned char*)d_ws;
    MP p{};
    for (int i = 0; i < 35; ++i) p.in[i] = in[i];
    p.out = out; p.ws = ws;
    (void)hipMemsetAsync(ws + WS_CTL, 0, 16384, stream);
    launch_mega(p, 0, 16, grid_blocks, stream);
}
```

```cpp
#include <hip/hip_runtime.h>
#include <hip/hip_cooperative_groups.h>
namespace cg = cooperative_groups;
#include <cstdint>
#include <cstdio>

typedef unsigned short bf16_t;
typedef short bf16x8 __attribute__((ext_vector_type(8)));
typedef float f32x4 __attribute__((ext_vector_type(4)));
typedef unsigned u32x4 __attribute__((ext_vector_type(4)));
typedef unsigned u32x2 __attribute__((ext_vector_type(2)));

constexpr int T_P = 16384, T_S = 512, T = 16896, DM = 1024;
constexpr int NIN = 2176, NINP = 2304, DFF = 2816;
constexpr int C_A = 0, C_B = 512, C_C = 1408, C_Q = 1664, C_K = 1920, C_V = 2048;

constexpr size_t O_Y = 0, O_CONV_P = 17301504, O_CONV_S = 17362944, O_RWKV_P = 17608704, O_RWKV_S = 17739776,
                 O_SHIFT_P = 18264064, O_SHIFT_S = 18271232, O_POOL_P = 18299904, O_POOL_S = 18330624,
                 O_K_P = 18453504, O_K_S = 18584576, O_V_P = 19108864, O_V_S = 19239936, O_END = 19764224;

constexpr size_t WS_CTL = 0;
constexpr size_t WS_WIN = 16384;
constexpr size_t WS_WOUT = WS_WIN + 2ull * NINP * DM * 2;
constexpr size_t WS_WGU = WS_WOUT + 2ull * DM * DM * 2;
constexpr size_t WS_WD = WS_WGU + 2ull * 2 * DFF * DM * 2;
constexpr size_t WS_LWT = WS_WD + 2ull * DM * DFF * 2;
constexpr size_t WS_XB = WS_LWT + 2ull * 256 * 128 * 2;
constexpr size_t WS_YMIX = WS_XB + (size_t)T * DM * 2;
constexpr size_t WS_RSS = WS_YMIX + (size_t)T * DM * 2;
constexpr size_t WS_R = WS_RSS + (size_t)T * 32 * 4;
constexpr size_t WS_PROJ = WS_R;
constexpr size_t WS_H = WS_R;
constexpr size_t WS_RW = WS_PROJ + (size_t)T * NINP * 2;
constexpr int NCH = T / 32, NCHH = NCH * 4;
constexpr size_t WS_PT = WS_RW;
constexpr size_t WS_QQ = WS_PT + (size_t)NCHH * 4096 * 2;
constexpr size_t WS_ZZ = WS_QQ + (size_t)NCHH * 4096 * 2;
constexpr size_t WS_Y0 = WS_ZZ + (size_t)NCHH * 2048 * 2;
constexpr size_t WS_SC = WS_Y0 + (size_t)NCHH * 2048 * 2;
constexpr size_t WS_GATE = WS_SC + (size_t)NCHH * 4096 * 2;
constexpr size_t WS_BV = WS_GATE + (size_t)T * 256 * 2;
constexpr size_t WS_GLU = WS_BV + (size_t)T * 256 * 2;
constexpr size_t WS_PWT = WS_GLU + (size_t)T * 256 * 2;
constexpr size_t WS_RWEND = WS_PWT + 2ull * 4 * 64 * 64 * 2;
constexpr size_t RW_BF = (size_t)T * 256 * 2;
constexpr size_t WS_RW_R = WS_RWEND, WS_RW_K = WS_RW_R + RW_BF, WS_RW_V = WS_RW_R + 2 * RW_BF, WS_RW_A = WS_RW_R + 3 * RW_BF,
                 WS_RW_B = WS_RW_R + 4 * RW_BF, WS_RW_G = WS_RW_R + 5 * RW_BF, WS_RW_W = WS_RW_R + 6 * RW_BF;
constexpr size_t WS_END = WS_RWEND;

__device__ __forceinline__ float bf2f(bf16_t h) { return __uint_as_float((unsigned)h << 16); }
typedef __bf16 bf16x2_t __attribute__((ext_vector_type(2)));
typedef float f32x2 __attribute__((ext_vector_type(2)));
__device__ __forceinline__ unsigned pk2(float lo, float hi) { const f32x2 v = {lo, hi}; return __builtin_bit_cast(unsigned, __builtin_convertvector(v, bf16x2_t)); }
__device__ __forceinline__ u32x2 pk4(f32x4 v) { u32x2 o; o.x = pk2(v.x, v.y); o.y = pk2(v.z, v.w); return o; }
__device__ __forceinline__ bf16_t f2bf(float f) { return (bf16_t)(pk2(f, 0.f) & 0xffffu); }
__device__ __forceinline__ void unpack8(u32x4 v, float* f) {
    f[0] = __uint_as_float(v.x << 16); f[1] = __uint_as_float(v.x & 0xffff0000u); f[2] = __uint_as_float(v.y << 16); f[3] = __uint_as_float(v.y & 0xffff0000u);
    f[4] = __uint_as_float(v.z << 16); f[5] = __uint_as_float(v.z & 0xffff0000u); f[6] = __uint_as_float(v.w << 16); f[7] = __uint_as_float(v.w & 0xffff0000u);
}
__device__ __forceinline__ float wave_sum(float v) {
#pragma unroll
    for (int o = 1; o < 64; o <<= 1) v += __shfl_xor(v, o);
    return v;
}
__device__ __forceinline__ float wave_sum_u(float v) {
    v += __int_as_float(__builtin_amdgcn_update_dpp(0, __float_as_int(v), 0xB1, 0xF, 0xF, false));
    v += __int_as_float(__builtin_amdgcn_update_dpp(0, __float_as_int(v), 0x4E, 0xF, 0xF, false));
    v += __int_as_float(__builtin_amdgcn_update_dpp(0, __float_as_int(v), 0x141, 0xF, 0xF, false));
    v += __int_as_float(__builtin_amdgcn_update_dpp(0, __float_as_int(v), 0x140, 0xF, 0xF, false));
    v += __int_as_float(__builtin_amdgcn_update_dpp(0, __float_as_int(v), 0x142, 0xA, 0xF, false));
    v += __int_as_float(__builtin_amdgcn_update_dpp(0, __float_as_int(v), 0x143, 0xC, 0xF, false));
    return __int_as_float(__builtin_amdgcn_readlane(__float_as_int(v), 63));
}
__device__ __forceinline__ float sigmoidf_(float x) { return __builtin_amdgcn_rcpf(1.f + __expf(-x)); }

__device__ __forceinline__ void p0_item(const float* __restrict__ W, int K, int N, bf16_t* __restrict__ WT, const float* __restrict__ g, int grp, int stride, int off, float* scr, int item, int lane, bool glu_map = false) {
    const int nblk = N / 32, kb = item / nblk, nb = item - kb * nblk, k0 = 64 * kb, n0 = 32 * nb;
    float v[32];
#pragma unroll
    for (int i = 0; i < 32; ++i) v[i] = W[(size_t)(k0 + 2 * i + (lane >> 5)) * N + n0 + (lane & 31)];
#pragma unroll
    for (int i = 0; i < 32; ++i) { const int kk = 2 * i + (lane >> 5); scr[kk * 33 + (lane & 31)] = g ? v[i] * g[k0 + kk] : v[i]; }
    asm volatile("s_waitcnt lgkmcnt(0)" ::: "memory");
    const int c = lane & 7;
#pragma unroll
    for (int j = 0; j < 4; ++j) {
        const int n = n0 + (lane >> 3) + 8 * j; const float* sp = scr + (8 * c) * 33 + (n - n0);
        u32x4 o; o.x = pk2(sp[0], sp[33]); o.y = pk2(sp[2 * 33], sp[3 * 33]); o.z = pk2(sp[4 * 33], sp[5 * 33]); o.w = pk2(sp[6 * 33], sp[7 * 33]);
        int r = (n / grp) * stride + off + (n % grp);
        if (glu_map && n < 512) { const int n2 = n & 255; r = (n2 >> 2) * 8 + (n >> 8) * 4 + (n2 & 3); }
        *(u32x4*)(WT + (size_t)r * K + k0 + 8 * c) = o;
    }
    asm volatile("s_waitcnt lgkmcnt(0)" ::: "memory");
}

__device__ __forceinline__ void d_xprep(int row, const float* __restrict__ xp, const float* __restrict__ xs, bf16_t* __restrict__ XB, float* __restrict__ RSS) {
    const int lane = threadIdx.x & 63;
    const float* x = row < T_P ? xp + (size_t)row * DM : xs + (size_t)(row - T_P) * DM;
    float ss = 0.f;
#pragma unroll
    for (int j = 0; j < 4; ++j) {
        const f32x4 v = ((const f32x4*)x)[lane + 64 * j];
        ss += v.x * v.x + v.y * v.y + v.z * v.z + v.w * v.w;
        u32x2 o; o.x = pk2(v.x, v.y); o.y = pk2(v.z, v.w);
        *(u32x2*)(XB + (size_t)row * DM + (lane + 64 * j) * 4) = o;
    }
    ss = wave_sum(ss);
    if (lane < 16) RSS[(size_t)row * 16 + lane] = lane == 0 ? ss : 0.f;
}

__device__ __forceinline__ float rss_rstd(const float* RSS, int row) {
    float s = 0.f;
#pragma unroll
    for (int j = 0; j < 4; ++j) { const f32x4 v = ((const f32x4*)(RSS + (size_t)row * 16))[j]; s += (v.x + v.y) + (v.z + v.w); }
    return rsqrtf(s * (1.f / DM) + 1e-6f);
}
struct EpiProj {
    bf16_t* PROJ; const float* RSS; bf16_t* GLU;
    __device__ __forceinline__ float rowscale(int row) const { return rss_rstd(RSS, row); }
    __device__ __forceinline__ void one(int row, int col, f32x4 v0, f32x4 v1, float rs) const {
        v0 *= rs; v1 *= rs;
        if (col < 512) { const f32x4 gl = {v0.x * sigmoidf_(v1.x), v0.y * sigmoidf_(v1.y), v0.z * sigmoidf_(v1.z), v0.w * sigmoidf_(v1.w)}; *(u32x2*)(GLU + (size_t)row * 256 + (col >> 1)) = pk4(gl); }
        else { u32x4 o; o.x = pk2(v0.x, v0.y); o.y = pk2(v0.z, v0.w); o.z = pk2(v1.x, v1.y); o.w = pk2(v1.z, v1.w); *(u32x4*)(PROJ + (size_t)row * NINP + col) = o; }
    }
    __device__ __forceinline__ void operator()(int row, int col, f32x4 v0, f32x4 v1, f32x4 w0, f32x4 w1, float rs) const { one(row, col, v0, v1, rs); one(row, col + 128, w0, w1, rs); }
};
template <int SRC, bool WF32, bool WBF> struct EpiRes {
    const float* xin_p; const float* xin_s; float* xout; bf16_t* XB; float* RSS;
    __device__ __forceinline__ float rowscale(int) const { return 1.f; }
    __device__ __forceinline__ float half8(int row, int col, f32x4 v0, f32x4 v1) const {
        f32x4 a, b;
        if (SRC == 0) { const float* xi = (row < T_P ? xin_p + (size_t)row * DM : xin_s + (size_t)(row - T_P) * DM) + col; a = *(const f32x4*)(xi); b = *(const f32x4*)(xi + 4); }
        else { float f[8]; unpack8(*(const u32x4*)(XB + (size_t)row * DM + col), f); a = (f32x4){f[0], f[1], f[2], f[3]}; b = (f32x4){f[4], f[5], f[6], f[7]}; }
        a += v0; b += v1;
        if (WF32) { *(f32x4*)(xout + (size_t)row * DM + col) = a; *(f32x4*)(xout + (size_t)row * DM + col + 4) = b; }
        if (WBF) { u32x4 o; o.x = pk2(a.x, a.y); o.y = pk2(a.z, a.w); o.z = pk2(b.x, b.y); o.w = pk2(b.z, b.w); *(u32x4*)(XB + (size_t)row * DM + col) = o; }
        return (a.x * a.x + a.y * a.y) + (a.z * a.z + a.w * a.w) + (b.x * b.x + b.y * b.y) + (b.z * b.z + b.w * b.w);
    }
    __device__ __forceinline__ void operator()(int row, int col, f32x4 v0, f32x4 v1, f32x4 w0, f32x4 w1, float) const {
        float ss = half8(row, col, v0, v1);
        ss += half8(row, col + 128, w0, w1);
        if (WBF) {
            ss += __shfl_xor(ss, 16); ss += __shfl_xor(ss, 32);
            if ((threadIdx.x & 63) < 16) RSS[(size_t)row * 16 + (col >> 8) * 4 + ((col >> 5) & 3)] = ss;
        }
    }
};
struct EpiGU {
    bf16_t* H; const float* RSS;
    __device__ __forceinline__ float rowscale(int row) const { return rss_rstd(RSS, row); }
    __device__ __forceinline__ u32x2 gu(f32x4 g, f32x4 u, float rs) const {
        g *= rs; u *= rs;
        const float h0 = g.x * sigmoidf_(g.x) * u.x, h1 = g.y * sigmoidf_(g.y) * u.y, h2 = g.z * sigmoidf_(g.z) * u.z, h3 = g.w * sigmoidf_(g.w) * u.w;
        u32x2 o; o.x = pk2(h0, h1); o.y = pk2(h2, h3); return o;
    }
    __device__ __forceinline__ void operator()(int row, int col, f32x4 g0, f32x4 u0, f32x4 g1, f32x4 u1, float rs) const {
        *(u32x2*)(H + (size_t)row * DFF + (col >> 1)) = gu(g0, u0, rs);
        *(u32x2*)(H + (size_t)row * DFF + (col >> 1) + 64) = gu(g1, u1, rs);
    }
};

struct Seq { int base, L, b, sample, pos0; };
__device__ __forceinline__ Seq seq_of(int sq) { Seq s; if (sq < 4) { s.base = sq * 4096; s.L = 4096; s.b = sq; s.sample = 0; s.pos0 = 0; } else { s.b = sq - 4; s.base = T_P + s.b * 32; s.L = 32; s.sample = 1; s.pos0 = 1024; } return s; }

struct RwkvW { const float *mu, *w0, *w2, *a0, *a2, *g2, *k_k, *k_a, *r_k, *gn_g, *gn_b; };

namespace pg8 {
#define PG8_LAS __attribute__((address_space(3)))
typedef unsigned short bf16_t;
typedef short bf16x8 __attribute__((ext_vector_type(8)));
typedef float f32x4 __attribute__((ext_vector_type(4)));
typedef unsigned u32x4 __attribute__((ext_vector_type(4)));
constexpr int BM = 256, BK = 64, HALF = 128, HTB = HALF * BK * 2  , STAGE_BYTES = 8 * HTB, NXCD = 8, WGM = 8;

__host__ __device__ __forceinline__ int lds_byte(int r, int c) { const int st = (r >> 4) * 2 + (c >> 5), rr = r & 15, cc = c & 31, ob = rr * 64 + cc * 2; return st * 1024 + (ob ^ (((ob >> 9) & 1) << 5)); }
__host__ __device__ __forceinline__ void stage_rc(int b, int& R, int& C) { const int st = b / 1024, sb = b % 1024, swz = sb ^ (((sb >> 9) & 1) << 5); R = (st >> 1) * 16 + swz / 64; C = (st & 1) * 32 + (swz % 64) / 2; }
__host__ __device__ __forceinline__ int perm32(int rho) { const int n = rho >> 4, i = rho & 15; return 8 * (i >> 2) + 4 * n + (i & 3); }

struct Unit { int pm, pn; };
struct Gemm { const bf16_t* A; const bf16_t* Bt; int M, N, K; };

struct StaticOrder {
    int nM, nN, nwg, G, c;
    __host__ __device__ void init(int M, int N, int G_, int c_) { nM = M / BM; nN = N / BM; nwg = nM * nN; G = G_; c = c_; }
    __host__ __device__ bool next(int i, Unit& u) const {
        const long L = (long)i * G + c; if (L >= nwg) return false;
        int wgid = (int)L; { const int q = nwg / NXCD, r = nwg % NXCD, xcd = wgid % NXCD, off = wgid / NXCD; wgid = (xcd < r ? xcd * (q + 1) : r * (q + 1) + (xcd - r) * q) + off; }
        const int nig = WGM * nN, gid = wgid / nig, fm = gid * WGM, gsz = (nM - fm) < WGM ? (nM - fm) : WGM;
        u.pm = fm + ((wgid % nig) % gsz); u.pn = (wgid % nig) / gsz; return true;
    }
    __device__ __forceinline__ void a_ready(const Unit&) const {}
    __device__ __forceinline__ void done(const Unit&) const {}
};


template <class Epi, class Sched, bool ALIGN_EPI = false, bool SP2 = false>
__device__ __forceinline__ void gemm_phase(PG8_LAS unsigned char* lds, const Gemm g, const Sched& S, const Epi& E) {
    int tid_ = threadIdx.x; asm volatile("" : "+v"(tid_));
    const int tid = tid_, wid = __builtin_amdgcn_readfirstlane(tid >> 6), lane = tid & 63, wr = wid >> 2, wc = wid & 3, fr = lane & 15, fq = lane >> 4;
    const int K = g.K, nt = K / BK;
    unsigned voffA[2], voffB[2];
#pragma unroll
    for (int i = 0; i < 2; ++i) { int R, C; stage_rc(tid * 16 + i * 8192, R, C); const int Rb = Epi::PERM ? ((R & ~31) + perm32(R & 31)) : R;
        voffA[i] = (unsigned)(R * K + C) * 2u; voffB[i] = (unsigned)(Rb * K + C) * 2u; }
    const size_t kstep = (size_t)(BK * 2);
    const size_t hstep = (size_t)HALF * K * 2;
    const size_t tstep = 2 * hstep;
    const unsigned ldsw = (unsigned)wid * 1024u;
    const int aoff = lds_byte(wr * 64 + fr, fq * 8), boff = lds_byte(wc * 32 + fr, fq * 8);
#define PG8_SA(b, h) (((b) * 2 + (h)) * HTB)
#define PG8_SB(b, h) ((4 + (b) * 2 + (h)) * HTB)
#define PG8_STAGE(bufoff, gbase, voff) do { _Pragma("unroll") for (int _i = 0; _i < 2; ++_i) \
        __builtin_amdgcn_global_load_lds((const unsigned*)((const char*)(gbase) + (voff)[_i]), (PG8_LAS unsigned*)(lds + (bufoff) + ldsw + _i * 8192), 16, 0, 0); } while (0)
#define PG8_LDA(dst, b, h) do { _Pragma("unroll") for (int m = 0; m < 4; ++m) _Pragma("unroll") for (int k = 0; k < 2; ++k) dst[m][k] = *(const PG8_LAS bf16x8*)(lds + PG8_SA(b, h) + aoff + m * 2048 + k * 1024); } while (0)
#define PG8_LDB(dst, b, h) do { _Pragma("unroll") for (int n = 0; n < 2; ++n) _Pragma("unroll") for (int k = 0; k < 2; ++k) dst[n][k] = *(const PG8_LAS bf16x8*)(lds + PG8_SB(b, h) + boff + n * 2048 + k * 1024); } while (0)
#define PG8_MMA(ai, bj, At, Bt) do { __builtin_amdgcn_s_setprio(1); _Pragma("unroll") for (int m = 0; m < 4; ++m) _Pragma("unroll") for (int n = 0; n < 2; ++n) _Pragma("unroll") for (int k = 0; k < 2; ++k) \
        acc[ai][bj][m][n] = __builtin_amdgcn_mfma_f32_16x16x32_bf16(Bt[n][k], At[m][k], acc[ai][bj][m][n], 0, 0, 0); __builtin_amdgcn_s_setprio(0); } while (0)
#define PG8_WAIT_V(n) asm volatile("s_waitcnt vmcnt(" #n ")" ::: "memory")
#define PG8_WAIT_L(n) asm volatile("s_waitcnt lgkmcnt(" #n ")" ::: "memory")
#define PG8_BAR __builtin_amdgcn_s_barrier()
#define PG8_SCHED __builtin_amdgcn_sched_barrier(0)
    Unit cur, nxt; int ui = 0;
    if (!S.next(0, cur)) return;
    f32x4 acc[2][2][4][2];
#pragma unroll
    for (int a = 0; a < 2; ++a)
#pragma unroll
        for (int b = 0; b < 2; ++b)
#pragma unroll
            for (int m = 0; m < 4; ++m)
#pragma unroll
                for (int n = 0; n < 2; ++n) acc[a][b][m][n] = (f32x4){0.f, 0.f, 0.f, 0.f};
    bf16x8 At[4][2], B0[2][2], B1[2][2];
    const char* cA = (const char*)g.A + (size_t)cur.pm * tstep; const char* cB = (const char*)g.Bt + (size_t)cur.pn * tstep;
    S.a_ready(cur);
    if constexpr (SP2) {
        PG8_STAGE(PG8_SB(0, 0), cB, voffB); PG8_STAGE(PG8_SB(0, 1), cB + hstep, voffB); PG8_STAGE(PG8_SA(0, 0), cA, voffA); PG8_STAGE(PG8_SA(0, 1), cA + hstep, voffA);
        if (wr == 1) PG8_BAR;
        PG8_WAIT_V(2); PG8_BAR;
        PG8_STAGE(PG8_SB(1, 0), cB + kstep, voffB); PG8_STAGE(PG8_SA(1, 0), cA + kstep, voffA); PG8_STAGE(PG8_SB(1, 1), cB + hstep + kstep, voffB);
        PG8_WAIT_V(6); PG8_BAR;
    } else {
        PG8_STAGE(PG8_SB(0, 0), cB, voffB); PG8_STAGE(PG8_SA(0, 0), cA, voffA); PG8_STAGE(PG8_SB(0, 1), cB + hstep, voffB); PG8_STAGE(PG8_SA(0, 1), cA + hstep, voffA);
        if (wr == 1) PG8_BAR;
        PG8_WAIT_V(4); PG8_BAR;
        PG8_STAGE(PG8_SB(1, 0), cB + kstep, voffB); PG8_STAGE(PG8_SA(1, 0), cA + kstep, voffA); PG8_STAGE(PG8_SB(1, 1), cB + hstep + kstep, voffB);
        PG8_WAIT_V(6); PG8_BAR;
    }
    for (;;) {
        const bool has_next = S.next(ui + 1, nxt);
        const char* nA = has_next ? (const char*)g.A + (size_t)nxt.pm * tstep : cA; const char* nB = has_next ? (const char*)g.Bt + (size_t)nxt.pn * tstep : cB;
        for (int t = 0; t < nt; t += 2) {
            const bool last = (t == nt - 2);
            const char* a1 = cA + (size_t)(t + 1) * kstep;
            const char* a2 = last ? nA : cA + (size_t)(t + 2) * kstep; const char* b2 = last ? nB : cB + (size_t)(t + 2) * kstep;
            const char* a3 = a2 + kstep; const char* b3 = b2 + kstep;
            if (last && has_next) S.a_ready(nxt);
            if constexpr (SP2) {
            PG8_LDB(B0, 0, 0); PG8_LDB(B1, 0, 1); PG8_SCHED; PG8_LDA(At, 0, 0); PG8_STAGE(PG8_SA(1, 1), a1 + hstep, voffA);
            PG8_WAIT_V(8); PG8_WAIT_L(0); PG8_BAR; PG8_MMA(0, 0, At, B0); PG8_MMA(0, 1, At, B1); PG8_BAR; PG8_SCHED;
            PG8_LDA(At, 0, 1); PG8_STAGE(PG8_SB(0, 0), b2, voffB); PG8_STAGE(PG8_SB(0, 1), b2 + hstep, voffB); PG8_STAGE(PG8_SA(0, 0), a2, voffA);
            PG8_WAIT_V(8); PG8_WAIT_L(0); PG8_BAR; PG8_MMA(1, 0, At, B0); PG8_MMA(1, 1, At, B1); PG8_BAR; PG8_SCHED;
            PG8_LDB(B0, 1, 0); PG8_LDB(B1, 1, 1); PG8_SCHED; PG8_LDA(At, 1, 0); PG8_STAGE(PG8_SA(0, 1), a2 + hstep, voffA);
            PG8_WAIT_V(8); PG8_WAIT_L(0); PG8_BAR; PG8_MMA(0, 0, At, B0); PG8_MMA(0, 1, At, B1); PG8_BAR; PG8_SCHED;
            PG8_LDA(At, 1, 1); PG8_STAGE(PG8_SB(1, 0), b3, voffB); PG8_STAGE(PG8_SB(1, 1), b3 + hstep, voffB); PG8_STAGE(PG8_SA(1, 0), a3, voffA);
            PG8_WAIT_V(8); PG8_WAIT_L(0); PG8_BAR; PG8_MMA(1, 0, At, B0); PG8_MMA(1, 1, At, B1); PG8_BAR; PG8_SCHED;
            } else {
            PG8_LDB(B0, 0, 0); PG8_SCHED; PG8_LDA(At, 0, 0); PG8_STAGE(PG8_SA(1, 1), a1 + hstep, voffA);
            PG8_WAIT_L(8); PG8_BAR; PG8_WAIT_L(0); PG8_MMA(0, 0, At, B0); PG8_BAR; PG8_SCHED;
            PG8_LDB(B1, 0, 1); PG8_STAGE(PG8_SB(0, 0), b2, voffB);
            PG8_BAR; PG8_WAIT_L(0); PG8_MMA(0, 1, At, B1); PG8_BAR;
            PG8_LDA(At, 0, 1); PG8_STAGE(PG8_SA(0, 0), a2, voffA);
            PG8_BAR; PG8_WAIT_L(0); PG8_MMA(1, 0, At, B0); PG8_BAR; PG8_SCHED;
            PG8_STAGE(PG8_SB(0, 1), b2 + hstep, voffB);
            PG8_WAIT_V(6); PG8_BAR; PG8_MMA(1, 1, At, B1); PG8_BAR;
            PG8_LDB(B0, 1, 0); PG8_SCHED; PG8_LDA(At, 1, 0); PG8_STAGE(PG8_SA(0, 1), a2 + hstep, voffA);
            PG8_WAIT_L(8); PG8_BAR; PG8_WAIT_L(0); PG8_MMA(0, 0, At, B0); PG8_BAR; PG8_SCHED;
            PG8_LDB(B1, 1, 1); PG8_STAGE(PG8_SB(1, 0), b3, voffB);
            PG8_BAR; PG8_WAIT_L(0); PG8_MMA(0, 1, At, B1); PG8_BAR;
            PG8_LDA(At, 1, 1); PG8_STAGE(PG8_SA(1, 0), a3, voffA);
            PG8_BAR; PG8_WAIT_L(0); PG8_MMA(1, 0, At, B0); PG8_BAR; PG8_SCHED;
            PG8_STAGE(PG8_SB(1, 1), b3 + hstep, voffB);
            PG8_WAIT_V(6); PG8_BAR; PG8_MMA(1, 1, At, B1); PG8_BAR;
            }
        }
        if constexpr (ALIGN_EPI) { if (wr == 0) PG8_BAR; }
        if constexpr (!Epi::AFTER_DRAIN) { E(acc, cur, wr, wc, fr, fq); S.done(cur); }
        if (!has_next) break;
#pragma unroll
        for (int a = 0; a < 2; ++a)
#pragma unroll
            for (int b = 0; b < 2; ++b)
#pragma unroll
                for (int m = 0; m < 4; ++m)
#pragma unroll
                    for (int n = 0; n < 2; ++n) acc[a][b][m][n] = (f32x4){0.f, 0.f, 0.f, 0.f};
        cur = nxt; cA = nA; cB = nB; ++ui;
        if constexpr (ALIGN_EPI) { if (wr == 1) PG8_BAR; }
    }
    PG8_WAIT_V(0);
    if constexpr (!ALIGN_EPI) { if (wr == 0) PG8_BAR; }
    PG8_BAR;
    if constexpr (Epi::AFTER_DRAIN) { E.fused(acc, cur, wr, wc, fr, fq, lds, wid, lane); S.done(cur); }
#undef PG8_SA
#undef PG8_SB
#undef PG8_STAGE
#undef PG8_LDA
#undef PG8_LDB
#undef PG8_MMA
#undef PG8_WAIT_V
#undef PG8_WAIT_L
#undef PG8_BAR
#undef PG8_SCHED
}
}


struct AttnP { const bf16_t* PROJ; const float *cache_k, *cache_v, *qn, *kn, *sinks; bf16_t* YMIX; float *ko_p, *ko_s, *vo_p, *vo_s; };
constexpr int KN_STRIDE = 72, VT_STRIDE = 200, ATT_VT_OFF = 192 * KN_STRIDE * 2;
__device__ __forceinline__ void attn_unit(unsigned char* lds, int unit, const AttnP& a) {
    int tid_ = threadIdx.x; asm volatile("" : "+v"(tid_));
    const int tid = tid_, lane = tid & 63, w = __builtin_amdgcn_readfirstlane(tid >> 6), fr = lane & 15, fq = lane >> 4;
    int sq, chunk, hkv; if (unit < 512) { sq = unit >> 7; chunk = (unit & 127) >> 1; hkv = unit & 1; } else { sq = 4 + ((unit - 512) >> 1); chunk = 0; hkv = unit & 1; }
    const Seq s = seq_of(sq);
    int nk, ncache, ktok0;
    if (s.sample) { nk = 160; ncache = 128; ktok0 = s.base; }
    else { const int back = chunk < 2 ? chunk : 2; nk = 64 * (back + 1); ncache = 0; ktok0 = s.base + (chunk - back) * 64; }
    bf16_t* Kn = (bf16_t*)lds; bf16_t* Vt = (bf16_t*)(lds + ATT_VT_OFF);
    int g, mt; bool act; if (!s.sample) { g = w >> 2; mt = w & 3; act = true; } else { g = (w >> 1) & 1; mt = w & 1; act = w < 4; }
    const bf16_t* qp = a.PROJ + (size_t)(s.base + chunk * 64 + mt * 16 + fr) * NINP + C_Q + (hkv * 2 + g) * 64 + 8 * fq;
    u32x4 qr0 = {0u, 0u, 0u, 0u}, qr1 = qr0;
    if (act) { qr0 = *(const u32x4*)qp; qr1 = *(const u32x4*)(qp + 32); }
    u32x4 kraw[3], vraw[3]; f32x4 kc[3][2], vc[3][2];
#pragma unroll
    for (int q = 0; q < 3; ++q) {
        const int p = tid + 512 * q, j = p >> 3, ch = p & 7;
        kraw[q] = (u32x4){0u, 0u, 0u, 0u}; vraw[q] = kraw[q]; kc[q][0] = (f32x4){0.f, 0.f, 0.f, 0.f}; kc[q][1] = kc[q][0]; vc[q][0] = kc[q][0]; vc[q][1] = kc[q][0];
        if (p < nk * 8) {
            if (j < ncache) {
                const float* kp = a.cache_k + (((size_t)s.b * 128 + j) * 2 + hkv) * 64 + ch * 8; const float* vp = a.cache_v + (((size_t)s.b * 128 + j) * 2 + hkv) * 64 + ch * 8;
                kc[q][0] = *(const f32x4*)kp; kc[q][1] = *(const f32x4*)(kp + 4); vc[q][0] = *(const f32x4*)vp; vc[q][1] = *(const f32x4*)(vp + 4);
            } else {
                const bf16_t* pp = a.PROJ + (size_t)(ktok0 + j - ncache) * NINP + hkv * 64 + ch * 8;
                kraw[q] = *(const u32x4*)(pp + C_K); vraw[q] = *(const u32x4*)(pp + C_V);
            }
        }
    }
#pragma unroll
    for (int q = 0; q < 3; ++q) {
        const int p = tid + 512 * q, j = p >> 3, ch = p & 7;
        if (p < nk * 8) {
        float kf[8], vf[8];
        if (j < ncache) {
            kf[0] = kc[q][0].x; kf[1] = kc[q][0].y; kf[2] = kc[q][0].z; kf[3] = kc[q][0].w; kf[4] = kc[q][1].x; kf[5] = kc[q][1].y; kf[6] = kc[q][1].z; kf[7] = kc[q][1].w;
            vf[0] = vc[q][0].x; vf[1] = vc[q][0].y; vf[2] = vc[q][0].z; vf[3] = vc[q][0].w; vf[4] = vc[q][1].x; vf[5] = vc[q][1].y; vf[6] = vc[q][1].z; vf[7] = vc[q][1].w;
        } else {
            unpack8(kraw[q], kf); unpack8(vraw[q], vf);
            float ss = 0.f;
#pragma unroll
            for (int i = 0; i < 8; ++i) ss += kf[i] * kf[i];
            ss += __shfl_xor(ss, 1); ss += __shfl_xor(ss, 2); ss += __shfl_xor(ss, 4);
            const float rs = rsqrtf(ss * (1.f / 64.f) + 1e-6f);
            const f32x4 g0 = *(const f32x4*)(a.kn + ch * 8), g1 = *(const f32x4*)(a.kn + ch * 8 + 4);
            kf[0] *= rs * g0.x; kf[1] *= rs * g0.y; kf[2] *= rs * g0.z; kf[3] *= rs * g0.w; kf[4] *= rs * g1.x; kf[5] *= rs * g1.y; kf[6] *= rs * g1.z; kf[7] *= rs * g1.w;
        }
        u32x4 ko; ko.x = pk2(kf[0], kf[1]); ko.y = pk2(kf[2], kf[3]); ko.z = pk2(kf[4], kf[5]); ko.w = pk2(kf[6], kf[7]);
        *(u32x4*)(Kn + j * KN_STRIDE + ch * 8) = ko;
#pragma unroll
        for (int i = 0; i < 8; ++i) Vt[(ch * 8 + i) * VT_STRIDE + j] = f2bf(vf[i]);
        float* ko_ = nullptr; float* vo_ = nullptr;
        if (s.sample) { if (j >= 32) { ko_ = a.ko_s + ((size_t)s.b * 128 + (j - 32)) * 128 + hkv * 64 + ch * 8; vo_ = a.vo_s + ((size_t)s.b * 128 + (j - 32)) * 128 + hkv * 64 + ch * 8; } }
        else if (chunk >= 62 && j >= nk - 64) { const int jj = (chunk - 62) * 64 + (j - (nk - 64)); ko_ = a.ko_p + ((size_t)s.b * 128 + jj) * 128 + hkv * 64 + ch * 8; vo_ = a.vo_p + ((size_t)s.b * 128 + jj) * 128 + hkv * 64 + ch * 8; }
        if (ko_) { *(f32x4*)ko_ = (f32x4){kf[0], kf[1], kf[2], kf[3]}; *(f32x4*)(ko_ + 4) = (f32x4){kf[4], kf[5], kf[6], kf[7]}; *(f32x4*)vo_ = (f32x4){vf[0], vf[1], vf[2], vf[3]}; *(f32x4*)(vo_ + 4) = (f32x4){vf[4], vf[5], vf[6], vf[7]}; }
        }
    }
    __syncthreads();
    if (act) {
        const int qh = hkv * 2 + g, tok = s.base + chunk * 64 + mt * 16 + fr, nkt = nk >> 4, nks = nk >> 5;
        float qf[16]; unpack8(qr0, qf); unpack8(qr1, qf + 8);
        float ss = 0.f;
#pragma unroll
        for (int i = 0; i < 16; ++i) ss += qf[i] * qf[i];
        ss += __shfl_xor(ss, 16); ss += __shfl_xor(ss, 32);
        const float rs = rsqrtf(ss * (1.f / 64.f) + 1e-6f) * 0.125f;
#pragma unroll
        for (int i = 0; i < 8; ++i) { qf[i] *= rs * a.qn[8 * fq + i]; qf[8 + i] *= rs * a.qn[32 + 8 * fq + i]; }
        union { u32x4 u; bf16x8 v; } qa, qb;
        qa.u.x = pk2(qf[0], qf[1]); qa.u.y = pk2(qf[2], qf[3]); qa.u.z = pk2(qf[4], qf[5]); qa.u.w = pk2(qf[6], qf[7]);
        qb.u.x = pk2(qf[8], qf[9]); qb.u.y = pk2(qf[10], qf[11]); qb.u.z = pk2(qf[12], qf[13]); qb.u.w = pk2(qf[14], qf[15]);
        f32x4 sacc[12];
        const float sink = a.sinks[qh];
        float m = sink;
#pragma unroll
        for (int kt = 0; kt < 12; ++kt) {
            sacc[kt] = (f32x4){0.f, 0.f, 0.f, 0.f};
            if (kt < nkt) {
                const bf16x8 k0 = *(const bf16x8*)(Kn + (kt * 16 + fr) * KN_STRIDE + 8 * fq), k1 = *(const bf16x8*)(Kn + (kt * 16 + fr) * KN_STRIDE + 32 + 8 * fq);
                sacc[kt] = __builtin_amdgcn_mfma_f32_16x16x32_bf16(k0, qa.v, sacc[kt], 0, 0, 0);
                sacc[kt] = __builtin_amdgcn_mfma_f32_16x16x32_bf16(k1, qb.v, sacc[kt], 0, 0, 0);
                m = fmaxf(m, fmaxf(fmaxf(sacc[kt].x, sacc[kt].y), fmaxf(sacc[kt].z, sacc[kt].w)));
            }
        }
        m = fmaxf(m, __shfl_xor(m, 16)); m = fmaxf(m, __shfl_xor(m, 32));
        float lsum = 0.f;
#pragma unroll
        for (int kt = 0; kt < 12; ++kt) if (kt < nkt) {
            sacc[kt].x = __expf(sacc[kt].x - m); sacc[kt].y = __expf(sacc[kt].y - m); sacc[kt].z = __expf(sacc[kt].z - m); sacc[kt].w = __expf(sacc[kt].w - m);
            lsum += (sacc[kt].x + sacc[kt].y) + (sacc[kt].z + sacc[kt].w);
        }
        lsum += __shfl_xor(lsum, 16); lsum += __shfl_xor(lsum, 32);
        lsum += __expf(sink - m);
        f32x4 oacc[4];
#pragma unroll
        for (int dt = 0; dt < 4; ++dt) oacc[dt] = (f32x4){0.f, 0.f, 0.f, 0.f};
#pragma unroll
        for (int ks = 0; ks < 6; ++ks) if (ks < nks) {
            union { u32x4 u; bf16x8 v; } pf;
            pf.u.x = pk2(sacc[2 * ks].x, sacc[2 * ks].y); pf.u.y = pk2(sacc[2 * ks].z, sacc[2 * ks].w); pf.u.z = pk2(sacc[2 * ks + 1].x, sacc[2 * ks + 1].y); pf.u.w = pk2(sacc[2 * ks + 1].z, sacc[2 * ks + 1].w);
#pragma unroll
            for (int dt = 0; dt < 4; ++dt) {
                union { u32x4 u; bf16x8 v; } vf;
                const u32x2 lo = *(const u32x2*)(Vt + (dt * 16 + fr) * VT_STRIDE + 32 * ks + 4 * fq), hi2 = *(const u32x2*)(Vt + (dt * 16 + fr) * VT_STRIDE + 32 * ks + 16 + 4 * fq);
                vf.u.x = lo.x; vf.u.y = lo.y; vf.u.z = hi2.x; vf.u.w = hi2.y;
                oacc[dt] = __builtin_amdgcn_mfma_f32_16x16x32_bf16(vf.v, pf.v, oacc[dt], 0, 0, 0);
            }
        }
        const float inv = 1.f / lsum;
#pragma unroll
        for (int dt = 0; dt < 4; ++dt) { u32x2 o; o.x = pk2(oacc[dt].x * inv, oacc[dt].y * inv); o.y = pk2(oacc[dt].z * inv, oacc[dt].w * inv);
            *(u32x2*)(a.YMIX + (size_t)tok * DM + 768 + qh * 64 + dt * 16 + 4 * fq) = o; }
    }
    __syncthreads();
}

struct ConvPoolP { const bf16_t* PROJ; const float *cache_conv, *cw, *cb, *lg, *lb, *cache_pool, *pw, *psc; bf16_t* YMIX; float *co_p, *co_s, *po_p, *po_s; const bf16_t *GLU, *PWT; };
__device__ __forceinline__ void convpool_tile(float* sm, int tile, const ConvPoolP& a) {
    int tid_ = threadIdx.x; asm volatile("" : "+v"(tid_));
    int c = tid_ & 255;
#define RELAUNDER() asm volatile("" : "+v"(c))
    int sq, t0; if (tile < 1024) { sq = tile >> 8; t0 = (tile & 255) * 16; } else { sq = 4 + ((tile - 1024) >> 1); t0 = ((tile - 1024) & 1) * 16; }
    const Seq s = seq_of(sq);
    float* ext = sm;
    float* yb = sm + 46 * 256;
    bf16_t* db = (bf16_t*)yb;
    {
        u32x4 vv[6]; f32x4 h0[6], h1[6];
#pragma unroll
        for (int q = 0; q < 6; ++q) {
            const int pr = c + 256 * q, i = pr >> 5, cg = pr & 31, t = t0 - 30 + i;
            vv[q] = (u32x4){0u, 0u, 0u, 0u}; h0[q] = (f32x4){0.f, 0.f, 0.f, 0.f}; h1[q] = h0[q];
            if (i < 46) {
                if (t >= 0) vv[q] = *(const u32x4*)(a.GLU + (size_t)(s.base + t) * 256 + cg * 8);
                else if (s.sample) { const float* p = a.cache_conv + ((size_t)s.b * 30 + 30 + t) * 256 + cg * 8; h0[q] = *(const f32x4*)p; h1[q] = *(const f32x4*)(p + 4); }
            }
        }
#pragma unroll
        for (int q = 0; q < 6; ++q) {
            const int pr = c + 256 * q, i = pr >> 5, cg = pr & 31, t = t0 - 30 + i;
            if (i < 46) {
                f32x4 e0 = h0[q], e1 = h1[q];
                if (t >= 0) { float v[8]; unpack8(vv[q], v); e0 = (f32x4){v[0], v[1], v[2], v[3]}; e1 = (f32x4){v[4], v[5], v[6], v[7]}; }
                *(f32x4*)(ext + i * 256 + cg * 8) = e0; *(f32x4*)(ext + i * 256 + cg * 8 + 4) = e1;
            }
        }
    }
    __syncthreads(); RELAUNDER();
    {
        float e[46];
#pragma unroll
        for (int i = 0; i < 46; ++i) e[i] = ext[i * 256 + c];
        float* o = s.sample ? a.co_s + (size_t)s.b * 30 * 256 : a.co_p + (size_t)s.b * 30 * 256;
        if (t0 + 15 >= s.L - 30) {
#pragma unroll
            for (int i = 0; i < 16; ++i) { const int t = t0 + i; if (t >= s.L - 30) o[(t - (s.L - 30)) * 256 + c] = e[i + 30]; }
        }
        float y[16]; const float bias = a.cb[c];
#pragma unroll
        for (int i = 0; i < 16; ++i) y[i] = bias;
#pragma unroll
        for (int j = 0; j < 31; ++j) { const float wj = a.cw[j * 256 + c];
#pragma unroll
            for (int i = 0; i < 16; ++i) y[i] += wj * e[i + j]; }
#pragma unroll
        for (int i = 0; i < 16; ++i) yb[i * 256 + c] = y[i];
    }
    __syncthreads(); RELAUNDER();
    u32x4 pv[4]; f32x4 ph0[4], ph1[4];
#pragma unroll
    for (int q = 0; q < 4; ++q) {
        const int pr = c + 256 * q, i = pr >> 5, cg = pr & 31, t = t0 - 15 + i;
        pv[q] = (u32x4){0u, 0u, 0u, 0u}; ph0[q] = (f32x4){0.f, 0.f, 0.f, 0.f}; ph1[q] = ph0[q];
        if (i < 31) {
            if (t >= 0) pv[q] = *(const u32x4*)(a.PROJ + (size_t)(s.base + t) * NINP + C_C + cg * 8);
            else if (s.sample) { const float* p = a.cache_pool + ((size_t)s.b * 15 + 15 + t) * 256 + cg * 8; ph0[q] = *(const f32x4*)p; ph1[q] = *(const f32x4*)(p + 4); }
        }
    }
    {
        const int wv = c >> 6, lane = c & 63;
        const f32x4 g4 = ((const f32x4*)a.lg)[lane], b4 = ((const f32x4*)a.lb)[lane];
#pragma unroll 1
        for (int i = wv; i < 16; i += 4) {
            const f32x4 v = ((const f32x4*)(yb + i * 256))[lane];
            const float mean = wave_sum_u((v.x + v.y) + (v.z + v.w)) * (1.f / 256.f);
            const f32x4 d = v - mean;
            const float var = wave_sum_u((d.x * d.x + d.y * d.y) + (d.z * d.z + d.w * d.w)) * (1.f / 256.f);
            const float rstd = rsqrtf(var + 1e-5f);
            f32x4 o = d * rstd * g4 + b4;
            o.x *= sigmoidf_(o.x); o.y *= sigmoidf_(o.y); o.z *= sigmoidf_(o.z); o.w *= sigmoidf_(o.w);
            *(u32x2*)(a.YMIX + (size_t)(s.base + t0 + i) * DM + 0 + lane * 4) = pk4(o);
        }
    }
    __syncthreads(); RELAUNDER();
#pragma unroll
    for (int q = 0; q < 4; ++q) {
        const int pr = c + 256 * q, i = pr >> 5, cg = pr & 31, t = t0 - 15 + i;
        if (i < 31) {
            f32x4 e0 = ph0[q], e1 = ph1[q];
            if (t >= 0) { float v[8]; unpack8(pv[q], v); e0 = (f32x4){v[0], v[1], v[2], v[3]}; e1 = (f32x4){v[4], v[5], v[6], v[7]}; }
            *(f32x4*)(ext + i * 256 + cg * 8) = e0; *(f32x4*)(ext + i * 256 + cg * 8 + 4) = e1;
        }
    }
    __syncthreads(); RELAUNDER();
    {
        float e[31];
#pragma unroll
        for (int i = 0; i < 31; ++i) e[i] = ext[i * 256 + c];
        float* o = s.sample ? a.po_s + (size_t)s.b * 15 * 256 : a.po_p + (size_t)s.b * 15 * 256;
        if (t0 + 15 >= s.L - 15) {
#pragma unroll
            for (int i = 0; i < 16; ++i) { const int t = t0 + i; if (t >= s.L - 15) o[(t - (s.L - 15)) * 256 + c] = e[i + 15]; }
        }
        const int g = __builtin_amdgcn_readfirstlane(c >> 6), w = 2 << g;
        float w2[16], w4[16], w8[16], w16[16];
#pragma unroll
        for (int i = 0; i < 16; ++i) w2[i] = e[15 + i] + e[14 + i];
        if (g >= 1) {
#pragma unroll
            for (int i = 0; i < 16; ++i) w4[i] = (e[15 + i] + e[14 + i]) + (e[13 + i] + e[12 + i]);
        }
        if (g >= 2) {
#pragma unroll
            for (int i = 0; i < 16; ++i) w8[i] = ((e[15 + i] + e[14 + i]) + (e[13 + i] + e[12 + i])) + ((e[11 + i] + e[10 + i]) + (e[9 + i] + e[8 + i]));
        }
        if (g == 3) {
            float cs[32]; cs[0] = e[0];
#pragma unroll
            for (int k = 1; k < 31; ++k) cs[k] = cs[k - 1] + e[k];
#pragma unroll
            for (int i = 0; i < 16; ++i) w16[i] = i == 0 ? cs[15] : cs[15 + i] - cs[i - 1];
        }
#pragma unroll
        for (int i = 0; i < 16; ++i) {
            const float sum = g == 0 ? w2[i] : (g == 1 ? w4[i] : (g == 2 ? w8[i] : w16[i]));
            const int pos = s.pos0 + t0 + i; const int cnt = (pos + 1) < w ? (pos + 1) : w;
            db[i * 264 + c] = f2bf(sum * __builtin_amdgcn_rcpf((float)cnt) - e[15 + i]);
        }
    }
    __syncthreads(); RELAUNDER();
    {
        const int g = __builtin_amdgcn_readfirstlane(c >> 6), lane = c & 63, fr = lane & 15, fq = lane >> 4;
        const bf16x8 d0 = *(const bf16x8*)(db + fr * 264 + g * 64 + 8 * fq), d1 = *(const bf16x8*)(db + fr * 264 + g * 64 + 32 + 8 * fq);
#pragma unroll
        for (int dt = 0; dt < 4; ++dt) {
            const bf16_t* wp = a.PWT + ((size_t)g * 64 + 16 * dt + fr) * 64 + 8 * fq;
            f32x4 acc = __builtin_amdgcn_mfma_f32_16x16x32_bf16(*(const bf16x8*)wp, d0, (f32x4){0.f, 0.f, 0.f, 0.f}, 0, 0, 0);
            acc = __builtin_amdgcn_mfma_f32_16x16x32_bf16(*(const bf16x8*)(wp + 32), d1, acc, 0, 0, 0);
            acc *= *(const f32x4*)(a.psc + g * 64 + 16 * dt + 4 * fq);
            *(u32x2*)(a.YMIX + (size_t)(s.base + t0 + fr) * DM + 512 + g * 64 + 16 * dt + 4 * fq) = pk4(acc);
        }
    }
    __syncthreads();
#undef RELAUNDER
}

struct RwkvG { bf16_t *PT, *QQ, *ZZ, *Y0, *SC, *GATE, *BV; const bf16_t* LWT; };
constexpr int RC_HEAD = 30208, RC_MAB = 0, RC_MAK = 4608, RC_MRB = 7168, RC_MRK = 9728, RC_TM = 12288, RC_MAKVT = 14848, RC_GT = 19968, RC_U0T = 25088;
constexpr int RB_BASE = 2 * RC_HEAD, RB_HEAD = 38912, RB_AT = 0, RB_BH = 4608, RB_KH = 9216, RB_RT = 13824, RB_ATT = 18432, RB_BHT = 23552, RB_KHT = 28672, RB_VT = 33792;
constexpr int RA_LAT = 0, RA_WL = 8704, RA_AL = 25088, RA_SCN = 41472, R_WLS = RB_BASE + 2 * RB_HEAD;
constexpr int NS = 72, TS = 40, LATS = 136, MABS = 36;
__device__ __forceinline__ bf16x8 ldf(const bf16_t* base, int row, int stride, int col) { return *(const bf16x8*)(base + row * stride + col); }
#define MFMA16(a, b, c) __builtin_amdgcn_mfma_f32_16x16x32_bf16((a), (b), (c), 0, 0, 0)

__device__ __forceinline__ void rwkv_item(unsigned char* lds, int item, int l, const bf16_t* __restrict__ PROJ, const float* __restrict__ shift_in, const RwkvW& w, const RwkvG& G) {
    int tid = threadIdx.x; asm volatile("" : "+v"(tid));
    const int wv = __builtin_amdgcn_readfirstlane(tid >> 6);
    const int cid = item >> 1, hp = item & 1, tok0 = cid * 32;
    const bool sample = cid >= 512, first = sample || ((cid & 127) == 0);
    const int sb = cid - 512;
    bf16_t* LAT = (bf16_t*)(lds + RA_LAT); float* WLb = (float*)(lds + RA_WL); float* ALb = (float*)(lds + RA_AL); float* SCN = (float*)(lds + RA_SCN); float* WLs = (float*)(lds + R_WLS);
    const int lane0 = tid & 63, fr0 = lane0 & 15, fq0 = lane0 >> 4;
    const bf16_t* lwp = G.LWT + ((size_t)l * 256 + hp * 128 + 16 * wv + fr0) * 128 + 8 * fq0;
    const bf16x8 fw = *(const bf16x8*)(lwp), fa = *(const bf16x8*)(lwp + 32), fg0 = *(const bf16x8*)(lwp + 64), fg1 = *(const bf16x8*)(lwp + 96);
    const f32x4 w0v = *(const f32x4*)(w.w0 + hp * 128 + 16 * wv + 4 * fq0), a0v = *(const f32x4*)(w.a0 + hp * 128 + 16 * wv + 4 * fq0);
    const int c3 = tid & 127, tq3 = tid >> 7, cg3 = hp * 128 + c3;
    float ur[9], uk[9], uv[9];
#pragma unroll
    for (int i = 0; i < 9; ++i) {
        const int t = 8 * tq3 - 1 + i;
        if (t >= 0 || !first) { const bf16_t* p = PROJ + (size_t)(tok0 + t) * NINP + C_B + cg3; ur[i] = bf2f(p[0]); uk[i] = bf2f(p[256]); uv[i] = bf2f(p[512]); }
        else if (sample) { const float* p = shift_in + (size_t)sb * 896 + cg3; ur[i] = p[0]; uk[i] = p[256]; uv[i] = p[512]; }
        else { ur[i] = 0.f; uk[i] = 0.f; uv[i] = 0.f; }
    }
    const float mur = w.mu[cg3], muk = w.mu[256 + cg3], muv = w.mu[512 + cg3], kkw = w.k_k[cg3], kaw = w.k_a[cg3], rkw = w.r_k[cg3];
    {
        const int t = tid >> 4, j8 = (tid & 15) * 8, col = 768 + j8;
        float u[8], pv[8];
        unpack8(*(const u32x4*)(PROJ + (size_t)(tok0 + t) * NINP + C_B + col), u);
        if (t > 0 || !first) unpack8(*(const u32x4*)(PROJ + (size_t)(tok0 + t - 1) * NINP + C_B + col), pv);
        else if (sample) { const f32x4 a = *(const f32x4*)(shift_in + (size_t)sb * 896 + col), b = *(const f32x4*)(shift_in + (size_t)sb * 896 + col + 4); pv[0] = a.x; pv[1] = a.y; pv[2] = a.z; pv[3] = a.w; pv[4] = b.x; pv[5] = b.y; pv[6] = b.z; pv[7] = b.w; }
        else {
#pragma unroll
            for (int i = 0; i < 8; ++i) pv[i] = 0.f; }
        const f32x4 m0 = *(const f32x4*)(w.mu + col), m1 = *(const f32x4*)(w.mu + col + 4);
        const float mu[8] = {m0.x, m0.y, m0.z, m0.w, m1.x, m1.y, m1.z, m1.w};
        float x[8];
#pragma unroll
        for (int i = 0; i < 8; ++i) { const float xs = u[i] + mu[i] * (pv[i] - u[i]); x[i] = j8 < 32 ? 1.f - 2.f / (1.f + __expf(2.f * xs)) : (j8 < 64 ? xs : sigmoidf_(xs)); }
        u32x4 o; o.x = pk2(x[0], x[1]); o.y = pk2(x[2], x[3]); o.z = pk2(x[4], x[5]); o.w = pk2(x[6], x[7]);
        *(u32x4*)(LAT + t * LATS + j8) = o;
    }
    __syncthreads();
    {
        asm volatile("" : "+v"(tid)); const int lane = tid & 63, fr = lane & 15, fq = lane >> 4;
        const int c0l = 16 * wv, cg0 = hp * 128 + c0l;
#pragma unroll
        for (int tt = 0; tt < 2; ++tt) {
            const int t = 16 * tt + fr;
            const f32x4 z = {0.f, 0.f, 0.f, 0.f};
            f32x4 aw = MFMA16(fw, ldf(LAT, t, LATS, 8 * fq), z);
            f32x4 aa = MFMA16(fa, ldf(LAT, t, LATS, 32 + 8 * fq), z);
            f32x4 ag = MFMA16(fg0, ldf(LAT, t, LATS, 64 + 8 * fq), z);
            ag = MFMA16(fg1, ldf(LAT, t, LATS, 96 + 8 * fq), ag);
            *(f32x4*)(WLb + t * 128 + c0l + 4 * fq) = aw + w0v;
            *(f32x4*)(ALb + t * 128 + c0l + 4 * fq) = aa + a0v;
            *(u32x2*)(G.GATE + (size_t)(tok0 + t) * 256 + cg0 + 4 * fq) = pk4(ag);
        }
    }
    __syncthreads();
    {
        asm volatile("" : "+v"(tid));
        const int c = tid & 127, tq = tid >> 7, hd = c >> 6, c64 = c & 63, cg = hp * 128 + c;
        unsigned char* hb = lds + RB_BASE + hd * RB_HEAD;
        bf16_t *AT = (bf16_t*)(hb + RB_AT), *BH = (bf16_t*)(hb + RB_BH), *KH = (bf16_t*)(hb + RB_KH), *RT = (bf16_t*)(hb + RB_RT);
        bf16_t *ATt = (bf16_t*)(hb + RB_ATT), *BHt = (bf16_t*)(hb + RB_BHT), *KHt = (bf16_t*)(hb + RB_KHT), *Vt = (bf16_t*)(hb + RB_VT);
        float lw[8], cl[8];
        float run = 0.f;
#pragma unroll
        for (int i = 0; i < 8; ++i) { lw[i] = -0.60653066f * sigmoidf_(WLb[(8 * tq + i) * 128 + c]); run += lw[i]; cl[i] = run; }
        SCN[tq * 128 + c] = run;
        __syncthreads();
        float pre = 0.f, tot = 0.f;
#pragma unroll
        for (int q = 0; q < 4; ++q) { const float v = SCN[q * 128 + c]; tot += v; if (q < tq) pre += v; }
        if (tq == 0) WLs[c] = __expf(tot);
        float at8[8], bh8[8], kh8[8], vv8[8];
        float rr8[8], kk8[8], km8[8], ar8[8], ss8[8], bo8[8];
#pragma unroll
        for (int i = 0; i < 8; ++i) {
            const int t = 8 * tq + i;
            rr8[i] = ur[i + 1] + mur * (ur[i] - ur[i + 1]); const float k = uk[i + 1] + muk * (uk[i] - uk[i + 1]); vv8[i] = uv[i + 1] + muv * (uv[i] - uv[i + 1]);
            ar8[i] = __builtin_amdgcn_rcpf(1.f + __expf(-ALb[t * 128 + c]));
            kk8[i] = k * kkw; km8[i] = k * (1.f + (ar8[i] - 1.f) * kaw);
            ss8[i] = kk8[i] * kk8[i]; bo8[i] = rr8[i] * km8[i] * rkw;
        }
#pragma unroll
        for (int i = 0; i < 8; ++i) { ss8[i] = wave_sum_u(ss8[i]); bo8[i] = wave_sum_u(bo8[i]); }
        float Wprev = __expf(pre);
#pragma unroll
        for (int i = 0; i < 8; ++i) {
            const int t = 8 * tq + i;
            const float W = __expf(pre + cl[i]), iW = __builtin_amdgcn_rcpf(W), Wp = Wprev;
            Wprev = W;
            const float kkn = kk8[i] * fminf(__builtin_amdgcn_rsqf(ss8[i]), 1e12f);
            const float at = -kkn * Wp, bh = kkn * ar8[i] * iW, kh = km8[i] * iW, rt = rr8[i] * W;
            AT[t * NS + c64] = f2bf(at); BH[t * NS + c64] = f2bf(bh); KH[t * NS + c64] = f2bf(kh); RT[t * NS + c64] = f2bf(rt);
            at8[i] = at; bh8[i] = bh; kh8[i] = kh;
            G.BV[(size_t)(tok0 + t) * 256 + cg] = f2bf(bo8[i] * vv8[i]);
        }
        u32x4 o;
        o.x = pk2(at8[0], at8[1]); o.y = pk2(at8[2], at8[3]); o.z = pk2(at8[4], at8[5]); o.w = pk2(at8[6], at8[7]); *(u32x4*)(ATt + c64 * TS + 8 * tq) = o;
        o.x = pk2(bh8[0], bh8[1]); o.y = pk2(bh8[2], bh8[3]); o.z = pk2(bh8[4], bh8[5]); o.w = pk2(bh8[6], bh8[7]); *(u32x4*)(BHt + c64 * TS + 8 * tq) = o;
        o.x = pk2(kh8[0], kh8[1]); o.y = pk2(kh8[2], kh8[3]); o.z = pk2(kh8[4], kh8[5]); o.w = pk2(kh8[6], kh8[7]); *(u32x4*)(KHt + c64 * TS + 8 * tq) = o;
        o.x = pk2(vv8[0], vv8[1]); o.y = pk2(vv8[2], vv8[3]); o.z = pk2(vv8[4], vv8[5]); o.w = pk2(vv8[6], vv8[7]); *(u32x4*)(Vt + c64 * TS + 8 * tq) = o;
    }
    __syncthreads();
    asm volatile("" : "+v"(tid)); const int lane = tid & 63, fr = lane & 15, fq = lane >> 4;
    const int hd = wv >> 2, wg = wv & 3, h = hp * 2 + hd; const size_t ch = (size_t)cid * 4 + h;
    unsigned char* hb = lds + RB_BASE + hd * RB_HEAD; unsigned char* cb = lds + hd * RC_HEAD;
    const bf16_t *AT = (const bf16_t*)(hb + RB_AT), *BH = (const bf16_t*)(hb + RB_BH), *KH = (const bf16_t*)(hb + RB_KH), *RT = (const bf16_t*)(hb + RB_RT);
    const bf16_t *ATt = (const bf16_t*)(hb + RB_ATT), *BHt = (const bf16_t*)(hb + RB_BHT), *KHt = (const bf16_t*)(hb + RB_KHT), *Vt = (const bf16_t*)(hb + RB_VT);
    float* Mab = (float*)(cb + RC_MAB);
    bf16_t *Mak = (bf16_t*)(cb + RC_MAK), *Mrb = (bf16_t*)(cb + RC_MRB), *Mrk = (bf16_t*)(cb + RC_MRK), *Tm = (bf16_t*)(cb + RC_TM), *MakVt = (bf16_t*)(cb + RC_MAKVT), *GT = (bf16_t*)(cb + RC_GT), *U0T = (bf16_t*)(cb + RC_U0T);
    const f32x4 z4 = {0.f, 0.f, 0.f, 0.f};
    {
        const bf16_t* rowsrc = (wg >> 1) ? RT : AT; const bf16_t* colsrc = (wg & 1) ? KH : BH;
        bf16_t* Mo = wg == 1 ? Mak : (wg == 2 ? Mrb : Mrk);
#pragma unroll
        for (int tt = 0; tt < 2; ++tt)
#pragma unroll
            for (int st = 0; st < 2; ++st) {
                f32x4 acc = MFMA16(ldf(colsrc, 16 * st + fr, NS, 8 * fq), ldf(rowsrc, 16 * tt + fr, NS, 8 * fq), z4);
                acc = MFMA16(ldf(colsrc, 16 * st + fr, NS, 32 + 8 * fq), ldf(rowsrc, 16 * tt + fr, NS, 32 + 8 * fq), acc);
                const int t = 16 * tt + fr, s0 = 16 * st + 4 * fq, lim = (wg >> 1) ? t + 1 : t;
                acc.x = (s0 + 0 < lim) ? acc.x : 0.f; acc.y = (s0 + 1 < lim) ? acc.y : 0.f; acc.z = (s0 + 2 < lim) ? acc.z : 0.f; acc.w = (s0 + 3 < lim) ? acc.w : 0.f;
                if (wg == 0) *(f32x4*)(Mab + t * MABS + s0) = acc; else *(u32x2*)(Mo + t * TS + s0) = pk4(acc);
            }
    }
    __syncthreads();
    const float* WL = (const float*)(lds + R_WLS) + hd * 64;
    if (wg == 0) {
        {
            const int j = lane & 31;
            float Tc[32];
            f32x4 cur[8];
#pragma unroll
            for (int q = 0; q < 8; ++q) cur[q] = (f32x4){0.f, 0.f, 0.f, 0.f};
#pragma unroll
            for (int t = 0; t < 32; ++t) {
                f32x4 nx[8];
#pragma unroll
                for (int q = 0; q < 8; ++q) nx[q] = (t + 1 < 32 && 4 * q < t + 1) ? *(const f32x4*)(Mab + (t + 1) * MABS + 4 * q) : (f32x4){0.f, 0.f, 0.f, 0.f};
                float a0 = (t == j) ? 1.f : 0.f, a1 = 0.f;
#pragma unroll
                for (int s2 = 0; s2 < t; ++s2) { const float nv = cur[s2 >> 2][s2 & 3]; if (s2 & 1) a1 += nv * Tc[s2]; else a0 += nv * Tc[s2]; }
                Tc[t] = a0 + a1;
#pragma unroll
                for (int q = 0; q < 8; ++q) cur[q] = nx[q];
            }
            if (lane < 32) {
#pragma unroll
                for (int t = 0; t < 32; ++t) Tm[t * TS + j] = f2bf(Tc[t]);
            }
        }
        __syncthreads();
#pragma unroll
        for (int rt = 0; rt < 2; ++rt)
#pragma unroll
            for (int tt = 0; tt < 2; ++tt) {
                const f32x4 acc = MFMA16(ldf(Tm, 16 * tt + fr, TS, 8 * fq), ldf(ATt, 16 * rt + fr, TS, 8 * fq), z4);
                *(u32x2*)(GT + (16 * rt + fr) * TS + 16 * tt + 4 * fq) = pk4(acc);
            }
        __syncthreads();
#pragma unroll
        for (int tt = 0; tt < 2; ++tt)
#pragma unroll
            for (int ks = 0; ks < 2; ++ks) {
                u32x2 pc[2];
#pragma unroll
                for (int hf = 0; hf < 2; ++hf) {
                    const int kt = 2 * ks + hf;
                    f32x4 acc = MFMA16(ldf(GT, 16 * kt + fr, TS, 8 * fq), ldf(Mrb, 16 * tt + fr, TS, 8 * fq), z4);
                    const int t = 16 * tt + fr, k0 = 16 * kt + 4 * fq;
                    const u32x2 rr = *(const u32x2*)(RT + t * NS + k0);
                    acc.x += __uint_as_float(rr.x << 16); acc.y += __uint_as_float(rr.x & 0xffff0000u); acc.z += __uint_as_float(rr.y << 16); acc.w += __uint_as_float(rr.y & 0xffff0000u);
                    pc[hf] = pk4(acc);
                }
                *(u32x4*)(G.ZZ + ch * 2048 + ((tt * 2 + ks) * 64 + lane) * 8) = (u32x4){pc[0].x, pc[0].y, pc[1].x, pc[1].y};
            }
    } else if (wg == 1) {
#pragma unroll
        for (int vt = 0; vt < 4; ++vt)
#pragma unroll
            for (int tt = 0; tt < 2; ++tt) {
                const f32x4 acc = MFMA16(ldf(Mak, 16 * tt + fr, TS, 8 * fq), ldf(Vt, 16 * vt + fr, TS, 8 * fq), z4);
                *(u32x2*)(MakVt + (16 * vt + fr) * TS + 16 * tt + 4 * fq) = pk4(acc);
            }
        __syncthreads();
#pragma unroll
        for (int rt = 2; rt < 4; ++rt)
#pragma unroll
            for (int tt = 0; tt < 2; ++tt) {
                const f32x4 acc = MFMA16(ldf(Tm, 16 * tt + fr, TS, 8 * fq), ldf(ATt, 16 * rt + fr, TS, 8 * fq), z4);
                *(u32x2*)(GT + (16 * rt + fr) * TS + 16 * tt + 4 * fq) = pk4(acc);
            }
        __syncthreads();
#pragma unroll
        for (int kp = 0; kp < 4; ++kp)
#pragma unroll
            for (int ks = 0; ks < 2; ++ks) {
                u32x2 pc[2];
#pragma unroll
                for (int hf = 0; hf < 2; ++hf) {
                    const int kt = 2 * ks + hf;
                    f32x4 acc = MFMA16(ldf(GT, 16 * kt + fr, TS, 8 * fq), ldf(BHt, 16 * kp + fr, TS, 8 * fq), z4);
                    const int kq = 16 * kp + fr, k0 = 16 * kt + 4 * fq; const float wl = WL[kq];
                    acc.x = (acc.x + (k0 + 0 == kq ? 1.f : 0.f)) * wl; acc.y = (acc.y + (k0 + 1 == kq ? 1.f : 0.f)) * wl; acc.z = (acc.z + (k0 + 2 == kq ? 1.f : 0.f)) * wl; acc.w = (acc.w + (k0 + 3 == kq ? 1.f : 0.f)) * wl;
                    pc[hf] = pk4(acc);
                }
                *(u32x4*)(G.PT + ch * 4096 + ((kp * 2 + ks) * 64 + lane) * 8) = (u32x4){pc[0].x, pc[0].y, pc[1].x, pc[1].y};
            }
    } else if (wg == 2) {
        f32x4 y0acc[2][4];
#pragma unroll
        for (int tt = 0; tt < 2; ++tt)
#pragma unroll
            for (int vt = 0; vt < 4; ++vt) y0acc[tt][vt] = MFMA16(ldf(Vt, 16 * vt + fr, TS, 8 * fq), ldf(Mrk, 16 * tt + fr, TS, 8 * fq), z4);
        __syncthreads();
#pragma unroll
        for (int rt = 0; rt < 2; ++rt)
#pragma unroll
            for (int tt = 0; tt < 2; ++tt) {
                const f32x4 acc = MFMA16(ldf(Tm, 16 * tt + fr, TS, 8 * fq), ldf(MakVt, 16 * rt + fr, TS, 8 * fq), z4);
                *(u32x2*)(U0T + (16 * rt + fr) * TS + 16 * tt + 4 * fq) = pk4(acc);
            }
        __syncthreads();
#pragma unroll
        for (int tt = 0; tt < 2; ++tt)
#pragma unroll
            for (int vp = 0; vp < 2; ++vp) {
                const f32x4 a0 = MFMA16(ldf(U0T, 16 * (2 * vp) + fr, TS, 8 * fq), ldf(Mrb, 16 * tt + fr, TS, 8 * fq), y0acc[tt][2 * vp]);
                const f32x4 a1 = MFMA16(ldf(U0T, 16 * (2 * vp + 1) + fr, TS, 8 * fq), ldf(Mrb, 16 * tt + fr, TS, 8 * fq), y0acc[tt][2 * vp + 1]);
                const u32x2 p0 = pk4(a0), p1 = pk4(a1);
                *(u32x4*)(G.Y0 + ch * 2048 + ((tt * 2 + vp) * 64 + lane) * 8) = (u32x4){p0.x, p0.y, p1.x, p1.y};
            }
    } else {
        f32x4 qacc[4][4];
#pragma unroll
        for (int vt = 0; vt < 4; ++vt)
#pragma unroll
            for (int kt = 0; kt < 4; ++kt) qacc[vt][kt] = MFMA16(ldf(KHt, 16 * kt + fr, TS, 8 * fq), ldf(Vt, 16 * vt + fr, TS, 8 * fq), z4);
        __syncthreads();
#pragma unroll
        for (int rt = 2; rt < 4; ++rt)
#pragma unroll
            for (int tt = 0; tt < 2; ++tt) {
                const f32x4 acc = MFMA16(ldf(Tm, 16 * tt + fr, TS, 8 * fq), ldf(MakVt, 16 * rt + fr, TS, 8 * fq), z4);
                *(u32x2*)(U0T + (16 * rt + fr) * TS + 16 * tt + 4 * fq) = pk4(acc);
            }
        __syncthreads();
#pragma unroll
        for (int vt = 0; vt < 4; ++vt)
#pragma unroll
            for (int hf2 = 0; hf2 < 2; ++hf2) {
                u32x2 pc[2];
#pragma unroll
                for (int hf = 0; hf < 2; ++hf) {
                    const int kt = 2 * hf2 + hf;
                    f32x4 acc = MFMA16(ldf(BHt, 16 * kt + fr, TS, 8 * fq), ldf(U0T, 16 * vt + fr, TS, 8 * fq), qacc[vt][kt]);
                    acc *= *(const f32x4*)(WL + 16 * kt + 4 * fq);
                    pc[hf] = pk4(acc);
                }
                *(u32x4*)(G.QQ + ch * 4096 + ((vt * 2 + hf2) * 64 + lane) * 8) = (u32x4){pc[0].x, pc[0].y, pc[1].x, pc[1].y};
            }
    }
    __syncthreads();
}

__device__ __forceinline__ void chain_step(f32x4 (&acc)[4], const bf16x8 (&fa)[4][2], u32x4 q01, u32x4 q23, bf16_t* __restrict__ scp) {
    union { u32x4 u; bf16x8 v; } bs[2];
    const u32x2 a = pk4(acc[0]), b = pk4(acc[1]), c2 = pk4(acc[2]), d = pk4(acc[3]);
    *(u32x4*)(scp) = (u32x4){a.x, a.y, b.x, b.y}; *(u32x4*)(scp + 512) = (u32x4){c2.x, c2.y, d.x, d.y};
    bs[0].u = (u32x4){a.x, a.y, b.x, b.y}; bs[1].u = (u32x4){c2.x, c2.y, d.x, d.y};
    acc[0] = (f32x4){__uint_as_float(q01.x << 16), __uint_as_float(q01.x & 0xffff0000u), __uint_as_float(q01.y << 16), __uint_as_float(q01.y & 0xffff0000u)};
    acc[1] = (f32x4){__uint_as_float(q01.z << 16), __uint_as_float(q01.z & 0xffff0000u), __uint_as_float(q01.w << 16), __uint_as_float(q01.w & 0xffff0000u)};
    acc[2] = (f32x4){__uint_as_float(q23.x << 16), __uint_as_float(q23.x & 0xffff0000u), __uint_as_float(q23.y << 16), __uint_as_float(q23.y & 0xffff0000u)};
    acc[3] = (f32x4){__uint_as_float(q23.z << 16), __uint_as_float(q23.z & 0xffff0000u), __uint_as_float(q23.w << 16), __uint_as_float(q23.w & 0xffff0000u)};
#pragma unroll
    for (int it = 0; it < 4; ++it) { acc[it] = MFMA16(fa[it][0], bs[0].v, acc[it]); acc[it] = MFMA16(fa[it][1], bs[1].v, acc[it]); }
}
__device__ __forceinline__ void rwkv_chain1(int sq, int h, int wg, const float* __restrict__ state_in, const RwkvG& G, float* __restrict__ st_s) {
    int tid_ = threadIdx.x; asm volatile("" : "+v"(tid_));
    const int lane = tid_ & 63, fr = lane & 15, fq = lane >> 4, j0 = 16 * wg;
    const Seq s = seq_of(sq);
    const size_t ch = (size_t)(s.base / 32) * 4 + h;
    f32x4 acc[4];
#pragma unroll
    for (int it = 0; it < 4; ++it) acc[it] = *(const f32x4*)(state_in + (((size_t)s.b * 4 + h) * 64 + j0 + fr) * 64 + 16 * it + 4 * fq);
    bf16x8 fa[4][2];
#pragma unroll
    for (int it = 0; it < 4; ++it)
#pragma unroll
        for (int ks = 0; ks < 2; ++ks) fa[it][ks] = *(const bf16x8*)(G.PT + ch * 4096 + ((it * 2 + ks) * 64 + lane) * 8);
    const u32x4 q01 = *(const u32x4*)(G.QQ + ch * 4096 + ((wg * 2) * 64 + lane) * 8), q23 = *(const u32x4*)(G.QQ + ch * 4096 + ((wg * 2 + 1) * 64 + lane) * 8);
    chain_step(acc, fa, q01, q23, G.SC + ch * 4096 + wg * 1024 + lane * 8);
    float* o = st_s + (((size_t)s.b * 4 + h) * 64 + j0 + fr) * 64 + 4 * fq;
#pragma unroll
    for (int it = 0; it < 4; ++it) *(f32x4*)(o + 16 * it) = acc[it];
}
constexpr int CH_RP = 16, CH_RQ = 16, CH_SLOT = 8192  ;
#define CH_BAR() do { __builtin_amdgcn_s_waitcnt(0xc07f); __builtin_amdgcn_s_barrier(); } while (0)
__device__ __forceinline__ void rwkv_chain_lds(unsigned char* lds, int sq, int h, const RwkvG& G, float* __restrict__ st_p) {
    constexpr int nc = 4096 / 32;
    static_assert(nc % CH_RP == 0 && CH_RP % CH_RQ == 0, "ring depths must divide the chunk count");
    int tid_ = threadIdx.x; asm volatile("" : "+v"(tid_));
    const int wv = __builtin_amdgcn_readfirstlane(tid_ >> 6);
    const Seq s = seq_of(sq);
    const size_t ch0 = (size_t)(s.base / 32) * 4 + h;
    if (wv >= 4) {
        int tl_ = threadIdx.x; asm volatile("" : "+v"(tl_)); const int lane = tl_ & 63;
        const int lw = wv - 4;
        const bf16_t* pn = G.PT + ch0 * 4096 + (size_t)(lw * 128 + lane) * 8;
        unsigned char* dst0 = lds + (lw * 128 + lane) * 16;
        u32x4 ld[CH_RP][2];
#pragma unroll
        for (int c = 0; c < CH_RP; ++c) {
#pragma unroll
            for (int i = 0; i < 2; ++i) ld[c][i] = *(const u32x4*)(pn + i * 512);
            pn += 16384; asm volatile("" : "+v"(pn));
        }
#pragma unroll
        for (int i = 0; i < 2; ++i) *(u32x4*)(dst0 + i * 1024) = ld[0][i];
#pragma unroll
        for (int i = 0; i < 2; ++i) ld[0][i] = *(const u32x4*)(pn + i * 512);
        pn += 16384; asm volatile("" : "+v"(pn));
        CH_BAR();
#pragma unroll 1
        for (int s0 = 0; s0 < nc; s0 += CH_RP) {
#pragma unroll
            for (int j = 0; j < CH_RP; ++j) {
                const int nx = s0 + j + 1, set = (j + 1) % CH_RP;
                unsigned char* d = dst0 + (nx & 1) * CH_SLOT;
#pragma unroll
                for (int i = 0; i < 2; ++i) *(u32x4*)(d + i * 1024) = ld[set][i];
#pragma unroll
                for (int i = 0; i < 2; ++i) ld[set][i] = *(const u32x4*)(pn + i * 512);
                pn += (nx + CH_RP + 1 < nc) ? 16384 : 0; asm volatile("" : "+v"(pn));
                CH_BAR();
            }
        }
    } else {
        int tc_ = threadIdx.x; asm volatile("" : "+v"(tc_)); const int lane = tc_ & 63, fr = lane & 15, fq = lane >> 4;
        const int j0 = 16 * wv;
        const bf16_t* qn = G.QQ + ch0 * 4096 + (size_t)((wv * 2) * 64 + lane) * 8;
        u32x4 qr[CH_RQ][2];
#pragma unroll
        for (int c = 0; c < CH_RQ; ++c) { qr[c][0] = *(const u32x4*)(qn); qr[c][1] = *(const u32x4*)(qn + 512); qn += 16384; asm volatile("" : "+v"(qn)); }
        bf16_t* scp = G.SC + ch0 * 4096 + wv * 1024 + lane * 8;
        f32x4 acc[4];
#pragma unroll
        for (int it = 0; it < 4; ++it) acc[it] = (f32x4){0.f, 0.f, 0.f, 0.f};
        CH_BAR();
#pragma unroll 1
        for (int s0 = 0; s0 < nc; s0 += CH_RP) {
#pragma unroll
            for (int j = 0; j < CH_RP; ++j) {
                const int st = s0 + j, qs = j % CH_RQ;
                const unsigned char* sl = lds + (st & 1) * CH_SLOT;
                bf16x8 fa[4][2];
#pragma unroll
                for (int it = 0; it < 4; ++it)
#pragma unroll
                    for (int ks = 0; ks < 2; ++ks) fa[it][ks] = *(const bf16x8*)(sl + ((it * 2 + ks) * 64 + lane) * 16);
                const u32x4 q01 = qr[qs][0], q23 = qr[qs][1];
                qr[qs][0] = *(const u32x4*)(qn); qr[qs][1] = *(const u32x4*)(qn + 512);
                qn += (st + CH_RQ + 1 < nc) ? 16384 : 0; asm volatile("" : "+v"(qn));
                chain_step(acc, fa, q01, q23, scp);
                scp += 16384; asm volatile("" : "+v"(scp));
                CH_BAR();
            }
        }
        int t3 = threadIdx.x; asm volatile("" : "+v"(t3));
        const int l3 = t3 & 63, fr3 = l3 & 15, fq3 = l3 >> 4;
        float* o = st_p + (((size_t)s.b * 4 + h) * 64 + j0 + fr3) * 64 + 4 * fq3;
#pragma unroll
        for (int it = 0; it < 4; ++it) *(f32x4*)(o + 16 * it) = acc[it];
    }
}

__device__ __forceinline__ void rwkv_out(int wi, const RwkvW& w, const RwkvG& G, bf16_t* __restrict__ YMIX) {
    int tid_ = threadIdx.x; asm volatile("" : "+v"(tid_));
    const int lane = tid_ & 63, fr = lane & 15, fq = lane >> 4;
    const size_t ch = (size_t)(wi >> 1); const int tt = wi & 1, h = (int)(ch & 3), cid = (int)(ch >> 2);
    const int t = 16 * tt + fr, tok = cid * 32 + t;
    const bf16x8 z0 = *(const bf16x8*)(G.ZZ + ch * 2048 + ((tt * 2 + 0) * 64 + lane) * 8), z1 = *(const bf16x8*)(G.ZZ + ch * 2048 + ((tt * 2 + 1) * 64 + lane) * 8);
    const u32x4 yp0 = *(const u32x4*)(G.Y0 + ch * 2048 + ((tt * 2 + 0) * 64 + lane) * 8), yp1 = *(const u32x4*)(G.Y0 + ch * 2048 + ((tt * 2 + 1) * 64 + lane) * 8);
    f32x4 y[4]; float sum = 0.f;
#pragma unroll
    for (int vt = 0; vt < 4; ++vt) {
        const bf16_t* sp = G.SC + ch * 4096 + vt * 1024 + lane * 8;
        const u32x4 yp = vt < 2 ? yp0 : yp1; const unsigned ya = (vt & 1) ? yp.z : yp.x, yb2 = (vt & 1) ? yp.w : yp.y;
        f32x4 acc = {__uint_as_float(ya << 16), __uint_as_float(ya & 0xffff0000u), __uint_as_float(yb2 << 16), __uint_as_float(yb2 & 0xffff0000u)};
        acc = MFMA16(*(const bf16x8*)sp, z0, acc); acc = MFMA16(*(const bf16x8*)(sp + 512), z1, acc);
        y[vt] = acc; sum += (acc.x + acc.y) + (acc.z + acc.w);
    }
    sum += __shfl_xor(sum, 16); sum += __shfl_xor(sum, 32);
    const float mean = sum * (1.f / 64.f); float var = 0.f;
#pragma unroll
    for (int vt = 0; vt < 4; ++vt) { y[vt] -= mean; var += (y[vt].x * y[vt].x + y[vt].y * y[vt].y) + (y[vt].z * y[vt].z + y[vt].w * y[vt].w); }
    var += __shfl_xor(var, 16); var += __shfl_xor(var, 32);
    const float rstd = rsqrtf(var * (1.f / 64.f) + 64e-5f);
#pragma unroll
    for (int vt = 0; vt < 4; ++vt) {
        const int c = h * 64 + 16 * vt + 4 * fq;
        const f32x4 gg = *(const f32x4*)(w.gn_g + c), gb = *(const f32x4*)(w.gn_b + c);
        const u32x2 bv = *(const u32x2*)(G.BV + (size_t)tok * 256 + c), gt = *(const u32x2*)(G.GATE + (size_t)tok * 256 + c);
        f32x4 o = y[vt] * rstd * gg + gb;
        o.x = (o.x + __uint_as_float(bv.x << 16)) * __uint_as_float(gt.x << 16); o.y = (o.y + __uint_as_float(bv.x & 0xffff0000u)) * __uint_as_float(gt.x & 0xffff0000u);
        o.z = (o.z + __uint_as_float(bv.y << 16)) * __uint_as_float(gt.y << 16); o.w = (o.w + __uint_as_float(bv.y & 0xffff0000u)) * __uint_as_float(gt.y & 0xffff0000u);
        *(u32x2*)(YMIX + (size_t)tok * DM + 256 + c) = pk4(o);
    }
}


template <int K, int SRC, bool WF32, bool WBF>
__device__ __forceinline__ void gemm_tail(unsigned char* lds, const bf16_t* __restrict__ A, const bf16_t* __restrict__ Bt, const float* __restrict__ xin_s, float* __restrict__ xout, bf16_t* __restrict__ XB, float* __restrict__ RSS) {
    int tid_ = threadIdx.x; asm volatile("" : "+v"(tid_));
    const int lane = tid_ & 63, w = __builtin_amdgcn_readfirstlane(tid_ >> 6), fr = lane & 15, fq = lane >> 4;
    float* part = (float*)lds;
    for (int tb = blockIdx.x; tb < 256; tb += gridDim.x) {
        const int mi = tb >> 4, ni = tb & 15, rt = w >> 2, ct = w & 3;
        const int r0 = 32 * mi + 16 * rt, c0 = 64 * ni + 16 * ct;
        const bf16_t* ap = A + (size_t)(T_P + r0 + fr) * K + 8 * fq; const bf16_t* bp = Bt + (size_t)(c0 + fr) * K + 8 * fq;
        f32x4 acc = {0.f, 0.f, 0.f, 0.f};
#pragma unroll 1
        for (int k0 = 0; k0 + 512 <= K; k0 += 512) {
            bf16x8 av[16], bv[16];
#pragma unroll
            for (int u = 0; u < 16; ++u) { av[u] = *(const bf16x8*)(ap + k0 + 32 * u); bv[u] = *(const bf16x8*)(bp + k0 + 32 * u); }
#pragma unroll
            for (int u = 0; u < 16; ++u) acc = MFMA16(bv[u], av[u], acc);
        }
        if (K % 512) {
            constexpr int k0 = K - (K % 512), NU = (K % 512) / 32;
            bf16x8 av[NU > 0 ? NU : 1], bv[NU > 0 ? NU : 1];
#pragma unroll
            for (int u = 0; u < NU; ++u) { av[u] = *(const bf16x8*)(ap + k0 + 32 * u); bv[u] = *(const bf16x8*)(bp + k0 + 32 * u); }
#pragma unroll
            for (int u = 0; u < NU; ++u) acc = MFMA16(bv[u], av[u], acc);
        }
        const int row = r0 + fr, col = c0 + 4 * fq;
        f32x4 x;
        if (SRC == 0) x = *(const f32x4*)(xin_s + (size_t)row * DM + col);
        else { const u32x2 r = *(const u32x2*)(XB + (size_t)(T_P + row) * DM + col); x = (f32x4){__uint_as_float(r.x << 16), __uint_as_float(r.x & 0xffff0000u), __uint_as_float(r.y << 16), __uint_as_float(r.y & 0xffff0000u)}; }
        x += acc;
        if (WF32) *(f32x4*)(xout + (size_t)(T_P + row) * DM + col) = x;
        if (WBF) {
            *(u32x2*)(XB + (size_t)(T_P + row) * DM + col) = pk4(x);
            float ss = (x.x * x.x + x.y * x.y) + (x.z * x.z + x.w * x.w);
            ss += __shfl_xor(ss, 16); ss += __shfl_xor(ss, 32);
            if (lane < 16) part[(rt * 4 + ct) * 16 + fr] = ss;
            __syncthreads();
            if (tid_ < 32) { const int rr = tid_ >> 4, f = tid_ & 15; RSS[(size_t)(T_P + 32 * mi + 16 * rr + f) * 16 + ni] = (part[(rr * 4 + 0) * 16 + f] + part[(rr * 4 + 1) * 16 + f]) + (part[(rr * 4 + 2) * 16 + f] + part[(rr * 4 + 3) * 16 + f]); }
            __syncthreads();
        }
    }
}

template <class E2> struct EpiAdapt {
    static constexpr bool PERM = true, AFTER_DRAIN = false; E2 e;
    __device__ __forceinline__ void operator()(const pg8::f32x4 (&acc)[2][2][4][2], const pg8::Unit& u, int wr, int wc, int fr, int fq) const {
#pragma unroll
        for (int ai = 0; ai < 2; ++ai)
#pragma unroll
            for (int m = 0; m < 4; ++m) {
                const int row = u.pm * 256 + ai * 128 + wr * 64 + m * 16 + fr;
                const float rs = e.rowscale(row);
                e(row, u.pn * 256 + wc * 32 + 8 * fq, acc[ai][0][m][0], acc[ai][0][m][1], acc[ai][1][m][0], acc[ai][1][m][1], rs);
            }
    }
};

#define LAS __attribute__((address_space(3)))
#define XB_TMO      128
#define XB_XCNT(j)  (256  + 64 * (j))
#define XB_XSUB(j)  (1280 + 64 * (j))
#define XB_XGEN(j)  (2304 + 64 * (j))
#define XB_TOP      3328
#define XB_TOPGEN   3392
#define XCD_BAR_WORDS 3456
#define XB_SPIN_CAP (1u << 18)

__device__ __forceinline__ unsigned xb_ld(unsigned* p)              { return __hip_atomic_load(p, __ATOMIC_RELAXED, __HIP_MEMORY_SCOPE_AGENT); }
__device__ __forceinline__ unsigned xb_add(unsigned* p, unsigned v) { return __hip_atomic_fetch_add(p, v, __ATOMIC_RELAXED, __HIP_MEMORY_SCOPE_AGENT); }
__device__ __forceinline__ unsigned xb_xcc_id() { return (unsigned)__builtin_amdgcn_s_getreg((3 << 11) | 20) & 0xFu; }
#define XB_SPIN(cond, bar) do { unsigned _sp = 0; while (cond) { __builtin_amdgcn_s_sleep(1); \
    if ((++_sp & 255u) == 0u) { if (xb_ld(&(bar)[XB_TMO])) break; if (_sp > XB_SPIN_CAP) { atomicAdd(&(bar)[XB_TMO], 1u); break; } } } } while (0)

struct XcdBarrier {
    unsigned* bar; unsigned x;
    unsigned* psub; unsigned* pgen;
    volatile LAS unsigned* st;
};

__device__ __forceinline__ XcdBarrier xcd_barrier_post(unsigned* bar, volatile LAS unsigned* st) {
    XcdBarrier b; b.bar = bar; b.x = xb_xcc_id(); b.st = st; b.psub = bar + XB_XSUB(b.x); b.pgen = bar + XB_XGEN(b.x);
    if (threadIdx.x == 0) (void)xb_add(&bar[XB_XCNT(b.x)], 1u);
    return b;
}
__device__ __forceinline__ void xcd_barrier_complete(unsigned* bar, unsigned x, unsigned& nloc, unsigned& nx) {
    const unsigned G = gridDim.x * gridDim.y * gridDim.z;
    unsigned sum, cnt, mine, sp = 0u;
    for (;;) {
        sum = 0u; cnt = 0u; mine = 0u;
#pragma unroll
        for (unsigned j = 0; j < 16; ++j) { const unsigned c = xb_ld(&bar[XB_XCNT(j)]); sum += c; cnt += (c > 0u) ? 1u : 0u; mine = (j == x) ? c : mine; }
        if (sum == G) break;
        __builtin_amdgcn_s_sleep(1);
        if ((++sp & 255u) == 0u) { if (xb_ld(&bar[XB_TMO])) break; if (sp > XB_SPIN_CAP) { atomicAdd(&bar[XB_TMO], 1u); break; } }
    }
    nloc = mine > 0u ? mine : 1u; nx = cnt > 0u ? cnt : 1u;
}

__device__ __forceinline__ void xcd_barrier(const XcdBarrier& b) {
    asm volatile("s_waitcnt vmcnt(0)" ::: "memory");
    __syncthreads();
    if (threadIdx.x == 0) {
        unsigned* bar = b.bar;
        __builtin_amdgcn_s_waitcnt(0);
        unsigned nloc = b.st[0], nx = b.st[1];
        const unsigned old = xb_add(b.psub, 1u);
        const unsigned gen = old / nloc;
        if (old + 1u == (gen + 1u) * nloc) {
            __builtin_amdgcn_fence(__ATOMIC_RELEASE, "agent");
            asm volatile("s_waitcnt vmcnt(0)" ::: "memory");
            const unsigned og = xb_add(&bar[XB_TOP], 1u);
            const unsigned tg = og / nx;
            if (og + 1u == (tg + 1u) * nx) xb_add(&bar[XB_TOPGEN], 1u);
            else XB_SPIN(xb_ld(&bar[XB_TOPGEN]) == tg, bar);
            __builtin_amdgcn_fence(__ATOMIC_ACQUIRE, "agent");
            xb_add(b.pgen, 1u);
            asm volatile("s_waitcnt vmcnt(0)" ::: "memory");
        } else {
            XB_SPIN(xb_ld(b.pgen) == gen, bar);
            __builtin_amdgcn_fence(__ATOMIC_ACQUIRE, "agent");
            asm volatile("s_waitcnt vmcnt(0)" ::: "memory");
        }
    }
    __syncthreads();
}


__device__ __forceinline__ void xcd_census(const XcdBarrier& b) { if (threadIdx.x == 0) { unsigned nloc, nx; xcd_barrier_complete(b.bar, b.x, nloc, nx); b.st[0] = nloc; b.st[1] = nx; } __syncthreads(); }

constexpr int LDS_BYTES = 147456;
struct MP { const float* in[35]; float* out; unsigned char* ws; int ph_lo, ph_hi; };
constexpr int P0_I_IN = (DM / 64) * (NIN / 32), P0_I_OUT = (DM / 64) * (DM / 32), P0_I_G = (DM / 64) * (DFF / 32), P0_I_D = (DFF / 64) * (DM / 32), P0_IL = P0_I_IN + P0_I_OUT + 2 * P0_I_G + P0_I_D;
__device__ __forceinline__ const float* inptr_(int k);
__device__ __forceinline__ void p0_dispatch(int it, unsigned char* ws, float* scr, int lane) {
    const int l2 = it / P0_IL; int r = it - l2 * P0_IL;
    bf16_t* WIN_ = (bf16_t*)(ws + WS_WIN); bf16_t* WOUT_ = (bf16_t*)(ws + WS_WOUT); bf16_t* WGU_ = (bf16_t*)(ws + WS_WGU); bf16_t* WD_ = (bf16_t*)(ws + WS_WD);
    if (r < P0_I_IN) { p0_item(inptr_(9) + (size_t)l2 * DM * NIN, DM, NIN, WIN_ + (size_t)l2 * NINP * DM, inptr_(8) + l2 * DM, NIN, 0, 0, scr, r, lane, true); return; } r -= P0_I_IN;
    if (r < P0_I_OUT) { p0_item(inptr_(30) + (size_t)l2 * DM * DM, DM, DM, WOUT_ + (size_t)l2 * DM * DM, nullptr, DM, 0, 0, scr, r, lane); return; } r -= P0_I_OUT;
    if (r < P0_I_G) { p0_item(inptr_(32) + (size_t)l2 * DM * DFF, DM, DFF, WGU_ + (size_t)l2 * 2 * DFF * DM, inptr_(31) + l2 * DM, 4, 8, 0, scr, r, lane); return; } r -= P0_I_G;
    if (r < P0_I_G) { p0_item(inptr_(33) + (size_t)l2 * DM * DFF, DM, DFF, WGU_ + (size_t)l2 * 2 * DFF * DM, inptr_(31) + l2 * DM, 4, 8, 4, scr, r, lane); return; } r -= P0_I_G;
    p0_item(inptr_(34) + (size_t)l2 * DFF * DM, DFF, DM, WD_ + (size_t)l2 * DM * DFF, nullptr, DM, 0, 0, scr, r, lane);
}
__device__ __forceinline__ const float* inptr_(int k) { const float* const* ka = (const float* const*)__builtin_amdgcn_kernarg_segment_ptr(); asm volatile("" : "+s"(k)); return ka[k]; }
__device__ __forceinline__ int fresh_bx() { int b = blockIdx.x; asm volatile("" : "+s"(b)); return b; }
__global__ void __launch_bounds__(512, 2) mega(MP p) {
    extern __shared__ __attribute__((aligned(16))) unsigned char lds[];
    cg::grid_group grid = cg::this_grid();
    float* out = p.out; unsigned char* ws = p.ws;
#define INP(k) inptr_(k)
#define WIN ((bf16_t*)(ws + WS_WIN))
#define WOUT ((bf16_t*)(ws + WS_WOUT))
#define WGU ((bf16_t*)(ws + WS_WGU))
#define WD ((bf16_t*)(ws + WS_WD))
#define XB ((bf16_t*)(ws + WS_XB))
#define YMIX ((bf16_t*)(ws + WS_YMIX))
#define RSS ((float*)(ws + WS_RSS))
#define PROJ ((bf16_t*)(ws + WS_PROJ))
#define H ((bf16_t*)(ws + WS_H))
    const int lo = p.ph_lo, hi = p.ph_hi;
    int tid = threadIdx.x, half = tid >> 8;
#define FRESH() do { asm volatile("" : "+v"(tid)); half = tid >> 8; asm volatile("" : "+s"(ws), "+s"(out)); } while (0)
#ifndef TESTPH
#define TESTPH -1
#endif
    volatile LAS unsigned* bst = (volatile LAS unsigned*)(lds + LDS_BYTES - 16);
    if (threadIdx.x < 4) bst[threadIdx.x] = 0u;
    __syncthreads();
    const XcdBarrier xbar = xcd_barrier_post((unsigned*)(ws + WS_CTL), bst);
#ifndef PROF
#define PROF 0
#endif
    unsigned long long* tsb = (unsigned long long*)(ws + WS_CTL + 14336);
#ifndef DUP
#define DUP -1
#endif
#define REPS(k) for (int rep_ = 0; rep_ < ((DUP) == (k) ? 2 : 1); ++rep_)
#define REPSYNC(k) do { if ((DUP) == (k) && rep_ == 0) xcd_barrier(xbar); } while (0)
#define STAMP(k) do { if (PROF && blockIdx.x == 0 && threadIdx.x == 0) tsb[k] = __builtin_amdgcn_s_memrealtime(); } while (0)
    STAMP(0);
#define IN(k) ((TESTPH < 0 || TESTPH == ((k) > 8 ? (k) - 8 : (k))) && lo <= (k) && (k) < hi)
#define SEAM(k) do { if (IN((k) + 1)) { if ((k) == 0) { grid.sync(); xcd_census(xbar); } else xcd_barrier(xbar); } } while (0)
    if (IN(0)) REPS(0) {
        FRESH();
        {
            float* scr = (float*)lds + (tid >> 6) * (64 * 33);
            const int gw = blockIdx.x * 8 + (tid >> 6), ngw = gridDim.x * 8, lane = tid & 63;
            for (int it = gw; it < P0_I_IN; it += ngw) p0_dispatch(it, ws, scr, lane);
        }
        {
            bf16_t* PWT = (bf16_t*)(ws + WS_PWT);
            for (int i = blockIdx.x * 512 + tid; i < 2 * 4 * 64 * 64; i += gridDim.x * 512) { const int lg = i >> 12, d = (i >> 6) & 63, cc = i & 63; PWT[i] = f2bf(INP(25)[((size_t)lg * 64 + cc) * 64 + d]); }
        }
        {
            bf16_t* LWT = (bf16_t*)(ws + WS_LWT);
            for (int i = blockIdx.x * 512 + tid; i < 2 * 256 * 128; i += gridDim.x * 512) {
                const int l2 = i >> 15, c = (i >> 7) & 255, j = i & 127;
                const float v = j < 32 ? INP(16)[((size_t)l2 * 32 + j) * 256 + c] : (j < 64 ? INP(18)[((size_t)l2 * 32 + (j - 32)) * 256 + c] : INP(19)[((size_t)l2 * 64 + (j - 64)) * 256 + c]);
                LWT[i] = f2bf(v);
            }
        }
        for (int i = blockIdx.x; i < T / 16; i += gridDim.x) { d_xprep(i * 16 + (tid >> 6), INP(0), INP(1), XB, RSS); d_xprep(i * 16 + 8 + (tid >> 6), INP(0), INP(1), XB, RSS); }
        if (DUP == 0 && rep_ == 0) grid.sync(); else { SEAM(0); STAMP(1); }
    }
    for (int l = 0; l < 2; ++l) {
        const int pb = 1 + 8 * l;
        if (IN(pb + 0)) REPS(1) {
            FRESH();
            pg8::Gemm g{XB, WIN + (size_t)l * NINP * DM, T, NINP, DM}; pg8::StaticOrder S; S.init(T, NINP, gridDim.x, fresh_bx());
            EpiAdapt<EpiProj> E{EpiProj{PROJ, RSS, (bf16_t*)(ws + WS_GLU)}};
            pg8::gemm_phase<EpiAdapt<EpiProj>, pg8::StaticOrder, true, true>((LAS unsigned char*)lds, g, S, E);
            if (l == 0) {
                constexpr int NU1 = (T / 256) * (NINP / 256), NBUSY = NU1 % 256;
                if ((int)blockIdx.x >= NBUSY && gridDim.x == 256) {
                    float* scr = (float*)lds + (tid >> 6) * (64 * 33);
                    for (int it = P0_I_IN + ((int)blockIdx.x - NBUSY) * 8 + (tid >> 6); it < P0_IL + P0_I_IN + P0_I_OUT; it += (256 - NBUSY) * 8) p0_dispatch(it, ws, scr, tid & 63);
                } else if (gridDim.x != 256) {
                    float* scr = (float*)lds + (tid >> 6) * (64 * 33);
                    for (int it = P0_I_IN + (int)blockIdx.x * 8 + (tid >> 6); it < P0_IL + P0_I_IN + P0_I_OUT; it += (int)gridDim.x * 8) p0_dispatch(it, ws, scr, tid & 63);
                }
            }
            REPSYNC(1); if (!(DUP == 1 && rep_ == 0)) { SEAM(pb + 0); STAMP(pb + 1); }
        }
        if (IN(pb + 1)) REPS(2) {
            FRESH();
            int ll = l; asm volatile("" : "+s"(ll));
            const RwkvW rw{INP(14) + ll * 896, INP(15) + ll * 256, INP(16) + ll * 32 * 256, INP(17) + ll * 256, INP(18) + ll * 32 * 256, INP(19) + ll * 64 * 256, INP(20) + ll * 256, INP(21) + ll * 256, INP(22) + ll * 256, INP(23) + ll * 256, INP(24) + ll * 256};
            const RwkvG rg{(bf16_t*)(ws + WS_PT), (bf16_t*)(ws + WS_QQ), (bf16_t*)(ws + WS_ZZ), (bf16_t*)(ws + WS_Y0), (bf16_t*)(ws + WS_SC), (bf16_t*)(ws + WS_GATE), (bf16_t*)(ws + WS_BV), (const bf16_t*)(ws + WS_LWT)};
            for (int it = blockIdx.x; it < 1024; it += gridDim.x) rwkv_item(lds, it, ll, PROJ, INP(4) + (size_t)ll * 16 * 896, rw, rg);
            for (int i = blockIdx.x * 512 + tid; i < 20 * 896; i += gridDim.x * 512) {
                const int sq = i / 896, c = i - sq * 896; const Seq sx = seq_of(sq);
                const float v = bf2f(PROJ[(size_t)(sx.base + sx.L - 1) * NINP + C_B + c]);
                if (sx.sample) out[O_SHIFT_S + ((size_t)ll * 16 + sx.b) * 896 + c] = v; else out[O_SHIFT_P + ((size_t)ll * 4 + sx.b) * 896 + c] = v;
            }
            REPSYNC(2); if (!(DUP == 2 && rep_ == 0)) { SEAM(pb + 1); STAMP(pb + 2); }
        }
        if (IN(pb + 2)) REPS(3) {
            FRESH();
            int ll = l; asm volatile("" : "+s"(ll));
            const RwkvW rw{INP(14) + ll * 896, INP(15) + ll * 256, INP(16) + ll * 32 * 256, INP(17) + ll * 256, INP(18) + ll * 32 * 256, INP(19) + ll * 64 * 256, INP(20) + ll * 256, INP(21) + ll * 256, INP(22) + ll * 256, INP(23) + ll * 256, INP(24) + ll * 256};
            const RwkvG rg{(bf16_t*)(ws + WS_PT), (bf16_t*)(ws + WS_QQ), (bf16_t*)(ws + WS_ZZ), (bf16_t*)(ws + WS_Y0), (bf16_t*)(ws + WS_SC), (bf16_t*)(ws + WS_GATE), (bf16_t*)(ws + WS_BV), (const bf16_t*)(ws + WS_LWT)};
            if (blockIdx.x < 16) rwkv_chain_lds(lds, (int)blockIdx.x >> 2, (int)blockIdx.x & 3, rg, out + O_RWKV_P + (size_t)ll * 4 * 4 * 4096);
            else if (blockIdx.x < 48) {
                const int sidx = (int)blockIdx.x - 16;
                rwkv_item(lds, 1024 + sidx, ll, PROJ, INP(4) + (size_t)ll * 16 * 896, rw, rg);
                __syncthreads();
                const int wv = tid >> 6;
                rwkv_chain1(4 + (sidx >> 1), (sidx & 1) * 2 + (wv >> 2), wv & 3, INP(3) + (size_t)ll * 16 * 4 * 4096, rg, out + O_RWKV_S + (size_t)ll * 16 * 4 * 4096);
                __syncthreads();
                if (wv < 4) rwkv_out((((512 + (sidx >> 1)) * 4 + (sidx & 1) * 2 + (wv >> 1)) << 1) | (wv & 1), rw, rg, YMIX);
            }
            {
                const AttnP ap{PROJ, INP(6) + (size_t)ll * 16 * 128 * 128, INP(7) + (size_t)ll * 16 * 128 * 128, INP(27) + ll * 64, INP(28) + ll * 64, INP(29) + ll * 4, YMIX,
                               out + O_K_P + (size_t)ll * 4 * 128 * 128, out + O_K_S + (size_t)ll * 16 * 128 * 128, out + O_V_P + (size_t)ll * 4 * 128 * 128, out + O_V_S + (size_t)ll * 16 * 128 * 128};
                const ConvPoolP cp{PROJ, INP(2) + (size_t)ll * 16 * 30 * 256, INP(10) + ll * 31 * 256, INP(11) + ll * 256, INP(12) + ll * 256, INP(13) + ll * 256, INP(5) + (size_t)ll * 16 * 15 * 256, INP(25) + (size_t)ll * 4 * 64 * 64, INP(26) + ll * 256, YMIX,
                                   out + O_CONV_P + (size_t)ll * 4 * 30 * 256, out + O_CONV_S + (size_t)ll * 16 * 30 * 256, out + O_POOL_P + (size_t)ll * 4 * 15 * 256, out + O_POOL_S + (size_t)ll * 16 * 15 * 256, (const bf16_t*)(ws + WS_GLU), (const bf16_t*)(ws + WS_PWT) + (size_t)ll * 4 * 64 * 64};
                unsigned* ctr = (unsigned*)(ws + WS_CTL + 14848) + 64 * ll + 32 * (DUP == 3 ? rep_ : 0);
                volatile LAS unsigned* wsl = (volatile LAS unsigned*)(lds + LDS_BYTES - 32);
                for (;;) {
                    __syncthreads();
                    if (tid == 0) wsl[0] = __hip_atomic_fetch_add(ctr, 1u, __ATOMIC_RELAXED, __HIP_MEMORY_SCOPE_AGENT);
                    __syncthreads();
                    const unsigned idx = wsl[0];
                    if (idx >= 528u + 544u) break;
                    if (idx < 528u) convpool_tile((float*)lds + half * (62 * 256), 2 * (int)idx + half, cp);
                    else attn_unit(lds, (int)idx - 528, ap);
                }
            }
            REPSYNC(3); if (!(DUP == 3 && rep_ == 0)) { SEAM(pb + 2); STAMP(pb + 3); }
        }
        if (IN(pb + 3)) REPS(4) {
            FRESH();
            int ll = l; asm volatile("" : "+s"(ll));
            const RwkvW rw{INP(14) + ll * 896, INP(15) + ll * 256, INP(16) + ll * 32 * 256, INP(17) + ll * 256, INP(18) + ll * 32 * 256, INP(19) + ll * 64 * 256, INP(20) + ll * 256, INP(21) + ll * 256, INP(22) + ll * 256, INP(23) + ll * 256, INP(24) + ll * 256};
            const RwkvG rg{(bf16_t*)(ws + WS_PT), (bf16_t*)(ws + WS_QQ), (bf16_t*)(ws + WS_ZZ), (bf16_t*)(ws + WS_Y0), (bf16_t*)(ws + WS_SC), (bf16_t*)(ws + WS_GATE), (bf16_t*)(ws + WS_BV), (const bf16_t*)(ws + WS_LWT)};
            for (int wi = blockIdx.x * 8 + (tid >> 6); wi < 2 * 512 * 4; wi += gridDim.x * 8) rwkv_out(wi, rw, rg, YMIX);
            REPSYNC(4); if (!(DUP == 4 && rep_ == 0)) { SEAM(pb + 3); STAMP(pb + 4); }
        }
        if (IN(pb + 4)) {
            FRESH();
            pg8::Gemm g{YMIX, WOUT + (size_t)l * DM * DM, T_P, DM, DM}; pg8::StaticOrder S; S.init(T_P, DM, gridDim.x, fresh_bx());
            if (l == 0) {
                EpiAdapt<EpiRes<0, false, true>> E{EpiRes<0, false, true>{INP(0), INP(1), out, XB, RSS}};
                pg8::gemm_phase<EpiAdapt<EpiRes<0, false, true>>, pg8::StaticOrder, true, true>((LAS unsigned char*)lds, g, S, E);
                gemm_tail<DM, 0, false, true>(lds, YMIX, WOUT + (size_t)l * DM * DM, INP(1), out, XB, RSS);
            } else {
                EpiAdapt<EpiRes<1, false, true>> E{EpiRes<1, false, true>{nullptr, nullptr, out, XB, RSS}};
                pg8::gemm_phase<EpiAdapt<EpiRes<1, false, true>>, pg8::StaticOrder, true, true>((LAS unsigned char*)lds, g, S, E);
                gemm_tail<DM, 1, false, true>(lds, YMIX, WOUT + (size_t)l * DM * DM, nullptr, out, XB, RSS);
            }
            SEAM(pb + 4); STAMP(pb + 5);
        }
        if (IN(pb + 5)) REPS(6) {
            FRESH();
            pg8::Gemm g{XB, WGU + (size_t)l * 2 * DFF * DM, T, 2 * DFF, DM}; pg8::StaticOrder S; S.init(T, 2 * DFF, gridDim.x, fresh_bx());
            EpiAdapt<EpiGU> E{EpiGU{H, RSS}};
            pg8::gemm_phase<EpiAdapt<EpiGU>, pg8::StaticOrder, true, true>((LAS unsigned char*)lds, g, S, E);
            if (l == 0) {
                constexpr int NU3 = (T / 256) * (2 * DFF / 256), NBUSY3 = NU3 % 256;
                float* scr = (float*)lds + (tid >> 6) * (64 * 33);
                if (gridDim.x == 256) { if ((int)blockIdx.x >= NBUSY3) for (int it = P0_IL + P0_I_IN + P0_I_OUT + ((int)blockIdx.x - NBUSY3) * 8 + (tid >> 6); it < 2 * P0_IL; it += (256 - NBUSY3) * 8) p0_dispatch(it, ws, scr, tid & 63); }
                else for (int it = P0_IL + P0_I_IN + P0_I_OUT + (int)blockIdx.x * 8 + (tid >> 6); it < 2 * P0_IL; it += (int)gridDim.x * 8) p0_dispatch(it, ws, scr, tid & 63);
            }
            REPSYNC(6); if (!(DUP == 6 && rep_ == 0)) { SEAM(pb + 5); STAMP(pb + 6); }
        }
        if (IN(pb + 6)) {
            FRESH();
            pg8::Gemm g{H, WD + (size_t)l * DM * DFF, T_P, DM, DFF}; pg8::StaticOrder S; S.init(T_P, DM, gridDim.x, fresh_bx());
            if (l == 0) {
                EpiAdapt<EpiRes<1, false, true>> E{EpiRes<1, false, true>{nullptr, nullptr, out, XB, RSS}};
                pg8::gemm_phase<EpiAdapt<EpiRes<1, false, true>>, pg8::StaticOrder, true, true>((LAS unsigned char*)lds, g, S, E);
                gemm_tail<DFF, 1, false, true>(lds, H, WD + (size_t)l * DM * DFF, nullptr, out, XB, RSS);
                SEAM(pb + 7); STAMP(pb + 7);
            } else {
                EpiAdapt<EpiRes<1, true, false>> E{EpiRes<1, true, false>{nullptr, nullptr, out, XB, RSS}};
                pg8::gemm_phase<EpiAdapt<EpiRes<1, true, false>>, pg8::StaticOrder, true, true>((LAS unsigned char*)lds, g, S, E);
                gemm_tail<DFF, 1, true, false>(lds, H, WD + (size_t)l * DM * DFF, nullptr, out, XB, RSS);
            }
        }
    }
    if (PROF) {
        xcd_barrier(xbar); STAMP(16); xcd_barrier(xbar);
        const unsigned long long* t = tsb;
        const unsigned long long d[12] = {t[16] - t[0], t[1] - t[0], t[2] - t[1], t[3] - t[2], t[4] - t[3], t[5] - t[4], t[6] - t[5], t[7] - t[6], t[8] - t[7], t[10] - t[8], t[13] - t[10], t[16] - t[13]};
        const size_t off[12] = {O_Y, O_Y + (size_t)T_P * DM, O_CONV_P, O_CONV_S, O_RWKV_P, O_RWKV_S, O_SHIFT_P, O_SHIFT_S, O_POOL_P, O_POOL_S, O_K_P, O_K_S};
        const unsigned cap[12] = {99999, 99999, 61000, 99999, 99999, 99999, 7000, 28000, 30000, 99999, 99999, 99999};
        for (int k = 0; k < 12; ++k) { unsigned c = (unsigned)(d[k] / 10ull); if (c > cap[k]) c = cap[k]; for (unsigned i = blockIdx.x * 512 + threadIdx.x; i < c; i += gridDim.x * 512) ((unsigned*)out)[off[k] + i] = 0xAAAAAAAAu; }
    }
}

#undef WIN
#undef WOUT
#undef WGU
#undef WD
#undef XB
#undef YMIX
#undef RSS
#undef PROJ
#undef H
static void launch_mega(MP p, int lo, int hi, int grid_blocks, hipStream_t stream) {
    p.ph_lo = lo; p.ph_hi = hi;
    void* args[] = {&p};
    hipError_t e = hipLaunchCooperativeKernel((const void*)mega, dim3(grid_blocks), dim3(512), args, LDS_BYTES, stream);
    if (e != hipSuccess) fprintf(stderr, "cooperative launch failed: %s (grid %d)\n", hipGetErrorString(e), grid_blocks);
}
extern "C" void kernel_launch(void* const* d_in, const int* in_sizes, int n_in, void* d_out, int out_size, void* d_ws, size_t ws_size, hipStream_t stream) {
    static int grid_blocks = 0;
    if (grid_blocks == 0) {
        if (n_in != 35 || (size_t)out_size != O_END || ws_size < WS_END) { fprintf(stderr, "kernel_launch: unexpected sizes n_in %d out %d ws %zu (need %zu)\n", n_in, out_size, ws_size, (size_t)WS_END); grid_blocks = -1; return; }
        int dev = 0, cus = 0, per_cu = 0;
        (void)hipGetDevice(&dev);
        (void)hipDeviceGetAttribute(&cus, hipDeviceAttributeMultiprocessorCount, dev);
        (void)hipFuncSetAttribute((const void*)mega, hipFuncAttributeMaxDynamicSharedMemorySize, LDS_BYTES);
        (void)hipOccupancyMaxActiveBlocksPerMultiprocessor(&per_cu, mega, 512, LDS_BYTES);
        if (per_cu < 1) { fprintf(stderr, "kernel_launch: occupancy query says %d blocks per CU\n", per_cu); grid_blocks = -1; return; }
        grid_blocks = cus;
    }
    if (grid_blocks < 0) return;
    const float* const* in = (const float* const*)d_in;
    float* out = (float*)d_out; unsigned char* ws = (unsigned char*)d_ws;
    MP p{};
    for (int i = 0; i < 35; ++i) p.in[i] = in[i];
    p.out = out; p.ws = ws;
    (void)hipMemsetAsync(ws + WS_CTL, 0, 16384, stream);
    launch_mega(p, 0, 16, grid_blocks, stream);
}
```

```cpp
#include <hip/hip_runtime.h>
#include <hip/hip_cooperative_groups.h>
namespace cg = cooperative_groups;
#include <cstdint>
#include <cstdio>

typedef unsigned short bf16_t;
typedef short bf16x8 __attribute__((ext_vector_type(8)));
typedef float f32x4 __attribute__((ext_vector_type(4)));
typedef unsigned u32x4 __attribute__((ext_vector_type(4)));
typedef unsigned u32x2 __attribute__((ext_vector_type(2)));

constexpr int T_P = 16384, T_S = 512, T = 16896, DM = 1024;
constexpr int NIN = 2176, NINP = 2304, DFF = 2816;
constexpr int C_A = 0, C_B = 512, C_C = 1408, C_Q = 1664, C_K = 1920, C_V = 2048;

constexpr size_t O_Y = 0, O_CONV_P = 17301504, O_CONV_S = 17362944, O_RWKV_P = 17608704, O_RWKV_S = 17739776,
                 O_SHIFT_P = 18264064, O_SHIFT_S = 18271232, O_POOL_P = 18299904, O_POOL_S = 18330624,
                 O_K_P = 18453504, O_K_S = 18584576, O_V_P = 19108864, O_V_S = 19239936, O_END = 19764224;

constexpr size_t WS_CTL = 0;
constexpr size_t WS_WIN = 16384;
constexpr size_t WS_WOUT = WS_WIN + 2ull * NINP * DM * 2;
constexpr size_t WS_WGU = WS_WOUT + 2ull * DM * DM * 2;
constexpr size_t WS_WD = WS_WGU + 2ull * 2 * DFF * DM * 2;
constexpr size_t WS_LWT = WS_WD + 2ull * DM * DFF * 2;
constexpr size_t WS_XB = WS_LWT + 2ull * 256 * 128 * 2;
constexpr size_t WS_YMIX = WS_XB + (size_t)T * DM * 2;
constexpr size_t WS_RSS = WS_YMIX + (size_t)T * DM * 2;
constexpr size_t WS_R = WS_RSS + (size_t)T * 32 * 4;
constexpr size_t WS_PROJ = WS_R;
constexpr size_t WS_H = WS_R;
constexpr size_t WS_RW = WS_PROJ + (size_t)T * NINP * 2;
constexpr int NCH = T / 32, NCHH = NCH * 4;
constexpr size_t WS_PT = WS_RW;
constexpr size_t WS_QQ = WS_PT + (size_t)NCHH * 4096 * 2;
constexpr size_t WS_ZZ = WS_QQ + (size_t)NCHH * 4096 * 2;
constexpr size_t WS_Y0 = WS_ZZ + (size_t)NCHH * 2048 * 2;
constexpr size_t WS_SC = WS_Y0 + (size_t)NCHH * 2048 * 2;
constexpr size_t WS_GATE = WS_SC + (size_t)NCHH * 4096 * 2;
constexpr size_t WS_BV = WS_GATE + (size_t)T * 256 * 2;
constexpr size_t WS_GLU = WS_BV + (size_t)T * 256 * 2;
constexpr size_t WS_PWT = WS_GLU + (size_t)T * 256 * 2;
constexpr size_t WS_RWEND = WS_PWT + 2ull * 4 * 64 * 64 * 2;
constexpr size_t RW_BF = (size_t)T * 256 * 2;
constexpr size_t WS_RW_R = WS_RWEND, WS_RW_K = WS_RW_R + RW_BF, WS_RW_V = WS_RW_R + 2 * RW_BF, WS_RW_A = WS_RW_R + 3 * RW_BF,
                 WS_RW_B = WS_RW_R + 4 * RW_BF, WS_RW_G = WS_RW_R + 5 * RW_BF, WS_RW_W = WS_RW_R + 6 * RW_BF;
constexpr size_t WS_END = WS_RWEND;

__device__ __forceinline__ float bf2f(bf16_t h) { return __uint_as_float((unsigned)h << 16); }
typedef __bf16 bf16x2_t __attribute__((ext_vector_type(2)));
typedef float f32x2 __attribute__((ext_vector_type(2)));
__device__ __forceinline__ unsigned pk2(float lo, float hi) { const f32x2 v = {lo, hi}; return __builtin_bit_cast(unsigned, __builtin_convertvector(v, bf16x2_t)); }
__device__ __forceinline__ u32x2 pk4(f32x4 v) { u32x2 o; o.x = pk2(v.x, v.y); o.y = pk2(v.z, v.w); return o; }
__device__ __forceinline__ bf16_t f2bf(float f) { return (bf16_t)(pk2(f, 0.f) & 0xffffu); }
__device__ __forceinline__ void unpack8(u32x4 v, float* f) {
    f[0] = __uint_as_float(v.x << 16); f[1] = __uint_as_float(v.x & 0xffff0000u); f[2] = __uint_as_float(v.y << 16); f[3] = __uint_as_float(v.y & 0xffff0000u);
    f[4] = __uint_as_float(v.z << 16); f[5] = __uint_as_float(v.z & 0xffff0000u); f[6] = __uint_as_float(v.w << 16); f[7] = __uint_as_float(v.w & 0xffff0000u);
}
__device__ __forceinline__ float wave_sum(float v) {
#pragma unroll
    for (int o = 1; o < 64; o <<= 1) v += __shfl_xor(v, o);
    return v;
}
__device__ __forceinline__ float wave_sum_u(float v) {
    v += __int_as_float(__builtin_amdgcn_update_dpp(0, __float_as_int(v), 0xB1, 0xF, 0xF, false));
    v += __int_as_float(__builtin_amdgcn_update_dpp(0, __float_as_int(v), 0x4E, 0xF, 0xF, false));
    v += __int_as_float(__builtin_amdgcn_update_dpp(0, __float_as_int(v), 0x141, 0xF, 0xF, false));
    v += __int_as_float(__builtin_amdgcn_update_dpp(0, __float_as_int(v), 0x140, 0xF, 0xF, false));
    v += __int_as_float(__builtin_amdgcn_update_dpp(0, __float_as_int(v), 0x142, 0xA, 0xF, false));
    v += __int_as_float(__builtin_amdgcn_update_dpp(0, __float_as_int(v), 0x143, 0xC, 0xF, false));
    return __int_as_float(__builtin_amdgcn_readlane(__float_as_int(v), 63));
}
__device__ __forceinline__ float sigmoidf_(float x) { return __builtin_amdgcn_rcpf(1.f + __expf(-x)); }

__device__ __forceinline__ void p0_item(const float* __restrict__ W, int K, int N, bf16_t* __restrict__ WT, const float* __restrict__ g, int grp, int stride, int off, float* scr, int item, int lane, bool glu_map = false) {
    const int nblk = N / 32, kb = item / nblk, nb = item - kb * nblk, k0 = 64 * kb, n0 = 32 * nb;
    float v[32];
#pragma unroll
    for (int i = 0; i < 32; ++i) v[i] = W[(size_t)(k0 + 2 * i + (lane >> 5)) * N + n0 + (lane & 31)];
#pragma unroll
    for (int i = 0; i < 32; ++i) { const int kk = 2 * i + (lane >> 5); scr[kk * 33 + (lane & 31)] = g ? v[i] * g[k0 + kk] : v[i]; }
    asm volatile("s_waitcnt lgkmcnt(0)" ::: "memory");
    const int c = lane & 7;
#pragma unroll
    for (int j = 0; j < 4; ++j) {
        const int n = n0 + (lane >> 3) + 8 * j; const float* sp = scr + (8 * c) * 33 + (n - n0);
        u32x4 o; o.x = pk2(sp[0], sp[33]); o.y = pk2(sp[2 * 33], sp[3 * 33]); o.z = pk2(sp[4 * 33], sp[5 * 33]); o.w = pk2(sp[6 * 33], sp[7 * 33]);
        int r = (n / grp) * stride + off + (n % grp);
        if (glu_map && n < 512) { const int n2 = n & 255; r = (n2 >> 2) * 8 + (n >> 8) * 4 + (n2 & 3); }
        *(u32x4*)(WT + (size_t)r * K + k0 + 8 * c) = o;
    }
    asm volatile("s_waitcnt lgkmcnt(0)" ::: "memory");
}

__device__ __forceinline__ void d_xprep(int row, const float* __restrict__ xp, const float* __restrict__ xs, bf16_t* __restrict__ XB, float* __restrict__ RSS) {
    const int lane = threadIdx.x & 63;
    const float* x = row < T_P ? xp + (size_t)row * DM : xs + (size_t)(row - T_P) * DM;
    float ss = 0.f;
#pragma unroll
    for (int j = 0; j < 4; ++j) {
        const f32x4 v = ((const f32x4*)x)[lane + 64 * j];
        ss += v.x * v.x + v.y * v.y + v.z * v.z + v.w * v.w;
        u32x2 o; o.x = pk2(v.x, v.y); o.y = pk2(v.z, v.w);
        *(u32x2*)(XB + (size_t)row * DM + (lane + 64 * j) * 4) = o;
    }
    ss = wave_sum(ss);
    if (lane < 16) RSS[(size_t)row * 16 + lane] = lane == 0 ? ss : 0.f;
}

__device__ __forceinline__ float rss_rstd(const float* RSS, int row) {
    float s = 0.f;
#pragma unroll
    for (int j = 0; j < 4; ++j) { const f32x4 v = ((const f32x4*)(RSS + (size_t)row * 16))[j]; s += (v.x + v.y) + (v.z + v.w); }
    return rsqrtf(s * (1.f / DM) + 1e-6f);
}
struct EpiProj {
    bf16_t* PROJ; const float* RSS; bf16_t* GLU;
    __device__ __forceinline__ float rowscale(int row) const { return rss_rstd(RSS, row); }
    __device__ __forceinline__ void one(int row, int col, f32x4 v0, f32x4 v1, float rs) const {
        v0 *= rs; v1 *= rs;
        if (col < 512) { const f32x4 gl = {v0.x * sigmoidf_(v1.x), v0.y * sigmoidf_(v1.y), v0.z * sigmoidf_(v1.z), v0.w * sigmoidf_(v1.w)}; *(u32x2*)(GLU + (size_t)row * 256 + (col >> 1)) = pk4(gl); }
        else { u32x4 o; o.x = pk2(v0.x, v0.y); o.y = pk2(v0.z, v0.w); o.z = pk2(v1.x, v1.y); o.w = pk2(v1.z, v1.w); *(u32x4*)(PROJ + (size_t)row * NINP + col) = o; }
    }
    __device__ __forceinline__ void operator()(int row, int col, f32x4 v0, f32x4 v1, f32x4 w0, f32x4 w1, float rs) const { one(row, col, v0, v1, rs); one(row, col + 128, w0, w1, rs); }
};
template <int SRC, bool WF32, bool WBF> struct EpiRes {
    const float* xin_p; const float* xin_s; float* xout; bf16_t* XB; float* RSS;
    __device__ __forceinline__ float rowscale(int) const { return 1.f; }
    __device__ __forceinline__ float half8(int row, int col, f32x4 v0, f32x4 v1) const {
        f32x4 a, b;
        if (SRC == 0) { const float* xi = (row < T_P ? xin_p + (size_t)row * DM : xin_s + (size_t)(row - T_P) * DM) + col; a = *(const f32x4*)(xi); b = *(const f32x4*)(xi + 4); }
        else { float f[8]; unpack8(*(const u32x4*)(XB + (size_t)row * DM + col), f); a = (f32x4){f[0], f[1], f[2], f[3]}; b = (f32x4){f[4], f[5], f[6], f[7]}; }
        a += v0; b += v1;
        if (WF32) { *(f32x4*)(xout + (size_t)row * DM + col) = a; *(f32x4*)(xout + (size_t)row * DM + col + 4) = b; }
        if (WBF) { u32x4 o; o.x = pk2(a.x, a.y); o.y = pk2(a.z, a.w); o.z = pk2(b.x, b.y); o.w = pk2(b.z, b.w); *(u32x4*)(XB + (size_t)row * DM + col) = o; }
        return (a.x * a.x + a.y * a.y) + (a.z * a.z + a.w * a.w) + (b.x * b.x + b.y * b.y) + (b.z * b.z + b.w * b.w);
    }
    __device__ __forceinline__ void operator()(int row, int col, f32x4 v0, f32x4 v1, f32x4 w0, f32x4 w1, float) const {
        float ss = half8(row, col, v0, v1);
        ss += half8(row, col + 128, w0, w1);
        if (WBF) {
            ss += __shfl_xor(ss, 16); ss += __shfl_xor(ss, 32);
            if ((threadIdx.x & 63) < 16) RSS[(size_t)row * 16 + (col >> 8) * 4 + ((col >> 5) & 3)] = ss;
        }
    }
};
struct EpiGU {
    bf16_t* H; const float* RSS;
    __device__ __forceinline__ float rowscale(int row) const { return rss_rstd(RSS, row); }
    __device__ __forceinline__ u32x2 gu(f32x4 g, f32x4 u, float rs) const {
        g *= rs; u *= rs;
        const float h0 = g.x * sigmoidf_(g.x) * u.x, h1 = g.y * sigmoidf_(g.y) * u.y, h2 = g.z * sigmoidf_(g.z) * u.z, h3 = g.w * sigmoidf_(g.w) * u.w;
        u32x2 o; o.x = pk2(h0, h1); o.y = pk2(h2, h3); return o;
    }
    __device__ __forceinline__ void operator()(int row, int col, f32x4 g0, f32x4 u0, f32x4 g1, f32x4 u1, float rs) const {
        *(u32x2*)(H + (size_t)row * DFF + (col >> 1)) = gu(g0, u0, rs);
        *(u32x2*)(H + (size_t)row * DFF + (col >> 1) + 64) = gu(g1, u1, rs);
    }
};

struct Seq { int base, L, b, sample, pos0; };
__device__ __forceinline__ Seq seq_of(int sq) { Seq s; if (sq < 4) { s.base = sq * 4096; s.L = 4096; s.b = sq; s.sample = 0; s.pos0 = 0; } else { s.b = sq - 4; s.base = T_P + s.b * 32; s.L = 32; s.sample = 1; s.pos0 = 1024; } return s; }

struct RwkvW { const float *mu, *w0, *w2, *a0, *a2, *g2, *k_k, *k_a, *r_k, *gn_g, *gn_b; };

namespace pg8 {
#define PG8_LAS __attribute__((address_space(3)))
typedef unsigned short bf16_t;
typedef short bf16x8 __attribute__((ext_vector_type(8)));
typedef float f32x4 __attribute__((ext_vector_type(4)));
typedef unsigned u32x4 __attribute__((ext_vector_type(4)));
constexpr int BM = 256, BK = 64, HALF = 128, HTB = HALF * BK * 2  , STAGE_BYTES = 8 * HTB, NXCD = 8, WGM = 8;

__host__ __device__ __forceinline__ int lds_byte(int r, int c) { const int st = (r >> 4) * 2 + (c >> 5), rr = r & 15, cc = c & 31, ob = rr * 64 + cc * 2; return st * 1024 + (ob ^ (((ob >> 9) & 1) << 5)); }
__host__ __device__ __forceinline__ void stage_rc(int b, int& R, int& C) { const int st = b / 1024, sb = b % 1024, swz = sb ^ (((sb >> 9) & 1) << 5); R = (st >> 1) * 16 + swz / 64; C = (st & 1) * 32 + (swz % 64) / 2; }
__host__ __device__ __forceinline__ int perm32(int rho) { const int n = rho >> 4, i = rho & 15; return 8 * (i >> 2) + 4 * n + (i & 3); }

struct Unit { int pm, pn; };
struct Gemm { const bf16_t* A; const bf16_t* Bt; int M, N, K; };

struct StaticOrder {
    int nM, nN, nwg, G, c;
    __host__ __device__ void init(int M, int N, int G_, int c_) { nM = M / BM; nN = N / BM; nwg = nM * nN; G = G_; c = c_; }
    __host__ __device__ bool next(int i, Unit& u) const {
        const long L = (long)i * G + c; if (L >= nwg) return false;
        int wgid = (int)L; { const int q = nwg / NXCD, r = nwg % NXCD, xcd = wgid % NXCD, off = wgid / NXCD; wgid = (xcd < r ? xcd * (q + 1) : r * (q + 1) + (xcd - r) * q) + off; }
        const int nig = WGM * nN, gid = wgid / nig, fm = gid * WGM, gsz = (nM - fm) < WGM ? (nM - fm) : WGM;
        u.pm = fm + ((wgid % nig) % gsz); u.pn = (wgid % nig) / gsz; return true;
    }
    __device__ __forceinline__ void a_ready(const Unit&) const {}
    __device__ __forceinline__ void done(const Unit&) const {}
};


template <class Epi, class Sched, bool ALIGN_EPI = false, bool SP2 = false>
__device__ __forceinline__ void gemm_phase(PG8_LAS unsigned char* lds, const Gemm g, const Sched& S, const Epi& E) {
    int tid_ = threadIdx.x; asm volatile("" : "+v"(tid_));
    const int tid = tid_, wid = __builtin_amdgcn_readfirstlane(tid >> 6), lane = tid & 63, wr = wid >> 2, wc = wid & 3, fr = lane & 15, fq = lane >> 4;
    const int K = g.K, nt = K / BK;
    unsigned voffA[2], voffB[2];
#pragma unroll
    for (int i = 0; i < 2; ++i) { int R, C; stage_rc(tid * 16 + i * 8192, R, C); const int Rb = Epi::PERM ? ((R & ~31) + perm32(R & 31)) : R;
        voffA[i] = (unsigned)(R * K + C) * 2u; voffB[i] = (unsigned)(Rb * K + C) * 2u; }
    const size_t kstep = (size_t)(BK * 2);
    const size_t hstep = (size_t)HALF * K * 2;
    const size_t tstep = 2 * hstep;
    const unsigned ldsw = (unsigned)wid * 1024u;
    const int aoff = lds_byte(wr * 64 + fr, fq * 8), boff = lds_byte(wc * 32 + fr, fq * 8);
#define PG8_SA(b, h) (((b) * 2 + (h)) * HTB)
#define PG8_SB(b, h) ((4 + (b) * 2 + (h)) * HTB)
#define PG8_STAGE(bufoff, gbase, voff) do { _Pragma("unroll") for (int _i = 0; _i < 2; ++_i) \
        __builtin_amdgcn_global_load_lds((const unsigned*)((const char*)(gbase) + (voff)[_i]), (PG8_LAS unsigned*)(lds + (bufoff) + ldsw + _i * 8192), 16, 0, 0); } while (0)
#define PG8_LDA(dst, b, h) do { _Pragma("unroll") for (int m = 0; m < 4; ++m) _Pragma("unroll") for (int k = 0; k < 2; ++k) dst[m][k] = *(const PG8_LAS bf16x8*)(lds + PG8_SA(b, h) + aoff + m * 2048 + k * 1024); } while (0)
#define PG8_LDB(dst, b, h) do { _Pragma("unroll") for (int n = 0; n < 2; ++n) _Pragma("unroll") for (int k = 0; k < 2; ++k) dst[n][k] = *(const PG8_LAS bf16x8*)(lds + PG8_SB(b, h) + boff + n * 2048 + k * 1024); } while (0)
#define PG8_MMA(ai, bj, At, Bt) do { __builtin_amdgcn_s_setprio(1); _Pragma("unroll") for (int m = 0; m < 4; ++m) _Pragma("unroll") for (int n = 0; n < 2; ++n) _Pragma("unroll") for (int k = 0; k < 2; ++k) \
        acc[ai][bj][m][n] = __builtin_amdgcn_mfma_f32_16x16x32_bf16(Bt[n][k], At[m][k], acc[ai][bj][m][n], 0, 0, 0); __builtin_amdgcn_s_setprio(0); } while (0)
#define PG8_WAIT_V(n) asm volatile("s_waitcnt vmcnt(" #n ")" ::: "memory")
#define PG8_WAIT_L(n) asm volatile("s_waitcnt lgkmcnt(" #n ")" ::: "memory")
#define PG8_BAR __builtin_amdgcn_s_barrier()
#define PG8_SCHED __builtin_amdgcn_sched_barrier(0)
    Unit cur, nxt; int ui = 0;
    if (!S.next(0, cur)) return;
    f32x4 acc[2][2][4][2];
#pragma unroll
    for (int a = 0; a < 2; ++a)
#pragma unroll
        for (int b = 0; b < 2; ++b)
#pragma unroll
            for (int m = 0; m < 4; ++m)
#pragma unroll
                for (int n = 0; n < 2; ++n) acc[a][b][m][n] = (f32x4){0.f, 0.f, 0.f, 0.f};
    bf16x8 At[4][2], B0[2][2], B1[2][2];
    const char* cA = (const char*)g.A + (size_t)cur.pm * tstep; const char* cB = (const char*)g.Bt + (size_t)cur.pn * tstep;
    S.a_ready(cur);
    if constexpr (SP2) {
        PG8_STAGE(PG8_SB(0, 0), cB, voffB); PG8_STAGE(PG8_SB(0, 1), cB + hstep, voffB); PG8_STAGE(PG8_SA(0, 0), cA, voffA); PG8_STAGE(PG8_SA(0, 1), cA + hstep, voffA);
        if (wr == 1) PG8_BAR;
        PG8_WAIT_V(2); PG8_BAR;
        PG8_STAGE(PG8_SB(1, 0), cB + kstep, voffB); PG8_STAGE(PG8_SA(1, 0), cA + kstep, voffA); PG8_STAGE(PG8_SB(1, 1), cB + hstep + kstep, voffB);
        PG8_WAIT_V(6); PG8_BAR;
    } else {
        PG8_STAGE(PG8_SB(0, 0), cB, voffB); PG8_STAGE(PG8_SA(0, 0), cA, voffA); PG8_STAGE(PG8_SB(0, 1), cB + hstep, voffB); PG8_STAGE(PG8_SA(0, 1), cA + hstep, voffA);
        if (wr == 1) PG8_BAR;
        PG8_WAIT_V(4); PG8_BAR;
        PG8_STAGE(PG8_SB(1, 0), cB + kstep, voffB); PG8_STAGE(PG8_SA(1, 0), cA + kstep, voffA); PG8_STAGE(PG8_SB(1, 1), cB + hstep + kstep, voffB);
        PG8_WAIT_V(6); PG8_BAR;
    }
    for (;;) {
        const bool has_next = S.next(ui + 1, nxt);
        const char* nA = has_next ? (const char*)g.A + (size_t)nxt.pm * tstep : cA; const char* nB = has_next ? (const char*)g.Bt + (size_t)nxt.pn * tstep : cB;
        for (int t = 0; t < nt; t += 2) {
            const bool last = (t == nt - 2);
            const char* a1 = cA + (size_t)(t + 1) * kstep;
            const char* a2 = last ? nA : cA + (size_t)(t + 2) * kstep; const char* b2 = last ? nB : cB + (size_t)(t + 2) * kstep;
            const char* a3 = a2 + kstep; const char* b3 = b2 + kstep;
            if (last && has_next) S.a_ready(nxt);
            if constexpr (SP2) {
            PG8_LDB(B0, 0, 0); PG8_LDB(B1, 0, 1); PG8_SCHED; PG8_LDA(At, 0, 0); PG8_STAGE(PG8_SA(1, 1), a1 + hstep, voffA);
            PG8_WAIT_V(8); PG8_WAIT_L(0); PG8_BAR; PG8_MMA(0, 0, At, B0); PG8_MMA(0, 1, At, B1); PG8_BAR; PG8_SCHED;
            PG8_LDA(At, 0, 1); PG8_STAGE(PG8_SB(0, 0), b2, voffB); PG8_STAGE(PG8_SB(0, 1), b2 + hstep, voffB); PG8_STAGE(PG8_SA(0, 0), a2, voffA);
            PG8_WAIT_V(8); PG8_WAIT_L(0); PG8_BAR; PG8_MMA(1, 0, At, B0); PG8_MMA(1, 1, At, B1); PG8_BAR; PG8_SCHED;
            PG8_LDB(B0, 1, 0); PG8_LDB(B1, 1, 1); PG8_SCHED; PG8_LDA(At, 1, 0); PG8_STAGE(PG8_SA(0, 1), a2 + hstep, voffA);
            PG8_WAIT_V(8); PG8_WAIT_L(0); PG8_BAR; PG8_MMA(0, 0, At, B0); PG8_MMA(0, 1, At, B1); PG8_BAR; PG8_SCHED;
            PG8_LDA(At, 1, 1); PG8_STAGE(PG8_SB(1, 0), b3, voffB); PG8_STAGE(PG8_SB(1, 1), b3 + hstep, voffB); PG8_STAGE(PG8_SA(1, 0), a3, voffA);
            PG8_WAIT_V(8); PG8_WAIT_L(0); PG8_BAR; PG8_MMA(1, 0, At, B0); PG8_MMA(1, 1, At, B1); PG8_BAR; PG8_SCHED;
            } else {
            PG8_LDB(B0, 0, 0); PG8_SCHED; PG8_LDA(At, 0, 0); PG8_STAGE(PG8_SA(1, 1), a1 + hstep, voffA);
            PG8_WAIT_L(8); PG8_BAR; PG8_WAIT_L(0); PG8_MMA(0, 0, At, B0); PG8_BAR; PG8_SCHED;
            PG8_LDB(B1, 0, 1); PG8_STAGE(PG8_SB(0, 0), b2, voffB);
            PG8_BAR; PG8_WAIT_L(0); PG8_MMA(0, 1, At, B1); PG8_BAR;
            PG8_LDA(At, 0, 1); PG8_STAGE(PG8_SA(0, 0), a2, voffA);
            PG8_BAR; PG8_WAIT_L(0); PG8_MMA(1, 0, At, B0); PG8_BAR; PG8_SCHED;
            PG8_STAGE(PG8_SB(0, 1), b2 + hstep, voffB);
            PG8_WAIT_V(6); PG8_BAR; PG8_MMA(1, 1, At, B1); PG8_BAR;
            PG8_LDB(B0, 1, 0); PG8_SCHED; PG8_LDA(At, 1, 0); PG8_STAGE(PG8_SA(0, 1), a2 + hstep, voffA);
            PG8_WAIT_L(8); PG8_BAR; PG8_WAIT_L(0); PG8_MMA(0, 0, At, B0); PG8_BAR; PG8_SCHED;
            PG8_LDB(B1, 1, 1); PG8_STAGE(PG8_SB(1, 0), b3, voffB);
            PG8_BAR; PG8_WAIT_L(0); PG8_MMA(0, 1, At, B1); PG8_BAR;
            PG8_LDA(At, 1, 1); PG8_STAGE(PG8_SA(1, 0), a3, voffA);
            PG8_BAR; PG8_WAIT_L(0); PG8_MMA(1, 0, At, B0); PG8_BAR; PG8_SCHED;
            PG8_STAGE(PG8_SB(1, 1), b3 + hstep, voffB);
            PG8_WAIT_V(6); PG8_BAR; PG8_MMA(1, 1, At, B1); PG8_BAR;
            }
        }
        if constexpr (ALIGN_EPI) { if (wr == 0) PG8_BAR; }
        if constexpr (!Epi::AFTER_DRAIN) { E(acc, cur, wr, wc, fr, fq); S.done(cur); }
        if (!has_next) break;
#pragma unroll
        for (int a = 0; a < 2; ++a)
#pragma unroll
            for (int b = 0; b < 2; ++b)
#pragma unroll
                for (int m = 0; m < 4; ++m)
#pragma unroll
                    for (int n = 0; n < 2; ++n) acc[a][b][m][n] = (f32x4){0.f, 0.f, 0.f, 0.f};
        cur = nxt; cA = nA; cB = nB; ++ui;
        if constexpr (ALIGN_EPI) { if (wr == 1) PG8_BAR; }
    }
    PG8_WAIT_V(0);
    if constexpr (!ALIGN_EPI) { if (wr == 0) PG8_BAR; }
    PG8_BAR;
    if constexpr (Epi::AFTER_DRAIN) { E.fused(acc, cur, wr, wc, fr, fq, lds, wid, lane); S.done(cur); }
#undef PG8_SA
#undef PG8_SB
#undef PG8_STAGE
#undef PG8_LDA
#undef PG8_LDB
#undef PG8_MMA
#undef PG8_WAIT_V
#undef PG8_WAIT_L
#undef PG8_BAR
#undef PG8_SCHED
}
}


struct AttnP { const bf16_t* PROJ; const float *cache_k, *cache_v, *qn, *kn, *sinks; bf16_t* YMIX; float *ko_p, *ko_s, *vo_p, *vo_s; };
constexpr int KN_STRIDE = 72, VT_STRIDE = 200, ATT_VT_OFF = 192 * KN_STRIDE * 2;
__device__ __forceinline__ void attn_unit(unsigned char* lds, int unit, const AttnP& a) {
    int tid_ = threadIdx.x; asm volatile("" : "+v"(tid_));
    const int tid = tid_, lane = tid & 63, w = __builtin_amdgcn_readfirstlane(tid >> 6), fr = lane & 15, fq = lane >> 4;
    int sq, chunk, hkv; if (unit < 512) { sq = unit >> 7; chunk = (unit & 127) >> 1; hkv = unit & 1; } else { sq = 4 + ((unit - 512) >> 1); chunk = 0; hkv = unit & 1; }
    const Seq s = seq_of(sq);
    int nk, ncache, ktok0;
    if (s.sample) { nk = 160; ncache = 128; ktok0 = s.base; }
    else { const int back = chunk < 2 ? chunk : 2; nk = 64 * (back + 1); ncache = 0; ktok0 = s.base + (chunk - back) * 64; }
    bf16_t* Kn = (bf16_t*)lds; bf16_t* Vt = (bf16_t*)(lds + ATT_VT_OFF);
    int g, mt; bool act; if (!s.sample) { g = w >> 2; mt = w & 3; act = true; } else { g = (w >> 1) & 1; mt = w & 1; act = w < 4; }
    const bf16_t* qp = a.PROJ + (size_t)(s.base + chunk * 64 + mt * 16 + fr) * NINP + C_Q + (hkv * 2 + g) * 64 + 8 * fq;
    u32x4 qr0 = {0u, 0u, 0u, 0u}, qr1 = qr0;
    if (act) { qr0 = *(const u32x4*)qp; qr1 = *(const u32x4*)(qp + 32); }
    const f32x4 kng0 = *(const f32x4*)(a.kn + (tid & 7) * 8), kng1 = *(const f32x4*)(a.kn + (tid & 7) * 8 + 4);
    const f32x4 qn0 = *(const f32x4*)(a.qn + 8 * fq), qn1 = *(const f32x4*)(a.qn + 8 * fq + 4), qn2 = *(const f32x4*)(a.qn + 32 + 8 * fq), qn3 = *(const f32x4*)(a.qn + 32 + 8 * fq + 4);
    const float sink = a.sinks[hkv * 2 + g];
    u32x4 kraw[3], vraw[3]; f32x4 kc[3][2], vc[3][2];
#pragma unroll
    for (int q = 0; q < 3; ++q) {
        const int p = tid + 512 * q, j = p >> 3, ch = p & 7;
        kraw[q] = (u32x4){0u, 0u, 0u, 0u}; vraw[q] = kraw[q]; kc[q][0] = (f32x4){0.f, 0.f, 0.f, 0.f}; kc[q][1] = kc[q][0]; vc[q][0] = kc[q][0]; vc[q][1] = kc[q][0];
        if (p < nk * 8) {
            if (j < ncache) {
                const float* kp = a.cache_k + (((size_t)s.b * 128 + j) * 2 + hkv) * 64 + ch * 8; const float* vp = a.cache_v + (((size_t)s.b * 128 + j) * 2 + hkv) * 64 + ch * 8;
                kc[q][0] = *(const f32x4*)kp; kc[q][1] = *(const f32x4*)(kp + 4); vc[q][0] = *(const f32x4*)vp; vc[q][1] = *(const f32x4*)(vp + 4);
            } else {
                const bf16_t* pp = a.PROJ + (size_t)(ktok0 + j - ncache) * NINP + hkv * 64 + ch * 8;
                kraw[q] = *(const u32x4*)(pp + C_K); vraw[q] = *(const u32x4*)(pp + C_V);
            }
        }
    }
#pragma unroll
    for (int q = 0; q < 3; ++q) {
        const int p = tid + 512 * q, j = p >> 3, ch = p & 7;
        if (p < nk * 8) {
        float kf[8], vf[8];
        if (j < ncache) {
            kf[0] = kc[q][0].x; kf[1] = kc[q][0].y; kf[2] = kc[q][0].z; kf[3] = kc[q][0].w; kf[4] = kc[q][1].x; kf[5] = kc[q][1].y; kf[6] = kc[q][1].z; kf[7] = kc[q][1].w;
            vf[0] = vc[q][0].x; vf[1] = vc[q][0].y; vf[2] = vc[q][0].z; vf[3] = vc[q][0].w; vf[4] = vc[q][1].x; vf[5] = vc[q][1].y; vf[6] = vc[q][1].z; vf[7] = vc[q][1].w;
        } else {
            unpack8(kraw[q], kf); unpack8(vraw[q], vf);
            float ss = 0.f;
#pragma unroll
            for (int i = 0; i < 8; ++i) ss += kf[i] * kf[i];
            ss += __shfl_xor(ss, 1); ss += __shfl_xor(ss, 2); ss += __shfl_xor(ss, 4);
            const float rs = rsqrtf(ss * (1.f / 64.f) + 1e-6f);
            const f32x4 g0 = kng0, g1 = kng1;
            kf[0] *= rs * g0.x; kf[1] *= rs * g0.y; kf[2] *= rs * g0.z; kf[3] *= rs * g0.w; kf[4] *= rs * g1.x; kf[5] *= rs * g1.y; kf[6] *= rs * g1.z; kf[7] *= rs * g1.w;
        }
        u32x4 ko; ko.x = pk2(kf[0], kf[1]); ko.y = pk2(kf[2], kf[3]); ko.z = pk2(kf[4], kf[5]); ko.w = pk2(kf[6], kf[7]);
        *(u32x4*)(Kn + j * KN_STRIDE + ch * 8) = ko;
#pragma unroll
        for (int i = 0; i < 8; ++i) Vt[(ch * 8 + i) * VT_STRIDE + j] = f2bf(vf[i]);
        float* ko_ = nullptr; float* vo_ = nullptr;
        if (s.sample) { if (j >= 32) { ko_ = a.ko_s + ((size_t)s.b * 128 + (j - 32)) * 128 + hkv * 64 + ch * 8; vo_ = a.vo_s + ((size_t)s.b * 128 + (j - 32)) * 128 + hkv * 64 + ch * 8; } }
        else if (chunk >= 62 && j >= nk - 64) { const int jj = (chunk - 62) * 64 + (j - (nk - 64)); ko_ = a.ko_p + ((size_t)s.b * 128 + jj) * 128 + hkv * 64 + ch * 8; vo_ = a.vo_p + ((size_t)s.b * 128 + jj) * 128 + hkv * 64 + ch * 8; }
        if (ko_) { *(f32x4*)ko_ = (f32x4){kf[0], kf[1], kf[2], kf[3]}; *(f32x4*)(ko_ + 4) = (f32x4){kf[4], kf[5], kf[6], kf[7]}; *(f32x4*)vo_ = (f32x4){vf[0], vf[1], vf[2], vf[3]}; *(f32x4*)(vo_ + 4) = (f32x4){vf[4], vf[5], vf[6], vf[7]}; }
        }
    }
    __syncthreads();
    if (act) {
        const int qh = hkv * 2 + g, tok = s.base + chunk * 64 + mt * 16 + fr, nkt = nk >> 4, nks = nk >> 5;
        float qf[16]; unpack8(qr0, qf); unpack8(qr1, qf + 8);
        float ss = 0.f;
#pragma unroll
        for (int i = 0; i < 16; ++i) ss += qf[i] * qf[i];
        ss += __shfl_xor(ss, 16); ss += __shfl_xor(ss, 32);
        const float rs = rsqrtf(ss * (1.f / 64.f) + 1e-6f) * 0.125f;
#pragma unroll
        for (int i = 0; i < 4; ++i) { qf[i] *= rs * qn0[i]; qf[4 + i] *= rs * qn1[i]; qf[8 + i] *= rs * qn2[i]; qf[12 + i] *= rs * qn3[i]; }
        union { u32x4 u; bf16x8 v; } qa, qb;
        qa.u.x = pk2(qf[0], qf[1]); qa.u.y = pk2(qf[2], qf[3]); qa.u.z = pk2(qf[4], qf[5]); qa.u.w = pk2(qf[6], qf[7]);
        qb.u.x = pk2(qf[8], qf[9]); qb.u.y = pk2(qf[10], qf[11]); qb.u.z = pk2(qf[12], qf[13]); qb.u.w = pk2(qf[14], qf[15]);
        f32x4 sacc[12];
        float m = sink;
#pragma unroll
        for (int kt = 0; kt < 12; ++kt) {
            sacc[kt] = (f32x4){0.f, 0.f, 0.f, 0.f};
            if (kt < nkt) {
                const bf16x8 k0 = *(const bf16x8*)(Kn + (kt * 16 + fr) * KN_STRIDE + 8 * fq), k1 = *(const bf16x8*)(Kn + (kt * 16 + fr) * KN_STRIDE + 32 + 8 * fq);
                sacc[kt] = __builtin_amdgcn_mfma_f32_16x16x32_bf16(k0, qa.v, sacc[kt], 0, 0, 0);
                sacc[kt] = __builtin_amdgcn_mfma_f32_16x16x32_bf16(k1, qb.v, sacc[kt], 0, 0, 0);
                m = fmaxf(m, fmaxf(fmaxf(sacc[kt].x, sacc[kt].y), fmaxf(sacc[kt].z, sacc[kt].w)));
            }
        }
        m = fmaxf(m, __shfl_xor(m, 16)); m = fmaxf(m, __shfl_xor(m, 32));
        float lsum = 0.f;
#pragma unroll
        for (int kt = 0; kt < 12; ++kt) if (kt < nkt) {
            sacc[kt].x = __expf(sacc[kt].x - m); sacc[kt].y = __expf(sacc[kt].y - m); sacc[kt].z = __expf(sacc[kt].z - m); sacc[kt].w = __expf(sacc[kt].w - m);
            lsum += (sacc[kt].x + sacc[kt].y) + (sacc[kt].z + sacc[kt].w);
        }
        lsum += __shfl_xor(lsum, 16); lsum += __shfl_xor(lsum, 32);
        lsum += __expf(sink - m);
        f32x4 oacc[4];
#pragma unroll
        for (int dt = 0; dt < 4; ++dt) oacc[dt] = (f32x4){0.f, 0.f, 0.f, 0.f};
#pragma unroll
        for (int ks = 0; ks < 6; ++ks) if (ks < nks) {
            union { u32x4 u; bf16x8 v; } pf;
            pf.u.x = pk2(sacc[2 * ks].x, sacc[2 * ks].y); pf.u.y = pk2(sacc[2 * ks].z, sacc[2 * ks].w); pf.u.z = pk2(sacc[2 * ks + 1].x, sacc[2 * ks + 1].y); pf.u.w = pk2(sacc[2 * ks + 1].z, sacc[2 * ks + 1].w);
#pragma unroll
            for (int dt = 0; dt < 4; ++dt) {
                union { u32x4 u; bf16x8 v; } vf;
                const u32x2 lo = *(const u32x2*)(Vt + (dt * 16 + fr) * VT_STRIDE + 32 * ks + 4 * fq), hi2 = *(const u32x2*)(Vt + (dt * 16 + fr) * VT_STRIDE + 32 * ks + 16 + 4 * fq);
                vf.u.x = lo.x; vf.u.y = lo.y; vf.u.z = hi2.x; vf.u.w = hi2.y;
                oacc[dt] = __builtin_amdgcn_mfma_f32_16x16x32_bf16(vf.v, pf.v, oacc[dt], 0, 0, 0);
            }
        }
        const float inv = 1.f / lsum;
#pragma unroll
        for (int dt = 0; dt < 4; ++dt) { u32x2 o; o.x = pk2(oacc[dt].x * inv, oacc[dt].y * inv); o.y = pk2(oacc[dt].z * inv, oacc[dt].w * inv);
            *(u32x2*)(a.YMIX + (size_t)tok * DM + 768 + qh * 64 + dt * 16 + 4 * fq) = o; }
    }
    __syncthreads();
}

struct ConvPoolP { const bf16_t* PROJ; const float *cache_conv, *cw, *cb, *lg, *lb, *cache_pool, *pw, *psc; bf16_t* YMIX; float *co_p, *co_s, *po_p, *po_s; const bf16_t *GLU, *PWT; };
__device__ __forceinline__ void convpool_tile(float* sm, int tile, const ConvPoolP& a) {
    int tid_ = threadIdx.x; asm volatile("" : "+v"(tid_));
    int c = tid_ & 255;
#define RELAUNDER() asm volatile("" : "+v"(c))
    int sq, t0; if (tile < 1024) { sq = tile >> 8; t0 = (tile & 255) * 16; } else { sq = 4 + ((tile - 1024) >> 1); t0 = ((tile - 1024) & 1) * 16; }
    const Seq s = seq_of(sq);
    float* ext = sm;
    float* yb = sm + 46 * 256;
    bf16_t* db = (bf16_t*)yb;
    float cwr[31];
#pragma unroll
    for (int j = 0; j < 31; ++j) cwr[j] = a.cw[j * 256 + c];
    const float cbias = a.cb[c];
    const f32x4 lng4 = ((const f32x4*)a.lg)[c & 63], lnb4 = ((const f32x4*)a.lb)[c & 63];
    {
        u32x4 vv[6]; f32x4 h0[6], h1[6];
#pragma unroll
        for (int q = 0; q < 6; ++q) {
            const int pr = c + 256 * q, i = pr >> 5, cg = pr & 31, t = t0 - 30 + i;
            vv[q] = (u32x4){0u, 0u, 0u, 0u}; h0[q] = (f32x4){0.f, 0.f, 0.f, 0.f}; h1[q] = h0[q];
            if (i < 46) {
                if (t >= 0) vv[q] = *(const u32x4*)(a.GLU + (size_t)(s.base + t) * 256 + cg * 8);
                else if (s.sample) { const float* p = a.cache_conv + ((size_t)s.b * 30 + 30 + t) * 256 + cg * 8; h0[q] = *(const f32x4*)p; h1[q] = *(const f32x4*)(p + 4); }
            }
        }
#pragma unroll
        for (int q = 0; q < 6; ++q) {
            const int pr = c + 256 * q, i = pr >> 5, cg = pr & 31, t = t0 - 30 + i;
            if (i < 46) {
                f32x4 e0 = h0[q], e1 = h1[q];
                if (t >= 0) { float v[8]; unpack8(vv[q], v); e0 = (f32x4){v[0], v[1], v[2], v[3]}; e1 = (f32x4){v[4], v[5], v[6], v[7]}; }
                *(f32x4*)(ext + i * 256 + cg * 8) = e0; *(f32x4*)(ext + i * 256 + cg * 8 + 4) = e1;
            }
        }
    }
    __syncthreads(); RELAUNDER();
    {
        float e[46];
#pragma unroll
        for (int i = 0; i < 46; ++i) e[i] = ext[i * 256 + c];
        float* o = s.sample ? a.co_s + (size_t)s.b * 30 * 256 : a.co_p + (size_t)s.b * 30 * 256;
        if (t0 + 15 >= s.L - 30) {
#pragma unroll
            for (int i = 0; i < 16; ++i) { const int t = t0 + i; if (t >= s.L - 30) o[(t - (s.L - 30)) * 256 + c] = e[i + 30]; }
        }
        float y[16]; const float bias = cbias;
#pragma unroll
        for (int i = 0; i < 16; ++i) y[i] = bias;
#pragma unroll
        for (int j = 0; j < 31; ++j) { const float wj = cwr[j];
#pragma unroll
            for (int i = 0; i < 16; ++i) y[i] += wj * e[i + j]; }
#pragma unroll
        for (int i = 0; i < 16; ++i) yb[i * 256 + c] = y[i];
    }
    __syncthreads(); RELAUNDER();
    bf16x8 pwf[4][2]; f32x4 pscv[4];
    { const int g_ = c >> 6, l_ = c & 63, fr_ = l_ & 15, fq_ = l_ >> 4;
#pragma unroll
      for (int dt = 0; dt < 4; ++dt) { const bf16_t* wp = a.PWT + ((size_t)g_ * 64 + 16 * dt + fr_) * 64 + 8 * fq_; pwf[dt][0] = *(const bf16x8*)wp; pwf[dt][1] = *(const bf16x8*)(wp + 32); pscv[dt] = *(const f32x4*)(a.psc + g_ * 64 + 16 * dt + 4 * fq_); } }
    u32x4 pv[4]; f32x4 ph0[4], ph1[4];
#pragma unroll
    for (int q = 0; q < 4; ++q) {
        const int pr = c + 256 * q, i = pr >> 5, cg = pr & 31, t = t0 - 15 + i;
        pv[q] = (u32x4){0u, 0u, 0u, 0u}; ph0[q] = (f32x4){0.f, 0.f, 0.f, 0.f}; ph1[q] = ph0[q];
        if (i < 31) {
            if (t >= 0) pv[q] = *(const u32x4*)(a.PROJ + (size_t)(s.base + t) * NINP + C_C + cg * 8);
            else if (s.sample) { const float* p = a.cache_pool + ((size_t)s.b * 15 + 15 + t) * 256 + cg * 8; ph0[q] = *(const f32x4*)p; ph1[q] = *(const f32x4*)(p + 4); }
        }
    }
    {
        const int wv = c >> 6, lane = c & 63;
        const f32x4 g4 = lng4, b4 = lnb4;
#pragma unroll 1
        for (int i = wv; i < 16; i += 4) {
            const f32x4 v = ((const f32x4*)(yb + i * 256))[lane];
            const float mean = wave_sum_u((v.x + v.y) + (v.z + v.w)) * (1.f / 256.f);
            const f32x4 d = v - mean;
            const float var = wave_sum_u((d.x * d.x + d.y * d.y) + (d.z * d.z + d.w * d.w)) * (1.f / 256.f);
            const float rstd = rsqrtf(var + 1e-5f);
            f32x4 o = d * rstd * g4 + b4;
            o.x *= sigmoidf_(o.x); o.y *= sigmoidf_(o.y); o.z *= sigmoidf_(o.z); o.w *= sigmoidf_(o.w);
            *(u32x2*)(a.YMIX + (size_t)(s.base + t0 + i) * DM + 0 + lane * 4) = pk4(o);
        }
    }
    __syncthreads(); RELAUNDER();
#pragma unroll
    for (int q = 0; q < 4; ++q) {
        const int pr = c + 256 * q, i = pr >> 5, cg = pr & 31, t = t0 - 15 + i;
        if (i < 31) {
            f32x4 e0 = ph0[q], e1 = ph1[q];
            if (t >= 0) { float v[8]; unpack8(pv[q], v); e0 = (f32x4){v[0], v[1], v[2], v[3]}; e1 = (f32x4){v[4], v[5], v[6], v[7]}; }
            *(f32x4*)(ext + i * 256 + cg * 8) = e0; *(f32x4*)(ext + i * 256 + cg * 8 + 4) = e1;
        }
    }
    __syncthreads(); RELAUNDER();
    {
        float e[31];
#pragma unroll
        for (int i = 0; i < 31; ++i) e[i] = ext[i * 256 + c];
        float* o = s.sample ? a.po_s + (size_t)s.b * 15 * 256 : a.po_p + (size_t)s.b * 15 * 256;
        if (t0 + 15 >= s.L - 15) {
#pragma unroll
            for (int i = 0; i < 16; ++i) { const int t = t0 + i; if (t >= s.L - 15) o[(t - (s.L - 15)) * 256 + c] = e[i + 15]; }
        }
        const int g = __builtin_amdgcn_readfirstlane(c >> 6), w = 2 << g;
        float w2[16], w4[16], w8[16], w16[16];
#pragma unroll
        for (int i = 0; i < 16; ++i) w2[i] = e[15 + i] + e[14 + i];
        if (g >= 1) {
#pragma unroll
            for (int i = 0; i < 16; ++i) w4[i] = (e[15 + i] + e[14 + i]) + (e[13 + i] + e[12 + i]);
        }
        if (g >= 2) {
#pragma unroll
            for (int i = 0; i < 16; ++i) w8[i] = ((e[15 + i] + e[14 + i]) + (e[13 + i] + e[12 + i])) + ((e[11 + i] + e[10 + i]) + (e[9 + i] + e[8 + i]));
        }
        if (g == 3) {
            float cs[32]; cs[0] = e[0];
#pragma unroll
            for (int k = 1; k < 31; ++k) cs[k] = cs[k - 1] + e[k];
#pragma unroll
            for (int i = 0; i < 16; ++i) w16[i] = i == 0 ? cs[15] : cs[15 + i] - cs[i - 1];
        }
#pragma unroll
        for (int i = 0; i < 16; ++i) {
            const float sum = g == 0 ? w2[i] : (g == 1 ? w4[i] : (g == 2 ? w8[i] : w16[i]));
            const int pos = s.pos0 + t0 + i; const int cnt = (pos + 1) < w ? (pos + 1) : w;
            db[i * 264 + c] = f2bf(sum * __builtin_amdgcn_rcpf((float)cnt) - e[15 + i]);
        }
    }
    __syncthreads(); RELAUNDER();
    {
        const int g = __builtin_amdgcn_readfirstlane(c >> 6), lane = c & 63, fr = lane & 15, fq = lane >> 4;
        const bf16x8 d0 = *(const bf16x8*)(db + fr * 264 + g * 64 + 8 * fq), d1 = *(const bf16x8*)(db + fr * 264 + g * 64 + 32 + 8 * fq);
#pragma unroll
        for (int dt = 0; dt < 4; ++dt) {
            f32x4 acc = __builtin_amdgcn_mfma_f32_16x16x32_bf16(pwf[dt][0], d0, (f32x4){0.f, 0.f, 0.f, 0.f}, 0, 0, 0);
            acc = __builtin_amdgcn_mfma_f32_16x16x32_bf16(pwf[dt][1], d1, acc, 0, 0, 0);
            acc *= pscv[dt];
            *(u32x2*)(a.YMIX + (size_t)(s.base + t0 + fr) * DM + 512 + g * 64 + 16 * dt + 4 * fq) = pk4(acc);
        }
    }
    __syncthreads();
#undef RELAUNDER
}

struct RwkvG { bf16_t *PT, *QQ, *ZZ, *Y0, *SC, *GATE, *BV; const bf16_t* LWT; };
constexpr int RC_HEAD = 30208, RC_MAB = 0, RC_MAK = 4608, RC_MRB = 7168, RC_MRK = 9728, RC_TM = 12288, RC_MAKVT = 14848, RC_GT = 19968, RC_U0T = 25088;
constexpr int RB_BASE = 2 * RC_HEAD, RB_HEAD = 38912, RB_AT = 0, RB_BH = 4608, RB_KH = 9216, RB_RT = 13824, RB_ATT = 18432, RB_BHT = 23552, RB_KHT = 28672, RB_VT = 33792;
constexpr int RA_LAT = 0, RA_WL = 8704, RA_AL = 25088, RA_SCN = 41472, R_WLS = RB_BASE + 2 * RB_HEAD;
constexpr int NS = 72, TS = 40, LATS = 136, MABS = 36;
__device__ __forceinline__ bf16x8 ldf(const bf16_t* base, int row, int stride, int col) { return *(const bf16x8*)(base + row * stride + col); }
#define MFMA16(a, b, c) __builtin_amdgcn_mfma_f32_16x16x32_bf16((a), (b), (c), 0, 0, 0)

__device__ __forceinline__ void rwkv_item(unsigned char* lds, int item, int l, const bf16_t* __restrict__ PROJ, const float* __restrict__ shift_in, const RwkvW& w, const RwkvG& G) {
    int tid = threadIdx.x; asm volatile("" : "+v"(tid));
    const int wv = __builtin_amdgcn_readfirstlane(tid >> 6);
    const int cid = item >> 1, hp = item & 1, tok0 = cid * 32;
    const bool sample = cid >= 512, first = sample || ((cid & 127) == 0);
    const int sb = cid - 512;
    bf16_t* LAT = (bf16_t*)(lds + RA_LAT); float* WLb = (float*)(lds + RA_WL); float* ALb = (float*)(lds + RA_AL); float* SCN = (float*)(lds + RA_SCN); float* WLs = (float*)(lds + R_WLS);
    const int lane0 = tid & 63, fr0 = lane0 & 15, fq0 = lane0 >> 4;
    const bf16_t* lwp = G.LWT + ((size_t)l * 256 + hp * 128 + 16 * wv + fr0) * 128 + 8 * fq0;
    const bf16x8 fw = *(const bf16x8*)(lwp), fa = *(const bf16x8*)(lwp + 32), fg0 = *(const bf16x8*)(lwp + 64), fg1 = *(const bf16x8*)(lwp + 96);
    const f32x4 w0v = *(const f32x4*)(w.w0 + hp * 128 + 16 * wv + 4 * fq0), a0v = *(const f32x4*)(w.a0 + hp * 128 + 16 * wv + 4 * fq0);
    const int c3 = tid & 127, tq3 = tid >> 7, cg3 = hp * 128 + c3;
    float ur[9], uk[9], uv[9];
#pragma unroll
    for (int i = 0; i < 9; ++i) {
        const int t = 8 * tq3 - 1 + i;
        if (t >= 0 || !first) { const bf16_t* p = PROJ + (size_t)(tok0 + t) * NINP + C_B + cg3; ur[i] = bf2f(p[0]); uk[i] = bf2f(p[256]); uv[i] = bf2f(p[512]); }
        else if (sample) { const float* p = shift_in + (size_t)sb * 896 + cg3; ur[i] = p[0]; uk[i] = p[256]; uv[i] = p[512]; }
        else { ur[i] = 0.f; uk[i] = 0.f; uv[i] = 0.f; }
    }
    const float mur = w.mu[cg3], muk = w.mu[256 + cg3], muv = w.mu[512 + cg3], kkw = w.k_k[cg3], kaw = w.k_a[cg3], rkw = w.r_k[cg3];
    {
        const int t = tid >> 4, j8 = (tid & 15) * 8, col = 768 + j8;
        float u[8], pv[8];
        unpack8(*(const u32x4*)(PROJ + (size_t)(tok0 + t) * NINP + C_B + col), u);
        if (t > 0 || !first) unpack8(*(const u32x4*)(PROJ + (size_t)(tok0 + t - 1) * NINP + C_B + col), pv);
        else if (sample) { const f32x4 a = *(const f32x4*)(shift_in + (size_t)sb * 896 + col), b = *(const f32x4*)(shift_in + (size_t)sb * 896 + col + 4); pv[0] = a.x; pv[1] = a.y; pv[2] = a.z; pv[3] = a.w; pv[4] = b.x; pv[5] = b.y; pv[6] = b.z; pv[7] = b.w; }
        else {
#pragma unroll
            for (int i = 0; i < 8; ++i) pv[i] = 0.f; }
        const f32x4 m0 = *(const f32x4*)(w.mu + col), m1 = *(const f32x4*)(w.mu + col + 4);
        const float mu[8] = {m0.x, m0.y, m0.z, m0.w, m1.x, m1.y, m1.z, m1.w};
        float x[8];
#pragma unroll
        for (int i = 0; i < 8; ++i) { const float xs = u[i] + mu[i] * (pv[i] - u[i]); x[i] = j8 < 32 ? 1.f - 2.f / (1.f + __expf(2.f * xs)) : (j8 < 64 ? xs : sigmoidf_(xs)); }
        u32x4 o; o.x = pk2(x[0], x[1]); o.y = pk2(x[2], x[3]); o.z = pk2(x[4], x[5]); o.w = pk2(x[6], x[7]);
        *(u32x4*)(LAT + t * LATS + j8) = o;
    }
    __syncthreads();
    {
        asm volatile("" : "+v"(tid)); const int lane = tid & 63, fr = lane & 15, fq = lane >> 4;
        const int c0l = 16 * wv, cg0 = hp * 128 + c0l;
#pragma unroll
        for (int tt = 0; tt < 2; ++tt) {
            const int t = 16 * tt + fr;
            const f32x4 z = {0.f, 0.f, 0.f, 0.f};
            f32x4 aw = MFMA16(fw, ldf(LAT, t, LATS, 8 * fq), z);
            f32x4 aa = MFMA16(fa, ldf(LAT, t, LATS, 32 + 8 * fq), z);
            f32x4 ag = MFMA16(fg0, ldf(LAT, t, LATS, 64 + 8 * fq), z);
            ag = MFMA16(fg1, ldf(LAT, t, LATS, 96 + 8 * fq), ag);
            *(f32x4*)(WLb + t * 128 + c0l + 4 * fq) = aw + w0v;
            *(f32x4*)(ALb + t * 128 + c0l + 4 * fq) = aa + a0v;
            *(u32x2*)(G.GATE + (size_t)(tok0 + t) * 256 + cg0 + 4 * fq) = pk4(ag);
        }
    }
    __syncthreads();
    {
        asm volatile("" : "+v"(tid));
        const int c = tid & 127, tq = tid >> 7, hd = c >> 6, c64 = c & 63, cg = hp * 128 + c;
        unsigned char* hb = lds + RB_BASE + hd * RB_HEAD;
        bf16_t *AT = (bf16_t*)(hb + RB_AT), *BH = (bf16_t*)(hb + RB_BH), *KH = (bf16_t*)(hb + RB_KH), *RT = (bf16_t*)(hb + RB_RT);
        bf16_t *ATt = (bf16_t*)(hb + RB_ATT), *BHt = (bf16_t*)(hb + RB_BHT), *KHt = (bf16_t*)(hb + RB_KHT), *Vt = (bf16_t*)(hb + RB_VT);
        float lw[8], cl[8];
        float run = 0.f;
#pragma unroll
        for (int i = 0; i < 8; ++i) { lw[i] = -0.60653066f * sigmoidf_(WLb[(8 * tq + i) * 128 + c]); run += lw[i]; cl[i] = run; }
        SCN[tq * 128 + c] = run;
        __syncthreads();
        float pre = 0.f, tot = 0.f;
#pragma unroll
        for (int q = 0; q < 4; ++q) { const float v = SCN[q * 128 + c]; tot += v; if (q < tq) pre += v; }
        if (tq == 0) WLs[c] = __expf(tot);
        float at8[8], bh8[8], kh8[8], vv8[8];
        float rr8[8], kk8[8], km8[8], ar8[8], ss8[8], bo8[8];
#pragma unroll
        for (int i = 0; i < 8; ++i) {
            const int t = 8 * tq + i;
            rr8[i] = ur[i + 1] + mur * (ur[i] - ur[i + 1]); const float k = uk[i + 1] + muk * (uk[i] - uk[i + 1]); vv8[i] = uv[i + 1] + muv * (uv[i] - uv[i + 1]);
            ar8[i] = __builtin_amdgcn_rcpf(1.f + __expf(-ALb[t * 128 + c]));
            kk8[i] = k * kkw; km8[i] = k * (1.f + (ar8[i] - 1.f) * kaw);
            ss8[i] = kk8[i] * kk8[i]; bo8[i] = rr8[i] * km8[i] * rkw;
        }
#pragma unroll
        for (int i = 0; i < 8; ++i) { ss8[i] = wave_sum_u(ss8[i]); bo8[i] = wave_sum_u(bo8[i]); }
        float Wprev = __expf(pre);
#pragma unroll
        for (int i = 0; i < 8; ++i) {
            const int t = 8 * tq + i;
            const float W = __expf(pre + cl[i]), iW = __builtin_amdgcn_rcpf(W), Wp = Wprev;
            Wprev = W;
            const float kkn = kk8[i] * fminf(__builtin_amdgcn_rsqf(ss8[i]), 1e12f);
            const float at = -kkn * Wp, bh = kkn * ar8[i] * iW, kh = km8[i] * iW, rt = rr8[i] * W;
            AT[t * NS + c64] = f2bf(at); BH[t * NS + c64] = f2bf(bh); KH[t * NS + c64] = f2bf(kh); RT[t * NS + c64] = f2bf(rt);
            at8[i] = at; bh8[i] = bh; kh8[i] = kh;
            G.BV[(size_t)(tok0 + t) * 256 + cg] = f2bf(bo8[i] * vv8[i]);
        }
        u32x4 o;
        o.x = pk2(at8[0], at8[1]); o.y = pk2(at8[2], at8[3]); o.z = pk2(at8[4], at8[5]); o.w = pk2(at8[6], at8[7]); *(u32x4*)(ATt + c64 * TS + 8 * tq) = o;
        o.x = pk2(bh8[0], bh8[1]); o.y = pk2(bh8[2], bh8[3]); o.z = pk2(bh8[4], bh8[5]); o.w = pk2(bh8[6], bh8[7]); *(u32x4*)(BHt + c64 * TS + 8 * tq) = o;
        o.x = pk2(kh8[0], kh8[1]); o.y = pk2(kh8[2], kh8[3]); o.z = pk2(kh8[4], kh8[5]); o.w = pk2(kh8[6], kh8[7]); *(u32x4*)(KHt + c64 * TS + 8 * tq) = o;
        o.x = pk2(vv8[0], vv8[1]); o.y = pk2(vv8[2], vv8[3]); o.z = pk2(vv8[4], vv8[5]); o.w = pk2(vv8[6], vv8[7]); *(u32x4*)(Vt + c64 * TS + 8 * tq) = o;
    }
    __syncthreads();
    asm volatile("" : "+v"(tid)); const int lane = tid & 63, fr = lane & 15, fq = lane >> 4;
    const int hd = wv >> 2, wg = wv & 3, h = hp * 2 + hd; const size_t ch = (size_t)cid * 4 + h;
    unsigned char* hb = lds + RB_BASE + hd * RB_HEAD; unsigned char* cb = lds + hd * RC_HEAD;
    const bf16_t *AT = (const bf16_t*)(hb + RB_AT), *BH = (const bf16_t*)(hb + RB_BH), *KH = (const bf16_t*)(hb + RB_KH), *RT = (const bf16_t*)(hb + RB_RT);
    const bf16_t *ATt = (const bf16_t*)(hb + RB_ATT), *BHt = (const bf16_t*)(hb + RB_BHT), *KHt = (const bf16_t*)(hb + RB_KHT), *Vt = (const bf16_t*)(hb + RB_VT);
    float* Mab = (float*)(cb + RC_MAB);
    bf16_t *Mak = (bf16_t*)(cb + RC_MAK), *Mrb = (bf16_t*)(cb + RC_MRB), *Mrk = (bf16_t*)(cb + RC_MRK), *Tm = (bf16_t*)(cb + RC_TM), *MakVt = (bf16_t*)(cb + RC_MAKVT), *GT = (bf16_t*)(cb + RC_GT), *U0T = (bf16_t*)(cb + RC_U0T);
    const f32x4 z4 = {0.f, 0.f, 0.f, 0.f};
    {
        const bf16_t* rowsrc = (wg >> 1) ? RT : AT; const bf16_t* colsrc = (wg & 1) ? KH : BH;
        bf16_t* Mo = wg == 1 ? Mak : (wg == 2 ? Mrb : Mrk);
#pragma unroll
        for (int tt = 0; tt < 2; ++tt)
#pragma unroll
            for (int st = 0; st < 2; ++st) {
                f32x4 acc = MFMA16(ldf(colsrc, 16 * st + fr, NS, 8 * fq), ldf(rowsrc, 16 * tt + fr, NS, 8 * fq), z4);
                acc = MFMA16(ldf(colsrc, 16 * st + fr, NS, 32 + 8 * fq), ldf(rowsrc, 16 * tt + fr, NS, 32 + 8 * fq), acc);
                const int t = 16 * tt + fr, s0 = 16 * st + 4 * fq, lim = (wg >> 1) ? t + 1 : t;
                acc.x = (s0 + 0 < lim) ? acc.x : 0.f; acc.y = (s0 + 1 < lim) ? acc.y : 0.f; acc.z = (s0 + 2 < lim) ? acc.z : 0.f; acc.w = (s0 + 3 < lim) ? acc.w : 0.f;
                if (wg == 0) *(f32x4*)(Mab + t * MABS + s0) = acc; else *(u32x2*)(Mo + t * TS + s0) = pk4(acc);
            }
    }
    __syncthreads();
    const float* WL = (const float*)(lds + R_WLS) + hd * 64;
    if (wg == 0) {
        {
            const int j = lane & 31;
            float Tc[32];
            f32x4 cur[8];
#pragma unroll
            for (int q = 0; q < 8; ++q) cur[q] = (f32x4){0.f, 0.f, 0.f, 0.f};
#pragma unroll
            for (int t = 0; t < 32; ++t) {
                f32x4 nx[8];
#pragma unroll
                for (int q = 0; q < 8; ++q) nx[q] = (t + 1 < 32 && 4 * q < t + 1) ? *(const f32x4*)(Mab + (t + 1) * MABS + 4 * q) : (f32x4){0.f, 0.f, 0.f, 0.f};
                float a0 = (t == j) ? 1.f : 0.f, a1 = 0.f;
#pragma unroll
                for (int s2 = 0; s2 < t; ++s2) { const float nv = cur[s2 >> 2][s2 & 3]; if (s2 & 1) a1 += nv * Tc[s2]; else a0 += nv * Tc[s2]; }
                Tc[t] = a0 + a1;
#pragma unroll
                for (int q = 0; q < 8; ++q) cur[q] = nx[q];
            }
            if (lane < 32) {
#pragma unroll
                for (int t = 0; t < 32; ++t) Tm[t * TS + j] = f2bf(Tc[t]);
            }
        }
        __syncthreads();
#pragma unroll
        for (int rt = 0; rt < 2; ++rt)
#pragma unroll
            for (int tt = 0; tt < 2; ++tt) {
                const f32x4 acc = MFMA16(ldf(Tm, 16 * tt + fr, TS, 8 * fq), ldf(ATt, 16 * rt + fr, TS, 8 * fq), z4);
                *(u32x2*)(GT + (16 * rt + fr) * TS + 16 * tt + 4 * fq) = pk4(acc);
            }
        __syncthreads();
#pragma unroll
        for (int tt = 0; tt < 2; ++tt)
#pragma unroll
            for (int ks = 0; ks < 2; ++ks) {
                u32x2 pc[2];
#pragma unroll
                for (int hf = 0; hf < 2; ++hf) {
                    const int kt = 2 * ks + hf;
                    f32x4 acc = MFMA16(ldf(GT, 16 * kt + fr, TS, 8 * fq), ldf(Mrb, 16 * tt + fr, TS, 8 * fq), z4);
                    const int t = 16 * tt + fr, k0 = 16 * kt + 4 * fq;
                    const u32x2 rr = *(const u32x2*)(RT + t * NS + k0);
                    acc.x += __uint_as_float(rr.x << 16); acc.y += __uint_as_float(rr.x & 0xffff0000u); acc.z += __uint_as_float(rr.y << 16); acc.w += __uint_as_float(rr.y & 0xffff0000u);
                    pc[hf] = pk4(acc);
                }
                *(u32x4*)(G.ZZ + ch * 2048 + ((tt * 2 + ks) * 64 + lane) * 8) = (u32x4){pc[0].x, pc[0].y, pc[1].x, pc[1].y};
            }
    } else if (wg == 1) {
#pragma unroll
        for (int vt = 0; vt < 4; ++vt)
#pragma unroll
            for (int tt = 0; tt < 2; ++tt) {
                const f32x4 acc = MFMA16(ldf(Mak, 16 * tt + fr, TS, 8 * fq), ldf(Vt, 16 * vt + fr, TS, 8 * fq), z4);
                *(u32x2*)(MakVt + (16 * vt + fr) * TS + 16 * tt + 4 * fq) = pk4(acc);
            }
        __syncthreads();
#pragma unroll
        for (int rt = 2; rt < 4; ++rt)
#pragma unroll
            for (int tt = 0; tt < 2; ++tt) {
                const f32x4 acc = MFMA16(ldf(Tm, 16 * tt + fr, TS, 8 * fq), ldf(ATt, 16 * rt + fr, TS, 8 * fq), z4);
                *(u32x2*)(GT + (16 * rt + fr) * TS + 16 * tt + 4 * fq) = pk4(acc);
            }
        __syncthreads();
#pragma unroll
        for (int kp = 0; kp < 4; ++kp)
#pragma unroll
            for (int ks = 0; ks < 2; ++ks) {
                u32x2 pc[2];
#pragma unroll
                for (int hf = 0; hf < 2; ++hf) {
                    const int kt = 2 * ks + hf;
                    f32x4 acc = MFMA16(ldf(GT, 16 * kt + fr, TS, 8 * fq), ldf(BHt, 16 * kp + fr, TS, 8 * fq), z4);
                    const int kq = 16 * kp + fr, k0 = 16 * kt + 4 * fq; const float wl = WL[kq];
                    acc.x = (acc.x + (k0 + 0 == kq ? 1.f : 0.f)) * wl; acc.y = (acc.y + (k0 + 1 == kq ? 1.f : 0.f)) * wl; acc.z = (acc.z + (k0 + 2 == kq ? 1.f : 0.f)) * wl; acc.w = (acc.w + (k0 + 3 == kq ? 1.f : 0.f)) * wl;
                    pc[hf] = pk4(acc);
                }
                *(u32x4*)(G.PT + ch * 4096 + ((kp * 2 + ks) * 64 + lane) * 8) = (u32x4){pc[0].x, pc[0].y, pc[1].x, pc[1].y};
            }
    } else if (wg == 2) {
        f32x4 y0acc[2][4];
#pragma unroll
        for (int tt = 0; tt < 2; ++tt)
#pragma unroll
            for (int vt = 0; vt < 4; ++vt) y0acc[tt][vt] = MFMA16(ldf(Vt, 16 * vt + fr, TS, 8 * fq), ldf(Mrk, 16 * tt + fr, TS, 8 * fq), z4);
        __syncthreads();
#pragma unroll
        for (int rt = 0; rt < 2; ++rt)
#pragma unroll
            for (int tt = 0; tt < 2; ++tt) {
                const f32x4 acc = MFMA16(ldf(Tm, 16 * tt + fr, TS, 8 * fq), ldf(MakVt, 16 * rt + fr, TS, 8 * fq), z4);
                *(u32x2*)(U0T + (16 * rt + fr) * TS + 16 * tt + 4 * fq) = pk4(acc);
            }
        __syncthreads();
#pragma unroll
        for (int tt = 0; tt < 2; ++tt)
#pragma unroll
            for (int vp = 0; vp < 2; ++vp) {
                const f32x4 a0 = MFMA16(ldf(U0T, 16 * (2 * vp) + fr, TS, 8 * fq), ldf(Mrb, 16 * tt + fr, TS, 8 * fq), y0acc[tt][2 * vp]);
                const f32x4 a1 = MFMA16(ldf(U0T, 16 * (2 * vp + 1) + fr, TS, 8 * fq), ldf(Mrb, 16 * tt + fr, TS, 8 * fq), y0acc[tt][2 * vp + 1]);
                const u32x2 p0 = pk4(a0), p1 = pk4(a1);
                *(u32x4*)(G.Y0 + ch * 2048 + ((tt * 2 + vp) * 64 + lane) * 8) = (u32x4){p0.x, p0.y, p1.x, p1.y};
            }
    } else {
        f32x4 qacc[4][4];
#pragma unroll
        for (int vt = 0; vt < 4; ++vt)
#pragma unroll
            for (int kt = 0; kt < 4; ++kt) qacc[vt][kt] = MFMA16(ldf(KHt, 16 * kt + fr, TS, 8 * fq), ldf(Vt, 16 * vt + fr, TS, 8 * fq), z4);
        __syncthreads();
#pragma unroll
        for (int rt = 2; rt < 4; ++rt)
#pragma unroll
            for (int tt = 0; tt < 2; ++tt) {
                const f32x4 acc = MFMA16(ldf(Tm, 16 * tt + fr, TS, 8 * fq), ldf(MakVt, 16 * rt + fr, TS, 8 * fq), z4);
                *(u32x2*)(U0T + (16 * rt + fr) * TS + 16 * tt + 4 * fq) = pk4(acc);
            }
        __syncthreads();
#pragma unroll
        for (int vt = 0; vt < 4; ++vt)
#pragma unroll
            for (int hf2 = 0; hf2 < 2; ++hf2) {
                u32x2 pc[2];
#pragma unroll
                for (int hf = 0; hf < 2; ++hf) {
                    const int kt = 2 * hf2 + hf;
                    f32x4 acc = MFMA16(ldf(BHt, 16 * kt + fr, TS, 8 * fq), ldf(U0T, 16 * vt + fr, TS, 8 * fq), qacc[vt][kt]);
                    acc *= *(const f32x4*)(WL + 16 * kt + 4 * fq);
                    pc[hf] = pk4(acc);
                }
                *(u32x4*)(G.QQ + ch * 4096 + ((vt * 2 + hf2) * 64 + lane) * 8) = (u32x4){pc[0].x, pc[0].y, pc[1].x, pc[1].y};
            }
    }
    __syncthreads();
}

__device__ __forceinline__ void chain_step(f32x4 (&acc)[4], const bf16x8 (&fa)[4][2], u32x4 q01, u32x4 q23, bf16_t* __restrict__ scp) {
    union { u32x4 u; bf16x8 v; } bs[2];
    const u32x2 a = pk4(acc[0]), b = pk4(acc[1]), c2 = pk4(acc[2]), d = pk4(acc[3]);
    *(u32x4*)(scp) = (u32x4){a.x, a.y, b.x, b.y}; *(u32x4*)(scp + 512) = (u32x4){c2.x, c2.y, d.x, d.y};
    bs[0].u = (u32x4){a.x, a.y, b.x, b.y}; bs[1].u = (u32x4){c2.x, c2.y, d.x, d.y};
    acc[0] = (f32x4){__uint_as_float(q01.x << 16), __uint_as_float(q01.x & 0xffff0000u), __uint_as_float(q01.y << 16), __uint_as_float(q01.y & 0xffff0000u)};
    acc[1] = (f32x4){__uint_as_float(q01.z << 16), __uint_as_float(q01.z & 0xffff0000u), __uint_as_float(q01.w << 16), __uint_as_float(q01.w & 0xffff0000u)};
    acc[2] = (f32x4){__uint_as_float(q23.x << 16), __uint_as_float(q23.x & 0xffff0000u), __uint_as_float(q23.y << 16), __uint_as_float(q23.y & 0xffff0000u)};
    acc[3] = (f32x4){__uint_as_float(q23.z << 16), __uint_as_float(q23.z & 0xffff0000u), __uint_as_float(q23.w << 16), __uint_as_float(q23.w & 0xffff0000u)};
#pragma unroll
    for (int it = 0; it < 4; ++it) { acc[it] = MFMA16(fa[it][0], bs[0].v, acc[it]); acc[it] = MFMA16(fa[it][1], bs[1].v, acc[it]); }
}
__device__ __forceinline__ void rwkv_chain1(int sq, int h, int wg, const float* __restrict__ state_in, const RwkvG& G, float* __restrict__ st_s) {
    int tid_ = threadIdx.x; asm volatile("" : "+v"(tid_));
    const int lane = tid_ & 63, fr = lane & 15, fq = lane >> 4, j0 = 16 * wg;
    const Seq s = seq_of(sq);
    const size_t ch = (size_t)(s.base / 32) * 4 + h;
    f32x4 acc[4];
#pragma unroll
    for (int it = 0; it < 4; ++it) acc[it] = *(const f32x4*)(state_in + (((size_t)s.b * 4 + h) * 64 + j0 + fr) * 64 + 16 * it + 4 * fq);
    bf16x8 fa[4][2];
#pragma unroll
    for (int it = 0; it < 4; ++it)
#pragma unroll
        for (int ks = 0; ks < 2; ++ks) fa[it][ks] = *(const bf16x8*)(G.PT + ch * 4096 + ((it * 2 + ks) * 64 + lane) * 8);
    const u32x4 q01 = *(const u32x4*)(G.QQ + ch * 4096 + ((wg * 2) * 64 + lane) * 8), q23 = *(const u32x4*)(G.QQ + ch * 4096 + ((wg * 2 + 1) * 64 + lane) * 8);
    chain_step(acc, fa, q01, q23, G.SC + ch * 4096 + wg * 1024 + lane * 8);
    float* o = st_s + (((size_t)s.b * 4 + h) * 64 + j0 + fr) * 64 + 4 * fq;
#pragma unroll
    for (int it = 0; it < 4; ++it) *(f32x4*)(o + 16 * it) = acc[it];
}
constexpr int CH_RP = 16, CH_RQ = 16, CH_SLOT = 8192  ;
#define CH_BAR() do { __builtin_amdgcn_s_waitcnt(0xc07f); __builtin_amdgcn_s_barrier(); } while (0)
__device__ __forceinline__ void rwkv_chain_lds(unsigned char* lds, int sq, int h, const RwkvG& G, float* __restrict__ st_p) {
    constexpr int nc = 4096 / 32;
    static_assert(nc % CH_RP == 0 && CH_RP % CH_RQ == 0, "ring depths must divide the chunk count");
    int tid_ = threadIdx.x; asm volatile("" : "+v"(tid_));
    const int wv = __builtin_amdgcn_readfirstlane(tid_ >> 6);
    const Seq s = seq_of(sq);
    const size_t ch0 = (size_t)(s.base / 32) * 4 + h;
    if (wv >= 4) {
        int tl_ = threadIdx.x; asm volatile("" : "+v"(tl_)); const int lane = tl_ & 63;
        const int lw = wv - 4;
        const bf16_t* pn = G.PT + ch0 * 4096 + (size_t)(lw * 128 + lane) * 8;
        unsigned char* dst0 = lds + (lw * 128 + lane) * 16;
        u32x4 ld[CH_RP][2];
#pragma unroll
        for (int c = 0; c < CH_RP; ++c) {
#pragma unroll
            for (int i = 0; i < 2; ++i) ld[c][i] = *(const u32x4*)(pn + i * 512);
            pn += 16384; asm volatile("" : "+v"(pn));
        }
#pragma unroll
        for (int i = 0; i < 2; ++i) *(u32x4*)(dst0 + i * 1024) = ld[0][i];
#pragma unroll
        for (int i = 0; i < 2; ++i) ld[0][i] = *(const u32x4*)(pn + i * 512);
        pn += 16384; asm volatile("" : "+v"(pn));
        CH_BAR();
#pragma unroll 1
        for (int s0 = 0; s0 < nc; s0 += CH_RP) {
#pragma unroll
            for (int j = 0; j < CH_RP; ++j) {
                const int nx = s0 + j + 1, set = (j + 1) % CH_RP;
                unsigned char* d = dst0 + (nx & 1) * CH_SLOT;
#pragma unroll
                for (int i = 0; i < 2; ++i) *(u32x4*)(d + i * 1024) = ld[set][i];
#pragma unroll
                for (int i = 0; i < 2; ++i) ld[set][i] = *(const u32x4*)(pn + i * 512);
                pn += (nx + CH_RP + 1 < nc) ? 16384 : 0; asm volatile("" : "+v"(pn));
                CH_BAR();
            }
        }
    } else {
        int tc_ = threadIdx.x; asm volatile("" : "+v"(tc_)); const int lane = tc_ & 63, fr = lane & 15, fq = lane >> 4;
        const int j0 = 16 * wv;
        const bf16_t* qn = G.QQ + ch0 * 4096 + (size_t)((wv * 2) * 64 + lane) * 8;
        u32x4 qr[CH_RQ][2];
#pragma unroll
        for (int c = 0; c < CH_RQ; ++c) { qr[c][0] = *(const u32x4*)(qn); qr[c][1] = *(const u32x4*)(qn + 512); qn += 16384; asm volatile("" : "+v"(qn)); }
        bf16_t* scp = G.SC + ch0 * 4096 + wv * 1024 + lane * 8;
        f32x4 acc[4];
#pragma unroll
        for (int it = 0; it < 4; ++it) acc[it] = (f32x4){0.f, 0.f, 0.f, 0.f};
        CH_BAR();
#pragma unroll 1
        for (int s0 = 0; s0 < nc; s0 += CH_RP) {
#pragma unroll
            for (int j = 0; j < CH_RP; ++j) {
                const int st = s0 + j, qs = j % CH_RQ;
                const unsigned char* sl = lds + (st & 1) * CH_SLOT;
                bf16x8 fa[4][2];
#pragma unroll
                for (int it = 0; it < 4; ++it)
#pragma unroll
                    for (int ks = 0; ks < 2; ++ks) fa[it][ks] = *(const bf16x8*)(sl + ((it * 2 + ks) * 64 + lane) * 16);
                const u32x4 q01 = qr[qs][0], q23 = qr[qs][1];
                qr[qs][0] = *(const u32x4*)(qn); qr[qs][1] = *(const u32x4*)(qn + 512);
                qn += (st + CH_RQ + 1 < nc) ? 16384 : 0; asm volatile("" : "+v"(qn));
                chain_step(acc, fa, q01, q23, scp);
                scp += 16384; asm volatile("" : "+v"(scp));
                CH_BAR();
            }
        }
        int t3 = threadIdx.x; asm volatile("" : "+v"(t3));
        const int l3 = t3 & 63, fr3 = l3 & 15, fq3 = l3 >> 4;
        float* o = st_p + (((size_t)s.b * 4 + h) * 64 + j0 + fr3) * 64 + 4 * fq3;
#pragma unroll
        for (int it = 0; it < 4; ++it) *(f32x4*)(o + 16 * it) = acc[it];
    }
}

__device__ __forceinline__ void rwkv_out(int wi, const RwkvW& w, const RwkvG& G, bf16_t* __restrict__ YMIX) {
    int tid_ = threadIdx.x; asm volatile("" : "+v"(tid_));
    const int lane = tid_ & 63, fr = lane & 15, fq = lane >> 4;
    const size_t ch = (size_t)(wi >> 1); const int tt = wi & 1, h = (int)(ch & 3), cid = (int)(ch >> 2);
    const int t = 16 * tt + fr, tok = cid * 32 + t;
    const bf16x8 z0 = *(const bf16x8*)(G.ZZ + ch * 2048 + ((tt * 2 + 0) * 64 + lane) * 8), z1 = *(const bf16x8*)(G.ZZ + ch * 2048 + ((tt * 2 + 1) * 64 + lane) * 8);
    const u32x4 yp0 = *(const u32x4*)(G.Y0 + ch * 2048 + ((tt * 2 + 0) * 64 + lane) * 8), yp1 = *(const u32x4*)(G.Y0 + ch * 2048 + ((tt * 2 + 1) * 64 + lane) * 8);
    f32x4 gng[4], gnb[4];
#pragma unroll
    for (int vt = 0; vt < 4; ++vt) { gng[vt] = *(const f32x4*)(w.gn_g + h * 64 + 16 * vt + 4 * fq); gnb[vt] = *(const f32x4*)(w.gn_b + h * 64 + 16 * vt + 4 * fq); }
    f32x4 y[4]; float sum = 0.f;
#pragma unroll
    for (int vt = 0; vt < 4; ++vt) {
        const bf16_t* sp = G.SC + ch * 4096 + vt * 1024 + lane * 8;
        const u32x4 yp = vt < 2 ? yp0 : yp1; const unsigned ya = (vt & 1) ? yp.z : yp.x, yb2 = (vt & 1) ? yp.w : yp.y;
        f32x4 acc = {__uint_as_float(ya << 16), __uint_as_float(ya & 0xffff0000u), __uint_as_float(yb2 << 16), __uint_as_float(yb2 & 0xffff0000u)};
        acc = MFMA16(*(const bf16x8*)sp, z0, acc); acc = MFMA16(*(const bf16x8*)(sp + 512), z1, acc);
        y[vt] = acc; sum += (acc.x + acc.y) + (acc.z + acc.w);
    }
    sum += __shfl_xor(sum, 16); sum += __shfl_xor(sum, 32);
    const float mean = sum * (1.f / 64.f); float var = 0.f;
#pragma unroll
    for (int vt = 0; vt < 4; ++vt) { y[vt] -= mean; var += (y[vt].x * y[vt].x + y[vt].y * y[vt].y) + (y[vt].z * y[vt].z + y[vt].w * y[vt].w); }
    var += __shfl_xor(var, 16); var += __shfl_xor(var, 32);
    const float rstd = rsqrtf(var * (1.f / 64.f) + 64e-5f);
#pragma unroll
    for (int vt = 0; vt < 4; ++vt) {
        const int c = h * 64 + 16 * vt + 4 * fq;
        const f32x4 gg = gng[vt], gb = gnb[vt];
        const u32x2 bv = *(const u32x2*)(G.BV + (size_t)tok * 256 + c), gt = *(const u32x2*)(G.GATE + (size_t)tok * 256 + c);
        f32x4 o = y[vt] * rstd * gg + gb;
        o.x = (o.x + __uint_as_float(bv.x << 16)) * __uint_as_float(gt.x << 16); o.y = (o.y + __uint_as_float(bv.x & 0xffff0000u)) * __uint_as_float(gt.x & 0xffff0000u);
        o.z = (o.z + __uint_as_float(bv.y << 16)) * __uint_as_float(gt.y << 16); o.w = (o.w + __uint_as_float(bv.y & 0xffff0000u)) * __uint_as_float(gt.y & 0xffff0000u);
        *(u32x2*)(YMIX + (size_t)tok * DM + 256 + c) = pk4(o);
    }
}


template <int K, int SRC, bool WF32, bool WBF>
__device__ __forceinline__ void gemm_tail(unsigned char* lds, const bf16_t* __restrict__ A, const bf16_t* __restrict__ Bt, const float* __restrict__ xin_s, float* __restrict__ xout, bf16_t* __restrict__ XB, float* __restrict__ RSS) {
    int tid_ = threadIdx.x; asm volatile("" : "+v"(tid_));
    const int lane = tid_ & 63, w = __builtin_amdgcn_readfirstlane(tid_ >> 6), fr = lane & 15, fq = lane >> 4;
    float* part = (float*)lds;
    for (int tb = blockIdx.x; tb < 256; tb += gridDim.x) {
        const int mi = tb >> 4, ni = tb & 15, rt = w >> 2, ct = w & 3;
        const int r0 = 32 * mi + 16 * rt, c0 = 64 * ni + 16 * ct;
        const bf16_t* ap = A + (size_t)(T_P + r0 + fr) * K + 8 * fq; const bf16_t* bp = Bt + (size_t)(c0 + fr) * K + 8 * fq;
        f32x4 acc = {0.f, 0.f, 0.f, 0.f};
#pragma unroll 1
        for (int k0 = 0; k0 + 512 <= K; k0 += 512) {
            bf16x8 av[16], bv[16];
#pragma unroll
            for (int u = 0; u < 16; ++u) { av[u] = *(const bf16x8*)(ap + k0 + 32 * u); bv[u] = *(const bf16x8*)(bp + k0 + 32 * u); }
#pragma unroll
            for (int u = 0; u < 16; ++u) acc = MFMA16(bv[u], av[u], acc);
        }
        if (K % 512) {
            constexpr int k0 = K - (K % 512), NU = (K % 512) / 32;
            bf16x8 av[NU > 0 ? NU : 1], bv[NU > 0 ? NU : 1];
#pragma unroll
            for (int u = 0; u < NU; ++u) { av[u] = *(const bf16x8*)(ap + k0 + 32 * u); bv[u] = *(const bf16x8*)(bp + k0 + 32 * u); }
#pragma unroll
            for (int u = 0; u < NU; ++u) acc = MFMA16(bv[u], av[u], acc);
        }
        const int row = r0 + fr, col = c0 + 4 * fq;
        f32x4 x;
        if (SRC == 0) x = *(const f32x4*)(xin_s + (size_t)row * DM + col);
        else { const u32x2 r = *(const u32x2*)(XB + (size_t)(T_P + row) * DM + col); x = (f32x4){__uint_as_float(r.x << 16), __uint_as_float(r.x & 0xffff0000u), __uint_as_float(r.y << 16), __uint_as_float(r.y & 0xffff0000u)}; }
        x += acc;
        if (WF32) *(f32x4*)(xout + (size_t)(T_P + row) * DM + col) = x;
        if (WBF) {
            *(u32x2*)(XB + (size_t)(T_P + row) * DM + col) = pk4(x);
            float ss = (x.x * x.x + x.y * x.y) + (x.z * x.z + x.w * x.w);
            ss += __shfl_xor(ss, 16); ss += __shfl_xor(ss, 32);
            if (lane < 16) part[(rt * 4 + ct) * 16 + fr] = ss;
            __syncthreads();
            if (tid_ < 32) { const int rr = tid_ >> 4, f = tid_ & 15; RSS[(size_t)(T_P + 32 * mi + 16 * rr + f) * 16 + ni] = (part[(rr * 4 + 0) * 16 + f] + part[(rr * 4 + 1) * 16 + f]) + (part[(rr * 4 + 2) * 16 + f] + part[(rr * 4 + 3) * 16 + f]); }
            __syncthreads();
        }
    }
}

template <class E2> struct EpiAdapt {
    static constexpr bool PERM = true, AFTER_DRAIN = false; E2 e;
    __device__ __forceinline__ void operator()(const pg8::f32x4 (&acc)[2][2][4][2], const pg8::Unit& u, int wr, int wc, int fr, int fq) const {
#pragma unroll
        for (int ai = 0; ai < 2; ++ai)
#pragma unroll
            for (int m = 0; m < 4; ++m) {
                const int row = u.pm * 256 + ai * 128 + wr * 64 + m * 16 + fr;
                const float rs = e.rowscale(row);
                e(row, u.pn * 256 + wc * 32 + 8 * fq, acc[ai][0][m][0], acc[ai][0][m][1], acc[ai][1][m][0], acc[ai][1][m][1], rs);
            }
    }
};

#define LAS __attribute__((address_space(3)))
#define XB_TMO      128
#define XB_XCNT(j)  (256  + 64 * (j))
#define XB_XSUB(j)  (1280 + 64 * (j))
#define XB_XGEN(j)  (2304 + 64 * (j))
#define XB_TOP      3328
#define XB_TOPGEN   3392
#define XCD_BAR_WORDS 3456
#define XB_SPIN_CAP (1u << 18)

__device__ __forceinline__ unsigned xb_ld(unsigned* p)              { return __hip_atomic_load(p, __ATOMIC_RELAXED, __HIP_MEMORY_SCOPE_AGENT); }
__device__ __forceinline__ unsigned xb_add(unsigned* p, unsigned v) { return __hip_atomic_fetch_add(p, v, __ATOMIC_RELAXED, __HIP_MEMORY_SCOPE_AGENT); }
__device__ __forceinline__ unsigned xb_xcc_id() { return (unsigned)__builtin_amdgcn_s_getreg((3 << 11) | 20) & 0xFu; }
#define XB_SPIN(cond, bar) do { unsigned _sp = 0; while (cond) { __builtin_amdgcn_s_sleep(1); \
    if ((++_sp & 255u) == 0u) { if (xb_ld(&(bar)[XB_TMO])) break; if (_sp > XB_SPIN_CAP) { atomicAdd(&(bar)[XB_TMO], 1u); break; } } } } while (0)

struct XcdBarrier {
    unsigned* bar; unsigned x;
    unsigned* psub; unsigned* pgen;
    volatile LAS unsigned* st;
};

__device__ __forceinline__ XcdBarrier xcd_barrier_post(unsigned* bar, volatile LAS unsigned* st) {
    XcdBarrier b; b.bar = bar; b.x = xb_xcc_id(); b.st = st; b.psub = bar + XB_XSUB(b.x); b.pgen = bar + XB_XGEN(b.x);
    if (threadIdx.x == 0) (void)xb_add(&bar[XB_XCNT(b.x)], 1u);
    return b;
}
__device__ __forceinline__ void xcd_barrier_complete(unsigned* bar, unsigned x, unsigned& nloc, unsigned& nx) {
    const unsigned G = gridDim.x * gridDim.y * gridDim.z;
    unsigned sum, cnt, mine, sp = 0u;
    for (;;) {
        sum = 0u; cnt = 0u; mine = 0u;
#pragma unroll
        for (unsigned j = 0; j < 16; ++j) { const unsigned c = xb_ld(&bar[XB_XCNT(j)]); sum += c; cnt += (c > 0u) ? 1u : 0u; mine = (j == x) ? c : mine; }
        if (sum == G) break;
        __builtin_amdgcn_s_sleep(1);
        if ((++sp & 255u) == 0u) { if (xb_ld(&bar[XB_TMO])) break; if (sp > XB_SPIN_CAP) { atomicAdd(&bar[XB_TMO], 1u); break; } }
    }
    nloc = mine > 0u ? mine : 1u; nx = cnt > 0u ? cnt : 1u;
}

__device__ __forceinline__ void xcd_barrier(const XcdBarrier& b) {
    asm volatile("s_waitcnt vmcnt(0)" ::: "memory");
    __syncthreads();
    if (threadIdx.x == 0) {
        unsigned* bar = b.bar;
        __builtin_amdgcn_s_waitcnt(0);
        unsigned nloc = b.st[0], nx = b.st[1];
        const unsigned old = xb_add(b.psub, 1u);
        const unsigned gen = old / nloc;
        if (old + 1u == (gen + 1u) * nloc) {
            __builtin_amdgcn_fence(__ATOMIC_RELEASE, "agent");
            asm volatile("s_waitcnt vmcnt(0)" ::: "memory");
            const unsigned og = xb_add(&bar[XB_TOP], 1u);
            const unsigned tg = og / nx;
            if (og + 1u == (tg + 1u) * nx) xb_add(&bar[XB_TOPGEN], 1u);
            else XB_SPIN(xb_ld(&bar[XB_TOPGEN]) == tg, bar);
            __builtin_amdgcn_fence(__ATOMIC_ACQUIRE, "agent");
            xb_add(b.pgen, 1u);
            asm volatile("s_waitcnt vmcnt(0)" ::: "memory");
        } else {
            XB_SPIN(xb_ld(b.pgen) == gen, bar);
            __builtin_amdgcn_fence(__ATOMIC_ACQUIRE, "agent");
            asm volatile("s_waitcnt vmcnt(0)" ::: "memory");
        }
    }
    __syncthreads();
}


__device__ __forceinline__ void xcd_census(const XcdBarrier& b) { if (threadIdx.x == 0) { unsigned nloc, nx; xcd_barrier_complete(b.bar, b.x, nloc, nx); b.st[0] = nloc; b.st[1] = nx; } __syncthreads(); }

constexpr int LDS_BYTES = 147456;
struct MP { const float* in[35]; float* out; unsigned char* ws; int ph_lo, ph_hi; };
constexpr int P0_I_IN = (DM / 64) * (NIN / 32), P0_I_OUT = (DM / 64) * (DM / 32), P0_I_G = (DM / 64) * (DFF / 32), P0_I_D = (DFF / 64) * (DM / 32), P0_IL = P0_I_IN + P0_I_OUT + 2 * P0_I_G + P0_I_D;
__device__ __forceinline__ const float* inptr_(int k);
__device__ __forceinline__ void p0_dispatch(int it, unsigned char* ws, float* scr, int lane) {
    const int l2 = it / P0_IL; int r = it - l2 * P0_IL;
    bf16_t* WIN_ = (bf16_t*)(ws + WS_WIN); bf16_t* WOUT_ = (bf16_t*)(ws + WS_WOUT); bf16_t* WGU_ = (bf16_t*)(ws + WS_WGU); bf16_t* WD_ = (bf16_t*)(ws + WS_WD);
    if (r < P0_I_IN) { p0_item(inptr_(9) + (size_t)l2 * DM * NIN, DM, NIN, WIN_ + (size_t)l2 * NINP * DM, inptr_(8) + l2 * DM, NIN, 0, 0, scr, r, lane, true); return; } r -= P0_I_IN;
    if (r < P0_I_OUT) { p0_item(inptr_(30) + (size_t)l2 * DM * DM, DM, DM, WOUT_ + (size_t)l2 * DM * DM, nullptr, DM, 0, 0, scr, r, lane); return; } r -= P0_I_OUT;
    if (r < P0_I_G) { p0_item(inptr_(32) + (size_t)l2 * DM * DFF, DM, DFF, WGU_ + (size_t)l2 * 2 * DFF * DM, inptr_(31) + l2 * DM, 4, 8, 0, scr, r, lane); return; } r -= P0_I_G;
    if (r < P0_I_G) { p0_item(inptr_(33) + (size_t)l2 * DM * DFF, DM, DFF, WGU_ + (size_t)l2 * 2 * DFF * DM, inptr_(31) + l2 * DM, 4, 8, 4, scr, r, lane); return; } r -= P0_I_G;
    p0_item(inptr_(34) + (size_t)l2 * DFF * DM, DFF, DM, WD_ + (size_t)l2 * DM * DFF, nullptr, DM, 0, 0, scr, r, lane);
}
__device__ __forceinline__ const float* inptr_(int k) { const float* const* ka = (const float* const*)__builtin_amdgcn_kernarg_segment_ptr(); asm volatile("" : "+s"(k)); return ka[k]; }
__device__ __forceinline__ int fresh_bx() { int b = blockIdx.x; asm volatile("" : "+s"(b)); return b; }
__global__ void __launch_bounds__(512, 2) mega(MP p) {
    extern __shared__ __attribute__((aligned(16))) unsigned char lds[];
    cg::grid_group grid = cg::this_grid();
    float* out = p.out; unsigned char* ws = p.ws;
#define INP(k) inptr_(k)
#define WIN ((bf16_t*)(ws + WS_WIN))
#define WOUT ((bf16_t*)(ws + WS_WOUT))
#define WGU ((bf16_t*)(ws + WS_WGU))
#define WD ((bf16_t*)(ws + WS_WD))
#define XB ((bf16_t*)(ws + WS_XB))
#define YMIX ((bf16_t*)(ws + WS_YMIX))
#define RSS ((float*)(ws + WS_RSS))
#define PROJ ((bf16_t*)(ws + WS_PROJ))
#define H ((bf16_t*)(ws + WS_H))
    const int lo = p.ph_lo, hi = p.ph_hi;
    int tid = threadIdx.x, half = tid >> 8;
#define FRESH() do { asm volatile("" : "+v"(tid)); half = tid >> 8; asm volatile("" : "+s"(ws), "+s"(out)); } while (0)
#ifndef TESTPH
#define TESTPH -1
#endif
    volatile LAS unsigned* bst = (volatile LAS unsigned*)(lds + LDS_BYTES - 16);
    if (threadIdx.x < 4) bst[threadIdx.x] = 0u;
    __syncthreads();
    const XcdBarrier xbar = xcd_barrier_post((unsigned*)(ws + WS_CTL), bst);
#ifndef PROF
#define PROF 0
#endif
    unsigned long long* tsb = (unsigned long long*)(ws + WS_CTL + 14336);
#ifndef DUP
#define DUP -1
#endif
#define REPS(k) for (int rep_ = 0; rep_ < ((DUP) == (k) ? 2 : 1); ++rep_)
#define REPSYNC(k) do { if ((DUP) == (k) && rep_ == 0) xcd_barrier(xbar); } while (0)
#define STAMP(k) do { if (PROF && blockIdx.x == 0 && threadIdx.x == 0) tsb[k] = __builtin_amdgcn_s_memrealtime(); } while (0)
    STAMP(0);
#define IN(k) ((TESTPH < 0 || TESTPH == ((k) > 8 ? (k) - 8 : (k))) && lo <= (k) && (k) < hi)
#define SEAM(k) do { if (IN((k) + 1)) { if ((k) == 0) { grid.sync(); xcd_census(xbar); } else xcd_barrier(xbar); } } while (0)
    if (IN(0)) REPS(0) {
        FRESH();
        {
            float* scr = (float*)lds + (tid >> 6) * (64 * 33);
            const int gw = blockIdx.x * 8 + (tid >> 6), ngw = gridDim.x * 8, lane = tid & 63;
            for (int it = gw; it < P0_I_IN; it += ngw) p0_dispatch(it, ws, scr, lane);
        }
        {
            bf16_t* PWT = (bf16_t*)(ws + WS_PWT);
            for (int i = blockIdx.x * 512 + tid; i < 2 * 4 * 64 * 64; i += gridDim.x * 512) { const int lg = i >> 12, d = (i >> 6) & 63, cc = i & 63; PWT[i] = f2bf(INP(25)[((size_t)lg * 64 + cc) * 64 + d]); }
        }
        {
            bf16_t* LWT = (bf16_t*)(ws + WS_LWT);
            for (int i = blockIdx.x * 512 + tid; i < 2 * 256 * 128; i += gridDim.x * 512) {
                const int l2 = i >> 15, c = (i >> 7) & 255, j = i & 127;
                const float v = j < 32 ? INP(16)[((size_t)l2 * 32 + j) * 256 + c] : (j < 64 ? INP(18)[((size_t)l2 * 32 + (j - 32)) * 256 + c] : INP(19)[((size_t)l2 * 64 + (j - 64)) * 256 + c]);
                LWT[i] = f2bf(v);
            }
        }
        for (int i = blockIdx.x; i < T / 16; i += gridDim.x) { d_xprep(i * 16 + (tid >> 6), INP(0), INP(1), XB, RSS); d_xprep(i * 16 + 8 + (tid >> 6), INP(0), INP(1), XB, RSS); }
        if (DUP == 0 && rep_ == 0) grid.sync(); else { SEAM(0); STAMP(1); }
    }
    for (int l = 0; l < 2; ++l) {
        const int pb = 1 + 8 * l;
        if (IN(pb + 0)) REPS(1) {
            FRESH();
            pg8::Gemm g{XB, WIN + (size_t)l * NINP * DM, T, NINP, DM}; pg8::StaticOrder S; S.init(T, NINP, gridDim.x, fresh_bx());
            EpiAdapt<EpiProj> E{EpiProj{PROJ, RSS, (bf16_t*)(ws + WS_GLU)}};
            pg8::gemm_phase<EpiAdapt<EpiProj>, pg8::StaticOrder, true, true>((LAS unsigned char*)lds, g, S, E);
            if (l == 0) {
                constexpr int NU1 = (T / 256) * (NINP / 256), NBUSY = NU1 % 256;
                if ((int)blockIdx.x >= NBUSY && gridDim.x == 256) {
                    float* scr = (float*)lds + (tid >> 6) * (64 * 33);
                    for (int it = P0_I_IN + ((int)blockIdx.x - NBUSY) * 8 + (tid >> 6); it < P0_IL + P0_I_IN + P0_I_OUT; it += (256 - NBUSY) * 8) p0_dispatch(it, ws, scr, tid & 63);
                } else if (gridDim.x != 256) {
                    float* scr = (float*)lds + (tid >> 6) * (64 * 33);
                    for (int it = P0_I_IN + (int)blockIdx.x * 8 + (tid >> 6); it < P0_IL + P0_I_IN + P0_I_OUT; it += (int)gridDim.x * 8) p0_dispatch(it, ws, scr, tid & 63);
                }
            }
            REPSYNC(1); if (!(DUP == 1 && rep_ == 0)) { SEAM(pb + 0); STAMP(pb + 1); }
        }
        if (IN(pb + 1)) REPS(2) {
            FRESH();
            int ll = l; asm volatile("" : "+s"(ll));
            const RwkvW rw{INP(14) + ll * 896, INP(15) + ll * 256, INP(16) + ll * 32 * 256, INP(17) + ll * 256, INP(18) + ll * 32 * 256, INP(19) + ll * 64 * 256, INP(20) + ll * 256, INP(21) + ll * 256, INP(22) + ll * 256, INP(23) + ll * 256, INP(24) + ll * 256};
            const RwkvG rg{(bf16_t*)(ws + WS_PT), (bf16_t*)(ws + WS_QQ), (bf16_t*)(ws + WS_ZZ), (bf16_t*)(ws + WS_Y0), (bf16_t*)(ws + WS_SC), (bf16_t*)(ws + WS_GATE), (bf16_t*)(ws + WS_BV), (const bf16_t*)(ws + WS_LWT)};
            for (int it = blockIdx.x; it < 1024; it += gridDim.x) rwkv_item(lds, it, ll, PROJ, INP(4) + (size_t)ll * 16 * 896, rw, rg);
            for (int i = blockIdx.x * 512 + tid; i < 20 * 896; i += gridDim.x * 512) {
                const int sq = i / 896, c = i - sq * 896; const Seq sx = seq_of(sq);
                const float v = bf2f(PROJ[(size_t)(sx.base + sx.L - 1) * NINP + C_B + c]);
                if (sx.sample) out[O_SHIFT_S + ((size_t)ll * 16 + sx.b) * 896 + c] = v; else out[O_SHIFT_P + ((size_t)ll * 4 + sx.b) * 896 + c] = v;
            }
            REPSYNC(2); if (!(DUP == 2 && rep_ == 0)) { SEAM(pb + 1); STAMP(pb + 2); }
        }
        if (IN(pb + 2)) REPS(3) {
            FRESH();
            int ll = l; asm volatile("" : "+s"(ll));
            const RwkvW rw{INP(14) + ll * 896, INP(15) + ll * 256, INP(16) + ll * 32 * 256, INP(17) + ll * 256, INP(18) + ll * 32 * 256, INP(19) + ll * 64 * 256, INP(20) + ll * 256, INP(21) + ll * 256, INP(22) + ll * 256, INP(23) + ll * 256, INP(24) + ll * 256};
            const RwkvG rg{(bf16_t*)(ws + WS_PT), (bf16_t*)(ws + WS_QQ), (bf16_t*)(ws + WS_ZZ), (bf16_t*)(ws + WS_Y0), (bf16_t*)(ws + WS_SC), (bf16_t*)(ws + WS_GATE), (bf16_t*)(ws + WS_BV), (const bf16_t*)(ws + WS_LWT)};
            if (blockIdx.x < 16) rwkv_chain_lds(lds, (int)blockIdx.x >> 2, (int)blockIdx.x & 3, rg, out + O_RWKV_P + (size_t)ll * 4 * 4 * 4096);
            else if (blockIdx.x < 48) {
                const int sidx = (int)blockIdx.x - 16;
                rwkv_item(lds, 1024 + sidx, ll, PROJ, INP(4) + (size_t)ll * 16 * 896, rw, rg);
                __syncthreads();
                const int wv = tid >> 6;
                rwkv_chain1(4 + (sidx >> 1), (sidx & 1) * 2 + (wv >> 2), wv & 3, INP(3) + (size_t)ll * 16 * 4 * 4096, rg, out + O_RWKV_S + (size_t)ll * 16 * 4 * 4096);
                __syncthreads();
                if (wv < 4) rwkv_out((((512 + (sidx >> 1)) * 4 + (sidx & 1) * 2 + (wv >> 1)) << 1) | (wv & 1), rw, rg, YMIX);
            }
            {
                const AttnP ap{PROJ, INP(6) + (size_t)ll * 16 * 128 * 128, INP(7) + (size_t)ll * 16 * 128 * 128, INP(27) + ll * 64, INP(28) + ll * 64, INP(29) + ll * 4, YMIX,
                               out + O_K_P + (size_t)ll * 4 * 128 * 128, out + O_K_S + (size_t)ll * 16 * 128 * 128, out + O_V_P + (size_t)ll * 4 * 128 * 128, out + O_V_S + (size_t)ll * 16 * 128 * 128};
                const ConvPoolP cp{PROJ, INP(2) + (size_t)ll * 16 * 30 * 256, INP(10) + ll * 31 * 256, INP(11) + ll * 256, INP(12) + ll * 256, INP(13) + ll * 256, INP(5) + (size_t)ll * 16 * 15 * 256, INP(25) + (size_t)ll * 4 * 64 * 64, INP(26) + ll * 256, YMIX,
                                   out + O_CONV_P + (size_t)ll * 4 * 30 * 256, out + O_CONV_S + (size_t)ll * 16 * 30 * 256, out + O_POOL_P + (size_t)ll * 4 * 15 * 256, out + O_POOL_S + (size_t)ll * 16 * 15 * 256, (const bf16_t*)(ws + WS_GLU), (const bf16_t*)(ws + WS_PWT) + (size_t)ll * 4 * 64 * 64};
                unsigned* ctr = (unsigned*)(ws + WS_CTL + 14848) + 64 * ll + 32 * (DUP == 3 ? rep_ : 0);
                volatile LAS unsigned* wsl = (volatile LAS unsigned*)(lds + LDS_BYTES - 32);
                for (;;) {
                    __syncthreads();
                    if (tid == 0) wsl[0] = __hip_atomic_fetch_add(ctr, 1u, __ATOMIC_RELAXED, __HIP_MEMORY_SCOPE_AGENT);
                    __syncthreads();
                    const unsigned idx = wsl[0];
                    if (idx >= 528u + 544u) break;
                    if (idx < 528u) convpool_tile((float*)lds + half * (62 * 256), 2 * (int)idx + half, cp);
                    else attn_unit(lds, (int)idx - 528, ap);
                }
            }
            REPSYNC(3); if (!(DUP == 3 && rep_ == 0)) { SEAM(pb + 2); STAMP(pb + 3); }
        }
        if (IN(pb + 3)) REPS(4) {
            FRESH();
            int ll = l; asm volatile("" : "+s"(ll));
            const RwkvW rw{INP(14) + ll * 896, INP(15) + ll * 256, INP(16) + ll * 32 * 256, INP(17) + ll * 256, INP(18) + ll * 32 * 256, INP(19) + ll * 64 * 256, INP(20) + ll * 256, INP(21) + ll * 256, INP(22) + ll * 256, INP(23) + ll * 256, INP(24) + ll * 256};
            const RwkvG rg{(bf16_t*)(ws + WS_PT), (bf16_t*)(ws + WS_QQ), (bf16_t*)(ws + WS_ZZ), (bf16_t*)(ws + WS_Y0), (bf16_t*)(ws + WS_SC), (bf16_t*)(ws + WS_GATE), (bf16_t*)(ws + WS_BV), (const bf16_t*)(ws + WS_LWT)};
            for (int wi = blockIdx.x * 8 + (tid >> 6); wi < 2 * 512 * 4; wi += gridDim.x * 8) rwkv_out(wi, rw, rg, YMIX);
            REPSYNC(4); if (!(DUP == 4 && rep_ == 0)) { SEAM(pb + 3); STAMP(pb + 4); }
        }
        if (IN(pb + 4)) {
            FRESH();
            pg8::Gemm g{YMIX, WOUT + (size_t)l * DM * DM, T_P, DM, DM}; pg8::StaticOrder S; S.init(T_P, DM, gridDim.x, fresh_bx());
            if (l == 0) {
                EpiAdapt<EpiRes<0, false, true>> E{EpiRes<0, false, true>{INP(0), INP(1), out, XB, RSS}};
                pg8::gemm_phase<EpiAdapt<EpiRes<0, false, true>>, pg8::StaticOrder, true, true>((LAS unsigned char*)lds, g, S, E);
                gemm_tail<DM, 0, false, true>(lds, YMIX, WOUT + (size_t)l * DM * DM, INP(1), out, XB, RSS);
            } else {
                EpiAdapt<EpiRes<1, false, true>> E{EpiRes<1, false, true>{nullptr, nullptr, out, XB, RSS}};
                pg8::gemm_phase<EpiAdapt<EpiRes<1, false, true>>, pg8::StaticOrder, true, true>((LAS unsigned char*)lds, g, S, E);
                gemm_tail<DM, 1, false, true>(lds, YMIX, WOUT + (size_t)l * DM * DM, nullptr, out, XB, RSS);
            }
            SEAM(pb + 4); STAMP(pb + 5);
        }
        if (IN(pb + 5)) REPS(6) {
            FRESH();
            pg8::Gemm g{XB, WGU + (size_t)l * 2 * DFF * DM, T, 2 * DFF, DM}; pg8::StaticOrder S; S.init(T, 2 * DFF, gridDim.x, fresh_bx());
            EpiAdapt<EpiGU> E{EpiGU{H, RSS}};
            pg8::gemm_phase<EpiAdapt<EpiGU>, pg8::StaticOrder, true, true>((LAS unsigned char*)lds, g, S, E);
            if (l == 0) {
                constexpr int NU3 = (T / 256) * (2 * DFF / 256), NBUSY3 = NU3 % 256;
                float* scr = (float*)lds + (tid >> 6) * (64 * 33);
                if (gridDim.x == 256) { if ((int)blockIdx.x >= NBUSY3) for (int it = P0_IL + P0_I_IN + P0_I_OUT + ((int)blockIdx.x - NBUSY3) * 8 + (tid >> 6); it < 2 * P0_IL; it += (256 - NBUSY3) * 8) p0_dispatch(it, ws, scr, tid & 63); }
                else for (int it = P0_IL + P0_I_IN + P0_I_OUT + (int)blockIdx.x * 8 + (tid >> 6); it < 2 * P0_IL; it += (int)gridDim.x * 8) p0_dispatch(it, ws, scr, tid & 63);
            }
            REPSYNC(6); if (!(DUP == 6 && rep_ == 0)) { SEAM(pb + 5); STAMP(pb + 6); }
        }
        if (IN(pb + 6)) {
            FRESH();
            pg8::Gemm g{H, WD + (size_t)l * DM * DFF, T_P, DM, DFF}; pg8::StaticOrder S; S.init(T_P, DM, gridDim.x, fresh_bx());
            if (l == 0) {
                EpiAdapt<EpiRes<1, false, true>> E{EpiRes<1, false, true>{nullptr, nullptr, out, XB, RSS}};
                pg8::gemm_phase<EpiAdapt<EpiRes<1, false, true>>, pg8::StaticOrder, true, true>((LAS unsigned char*)lds, g, S, E);
                gemm_tail<DFF, 1, false, true>(lds, H, WD + (size_t)l * DM * DFF, nullptr, out, XB, RSS);
                SEAM(pb + 7); STAMP(pb + 7);
            } else {
                EpiAdapt<EpiRes<1, true, false>> E{EpiRes<1, true, false>{nullptr, nullptr, out, XB, RSS}};
                pg8::gemm_phase<EpiAdapt<EpiRes<1, true, false>>, pg8::StaticOrder, true, true>((LAS unsigned char*)lds, g, S, E);
                gemm_tail<DFF, 1, true, false>(lds, H, WD + (size_t)l * DM * DFF, nullptr, out, XB, RSS);
            }
        }
    }
    if (PROF) {
        xcd_barrier(xbar); STAMP(16); xcd_barrier(xbar);
        const unsigned long long* t = tsb;
        const unsigned long long d[12] = {t[16] - t[0], t[1] - t[0], t[2] - t[1], t[3] - t[2], t[4] - t[3], t[5] - t[4], t[6] - t[5], t[7] - t[6], t[8] - t[7], t[10] - t[8], t[13] - t[10], t[16] - t[13]};
        const size_t off[12] = {O_Y, O_Y + (size_t)T_P * DM, O_CONV_P, O_CONV_S, O_RWKV_P, O_RWKV_S, O_SHIFT_P, O_SHIFT_S, O_POOL_P, O_POOL_S, O_K_P, O_K_S};
        const unsigned cap[12] = {99999, 99999, 61000, 99999, 99999, 99999, 7000, 28000, 30000, 99999, 99999, 99999};
        for (int k = 0; k < 12; ++k) { unsigned c = (unsigned)(d[k] / 10ull); if (c > cap[k]) c = cap[k]; for (unsigned i = blockIdx.x * 512 + threadIdx.x; i < c; i += gridDim.x * 512) ((unsigned*)out)[off[k] + i] = 0xAAAAAAAAu; }
    }
}

#undef WIN
#undef WOUT
#undef WGU
#undef WD
#undef XB
#undef YMIX
#undef RSS
#undef PROJ
#undef H
static void launch_mega(MP p, int lo, int hi, int grid_blocks, hipStream_t stream) {
    p.ph_lo = lo; p.ph_hi = hi;
    void* args[] = {&p};
    hipError_t e = hipLaunchCooperativeKernel((const void*)mega, dim3(grid_blocks), dim3(512), args, LDS_BYTES, stream);
    if (e != hipSuccess) fprintf(stderr, "cooperative launch failed: %s (grid %d)\n", hipGetErrorString(e), grid_blocks);
}
extern "C" void kernel_launch(void* const* d_in, const int* in_sizes, int n_in, void* d_out, int out_size, void* d_ws, size_t ws_size, hipStream_t stream) {
    static int grid_blocks = 0;
    if (grid_blocks == 0) {
        if (n_in != 35 || (size_t)out_size != O_END || ws_size < WS_END) { fprintf(stderr, "kernel_launch: unexpected sizes n_in %d out %d ws %zu (need %zu)\n", n_in, out_size, ws_size, (size_t)WS_END); grid_blocks = -1; return; }
        int dev = 0, cus = 0, per_cu = 0;
        (void)hipGetDevice(&dev);
        (void)hipDeviceGetAttribute(&cus, hipDeviceAttributeMultiprocessorCount, dev);
        (void)hipFuncSetAttribute((const void*)mega, hipFuncAttributeMaxDynamicSharedMemorySize, LDS_BYTES);
        (void)hipOccupancyMaxActiveBlocksPerMultiprocessor(&per_cu, mega, 512, LDS_BYTES);
        if (per_cu < 1) { fprintf(stderr, "kernel_launch: occupancy query says %d blocks per CU\n", per_cu); grid_blocks = -1; return; }
        grid_blocks = cus;
    }
    if (grid_blocks < 0) return;
    const float* const* in = (const float* const*)d_in;
    float* out = (float*)d_out; unsigned char* ws = (unsigned char*)d_ws;
    MP p{};
    for (int i = 0; i < 35; ++i) p.in[i] = in[i];
    p.out = out; p.ws = ws;
    (void)hipMemsetAsync(ws + WS_CTL, 0, 16384, stream);
    launch_mega(p, 0, 16, grid_blocks, stream);
}
```
